# Optimizing an MI355X kernel written in HIP

```python
import jax, jax.numpy as jnp
from jax import lax
import numpy as np

D_MODEL = 1024
BATCH = 4
SEQ = 4096
DEPTH = 2

N_HEADS = 8
HEAD_DIM = 64
ATTN_WIDTH = N_HEADS * HEAD_DIM
DILATED_PATTERNS = ((128, 1), (512, 4), (2048, 16))
ATTN_BLOCK = 128
POOL_WINDOWS = (2, 4, 8, 16)
N_POOL_GROUPS = len(POOL_WINDOWS)
POOL_GROUP_DIM = 128
POOL_WIDTH = N_POOL_GROUPS * POOL_GROUP_DIM
N_BRANCHES = 2
IN_PROJ_WIDTH = 3 * ATTN_WIDTH + POOL_WIDTH + N_BRANCHES * D_MODEL
N_EXPERT_GROUPS = 4
EXPERTS_PER_GROUP = 8
N_EXPERTS = N_EXPERT_GROUPS * EXPERTS_PER_GROUP
TOP_K = 2
EXPERT_HIDDEN = 512
MOE_BLOCK = 128
RMS_EPS = 1e-6
NEG_INF = -1e30

kernel_name = "hybrid_dilated_attn_pool_hmoe"


def _rmsnorm(x, g):
    xf = x.astype(jnp.float32)
    y = xf * lax.rsqrt(jnp.mean(xf * xf, axis=-1, keepdims=True) + RMS_EPS)
    return (y * g.astype(jnp.float32)).astype(x.dtype)


def _dilated_branch(q, k, v, window, dilation):
    b_, h_, s_, e_ = q.shape
    steps = window // dilation
    span = dilation * ATTN_BLOCK
    s_pad = -(-s_ // span) * span
    n_strided = s_pad // dilation
    n_blk = n_strided // ATTN_BLOCK

    def to_blocks(t):
        t = jnp.pad(t, ((0, 0), (0, 0), (0, s_pad - s_), (0, 0)))
        t = t.reshape(b_, h_, n_strided, dilation, e_).transpose(0, 1, 3, 2, 4)
        return t.reshape(b_, h_, dilation, n_blk, ATTN_BLOCK, e_)

    def with_prev(t):
        prev = jnp.pad(t, ((0, 0), (0, 0), (0, 0), (1, 0), (0, 0), (0, 0)))[:, :, :, :-1]
        return jnp.concatenate([prev, t], axis=4)

    qb = to_blocks(q)
    kk = with_prev(to_blocks(k))
    vv = with_prev(to_blocks(v))
    s = jnp.einsum('bhcnqe,bhcnke->bhcnqk', qb, kk) * (HEAD_DIM ** -0.5)
    qi = jnp.arange(ATTN_BLOCK)[:, None]
    kj = jnp.arange(2 * ATTN_BLOCK)[None, :]
    dist = ATTN_BLOCK + qi - kj
    blk = jnp.arange(n_blk)[:, None, None]
    valid = (dist >= 0) & (dist <= steps) & (blk * ATTN_BLOCK - ATTN_BLOCK + kj >= 0)
    s = jnp.where(valid, s, NEG_INF)
    lse = jax.nn.logsumexp(s, axis=-1)
    p = jnp.exp(s - lse[..., None])
    o = jnp.einsum('bhcnqk,bhcnke->bhcnqe', p, vv)
    o = o.reshape(b_, h_, dilation, n_strided, e_).transpose(0, 1, 3, 2, 4).reshape(b_, h_, s_pad, e_)
    lse = lse.reshape(b_, h_, dilation, n_strided).transpose(0, 1, 3, 2).reshape(b_, h_, s_pad)
    return o[:, :, :s_], lse[:, :, :s_]


def _dilated_attention(q, k, v):
    outs, lses = [], []
    for window, dilation in DILATED_PATTERNS:
        o, l = _dilated_branch(q, k, v, window, dilation)
        outs.append(o)
        lses.append(l)
    wts = jax.nn.softmax(jnp.stack(lses, axis=0), axis=0)
    return jnp.einsum('gbhs,gbhse->bhse', wts, jnp.stack(outs, axis=0))


def _pool_mixer(u, w_mix, scale):
    b_, s_, _ = u.shape
    ug = u.reshape(b_, s_, N_POOL_GROUPS, POOL_GROUP_DIM).astype(jnp.float32)
    cs = jnp.cumsum(ug, axis=1)
    pos = jnp.arange(s_)
    outs = []
    for gi, w in enumerate(POOL_WINDOWS):
        c = cs[:, :, gi]
        lower = jnp.pad(c, ((0, 0), (w, 0), (0, 0)))[:, :s_]
        cnt = jnp.minimum(pos + 1, w).astype(jnp.float32)[None, :, None]
        outs.append((c - lower) / cnt - ug[:, :, gi])
    pooled = jnp.stack(outs, axis=2)
    mixed = jnp.einsum('bsgc,gcd->bsgd', pooled, w_mix.astype(jnp.float32))
    return (mixed.reshape(b_, s_, POOL_WIDTH) * scale.astype(jnp.float32)).astype(u.dtype)


def _hier_moe(h, w_rg, b_rg, w_re, b_re, w_gate, w_up, w_down):
    b_, s_, d_ = h.shape
    n_tok = b_ * s_
    hf = h.reshape(n_tok, d_)
    g_logits = jnp.dot(hf, w_rg).astype(jnp.float32) + b_rg.astype(jnp.float32)
    g_prob = jax.nn.softmax(g_logits, axis=-1)
    g_sel = jnp.argmax(g_logits, axis=-1).astype(jnp.int32)
    g_gate = jnp.take_along_axis(g_prob, g_sel[:, None], axis=1)[:, 0]
    e_logits_all = jnp.einsum('nd,gde->nge', hf, w_re).astype(jnp.float32) + b_re.astype(jnp.float32)
    e_logits = jnp.take_along_axis(e_logits_all, g_sel[:, None, None], axis=1)[:, 0]
    e_prob = jax.nn.softmax(e_logits, axis=-1)
    top_p, top_i = lax.top_k(e_prob, TOP_K)
    top_p = top_p / jnp.sum(top_p, axis=-1, keepdims=True)
    gate = g_gate[:, None] * top_p
    expert_id = g_sel[:, None] * EXPERTS_PER_GROUP + top_i.astype(jnp.int32)

    n_assign = n_tok * TOP_K
    e_flat = expert_id.reshape(n_assign)
    tok_flat = jnp.repeat(jnp.arange(n_tok, dtype=jnp.int32), TOP_K)
    w_flat = gate.reshape(n_assign)
    order = jnp.argsort(e_flat)
    e_s, tok_s, w_s = e_flat[order], tok_flat[order], w_flat[order]
    counts = jnp.bincount(e_flat, length=N_EXPERTS).astype(jnp.int32)
    start = jnp.cumsum(counts) - counts
    padded = (counts + MOE_BLOCK - 1) // MOE_BLOCK * MOE_BLOCK
    pend = jnp.cumsum(padded)
    pstart = pend - padded
    dest = pstart[e_s] + (jnp.arange(n_assign, dtype=jnp.int32) - start[e_s])
    buf_len = n_assign + N_EXPERTS * MOE_BLOCK
    n_blocks = buf_len // MOE_BLOCK
    buf_tok = jnp.full((buf_len,), n_tok, jnp.int32).at[dest].set(tok_s)
    buf_w = jnp.zeros((buf_len,), jnp.float32).at[dest].set(w_s)
    block_start = jnp.arange(n_blocks, dtype=jnp.int32) * MOE_BLOCK
    block_expert = jnp.minimum(jnp.searchsorted(pend, block_start, side='right'), N_EXPERTS - 1).astype(jnp.int32)
    x_rows = jnp.concatenate([hf, jnp.zeros((1, d_), hf.dtype)], axis=0)[buf_tok]
    x_rows = x_rows.reshape(n_blocks, MOE_BLOCK, d_)

    def expert_block(args):
        xb, e = args
        a = xb @ w_gate[e]
        bb = xb @ w_up[e]
        return (jax.nn.silu(a) * bb) @ w_down[e]

    y_rows = lax.map(expert_block, (x_rows, block_expert)).reshape(buf_len, d_)
    y = jnp.zeros((n_tok + 1, d_), jnp.float32).at[buf_tok].add(y_rows.astype(jnp.float32) * buf_w[:, None])
    return y[:n_tok].reshape(b_, s_, d_).astype(h.dtype)


def setup_inputs(seed: int = 0) -> dict:
    key = jax.random.key(seed)
    ks = jax.random.split(key, 18)
    f32 = jnp.float32
    nrm = lambda k, shape, scale: (jax.random.normal(k, shape, f32) * scale)
    return {
        "x": jax.random.normal(ks[0], (BATCH, SEQ, D_MODEL), f32),
        "norm1_g": 1.0 + nrm(ks[1], (DEPTH, D_MODEL), 0.02),
        "w_in": nrm(ks[2], (DEPTH, D_MODEL, IN_PROJ_WIDTH), D_MODEL ** -0.5),
        "q_norm_g": 1.0 + nrm(ks[3], (DEPTH, HEAD_DIM), 0.02),
        "k_norm_g": 1.0 + nrm(ks[4], (DEPTH, HEAD_DIM), 0.02),
        "w_attn_out": nrm(ks[5], (DEPTH, ATTN_WIDTH, D_MODEL), ATTN_WIDTH ** -0.5),
        "w_pool_mix": nrm(ks[6], (DEPTH, N_POOL_GROUPS, POOL_GROUP_DIM, POOL_GROUP_DIM), POOL_GROUP_DIM ** -0.5),
        "pool_scale": 1.0 + nrm(ks[7], (DEPTH, POOL_WIDTH), 0.1),
        "w_pool_out": nrm(ks[8], (DEPTH, POOL_WIDTH, D_MODEL), POOL_WIDTH ** -0.5),
        "w_o": nrm(ks[9], (DEPTH, D_MODEL, D_MODEL), D_MODEL ** -0.5),
        "norm2_g": 1.0 + nrm(ks[10], (DEPTH, D_MODEL), 0.02),
        "w_router_group": nrm(ks[11], (DEPTH, D_MODEL, N_EXPERT_GROUPS), D_MODEL ** -0.5),
        "b_router_group": nrm(ks[12], (DEPTH, N_EXPERT_GROUPS), 0.01),
        "w_router_expert": nrm(ks[13], (DEPTH, N_EXPERT_GROUPS, D_MODEL, EXPERTS_PER_GROUP), D_MODEL ** -0.5),
        "b_router_expert": nrm(ks[14], (DEPTH, N_EXPERT_GROUPS, EXPERTS_PER_GROUP), 0.01),
        "w_exp_gate": nrm(ks[15], (DEPTH, N_EXPERTS, D_MODEL, EXPERT_HIDDEN), D_MODEL ** -0.5),
        "w_exp_up": nrm(ks[16], (DEPTH, N_EXPERTS, D_MODEL, EXPERT_HIDDEN), D_MODEL ** -0.5),
        "w_exp_down": nrm(ks[17], (DEPTH, N_EXPERTS, EXPERT_HIDDEN, D_MODEL), EXPERT_HIDDEN ** -0.5),
    }


def reference(x, norm1_g, w_in, q_norm_g, k_norm_g, w_attn_out, w_pool_mix, pool_scale, w_pool_out,
              w_o, norm2_g, w_router_group, b_router_group, w_router_expert, b_router_expert,
              w_exp_gate, w_exp_up, w_exp_down):
    b_, s_, d_ = x.shape
    splits = [ATTN_WIDTH, 2 * ATTN_WIDTH, 3 * ATTN_WIDTH, 3 * ATTN_WIDTH + POOL_WIDTH,
              3 * ATTN_WIDTH + POOL_WIDTH + D_MODEL]
    for layer in range(DEPTH):
        h = _rmsnorm(x, norm1_g[layer])
        proj = h @ w_in[layer]
        q, k, v, u, gate_a, gate_p = jnp.split(proj, splits, axis=-1)
        q = _rmsnorm(q.reshape(b_, s_, N_HEADS, HEAD_DIM), q_norm_g[layer])
        k = _rmsnorm(k.reshape(b_, s_, N_HEADS, HEAD_DIM), k_norm_g[layer])
        v = v.reshape(b_, s_, N_HEADS, HEAD_DIM)
        q, k, v = (t.transpose(0, 2, 1, 3).astype(jnp.float32) for t in (q, k, v))
        attn = _dilated_attention(q, k, v).transpose(0, 2, 1, 3).reshape(b_, s_, ATTN_WIDTH).astype(x.dtype)
        y_a = attn @ w_attn_out[layer]
        y_p = _pool_mixer(u, w_pool_mix[layer], pool_scale[layer]) @ w_pool_out[layer]
        merged = jax.nn.sigmoid(gate_a) * y_a + jax.nn.sigmoid(gate_p) * y_p
        x = x + merged @ w_o[layer]
        h2 = _rmsnorm(x, norm2_g[layer])
        x = x + _hier_moe(h2, w_router_group[layer], b_router_group[layer], w_router_expert[layer],
                          b_router_expert[layer], w_exp_gate[layer], w_exp_up[layer], w_exp_down[layer])
    return x
```

```cpp
#include <hip/hip_runtime.h>
#include <stdint.h>

typedef unsigned short bf16_t;
typedef short bf16x8 __attribute__((ext_vector_type(8)));
typedef float f32x4 __attribute__((ext_vector_type(4)));
typedef unsigned u32x2 __attribute__((ext_vector_type(2)));
typedef unsigned u32x4 __attribute__((ext_vector_type(4)));

constexpr int DM = 1024, NB = 4, SEQ = 4096, NTOK = NB * SEQ, DEPTH = 2;
constexpr int NH = 8, HD = 64, AW = 512, PW = 512, INW = 4096;
constexpr int NEXP = 32, EH = 512, ECAP = NTOK;
constexpr int SLOTS = 40960;
constexpr float RMS_EPS = 1e-6f;

constexpr size_t MB = 1024 * 1024;
constexpr size_t OFF_CTRL = 0;
constexpr size_t OFF_WIN  = 1 * MB;
constexpr size_t OFF_WA   = OFF_WIN + 16 * MB;
constexpr size_t OFF_WPP  = OFF_WA + 2 * MB;
constexpr size_t OFF_WO   = OFF_WPP + 2 * MB;
constexpr size_t OFF_WGU  = OFF_WO + 4 * MB;
constexpr size_t OFF_WD   = OFF_WGU + 64 * MB;
constexpr size_t OFF_H    = OFF_WD + 32 * MB;
constexpr size_t OFF_PROJ = OFF_H + 32 * MB;
constexpr size_t OFF_ACT  = OFF_PROJ;
constexpr size_t OFF_YB   = OFF_PROJ + 40 * MB;
constexpr size_t OFF_AC   = OFF_PROJ + 128 * MB;
constexpr size_t OFF_PL   = OFF_AC + 16 * MB;
constexpr size_t OFF_T1   = OFF_PL + 16 * MB;
constexpr size_t OFF_XB   = OFF_T1 + 32 * MB;
constexpr size_t OFF_TOKE = OFF_XB + 64 * MB;
constexpr size_t OFF_TOKW = OFF_TOKE + 2 * MB;
constexpr size_t OFF_ASG  = OFF_TOKW + 2 * MB;
constexpr size_t WS_NEED  = OFF_ASG + 1 * MB;

__device__ __forceinline__ float bf2f(bf16_t b) { return __uint_as_float(((unsigned)b) << 16); }
__device__ __forceinline__ bf16_t f2bf(float f) { unsigned u = __float_as_uint(f); u += 0x7FFFu + ((u >> 16) & 1u); return (bf16_t)(u >> 16); }
__device__ __forceinline__ unsigned pack2(float lo, float hi) { return (unsigned)f2bf(lo) | ((unsigned)f2bf(hi) << 16); }
__device__ __forceinline__ float wave_sum(float v) {
#pragma unroll
    for (int o = 32; o >= 1; o >>= 1) v += __shfl_xor(v, o);
    return v;
}
__device__ __forceinline__ float wave_max(float v) {
#pragma unroll
    for (int o = 32; o >= 1; o >>= 1) v = fmaxf(v, __shfl_xor(v, o));
    return v;
}

__global__ void __launch_bounds__(256) k_tr(const float* __restrict__ src, bf16_t* __restrict__ dst, int K, int N, int mode, size_t srcBatch, size_t dstBatch) {
    __shared__ float t[64][65];
    const int n0 = blockIdx.x * 64, k0 = blockIdx.y * 64, z = blockIdx.z;
    src += (size_t)z * srcBatch; dst += (size_t)z * dstBatch;
    const int tx = threadIdx.x & 63, ty = threadIdx.x >> 6;
#pragma unroll
    for (int i = 0; i < 16; ++i) { const int k = ty + 4 * i; t[k][tx] = src[(size_t)(k0 + k) * N + n0 + tx]; }
    __syncthreads();
#pragma unroll
    for (int i = 0; i < 16; ++i) {
        const int n = n0 + ty + 4 * i;
        int nn = n;
        if (mode == 1) nn = (n >> 7) * 256 + (n & 127);
        if (mode == 2) nn = (n >> 7) * 256 + 128 + (n & 127);
        dst[(size_t)nn * K + k0 + tx] = f2bf(t[tx][ty + 4 * i]);
    }
}
__global__ void __launch_bounds__(256) k_foldpp(const float* __restrict__ wmix, const float* __restrict__ scale, const float* __restrict__ wpo, bf16_t* __restrict__ dst) {
    const int k = blockIdx.x, n = blockIdx.y * 256 + threadIdx.x, g = k >> 7;
    float acc = 0.f;
    for (int d = 0; d < 128; ++d) acc += wmix[(size_t)k * 128 + d] * scale[g * 128 + d] * wpo[(size_t)(g * 128 + d) * 1024 + n];
    dst[(size_t)n * 512 + k] = f2bf(acc);
}
__global__ void k_zero(unsigned* p, int n) { const int i = blockIdx.x * blockDim.x + threadIdx.x; if (i < n) p[i] = 0u; }

__global__ void __launch_bounds__(256) k_norm(const float* __restrict__ x, const float* __restrict__ g, bf16_t* __restrict__ h) {
    const int row = blockIdx.x * 4 + (threadIdx.x >> 6), lane = threadIdx.x & 63;
    const float* xr = x + (size_t)row * DM;
    f32x4 v[4]; float ss = 0.f;
#pragma unroll
    for (int i = 0; i < 4; ++i) { v[i] = *(const f32x4*)(xr + (i * 64 + lane) * 4); ss += v[i][0] * v[i][0] + v[i][1] * v[i][1] + v[i][2] * v[i][2] + v[i][3] * v[i][3]; }
    ss = wave_sum(ss);
    const float rstd = rsqrtf(ss * (1.0f / DM) + RMS_EPS);
#pragma unroll
    for (int i = 0; i < 4; ++i) {
        const f32x4 gv = *(const f32x4*)(g + (i * 64 + lane) * 4);
        u32x2 w; w.x = pack2(v[i][0] * rstd * gv[0], v[i][1] * rstd * gv[1]); w.y = pack2(v[i][2] * rstd * gv[2], v[i][3] * rstd * gv[3]);
        *(u32x2*)(h + (size_t)row * DM + (i * 64 + lane) * 4) = w;
    }
}

template <int MT, int NT>
__device__ __forceinline__ void wave_mma(const bf16_t* const (&ap)[MT], const bf16_t* const (&bp)[NT], int K, f32x4 (&acc)[MT][NT]) {
    for (int k = 0; k < K; k += 32) {
        bf16x8 a[MT], b[NT];
#pragma unroll
        for (int m = 0; m < MT; ++m) a[m] = *(const bf16x8*)(ap[m] + k);
#pragma unroll
        for (int n = 0; n < NT; ++n) b[n] = *(const bf16x8*)(bp[n] + k);
#pragma unroll
        for (int m = 0; m < MT; ++m)
#pragma unroll
            for (int n = 0; n < NT; ++n) acc[m][n] = __builtin_amdgcn_mfma_f32_16x16x32_bf16(b[n], a[m], acc[m][n], 0, 0, 0);
    }
}

struct EpiProj {
    bf16_t* out;
    __device__ __forceinline__ void operator()(int row, int col, f32x4 v) const {
        if (col >= 2048) {
#pragma unroll
            for (int j = 0; j < 4; ++j) v[j] = 1.0f / (1.0f + __expf(-v[j]));
        }
        u32x2 w; w.x = pack2(v[0], v[1]); w.y = pack2(v[2], v[3]);
        *(u32x2*)(out + (size_t)row * INW + col) = w;
    }
};
struct EpiGateA {
    const bf16_t* proj; bf16_t* t1;
    __device__ __forceinline__ void operator()(int row, int col, f32x4 v) const {
        const u32x2 gw = *(const u32x2*)(proj + (size_t)row * INW + 2048 + col);
        const float g0 = __uint_as_float(gw.x << 16), g1 = __uint_as_float(gw.x & 0xffff0000u), g2 = __uint_as_float(gw.y << 16), g3 = __uint_as_float(gw.y & 0xffff0000u);
        u32x2 w; w.x = pack2(v[0] * g0, v[1] * g1); w.y = pack2(v[2] * g2, v[3] * g3);
        *(u32x2*)(t1 + (size_t)row * DM + col) = w;
    }
};
struct EpiGateP {
    const bf16_t* proj; const bf16_t* t1; bf16_t* mg;
    __device__ __forceinline__ void operator()(int row, int col, f32x4 v) const {
        const u32x2 gw = *(const u32x2*)(proj + (size_t)row * INW + 3072 + col);
        const u32x2 tw = *(const u32x2*)(t1 + (size_t)row * DM + col);
        const float g0 = __uint_as_float(gw.x << 16), g1 = __uint_as_float(gw.x & 0xffff0000u), g2 = __uint_as_float(gw.y << 16), g3 = __uint_as_float(gw.y & 0xffff0000u);
        const float t0 = __uint_as_float(tw.x << 16), t1v = __uint_as_float(tw.x & 0xffff0000u), t2 = __uint_as_float(tw.y << 16), t3 = __uint_as_float(tw.y & 0xffff0000u);
        u32x2 w; w.x = pack2(t0 + v[0] * g0, t1v + v[1] * g1); w.y = pack2(t2 + v[2] * g2, t3 + v[3] * g3);
        *(u32x2*)(mg + (size_t)row * DM + col) = w;
    }
};
struct EpiResid {
    const float* xin; float* xout;
    __device__ __forceinline__ void operator()(int row, int col, f32x4 v) const {
        const f32x4 x = *(const f32x4*)(xin + (size_t)row * DM + col);
        *(f32x4*)(xout + (size_t)row * DM + col) = x + v;
    }
};

template <class Epi>
__global__ void __launch_bounds__(256) k_gemm(const bf16_t* __restrict__ A, int lda, const bf16_t* __restrict__ Bt, int ldb, int K, Epi epi) {
    const int wid = threadIdx.x >> 6, lane = threadIdx.x & 63, fr = lane & 15, fq = lane >> 4;
    const int bm = blockIdx.y * 128 + (wid >> 1) * 64, bn = blockIdx.x * 128 + (wid & 1) * 64;
    const bf16_t* ap[4]; const bf16_t* bp[4];
#pragma unroll
    for (int m = 0; m < 4; ++m) ap[m] = A + (size_t)(bm + 16 * m + fr) * lda + 8 * fq;
#pragma unroll
    for (int n = 0; n < 4; ++n) bp[n] = Bt + (size_t)(bn + 16 * n + fr) * ldb + 8 * fq;
    f32x4 acc[4][4];
#pragma unroll
    for (int m = 0; m < 4; ++m)
#pragma unroll
        for (int n = 0; n < 4; ++n) acc[m][n] = (f32x4){0.f, 0.f, 0.f, 0.f};
    wave_mma<4, 4>(ap, bp, K, acc);
#pragma unroll
    for (int m = 0; m < 4; ++m)
#pragma unroll
        for (int n = 0; n < 4; ++n) epi(bm + 16 * m + fr, bn + 16 * n + 4 * fq, acc[m][n]);
}

__global__ void __launch_bounds__(256) k_attn(const bf16_t* __restrict__ proj, const float* __restrict__ gq, const float* __restrict__ gk, bf16_t* __restrict__ ac) {
    __shared__ float qs_s[4][64];
    __shared__ float p_s[4][3][132];
    const int wid = threadIdx.x >> 6, lane = threadIdx.x & 63;
    const int gw = blockIdx.x * 4 + wid;
    const int tok = gw >> 3, h = gw & 7, pos = tok & (SEQ - 1);
    const float qv = bf2f(proj[(size_t)tok * INW + h * HD + lane]);
    const float qss = wave_sum(qv * qv);
    const float qr = rsqrtf(qss * (1.0f / HD) + RMS_EPS);
    qs_s[wid][lane] = qv * qr * gq[lane] * gk[lane] * 0.125f;
    __syncthreads();
    float qs[64];
#pragma unroll
    for (int d = 0; d < 64; ++d) qs[d] = qs_s[wid][d];
    float sc[3][3];
    float mx = -3.0e38f;
#pragma unroll
    for (int g = 0; g < 3; ++g) {
        const int dil = (g == 0) ? 1 : (g == 1 ? 4 : 16);
        const int jmax = min(128, pos / dil);
#pragma unroll
        for (int s = 0; s < 3; ++s) {
            const int j = (s < 2) ? (lane + 64 * s) : 128;
            const bool valid = (j <= jmax) && (s < 2 || lane == 0);
            float score = -3.0e38f;
            if (valid) {
                const bf16_t* kr = proj + (size_t)(tok - j * dil) * INW + AW + h * HD;
                float dot = 0.f, ss = 0.f;
#pragma unroll
                for (int c = 0; c < 8; ++c) {
                    const u32x4 w = *(const u32x4*)(kr + c * 8);
                    const unsigned ww[4] = {w.x, w.y, w.z, w.w};
#pragma unroll
                    for (int e = 0; e < 4; ++e) {
                        const float k0 = __uint_as_float(ww[e] << 16), k1 = __uint_as_float(ww[e] & 0xffff0000u);
                        dot += k0 * qs[c * 8 + 2 * e] + k1 * qs[c * 8 + 2 * e + 1];
                        ss += k0 * k0 + k1 * k1;
                    }
                }
                score = dot * rsqrtf(ss * (1.0f / HD) + RMS_EPS);
            }
            sc[g][s] = score;
            mx = fmaxf(mx, score);
        }
    }
    mx = wave_max(mx);
    float l = 0.f;
#pragma unroll
    for (int g = 0; g < 3; ++g)
#pragma unroll
        for (int s = 0; s < 3; ++s) {
            const float p = (sc[g][s] > -1.0e38f) ? __expf(sc[g][s] - mx) : 0.f;
            l += p;
            if (s < 2) p_s[wid][g][lane + 64 * s] = p; else if (lane == 0) p_s[wid][g][128] = p;
        }
    l = wave_sum(l);
    __syncthreads();
    float o = 0.f;
#pragma unroll
    for (int g = 0; g < 3; ++g) {
        const int dil = (g == 0) ? 1 : (g == 1 ? 4 : 16);
        const int jmax = min(128, pos / dil);
        for (int j = 0; j <= jmax; ++j) o += p_s[wid][g][j] * bf2f(proj[(size_t)(tok - j * dil) * INW + 2 * AW + h * HD + lane]);
    }
    ac[(size_t)tok * AW + h * HD + lane] = f2bf(o / l);
}

__global__ void __launch_bounds__(256) k_pool(const bf16_t* __restrict__ proj, bf16_t* __restrict__ pl) {
    const int tok = blockIdx.x, pos = tok & (SEQ - 1);
#pragma unroll
    for (int r = 0; r < 2; ++r) {
        const int k = threadIdx.x + 256 * r, g = k >> 7, w = 2 << g;
        const int cnt = min(pos + 1, w);
        float s = 0.f;
        for (int j = 0; j < cnt; ++j) s += bf2f(proj[(size_t)(tok - j) * INW + 3 * AW + k]);
        const float u = bf2f(proj[(size_t)tok * INW + 3 * AW + k]);
        pl[(size_t)tok * PW + k] = f2bf(s / (float)cnt - u);
    }
}

__global__ void __launch_bounds__(256) k_router(const float* __restrict__ x, const float* __restrict__ g2, const float* __restrict__ wrg, const float* __restrict__ brg,
                                                const float* __restrict__ wre, const float* __restrict__ bre, bf16_t* __restrict__ h,
                                                unsigned* __restrict__ cnt, int* __restrict__ tokE, float* __restrict__ tokW, int* __restrict__ asg) {
    const int tok = blockIdx.x * 4 + (threadIdx.x >> 6), lane = threadIdx.x & 63;
    const float* xr = x + (size_t)tok * DM;
    f32x4 v[4]; float ss = 0.f;
#pragma unroll
    for (int i = 0; i < 4; ++i) { v[i] = *(const f32x4*)(xr + (i * 64 + lane) * 4); ss += v[i][0] * v[i][0] + v[i][1] * v[i][1] + v[i][2] * v[i][2] + v[i][3] * v[i][3]; }
    ss = wave_sum(ss);
    const float rstd = rsqrtf(ss * (1.0f / DM) + RMS_EPS);
    float gl[4] = {0.f, 0.f, 0.f, 0.f};
#pragma unroll
    for (int i = 0; i < 4; ++i) {
        const int d0 = (i * 64 + lane) * 4;
        const f32x4 gv = *(const f32x4*)(g2 + d0);
#pragma unroll
        for (int j = 0; j < 4; ++j) v[i][j] = v[i][j] * rstd * gv[j];
        u32x2 w; w.x = pack2(v[i][0], v[i][1]); w.y = pack2(v[i][2], v[i][3]);
        *(u32x2*)(h + (size_t)tok * DM + d0) = w;
#pragma unroll
        for (int j = 0; j < 4; ++j) { const f32x4 wv = *(const f32x4*)(wrg + (size_t)(d0 + j) * 4);
#pragma unroll
            for (int o = 0; o < 4; ++o) gl[o] += v[i][j] * wv[o]; }
    }
#pragma unroll
    for (int o = 0; o < 4; ++o) gl[o] = wave_sum(gl[o]) + brg[o];
    int gs = 0; float gm = gl[0];
#pragma unroll
    for (int o = 1; o < 4; ++o) if (gl[o] > gm) { gm = gl[o]; gs = o; }
    float gden = 0.f;
#pragma unroll
    for (int o = 0; o < 4; ++o) gden += __expf(gl[o] - gm);
    const float ggate = 1.0f / gden;
    float el[8];
#pragma unroll
    for (int o = 0; o < 8; ++o) el[o] = 0.f;
    const float* we = wre + (size_t)gs * DM * 8;
#pragma unroll
    for (int i = 0; i < 4; ++i) {
        const int d0 = (i * 64 + lane) * 4;
#pragma unroll
        for (int j = 0; j < 4; ++j) { const f32x4 w0 = *(const f32x4*)(we + (size_t)(d0 + j) * 8), w1 = *(const f32x4*)(we + (size_t)(d0 + j) * 8 + 4);
#pragma unroll
            for (int o = 0; o < 4; ++o) { el[o] += v[i][j] * w0[o]; el[4 + o] += v[i][j] * w1[o]; } }
    }
#pragma unroll
    for (int o = 0; o < 8; ++o) el[o] = wave_sum(el[o]) + bre[gs * 8 + o];
    int i0 = 0; float m0 = el[0];
#pragma unroll
    for (int o = 1; o < 8; ++o) if (el[o] > m0) { m0 = el[o]; i0 = o; }
    int i1 = -1; float m1 = -3.0e38f;
#pragma unroll
    for (int o = 0; o < 8; ++o) if (o != i0 && el[o] > m1) { m1 = el[o]; i1 = o; }
    const float e1 = __expf(m1 - m0);
    const float p0 = 1.0f / (1.0f + e1), p1 = e1 / (1.0f + e1);
    if (lane == 0) {
        const int ea = gs * 8 + i0, eb = gs * 8 + i1;
        const int sa = (int)atomicAdd(cnt + ea, 1u), sb = (int)atomicAdd(cnt + eb, 1u);
        tokE[(size_t)ea * ECAP + sa] = tok; tokW[(size_t)ea * ECAP + sa] = ggate * p0;
        tokE[(size_t)eb * ECAP + sb] = tok; tokW[(size_t)eb * ECAP + sb] = ggate * p1;
        asg[tok * 4 + 0] = ea; asg[tok * 4 + 1] = sa; asg[tok * 4 + 2] = eb; asg[tok * 4 + 3] = sb;
    }
}

__device__ __forceinline__ bool find_tile(const unsigned* cnt, int tile, int& e, int& jt, int& pstart) {
    pstart = 0;
    for (e = 0; e < NEXP; ++e) {
        const int c = (int)cnt[e], nt = (c + 127) >> 7;
        if (tile < nt) { jt = tile; return true; }
        tile -= nt; pstart += ((c + 255) >> 8) << 8;
    }
    return false;
}

__global__ void __launch_bounds__(256) k_moe_gu(const bf16_t* __restrict__ H, const bf16_t* __restrict__ Wgu, const unsigned* __restrict__ cnt, const int* __restrict__ tokE, bf16_t* __restrict__ act) {
    int e, jt, pstart;
    if (!find_tile(cnt, blockIdx.x, e, jt, pstart)) return;
    const int c = (int)cnt[e];
    const int wid = threadIdx.x >> 6, lane = threadIdx.x & 63, fr = lane & 15, fq = lane >> 4;
    const int r0 = (wid >> 1) * 64, hc0 = blockIdx.y * 64 + (wid & 1) * 32;
    const bf16_t* ap[4]; const bf16_t* bp[4];
#pragma unroll
    for (int m = 0; m < 4; ++m) { const int idx = jt * 128 + r0 + 16 * m + fr; const int tok = idx < c ? tokE[(size_t)e * ECAP + idx] : 0; ap[m] = H + (size_t)tok * DM + 8 * fq; }
#pragma unroll
    for (int n = 0; n < 2; ++n) { const int hc = hc0 + 16 * n + fr; const int nn = (hc >> 7) * 256 + (hc & 127);
        bp[n] = Wgu + (size_t)e * DM * DM + (size_t)nn * DM + 8 * fq; bp[2 + n] = bp[n] + (size_t)128 * DM; }
    f32x4 acc[4][4];
#pragma unroll
    for (int m = 0; m < 4; ++m)
#pragma unroll
        for (int n = 0; n < 4; ++n) acc[m][n] = (f32x4){0.f, 0.f, 0.f, 0.f};
    wave_mma<4, 4>(ap, bp, DM, acc);
#pragma unroll
    for (int m = 0; m < 4; ++m)
#pragma unroll
        for (int n = 0; n < 2; ++n) {
            f32x4 a = acc[m][n], b = acc[m][2 + n], o;
#pragma unroll
            for (int j = 0; j < 4; ++j) o[j] = a[j] / (1.0f + __expf(-a[j])) * b[j];
            u32x2 w; w.x = pack2(o[0], o[1]); w.y = pack2(o[2], o[3]);
            *(u32x2*)(act + (size_t)(pstart + jt * 128 + r0 + 16 * m + fr) * EH + hc0 + 16 * n + 4 * fq) = w;
        }
}
__global__ void __launch_bounds__(256) k_moe_down(const bf16_t* __restrict__ act, const bf16_t* __restrict__ Wd, const unsigned* __restrict__ cnt, const float* __restrict__ tokW, bf16_t* __restrict__ yb) {
    int e, jt, pstart;
    if (!find_tile(cnt, blockIdx.x, e, jt, pstart)) return;
    const int c = (int)cnt[e];
    const int wid = threadIdx.x >> 6, lane = threadIdx.x & 63, fr = lane & 15, fq = lane >> 4;
    const int r0 = (wid >> 1) * 64, n0 = blockIdx.y * 128 + (wid & 1) * 64;
    const bf16_t* ap[4]; const bf16_t* bp[4];
#pragma unroll
    for (int m = 0; m < 4; ++m) ap[m] = act + (size_t)(pstart + jt * 128 + r0 + 16 * m + fr) * EH + 8 * fq;
#pragma unroll
    for (int n = 0; n < 4; ++n) bp[n] = Wd + (size_t)e * DM * EH + (size_t)(n0 + 16 * n + fr) * EH + 8 * fq;
    f32x4 acc[4][4];
#pragma unroll
    for (int m = 0; m < 4; ++m)
#pragma unroll
        for (int n = 0; n < 4; ++n) acc[m][n] = (f32x4){0.f, 0.f, 0.f, 0.f};
    wave_mma<4, 4>(ap, bp, EH, acc);
#pragma unroll
    for (int m = 0; m < 4; ++m) {
        const int idx = jt * 128 + r0 + 16 * m + fr;
        const float w = idx < c ? tokW[(size_t)e * ECAP + idx] : 0.f;
#pragma unroll
        for (int n = 0; n < 4; ++n) {
            const f32x4 v = acc[m][n] * w;
            u32x2 o; o.x = pack2(v[0], v[1]); o.y = pack2(v[2], v[3]);
            *(u32x2*)(yb + (size_t)(pstart + idx) * DM + n0 + 16 * n + 4 * fq) = o;
        }
    }
}
__global__ void __launch_bounds__(256) k_moe_comb(const float* __restrict__ xb, const bf16_t* __restrict__ yb, const unsigned* __restrict__ cnt, const int* __restrict__ asg, float* __restrict__ out) {
    __shared__ int ps[NEXP];
    if (threadIdx.x == 0) { int p = 0; for (int e = 0; e < NEXP; ++e) { ps[e] = p; p += (((int)cnt[e] + 255) >> 8) << 8; } }
    __syncthreads();
    const int tok = blockIdx.x;
    const int s0 = ps[asg[tok * 4 + 0]] + asg[tok * 4 + 1], s1 = ps[asg[tok * 4 + 2]] + asg[tok * 4 + 3];
    const int c = threadIdx.x * 4;
    const f32x4 x = *(const f32x4*)(xb + (size_t)tok * DM + c);
    const u32x2 a = *(const u32x2*)(yb + (size_t)s0 * DM + c), b = *(const u32x2*)(yb + (size_t)s1 * DM + c);
    f32x4 o;
    o[0] = x[0] + __uint_as_float(a.x << 16) + __uint_as_float(b.x << 16);
    o[1] = x[1] + __uint_as_float(a.x & 0xffff0000u) + __uint_as_float(b.x & 0xffff0000u);
    o[2] = x[2] + __uint_as_float(a.y << 16) + __uint_as_float(b.y << 16);
    o[3] = x[3] + __uint_as_float(a.y & 0xffff0000u) + __uint_as_float(b.y & 0xffff0000u);
    *(f32x4*)(out + (size_t)tok * DM + c) = o;
}

extern "C" void kernel_launch(void* const* d_in, const int* in_sizes, int n_in, void* d_out, int out_size, void* d_ws, size_t ws_size, hipStream_t stream) {
    (void)in_sizes; (void)n_in; (void)out_size; (void)ws_size;
    const float* x = (const float*)d_in[0];
    const float* norm1_g = (const float*)d_in[1];
    const float* w_in = (const float*)d_in[2];
    const float* q_norm_g = (const float*)d_in[3];
    const float* k_norm_g = (const float*)d_in[4];
    const float* w_attn_out = (const float*)d_in[5];
    const float* w_pool_mix = (const float*)d_in[6];
    const float* pool_scale = (const float*)d_in[7];
    const float* w_pool_out = (const float*)d_in[8];
    const float* w_o = (const float*)d_in[9];
    const float* norm2_g = (const float*)d_in[10];
    const float* w_rg = (const float*)d_in[11];
    const float* b_rg = (const float*)d_in[12];
    const float* w_re = (const float*)d_in[13];
    const float* b_re = (const float*)d_in[14];
    const float* w_eg = (const float*)d_in[15];
    const float* w_eu = (const float*)d_in[16];
    const float* w_ed = (const float*)d_in[17];
    char* ws = (char*)d_ws;
    unsigned* ctrl = (unsigned*)(ws + OFF_CTRL);
    bf16_t* WinT = (bf16_t*)(ws + OFF_WIN); bf16_t* WaT = (bf16_t*)(ws + OFF_WA); bf16_t* WppT = (bf16_t*)(ws + OFF_WPP); bf16_t* WoT = (bf16_t*)(ws + OFF_WO);
    bf16_t* WguT = (bf16_t*)(ws + OFF_WGU); bf16_t* WdT = (bf16_t*)(ws + OFF_WD);
    bf16_t* Hb = (bf16_t*)(ws + OFF_H); bf16_t* MG = Hb; bf16_t* PROJ = (bf16_t*)(ws + OFF_PROJ); bf16_t* ACT = (bf16_t*)(ws + OFF_ACT); bf16_t* YB = (bf16_t*)(ws + OFF_YB);
    bf16_t* AC = (bf16_t*)(ws + OFF_AC); bf16_t* PL = (bf16_t*)(ws + OFF_PL); bf16_t* T1 = (bf16_t*)(ws + OFF_T1);
    float* XB = (float*)(ws + OFF_XB); int* tokE = (int*)(ws + OFF_TOKE); float* tokW = (float*)(ws + OFF_TOKW); int* asg = (int*)(ws + OFF_ASG);
    float* out = (float*)d_out;

    k_zero<<<1, 256, 0, stream>>>(ctrl, 256);
    for (int l = 0; l < DEPTH; ++l) {
        k_tr<<<dim3(INW / 64, DM / 64, 1), 256, 0, stream>>>(w_in + (size_t)l * DM * INW, WinT + (size_t)l * INW * DM, DM, INW, 0, 0, 0);
        k_tr<<<dim3(DM / 64, AW / 64, 1), 256, 0, stream>>>(w_attn_out + (size_t)l * AW * DM, WaT + (size_t)l * DM * AW, AW, DM, 0, 0, 0);
        k_tr<<<dim3(DM / 64, DM / 64, 1), 256, 0, stream>>>(w_o + (size_t)l * DM * DM, WoT + (size_t)l * DM * DM, DM, DM, 0, 0, 0);
        k_foldpp<<<dim3(512, 4), 256, 0, stream>>>(w_pool_mix + (size_t)l * 4 * 128 * 128, pool_scale + (size_t)l * PW, w_pool_out + (size_t)l * PW * DM, WppT + (size_t)l * DM * PW);
    }
    for (int l = 0; l < DEPTH; ++l) {
        const float* xin = (l == 0) ? x : XB;
        unsigned* cnt = ctrl + 64 * l;
        k_tr<<<dim3(EH / 64, DM / 64, NEXP), 256, 0, stream>>>(w_eg + (size_t)l * NEXP * DM * EH, WguT, DM, EH, 1, (size_t)DM * EH, (size_t)DM * DM);
        k_tr<<<dim3(EH / 64, DM / 64, NEXP), 256, 0, stream>>>(w_eu + (size_t)l * NEXP * DM * EH, WguT, DM, EH, 2, (size_t)DM * EH, (size_t)DM * DM);
        k_tr<<<dim3(DM / 64, EH / 64, NEXP), 256, 0, stream>>>(w_ed + (size_t)l * NEXP * EH * DM, WdT, EH, DM, 0, (size_t)EH * DM, (size_t)DM * EH);
        k_norm<<<NTOK / 4, 256, 0, stream>>>(xin, norm1_g + (size_t)l * DM, Hb);
        k_gemm<EpiProj><<<dim3(INW / 128, NTOK / 128), 256, 0, stream>>>(Hb, DM, WinT + (size_t)l * INW * DM, DM, DM, EpiProj{PROJ});
        k_attn<<<NTOK * NH / 4, 256, 0, stream>>>(PROJ, q_norm_g + (size_t)l * HD, k_norm_g + (size_t)l * HD, AC);
        k_pool<<<NTOK, 256, 0, stream>>>(PROJ, PL);
        k_gemm<EpiGateA><<<dim3(DM / 128, NTOK / 128), 256, 0, stream>>>(AC, AW, WaT + (size_t)l * DM * AW, AW, AW, EpiGateA{PROJ, T1});
        k_gemm<EpiGateP><<<dim3(DM / 128, NTOK / 128), 256, 0, stream>>>(PL, PW, WppT + (size_t)l * DM * PW, PW, PW, EpiGateP{PROJ, T1, MG});
        k_gemm<EpiResid><<<dim3(DM / 128, NTOK / 128), 256, 0, stream>>>(MG, DM, WoT + (size_t)l * DM * DM, DM, DM, EpiResid{xin, XB});
        k_router<<<NTOK / 4, 256, 0, stream>>>(XB, norm2_g + (size_t)l * DM, w_rg + (size_t)l * DM * 4, b_rg + (size_t)l * 4, w_re + (size_t)l * 4 * DM * 8, b_re + (size_t)l * 32, Hb, cnt, tokE, tokW, asg);
        k_moe_gu<<<dim3(SLOTS / 128, EH / 64), 256, 0, stream>>>(Hb, WguT, cnt, tokE, ACT);
        k_moe_down<<<dim3(SLOTS / 128, DM / 128), 256, 0, stream>>>(ACT, WdT, cnt, tokW, YB);
        k_moe_comb<<<NTOK, 256, 0, stream>>>(XB, YB, cnt, asg, (l == DEPTH - 1) ? out : XB);
    }
}
```

```cpp
#include <hip/hip_runtime.h>
#include <stdint.h>
#include <stdio.h>

#define LAS __attribute__((address_space(3)))
typedef unsigned short bf16_t;
typedef short bf16x8 __attribute__((ext_vector_type(8)));
typedef float f32x2 __attribute__((ext_vector_type(2)));
typedef float f32x4 __attribute__((ext_vector_type(4)));
typedef float f32x16 __attribute__((ext_vector_type(16)));
typedef unsigned u32x2 __attribute__((ext_vector_type(2)));
typedef unsigned u32x4 __attribute__((ext_vector_type(4)));
typedef __bf16 bfv2 __attribute__((ext_vector_type(2)));

#ifndef MK_N_LAUNCHES
#define MK_N_LAUNCHES 19
#endif

constexpr int DM = 1024, SEQ = 4096, NTOK = 16384, DEPTH = 2;
constexpr int HD = 64, AW = 512, PW = 512, INW = 4096;
constexpr int NEXP = 32, EH = 512, ECAP = NTOK;
constexpr float RMS_EPS = 1e-6f;
constexpr int NTHREADS = 512, NWAVES = 8;

constexpr size_t MB = 1024 * 1024;
constexpr size_t OFF_CTRL = 0, CTRL_BYTES = 65536;
constexpr size_t OFF_WIN  = 1 * MB;
constexpr size_t OFF_WA   = OFF_WIN + 16 * MB;
constexpr size_t OFF_WPP  = OFF_WA + 2 * MB;
constexpr size_t OFF_WO   = OFF_WPP + 2 * MB;
constexpr size_t OFF_WGU  = OFF_WO + 4 * MB;
constexpr size_t OFF_WD   = OFF_WGU + 64 * MB;
constexpr size_t OFF_H    = OFF_WD + 32 * MB;
constexpr size_t OFF_PROJ = OFF_H + 32 * MB;
constexpr size_t OFF_ACT  = OFF_PROJ;
constexpr size_t OFF_YB   = OFF_PROJ + 40 * MB;
constexpr size_t OFF_AC   = OFF_PROJ + 128 * MB;
constexpr size_t OFF_PL   = OFF_AC + 16 * MB;
constexpr size_t OFF_OG   = OFF_PL + 16 * MB;
constexpr size_t OFF_T1   = OFF_OG;
constexpr size_t OFF_ML   = OFF_OG + 48 * MB;
constexpr size_t OFF_XB   = OFF_ML + 4 * MB;
constexpr size_t OFF_TOKE = OFF_XB + 64 * MB;
constexpr size_t OFF_TOKW = OFF_TOKE + 2 * MB;
constexpr size_t OFF_ASG  = OFF_TOKW + 2 * MB;
constexpr size_t WS_NEED  = OFF_ASG + 1 * MB;
constexpr int CW_CNT = 1024;
constexpr int CW_BAR = 8192;
constexpr int RING_BYTES = 131072, LCTL_OFF = RING_BYTES, LDS_BYTES = RING_BYTES + 1024;
constexpr int LI_BAR = 0, LI_TB = 16, LI_PS = 64, LI_CN = 112;

__device__ __forceinline__ float bflo(unsigned w) { return __uint_as_float(w << 16); }
__device__ __forceinline__ float bfhi(unsigned w) { return __uint_as_float(w & 0xffff0000u); }
__device__ __forceinline__ unsigned pack2(float lo, float hi) { f32x2 v = {lo, hi}; return __builtin_bit_cast(unsigned, __builtin_convertvector(v, bfv2)); }
__device__ __forceinline__ bf16_t f2bf(float f) { return (bf16_t)(pack2(f, 0.f) & 0xffffu); }
__device__ __forceinline__ float wave_sum(float v) {
#pragma unroll
    for (int o = 32; o >= 1; o >>= 1) v += __shfl_xor(v, o);
    return v;
}
__device__ __forceinline__ int opaque_tid() { int t = (int)threadIdx.x; asm volatile("" : "+v"(t)); return t; }
__device__ __forceinline__ float sigmoidf_(float v) { return 1.0f / (1.0f + __expf(-v)); }

#define XB_TMO      128
#define XB_XCNT(j)  (256  + 64 * (j))
#define XB_XSUB(j)  (1280 + 64 * (j))
#define XB_XGEN(j)  (2304 + 64 * (j))
#define XB_TOP      3328
#define XB_TOPGEN   3392
#define XCD_BAR_WORDS 3456
#define XB_SPIN_CAP (1u << 18)
__device__ __forceinline__ unsigned xb_ld(unsigned* p)              { return __hip_atomic_load(p, __ATOMIC_RELAXED, __HIP_MEMORY_SCOPE_AGENT); }
__device__ __forceinline__ unsigned xb_add(unsigned* p, unsigned v) { return __hip_atomic_fetch_add(p, v, __ATOMIC_RELAXED, __HIP_MEMORY_SCOPE_AGENT); }
__device__ __forceinline__ unsigned xb_xcc_id() { return (unsigned)__builtin_amdgcn_s_getreg((3 << 11) | 20) & 0xFu; }
#define XB_SPIN(cond, bar) do { unsigned _sp = 0; while (cond) { __builtin_amdgcn_s_sleep(1); \
    if ((++_sp & 255u) == 0u) { if (xb_ld(&(bar)[XB_TMO])) break; if (_sp > XB_SPIN_CAP) { atomicAdd(&(bar)[XB_TMO], 1u); break; } } } } while (0)
struct XcdBarrier { unsigned* bar; unsigned x; volatile LAS unsigned* st; };
__device__ __forceinline__ XcdBarrier xcd_barrier_post(unsigned* bar, volatile LAS unsigned* st) {
    XcdBarrier b; b.bar = bar; b.x = xb_xcc_id(); b.st = st;
    if (threadIdx.x == 0) (void)xb_add(&bar[XB_XCNT(b.x)], 1u);
    return b;
}
__device__ __forceinline__ void xcd_barrier_complete(unsigned* bar, unsigned x, unsigned& nloc, unsigned& nx) {
    const unsigned G = gridDim.x * gridDim.y * gridDim.z;
    unsigned sum, cnt, mine, sp = 0u;
    for (;;) {
        sum = 0u; cnt = 0u; mine = 0u;
#pragma unroll
        for (unsigned j = 0; j < 16; ++j) { const unsigned c = xb_ld(&bar[XB_XCNT(j)]); sum += c; cnt += (c > 0u) ? 1u : 0u; mine = (j == x) ? c : mine; }
        if (sum == G) break;
        __builtin_amdgcn_s_sleep(1);
        if ((++sp & 255u) == 0u) { if (xb_ld(&bar[XB_TMO])) break; if (sp > XB_SPIN_CAP) { atomicAdd(&bar[XB_TMO], 1u); break; } }
    }
    nloc = mine > 0u ? mine : 1u; nx = cnt > 0u ? cnt : 1u;
}
__device__ __forceinline__ void xcd_barrier(const XcdBarrier& b) {
    asm volatile("s_waitcnt vmcnt(0)" ::: "memory");
    __syncthreads();
    if (threadIdx.x == 0) {
        unsigned* bar = b.bar;
        __builtin_amdgcn_s_waitcnt(0);
        unsigned nloc = b.st[0], nx = b.st[1];
        if (nloc == 0u) { xcd_barrier_complete(bar, b.x, nloc, nx); b.st[0] = nloc; b.st[1] = nx; }
        const unsigned old = xb_add(&bar[XB_XSUB(b.x)], 1u);
        const unsigned gen = old / nloc;
        if (old + 1u == (gen + 1u) * nloc) {
            __builtin_amdgcn_fence(__ATOMIC_RELEASE, "agent");
            asm volatile("s_waitcnt vmcnt(0)" ::: "memory");
            const unsigned og = xb_add(&bar[XB_TOP], 1u);
            const unsigned tg = og / nx;
            if (og + 1u == (tg + 1u) * nx) xb_add(&bar[XB_TOPGEN], 1u);
            else XB_SPIN(xb_ld(&bar[XB_TOPGEN]) == tg, bar);
            __builtin_amdgcn_fence(__ATOMIC_ACQUIRE, "agent");
            xb_add(&bar[XB_XGEN(b.x)], 1u);
            asm volatile("s_waitcnt vmcnt(0)" ::: "memory");
        } else {
            XB_SPIN(xb_ld(&bar[XB_XGEN(b.x)]) == gen, bar);
            __builtin_amdgcn_fence(__ATOMIC_ACQUIRE, "agent");
            asm volatile("s_waitcnt vmcnt(0)" ::: "memory");
        }
    }
    __syncthreads();
}

namespace pg8 {
constexpr int BM = 256, BK = 64, HALF = 128, HTB = HALF * BK * 2, NXCD = 8, WGM = 8;
__device__ __forceinline__ int lds_byte(int r, int c) { const int st = (r >> 4) * 2 + (c >> 5), rr = r & 15, cc = c & 31, ob = rr * 64 + cc * 2; return st * 1024 + (ob ^ (((ob >> 9) & 1) << 5)); }
__device__ __forceinline__ void stage_rc(int b, int& R, int& C) { const int st = b / 1024, sb = b % 1024, swz = sb ^ (((sb >> 9) & 1) << 5); R = (st >> 1) * 16 + swz / 64; C = (st & 1) * 32 + (swz % 64) / 2; }
__device__ __forceinline__ int perm32(int rho) { const int n = rho >> 4, i = rho & 15; return 8 * (i >> 2) + 4 * n + (i & 3); }

struct Unit { const char* A; const char* B; int row0, col0, e, nvalid, j0; };

struct DenseOrder {
    const char* A; const char* Bt; int K, nM, nN, nwg, G, c;
    __device__ __forceinline__ void init(const void* A_, const void* Bt_, int M, int N, int K_, int G_, int c_) { A = (const char*)A_; Bt = (const char*)Bt_; K = K_; nM = M / BM; nN = N / BM; nwg = nM * nN; G = G_; c = c_; }
    __device__ __forceinline__ bool next(int i, Unit& u) const {
        const long L = (long)i * G + c; if (L >= nwg) return false;
        int wgid = (int)L; { const int q = nwg / NXCD, r = nwg % NXCD, xcd = wgid % NXCD, off = wgid / NXCD; wgid = (xcd < r ? xcd * (q + 1) : r * (q + 1) + (xcd - r) * q) + off; }
        const int nig = WGM * nN, gid = wgid / nig, fm = gid * WGM, gsz = (nM - fm) < WGM ? (nM - fm) : WGM;
        const int pm = fm + ((wgid % nig) % gsz), pn = (wgid % nig) / gsz;
        u.A = A + (size_t)pm * BM * K * 2; u.B = Bt + (size_t)pn * BM * K * 2; u.row0 = pm * BM; u.col0 = pn * BM; u.e = 0; u.nvalid = BM; u.j0 = 0; return true;
    }
    __device__ __forceinline__ unsigned row_off(const Unit&, int) const { return 0u; }
};
struct MoeOrder {
    const char* A; const char* Bt; size_t bExp; int K; const LAS int* tb; const LAS int* ps; const LAS int* cn; const int* tokE; int G, c; bool gather;
    __device__ __forceinline__ bool next(int i, Unit& u) const {
        const int L = i * G + c, total = tb[NEXP] * 4; if (L >= total) return false;
        const int rt = L >> 2, pn = L & 3;
        int e = 0;
        while (e < NEXP - 1 && tb[e + 1] <= rt) ++e;
        e = __builtin_amdgcn_readfirstlane(e);
        const int j = rt - __builtin_amdgcn_readfirstlane(tb[e]);
        const int pse = __builtin_amdgcn_readfirstlane(ps[e]), cne = __builtin_amdgcn_readfirstlane(cn[e]);
        u.e = e; u.row0 = pse + BM * j; u.col0 = pn * BM; u.nvalid = min(BM, cne - BM * j); u.j0 = e * ECAP + BM * j;
        u.B = Bt + (size_t)e * bExp + (size_t)pn * BM * K * 2;
        u.A = gather ? A : A + (size_t)u.row0 * K * 2;
        return true;
    }
    __device__ __forceinline__ unsigned row_off(const Unit& u, int R) const { const int t = R < u.nvalid ? tokE[u.j0 + R] : 0; return (unsigned)t * (unsigned)(K * 2); }
};

template <class Epi, class Sched, int BMODE, bool GATHER>
__device__ __forceinline__ void gemm_phase(LAS unsigned char* lds, const int K, const Sched& S, const Epi& E) {
    const int tid = opaque_tid(), wid = __builtin_amdgcn_readfirstlane(tid >> 6), lane = tid & 63, wr = wid >> 2, wc = wid & 3, fr = lane & 15, fq = lane >> 4;
    const int nt = K / BK;
    unsigned voffA[2][2], voffAn[2][2], voffB[2]; int RA[2], CA[2];
#pragma unroll
    for (int i = 0; i < 2; ++i) { int R, C; stage_rc(tid * 16 + i * 8192, R, C); RA[i] = R; CA[i] = C;
        const int Rb = (BMODE == 1) ? (64 * (R >> 5) + perm32(R & 31)) : (Epi::PERM ? ((R & ~31) + perm32(R & 31)) : R);
        voffB[i] = (unsigned)(Rb * K + C) * 2u;
#pragma unroll
        for (int h = 0; h < 2; ++h) { voffA[h][i] = (unsigned)((h * HALF + R) * K + C) * 2u; voffAn[h][i] = voffA[h][i]; } }
    const size_t kstep = (size_t)(BK * 2);
    const size_t hstepB = (size_t)((BMODE == 1) ? 32 : HALF) * K * 2;
    const unsigned ldsw = (unsigned)wid * 1024u;
    const int aoff = lds_byte(wr * 64 + fr, fq * 8), boff = lds_byte(wc * 32 + fr, fq * 8);
#define PG8_SA(b, h) (((b) * 2 + (h)) * HTB)
#define PG8_SB(b, h) ((4 + (b) * 2 + (h)) * HTB)
#define PG8_STAGE2(bufoff, gbase, v0, v1) do { \
        __builtin_amdgcn_global_load_lds((const unsigned*)((const char*)(gbase) + (v0)), (LAS unsigned*)(lds + (bufoff) + ldsw), 16, 0, 0); \
        __builtin_amdgcn_global_load_lds((const unsigned*)((const char*)(gbase) + (v1)), (LAS unsigned*)(lds + (bufoff) + ldsw + 8192), 16, 0, 0); } while (0)
#define PG8_STAGEB(bufoff, gbase) PG8_STAGE2(bufoff, gbase, voffB[0], voffB[1])
#define PG8_STAGEA(bufoff, gbase, h, nx) PG8_STAGE2(bufoff, gbase, ((GATHER && (nx)) ? voffAn[h][0] : voffA[h][0]), ((GATHER && (nx)) ? voffAn[h][1] : voffA[h][1]))
#define PG8_LDA(dst, b, h) do { _Pragma("unroll") for (int m = 0; m < 4; ++m) _Pragma("unroll") for (int k = 0; k < 2; ++k) dst[m][k] = *(const LAS bf16x8*)(lds + PG8_SA(b, h) + aoff + m * 2048 + k * 1024); } while (0)
#define PG8_LDB(dst, b, h) do { _Pragma("unroll") for (int n = 0; n < 2; ++n) _Pragma("unroll") for (int k = 0; k < 2; ++k) dst[n][k] = *(const LAS bf16x8*)(lds + PG8_SB(b, h) + boff + n * 2048 + k * 1024); } while (0)
#define PG8_MMA(ai, bj, At, Bt) do { __builtin_amdgcn_s_setprio(1); _Pragma("unroll") for (int m = 0; m < 4; ++m) _Pragma("unroll") for (int n = 0; n < 2; ++n) _Pragma("unroll") for (int k = 0; k < 2; ++k) \
        acc[ai][bj][m][n] = __builtin_amdgcn_mfma_f32_16x16x32_bf16(Bt[n][k], At[m][k], acc[ai][bj][m][n], 0, 0, 0); __builtin_amdgcn_s_setprio(0); } while (0)
#define PG8_WAIT_V(n) asm volatile("s_waitcnt vmcnt(" #n ")" ::: "memory")
#define PG8_WAIT_L(n) asm volatile("s_waitcnt lgkmcnt(" #n ")" ::: "memory")
#define PG8_BAR __builtin_amdgcn_s_barrier()
#define PG8_SCHED __builtin_amdgcn_sched_barrier(0)
    Unit cur, nxt; int ui = 0;
    if (!S.next(0, cur)) return;
    if (GATHER) {
#pragma unroll
        for (int h = 0; h < 2; ++h)
#pragma unroll
            for (int i = 0; i < 2; ++i) voffA[h][i] = S.row_off(cur, h * HALF + RA[i]) + (unsigned)CA[i] * 2u;
    }
    f32x4 acc[2][2][4][2];
#pragma unroll
    for (int a = 0; a < 2; ++a)
#pragma unroll
        for (int b = 0; b < 2; ++b)
#pragma unroll
            for (int m = 0; m < 4; ++m)
#pragma unroll
                for (int n = 0; n < 2; ++n) acc[a][b][m][n] = (f32x4){0.f, 0.f, 0.f, 0.f};
    bf16x8 At[4][2], B0[2][2], B1[2][2];
    const char* cA = cur.A; const char* cB = cur.B;
    PG8_STAGEB(PG8_SB(0, 0), cB); PG8_STAGEB(PG8_SB(0, 1), cB + hstepB); PG8_STAGEA(PG8_SA(0, 0), cA, 0, false); PG8_STAGEA(PG8_SA(0, 1), cA, 1, false);
    if (wr == 1) PG8_BAR;
    PG8_WAIT_V(2); PG8_BAR;
    PG8_STAGEB(PG8_SB(1, 0), cB + kstep); PG8_STAGEA(PG8_SA(1, 0), cA + kstep, 0, false); PG8_STAGEB(PG8_SB(1, 1), cB + hstepB + kstep);
    PG8_WAIT_V(6); PG8_BAR;
    for (;;) {
        const bool has_next = S.next(ui + 1, nxt);
        if (GATHER) {
#pragma unroll
            for (int h = 0; h < 2; ++h)
#pragma unroll
                for (int i = 0; i < 2; ++i) voffAn[h][i] = has_next ? (S.row_off(nxt, h * HALF + RA[i]) + (unsigned)CA[i] * 2u) : voffA[h][i];
        }
        const char* nA = has_next ? nxt.A : cA; const char* nB = has_next ? nxt.B : cB;
        for (int t = 0; t < nt; t += 2) {
            const bool last = (t == nt - 2);
            const char* a1 = cA + (size_t)(t + 1) * kstep;
            const char* a2 = last ? nA : cA + (size_t)(t + 2) * kstep; const char* b2 = last ? nB : cB + (size_t)(t + 2) * kstep;
            const char* a3 = a2 + kstep; const char* b3 = b2 + kstep;
            PG8_LDB(B0, 0, 0); PG8_LDB(B1, 0, 1); PG8_SCHED; PG8_LDA(At, 0, 0); PG8_STAGEA(PG8_SA(1, 1), a1, 1, false);
            PG8_WAIT_V(8); PG8_WAIT_L(0); PG8_BAR; PG8_MMA(0, 0, At, B0); PG8_MMA(0, 1, At, B1); PG8_BAR; PG8_SCHED;
            PG8_LDA(At, 0, 1); PG8_STAGEB(PG8_SB(0, 0), b2); PG8_STAGEB(PG8_SB(0, 1), b2 + hstepB); PG8_STAGEA(PG8_SA(0, 0), a2, 0, last);
            PG8_WAIT_V(8); PG8_WAIT_L(0); PG8_BAR; PG8_MMA(1, 0, At, B0); PG8_MMA(1, 1, At, B1); PG8_BAR; PG8_SCHED;
            PG8_LDB(B0, 1, 0); PG8_LDB(B1, 1, 1); PG8_SCHED; PG8_LDA(At, 1, 0); PG8_STAGEA(PG8_SA(0, 1), a2, 1, last);
            PG8_WAIT_V(8); PG8_WAIT_L(0); PG8_BAR; PG8_MMA(0, 0, At, B0); PG8_MMA(0, 1, At, B1); PG8_BAR; PG8_SCHED;
            PG8_LDA(At, 1, 1); PG8_STAGEB(PG8_SB(1, 0), b3); PG8_STAGEB(PG8_SB(1, 1), b3 + hstepB); PG8_STAGEA(PG8_SA(1, 0), a3, 0, last);
            PG8_WAIT_V(8); PG8_WAIT_L(0); PG8_BAR; PG8_MMA(1, 0, At, B0); PG8_MMA(1, 1, At, B1); PG8_BAR; PG8_SCHED;
        }
        if (wr == 0) PG8_BAR;
        E(acc, cur, wr, wc, fr, fq);
        if (!has_next) break;
#pragma unroll
        for (int a = 0; a < 2; ++a)
#pragma unroll
            for (int b = 0; b < 2; ++b)
#pragma unroll
                for (int m = 0; m < 4; ++m)
#pragma unroll
                    for (int n = 0; n < 2; ++n) acc[a][b][m][n] = (f32x4){0.f, 0.f, 0.f, 0.f};
        cur = nxt; cA = nA; cB = nB; ++ui;
        if (GATHER) {
#pragma unroll
            for (int h = 0; h < 2; ++h)
#pragma unroll
                for (int i = 0; i < 2; ++i) voffA[h][i] = voffAn[h][i];
        }
        if (wr == 1) PG8_BAR;
    }
    PG8_WAIT_V(0);
    PG8_BAR;
#undef PG8_SA
#undef PG8_SB
#undef PG8_STAGE2
#undef PG8_STAGEA
#undef PG8_STAGEB
#undef PG8_LDA
#undef PG8_LDB
#undef PG8_MMA
#undef PG8_WAIT_V
#undef PG8_WAIT_L
#undef PG8_BAR
#undef PG8_SCHED
}

struct EpiProj {
    static constexpr bool PERM = true;
    bf16_t* out; const float* gq; const float* gk;
    __device__ __forceinline__ void operator()(const f32x4 (&acc)[2][2][4][2], const Unit& u, int wr, int wc, int fr, int fq) const {
        const int pn = u.col0 >> 8;
        const int row0 = u.row0 + wr * 64 + fr, colb = u.col0 + 64 * wc + 8 * fq;
        if (pn < 4) {
            const float* g = (pn < 2) ? gq : gk; const float post = (pn < 2) ? 0.125f : 1.0f;
            f32x4 gv[2][2];
#pragma unroll
            for (int bj = 0; bj < 2; ++bj)
#pragma unroll
                for (int n = 0; n < 2; ++n) gv[bj][n] = *(const f32x4*)(g + 32 * bj + 8 * fq + 4 * n) * post;
#pragma unroll
            for (int ai = 0; ai < 2; ++ai)
#pragma unroll
                for (int m = 0; m < 4; ++m) {
                    float ss = 0.f;
#pragma unroll
                    for (int bj = 0; bj < 2; ++bj)
#pragma unroll
                        for (int n = 0; n < 2; ++n) { const f32x4 x = acc[ai][bj][m][n]; ss += (x[0] * x[0] + x[1] * x[1]) + (x[2] * x[2] + x[3] * x[3]); }
                    ss += __shfl_xor(ss, 16); ss += __shfl_xor(ss, 32);
                    const float rstd = rsqrtf(ss * (1.0f / HD) + RMS_EPS);
                    bf16_t* rowp = out + (size_t)(row0 + ai * HALF + m * 16) * INW + colb;
#pragma unroll
                    for (int bj = 0; bj < 2; ++bj) { const f32x4 v0 = acc[ai][bj][m][0] * rstd * gv[bj][0], v1 = acc[ai][bj][m][1] * rstd * gv[bj][1];
                        u32x4 w; w.x = pack2(v0[0], v0[1]); w.y = pack2(v0[2], v0[3]); w.z = pack2(v1[0], v1[1]); w.w = pack2(v1[2], v1[3]);
                        *(u32x4*)(rowp + 32 * bj) = w; }
                }
        } else {
            const bool sg = pn >= 8;
#pragma unroll
            for (int ai = 0; ai < 2; ++ai)
#pragma unroll
                for (int m = 0; m < 4; ++m) {
                    bf16_t* rowp = out + (size_t)(row0 + ai * HALF + m * 16) * INW + colb;
#pragma unroll
                    for (int bj = 0; bj < 2; ++bj) { f32x4 v0 = acc[ai][bj][m][0], v1 = acc[ai][bj][m][1];
                        if (sg) {
#pragma unroll
                            for (int j = 0; j < 4; ++j) { v0[j] = sigmoidf_(v0[j]); v1[j] = sigmoidf_(v1[j]); } }
                        u32x4 w; w.x = pack2(v0[0], v0[1]); w.y = pack2(v0[2], v0[3]); w.z = pack2(v1[0], v1[1]); w.w = pack2(v1[2], v1[3]);
                        *(u32x4*)(rowp + 32 * bj) = w; }
                }
        }
    }
};
template <int MODE> struct EpiGate {
    static constexpr bool PERM = true;
    const bf16_t* gate; const bf16_t* t1in; bf16_t* out;
    __device__ __forceinline__ void operator()(const f32x4 (&acc)[2][2][4][2], const Unit& u, int wr, int wc, int fr, int fq) const {
        const int row0 = u.row0 + wr * 64 + fr, col0 = u.col0 + wc * 32 + 8 * fq;
#pragma unroll
        for (int ai = 0; ai < 2; ++ai)
#pragma unroll
            for (int m = 0; m < 4; ++m) {
                const size_t r = (size_t)(row0 + ai * HALF + m * 16);
#pragma unroll
                for (int bj = 0; bj < 2; ++bj) {
                    const int c = col0 + bj * HALF;
                    const u32x4 g = *(const u32x4*)(gate + r * INW + c);
                    const f32x4 a0 = acc[ai][bj][m][0], a1 = acc[ai][bj][m][1];
                    float o[8] = {a0[0] * bflo(g.x), a0[1] * bfhi(g.x), a0[2] * bflo(g.y), a0[3] * bfhi(g.y), a1[0] * bflo(g.z), a1[1] * bfhi(g.z), a1[2] * bflo(g.w), a1[3] * bfhi(g.w)};
                    if (MODE == 1) { const u32x4 t = *(const u32x4*)(t1in + r * DM + c);
                        o[0] += bflo(t.x); o[1] += bfhi(t.x); o[2] += bflo(t.y); o[3] += bfhi(t.y); o[4] += bflo(t.z); o[5] += bfhi(t.z); o[6] += bflo(t.w); o[7] += bfhi(t.w); }
                    u32x4 w; w.x = pack2(o[0], o[1]); w.y = pack2(o[2], o[3]); w.z = pack2(o[4], o[5]); w.w = pack2(o[6], o[7]);
                    *(u32x4*)(out + r * DM + c) = w;
                }
            }
    }
};
struct EpiResid {
    static constexpr bool PERM = false;
    const float* xin; float* xout;
    __device__ __forceinline__ void operator()(const f32x4 (&acc)[2][2][4][2], const Unit& u, int wr, int wc, int fr, int fq) const {
        const int row0 = u.row0 + wr * 64 + fr, col0 = u.col0 + wc * 32 + 4 * fq;
#pragma unroll
        for (int ai = 0; ai < 2; ++ai)
#pragma unroll
            for (int m = 0; m < 4; ++m) { const size_t off = (size_t)(row0 + ai * HALF + m * 16) * DM + col0;
#pragma unroll
                for (int bj = 0; bj < 2; ++bj)
#pragma unroll
                    for (int n = 0; n < 2; ++n) { const f32x4 x = *(const f32x4*)(xin + off + bj * HALF + n * 16); *(f32x4*)(xout + off + bj * HALF + n * 16) = x + acc[ai][bj][m][n]; } }
    }
};
struct EpiSwiGLU {
    static constexpr bool PERM = true;
    bf16_t* act;
    __device__ __forceinline__ void operator()(const f32x4 (&acc)[2][2][4][2], const Unit& u, int wr, int wc, int fr, int fq) const {
        const int row0 = u.row0 + wr * 64 + fr, col0 = (u.col0 >> 1) + wc * 32 + 8 * fq;
#pragma unroll
        for (int ai = 0; ai < 2; ++ai)
#pragma unroll
            for (int m = 0; m < 4; ++m) {
                float o[8];
#pragma unroll
                for (int n = 0; n < 2; ++n)
#pragma unroll
                    for (int j = 0; j < 4; ++j) { const float a = acc[ai][0][m][n][j], b = acc[ai][1][m][n][j]; o[4 * n + j] = a * sigmoidf_(a) * b; }
                u32x4 w; w.x = pack2(o[0], o[1]); w.y = pack2(o[2], o[3]); w.z = pack2(o[4], o[5]); w.w = pack2(o[6], o[7]);
                *(u32x4*)(act + (size_t)(row0 + ai * HALF + m * 16) * EH + col0) = w;
            }
    }
};
struct EpiDown {
    static constexpr bool PERM = true;
    bf16_t* yb; const float* tokW;
    __device__ __forceinline__ void operator()(const f32x4 (&acc)[2][2][4][2], const Unit& u, int wr, int wc, int fr, int fq) const {
        const int col0 = u.col0 + wc * 32 + 8 * fq;
#pragma unroll
        for (int ai = 0; ai < 2; ++ai)
#pragma unroll
            for (int m = 0; m < 4; ++m) {
                const int rl = wr * 64 + fr + ai * HALF + m * 16;
                const float w = rl < u.nvalid ? tokW[u.j0 + rl] : 0.f;
#pragma unroll
                for (int bj = 0; bj < 2; ++bj) { const f32x4 v0 = acc[ai][bj][m][0] * w, v1 = acc[ai][bj][m][1] * w;
                    u32x4 o; o.x = pack2(v0[0], v0[1]); o.y = pack2(v0[2], v0[3]); o.z = pack2(v1[0], v1[1]); o.w = pack2(v1[2], v1[3]);
                    *(u32x4*)(yb + (size_t)(u.row0 + rl) * DM + col0 + bj * HALF) = o; }
            }
    }
};
}

constexpr int ATT_K_OFF = 0, ATT_V_OFF = 49152;
__device__ __forceinline__ unsigned kv_off(unsigned row, unsigned ch) { return row * 128u + 16u * (ch ^ (((row >> 1) & 7u) ^ ((row & 2u) << 1))); }

__device__ __forceinline__ void attn_unit(LAS unsigned char* lds, const bf16_t* __restrict__ proj, bf16_t* __restrict__ og, f32x2* __restrict__ ml, int uidx) {
    const int tid = opaque_tid(), wid = __builtin_amdgcn_readfirstlane(tid >> 6), lane = tid & 63;
    const int bh = uidx / 48, r48 = uidx % 48, g = r48 >> 4, rr = r48 & 15;
    const int b = bh >> 3, h = bh & 7;
    const int d = (g == 0) ? 1 : (g == 1 ? 4 : 16);
    const int c = (g == 0) ? 0 : (g == 1 ? (rr >> 2) : rr);
    const int blk = (g == 0) ? rr : (g == 1 ? (rr & 3) : 0);
    const int tok0 = b * SEQ + c;
    const int kbase = 256 * blk - 128;
    const int kr_min = (blk == 0) ? 128 : 0;
#pragma unroll
    for (int i = 0; i < 6; ++i) {
        const int idx = tid + NTHREADS * i, row = idx >> 3, ch = idx & 7;
        if (row >= kr_min) {
            const size_t t = (size_t)(tok0 + (kbase + row) * d);
            const u32x4 kv = *(const u32x4*)(proj + t * INW + AW + h * HD + ch * 8);
            const u32x4 vv = *(const u32x4*)(proj + t * INW + 2 * AW + h * HD + ch * 8);
            *(LAS u32x4*)(lds + ATT_K_OFF + kv_off(row, ch)) = kv;
            *(LAS u32x4*)(lds + ATT_V_OFF + kv_off(row, ch)) = vv;
        }
    }
    const int qn = 256 * blk + 32 * wid + (lane & 31);
    const size_t qt = (size_t)(tok0 + qn * d);
    bf16x8 qf[4];
#pragma unroll
    for (int ks = 0; ks < 4; ++ks) qf[ks] = *(const bf16x8*)(proj + qt * INW + h * HD + 16 * ks + 8 * (lane >> 5));
    __syncthreads();
    const int kt_min = (blk == 0) ? max(0, 4 - wid) : 0;
    const int hq = lane >> 5, qi = lane & 31;
    f32x16 S[5];
#pragma unroll
    for (int kt = 0; kt < 5; ++kt) {
#pragma unroll
        for (int i = 0; i < 16; ++i) S[kt][i] = 0.f;
        if (kt >= kt_min) {
            const unsigned krow = (unsigned)(32 * wid + 32 * kt + qi);
#pragma unroll
            for (int ks = 0; ks < 4; ++ks) {
                const bf16x8 kf = *(const LAS bf16x8*)(lds + ATT_K_OFF + kv_off(krow, (unsigned)(2 * ks + hq)));
                S[kt] = __builtin_amdgcn_mfma_f32_32x32x16_bf16(kf, qf[ks], S[kt], 0, 0, 0);
            }
        }
    }
    float mx = -3.0e38f;
#pragma unroll
    for (int kt = 0; kt < 5; ++kt)
#pragma unroll
        for (int i = 0; i < 16; ++i) {
            const int row = (i & 3) + 8 * (i >> 2) + 4 * hq;
            bool valid = kt >= kt_min;
            if (kt == 0) valid = valid && (row >= qi);
            if (kt == 4) valid = valid && (row <= qi);
            S[kt][i] = valid ? S[kt][i] : -3.0e38f;
            mx = fmaxf(mx, S[kt][i]);
        }
    mx = fmaxf(mx, __shfl_xor(mx, 32));
    float lsum = 0.f;
#pragma unroll
    for (int kt = 0; kt < 5; ++kt)
#pragma unroll
        for (int i = 0; i < 16; ++i) { const float p = (S[kt][i] > -1.0e38f) ? __expf(S[kt][i] - mx) : 0.f; S[kt][i] = p; lsum += p; }
    lsum += __shfl_xor(lsum, 32);
    f32x16 O[2];
#pragma unroll
    for (int dt = 0; dt < 2; ++dt)
#pragma unroll
        for (int i = 0; i < 16; ++i) O[dt][i] = 0.f;
    const unsigned blkq = (lane >> 4) & 1, q4 = (lane & 15) >> 2, p4 = lane & 3;
    const unsigned vbase = (unsigned)(size_t)(lds + ATT_V_OFF);
#pragma unroll
    for (int kt = 0; kt < 5; ++kt) {
        if (kt >= kt_min) {
#pragma unroll
            for (int s = 0; s < 2; ++s) {
                u32x4 pw;
                pw.x = pack2(S[kt][8 * s + 0], S[kt][8 * s + 1]); pw.y = pack2(S[kt][8 * s + 2], S[kt][8 * s + 3]);
                pw.z = pack2(S[kt][8 * s + 4], S[kt][8 * s + 5]); pw.w = pack2(S[kt][8 * s + 6], S[kt][8 * s + 7]);
                const bf16x8 pf = __builtin_bit_cast(bf16x8, pw);
                u32x2 v00, v01, v10, v11;
                const unsigned r0 = (unsigned)(32 * wid + 32 * kt + 16 * s + 4 * hq) + q4, r1 = r0 + 8;
                const unsigned a00 = vbase + kv_off(r0, 0u + 2 * blkq + (p4 >> 1)) + 8 * (p4 & 1), a01 = vbase + kv_off(r1, 0u + 2 * blkq + (p4 >> 1)) + 8 * (p4 & 1);
                const unsigned a10 = vbase + kv_off(r0, 4u + 2 * blkq + (p4 >> 1)) + 8 * (p4 & 1), a11 = vbase + kv_off(r1, 4u + 2 * blkq + (p4 >> 1)) + 8 * (p4 & 1);
                asm volatile("ds_read_b64_tr_b16 %0, %4\n\tds_read_b64_tr_b16 %1, %5\n\tds_read_b64_tr_b16 %2, %6\n\tds_read_b64_tr_b16 %3, %7\n\ts_waitcnt lgkmcnt(0)"
                             : "=&v"(v00), "=&v"(v01), "=&v"(v10), "=&v"(v11) : "v"(a00), "v"(a01), "v"(a10), "v"(a11) : "memory");
                u32x4 f0; f0.x = v00.x; f0.y = v00.y; f0.z = v01.x; f0.w = v01.y;
                u32x4 f1; f1.x = v10.x; f1.y = v10.y; f1.z = v11.x; f1.w = v11.y;
                O[0] = __builtin_amdgcn_mfma_f32_32x32x16_bf16(__builtin_bit_cast(bf16x8, f0), pf, O[0], 0, 0, 0);
                O[1] = __builtin_amdgcn_mfma_f32_32x32x16_bf16(__builtin_bit_cast(bf16x8, f1), pf, O[1], 0, 0, 0);
            }
        }
    }
    const float inv = 1.0f / lsum;
    bf16_t* orow = og + ((size_t)g * NTOK + qt) * AW + h * HD;
#pragma unroll
    for (int dt = 0; dt < 2; ++dt)
#pragma unroll
        for (int gq4 = 0; gq4 < 4; ++gq4) {
            u32x2 w; w.x = pack2(O[dt][4 * gq4 + 0] * inv, O[dt][4 * gq4 + 1] * inv); w.y = pack2(O[dt][4 * gq4 + 2] * inv, O[dt][4 * gq4 + 3] * inv);
            *(u32x2*)(orow + 32 * dt + 8 * gq4 + 4 * hq) = w;
        }
    if (lane < 32) ml[((size_t)g * NTOK + qt) * 8 + h] = (f32x2){mx, lsum};
    __syncthreads();
}

__device__ __forceinline__ void tr_item(LAS float* t, const float* __restrict__ src, bf16_t* __restrict__ dst, int K, int N, int mode, int item) {
    const int nb = N / 64, kb = item / nb, n0 = (item % nb) * 64, k0 = kb * 64;
    const int tt = opaque_tid(), tx = tt & 63, ty = tt >> 6;
#pragma unroll
    for (int i = 0; i < 8; ++i) { const int k = ty + 8 * i; t[k * 65 + tx] = src[(size_t)(k0 + k) * N + n0 + tx]; }
    __syncthreads();
#pragma unroll
    for (int i = 0; i < 8; ++i) {
        const int n = n0 + ty + 8 * i;
        int nn = n;
        if (mode == 1) nn = (n >> 7) * 256 + (n & 127);
        if (mode == 2) nn = (n >> 7) * 256 + 128 + (n & 127);
        dst[(size_t)nn * K + k0 + tx] = f2bf(t[tx * 65 + ty + 8 * i]);
    }
    __syncthreads();
}
__device__ __forceinline__ void convert_experts(LAS float* t, const float* weg, const float* weu, const float* wed, bf16_t* WguT, bf16_t* WdT, int G, int c) {
    constexpr int IT = (DM / 64) * (EH / 64);
    for (int it = c; it < 3 * NEXP * IT; it += G) {
        const int which = it / (NEXP * IT), r = it % (NEXP * IT), e = r / IT, item = r % IT;
        if (which == 0) tr_item(t, weg + (size_t)e * DM * EH, WguT + (size_t)e * DM * DM, DM, EH, 1, item);
        else if (which == 1) tr_item(t, weu + (size_t)e * DM * EH, WguT + (size_t)e * DM * DM, DM, EH, 2, item);
        else tr_item(t, wed + (size_t)e * EH * DM, WdT + (size_t)e * DM * EH, EH, DM, 0, item);
    }
}
__device__ __forceinline__ void norm_row(const float* __restrict__ xr, const float* __restrict__ g, bf16_t* __restrict__ hr, int lane) {
    f32x4 v[4]; float ss = 0.f;
#pragma unroll
    for (int i = 0; i < 4; ++i) { v[i] = *(const f32x4*)(xr + (i * 64 + lane) * 4); ss += (v[i][0] * v[i][0] + v[i][1] * v[i][1]) + (v[i][2] * v[i][2] + v[i][3] * v[i][3]); }
    ss = wave_sum(ss);
    const float rstd = rsqrtf(ss * (1.0f / DM) + RMS_EPS);
#pragma unroll
    for (int i = 0; i < 4; ++i) {
        const f32x4 gv = *(const f32x4*)(g + (i * 64 + lane) * 4);
        u32x2 w; w.x = pack2(v[i][0] * rstd * gv[0], v[i][1] * rstd * gv[1]); w.y = pack2(v[i][2] * rstd * gv[2], v[i][3] * rstd * gv[3]);
        *(u32x2*)(hr + (i * 64 + lane) * 4) = w;
    }
}
__device__ __forceinline__ void build_moe_tables(LAS int* L, const unsigned* cnt) {
    if (threadIdx.x == 0) {
        int t = 0, p = 0;
        for (int e = 0; e < NEXP; ++e) { const int c = (int)__hip_atomic_load(cnt + e * 64, __ATOMIC_RELAXED, __HIP_MEMORY_SCOPE_AGENT); L[LI_TB + e] = t; L[LI_PS + e] = p; L[LI_CN + e] = c; const int nt = (c + 255) >> 8; t += nt; p += nt * 256; }
        L[LI_TB + NEXP] = t; L[LI_PS + NEXP] = p;
    }
    __syncthreads();
}

struct Args { const float* in[18]; float* out; unsigned char* ws; int ph_lo, ph_hi; };
typedef const __attribute__((address_space(4))) Args* CArgsP;
__device__ __forceinline__ CArgsP kargs() { unsigned long long p = (unsigned long long)__builtin_amdgcn_kernarg_segment_ptr(); asm volatile("" : "+s"(p)); return (CArgsP)p; }
#define PHASE_PTRS \
    const CArgsP ka = kargs(); unsigned char* const ws = ka->ws; \
    unsigned* const ctrl = (unsigned*)(ws + OFF_CTRL); const float* const x_in = ka->in[0]; \
    bf16_t* const WinT = (bf16_t*)(ws + OFF_WIN); bf16_t* const WaT = (bf16_t*)(ws + OFF_WA); bf16_t* const WppT = (bf16_t*)(ws + OFF_WPP); bf16_t* const WoT = (bf16_t*)(ws + OFF_WO); \
    bf16_t* const WguT = (bf16_t*)(ws + OFF_WGU); bf16_t* const WdT = (bf16_t*)(ws + OFF_WD); \
    bf16_t* const Hb = (bf16_t*)(ws + OFF_H); bf16_t* const MG = Hb; bf16_t* const PROJ = (bf16_t*)(ws + OFF_PROJ); bf16_t* const ACT = (bf16_t*)(ws + OFF_ACT); bf16_t* const YB = (bf16_t*)(ws + OFF_YB); \
    bf16_t* const AC = (bf16_t*)(ws + OFF_AC); bf16_t* const PL = (bf16_t*)(ws + OFF_PL); bf16_t* const OG = (bf16_t*)(ws + OFF_OG); bf16_t* const T1 = (bf16_t*)(ws + OFF_T1); \
    f32x2* const ML = (f32x2*)(ws + OFF_ML); float* const XB = (float*)(ws + OFF_XB); int* const tokE = (int*)(ws + OFF_TOKE); float* const tokW = (float*)(ws + OFF_TOKW); int* const asg = (int*)(ws + OFF_ASG); \
    (void)ctrl; (void)x_in; (void)WinT; (void)WaT; (void)WppT; (void)WoT; (void)WguT; (void)WdT; (void)Hb; (void)MG; (void)PROJ; (void)ACT; (void)YB; (void)AC; (void)PL; (void)OG; (void)T1; (void)ML; (void)XB; (void)tokE; (void)tokW; (void)asg
#define LAYER_PTRS PHASE_PTRS; const int tid = opaque_tid(), lane = tid & 63, wid = __builtin_amdgcn_readfirstlane(tid >> 6), gw = vcu * NWAVES + wid; (void)lane; (void)gw; const float* const xin = (l == 0) ? x_in : XB; unsigned* const cnt = ctrl + CW_CNT + l * 2048; (void)xin; (void)cnt

__global__ void __launch_bounds__(NTHREADS, 2) fwd_kernel(Args args) {
    extern __shared__ __attribute__((aligned(16))) unsigned char lds_raw[];
    LAS unsigned char* lds = (LAS unsigned char*)lds_raw;
    LAS int* LC = (LAS int*)(lds + LCTL_OFF);
    const int G = gridDim.x, bx = blockIdx.x;
    const int vcu = (G % 8 == 0) ? (bx % 8) * (G / 8) + bx / 8 : bx;
    if (threadIdx.x < 4) LC[LI_BAR + threadIdx.x] = 0;
    __syncthreads();
    XcdBarrier bar; bar.bar = (unsigned*)(args.ws + OFF_CTRL) + CW_BAR; bar.x = 0; bar.st = nullptr;
    if (MK_N_LAUNCHES == 1) bar = xcd_barrier_post(bar.bar, (volatile LAS unsigned*)(LC + LI_BAR));
    const int lo = args.ph_lo, hi = args.ph_hi;
#ifndef PHASE_MASK
#define PHASE_MASK 0x3ff
#endif
#define EN(j) (((PHASE_MASK) >> (j)) & 1)
#define IN(k) (lo <= (k) && (k) < hi)
#define SEAM(k) do { if (IN(k) && IN((k) + 1)) xcd_barrier(bar); } while (0)
    const int NGW = G * NWAVES;

    if (EN(9) && IN(0)) {
        asm volatile("; PHASE_MARK 9");
        PHASE_PTRS; const int tid = opaque_tid(), lane = tid & 63, wid = __builtin_amdgcn_readfirstlane(tid >> 6), gw = vcu * NWAVES + wid;
        LAS float* t = (LAS float*)lds;
        for (int it = bx; it < 2 * (1024 + 128 + 256); it += G) {
            const int l = it / 1408, r = it % 1408;
            if (r < 1024) tr_item(t, ka->in[2] + (size_t)l * DM * INW, WinT + (size_t)l * INW * DM, DM, INW, 0, r);
            else if (r < 1152) tr_item(t, ka->in[5] + (size_t)l * AW * DM, WaT + (size_t)l * DM * AW, AW, DM, 0, r - 1024);
            else tr_item(t, ka->in[9] + (size_t)l * DM * DM, WoT + (size_t)l * DM * DM, DM, DM, 0, r - 1152);
        }
        for (int o = bx * NTHREADS + tid; o < DEPTH * PW * DM; o += G * NTHREADS) {
            const int l = o / (PW * DM), r = o % (PW * DM), k = r / DM, n = r % DM, g = k >> 7;
            const float* wm = ka->in[6] + (size_t)l * 4 * 128 * 128 + (size_t)k * 128;
            const float* sc = ka->in[7] + (size_t)l * PW + g * 128;
            const float* wp = ka->in[8] + (size_t)l * PW * DM + (size_t)(g * 128) * DM + n;
            float a = 0.f;
            for (int dd = 0; dd < 128; ++dd) a += wm[dd] * sc[dd] * wp[(size_t)dd * DM];
            WppT[(size_t)l * DM * PW + (size_t)n * PW + k] = f2bf(a);
        }
        convert_experts(t, ka->in[15], ka->in[16], ka->in[17], WguT, WdT, G, bx);
        for (int m = gw; m < NTOK; m += NGW) norm_row(x_in + (size_t)m * DM, ka->in[1], Hb + (size_t)m * DM, lane);
    }
    SEAM(0);

    for (int l = 0; l < DEPTH; ++l) {
        const int pb = 1 + 9 * l;
        if (EN(0) && IN(pb + 0)) {
            asm volatile("; PHASE_MARK 0");
            LAYER_PTRS;
            pg8::DenseOrder S; S.init(Hb, WinT + (size_t)l * INW * DM, NTOK, INW, DM, G, bx);
            pg8::EpiProj E{PROJ, ka->in[3] + (size_t)l * HD, ka->in[4] + (size_t)l * HD};
            pg8::gemm_phase<pg8::EpiProj, pg8::DenseOrder, 1, false>(lds, DM, S, E);
        }
        SEAM(pb + 0);
        if (EN(1) && IN(pb + 1)) {
            asm volatile("; PHASE_MARK 1");
            LAYER_PTRS;
            for (int u = vcu; u < 1536; u += G) attn_unit(lds, PROJ, OG, ML, u);
        }
        SEAM(pb + 1);
        if (EN(2) && IN(pb + 2)) {
            asm volatile("; PHASE_MARK 2");
            LAYER_PTRS;
            for (int tok = gw; tok < NTOK; tok += NGW) {
                const int c0 = 8 * lane, hh = lane >> 3;
                f32x2 s[3]; float M = -3.0e38f;
#pragma unroll
                for (int g = 0; g < 3; ++g) { s[g] = ML[((size_t)g * NTOK + tok) * 8 + hh]; M = fmaxf(M, s[g][0]); }
                float w[3], W = 0.f;
#pragma unroll
                for (int g = 0; g < 3; ++g) { w[g] = s[g][1] * __expf(s[g][0] - M); W += w[g]; }
                const float iw = 1.0f / W;
                float o[8] = {0.f, 0.f, 0.f, 0.f, 0.f, 0.f, 0.f, 0.f};
#pragma unroll
                for (int g = 0; g < 3; ++g) { const u32x4 v = *(const u32x4*)(OG + ((size_t)g * NTOK + tok) * AW + c0); const float f = w[g] * iw;
                    o[0] += f * bflo(v.x); o[1] += f * bfhi(v.x); o[2] += f * bflo(v.y); o[3] += f * bfhi(v.y); o[4] += f * bflo(v.z); o[5] += f * bfhi(v.z); o[6] += f * bflo(v.w); o[7] += f * bfhi(v.w); }
                u32x4 ow; ow.x = pack2(o[0], o[1]); ow.y = pack2(o[2], o[3]); ow.z = pack2(o[4], o[5]); ow.w = pack2(o[6], o[7]);
                *(u32x4*)(AC + (size_t)tok * AW + c0) = ow;
                const int pos = tok & (SEQ - 1), wnd = 2 << (lane >> 4), cntp = min(pos + 1, wnd);
                float sm[8] = {0.f, 0.f, 0.f, 0.f, 0.f, 0.f, 0.f, 0.f};
                u32x4 u0 = {0u, 0u, 0u, 0u};
                for (int j = 0; j < cntp; ++j) { const u32x4 v = *(const u32x4*)(PROJ + (size_t)(tok - j) * INW + 3 * AW + c0); if (j == 0) u0 = v;
                    sm[0] += bflo(v.x); sm[1] += bfhi(v.x); sm[2] += bflo(v.y); sm[3] += bfhi(v.y); sm[4] += bflo(v.z); sm[5] += bfhi(v.z); sm[6] += bflo(v.w); sm[7] += bfhi(v.w); }
                const float ic = 1.0f / (float)cntp;
                u32x4 pw; pw.x = pack2(sm[0] * ic - bflo(u0.x), sm[1] * ic - bfhi(u0.x)); pw.y = pack2(sm[2] * ic - bflo(u0.y), sm[3] * ic - bfhi(u0.y));
                pw.z = pack2(sm[4] * ic - bflo(u0.z), sm[5] * ic - bfhi(u0.z)); pw.w = pack2(sm[6] * ic - bflo(u0.w), sm[7] * ic - bfhi(u0.w));
                *(u32x4*)(PL + (size_t)tok * PW + c0) = pw;
            }
        }
        SEAM(pb + 2);
        if (EN(3) && IN(pb + 3)) {
            asm volatile("; PHASE_MARK 3");
            LAYER_PTRS;
            { pg8::DenseOrder S; S.init(AC, WaT + (size_t)l * DM * AW, NTOK, DM, AW, G, bx);
              pg8::EpiGate<0> E{PROJ + 2048, nullptr, T1};
              pg8::gemm_phase<pg8::EpiGate<0>, pg8::DenseOrder, 0, false>(lds, AW, S, E); }
            { pg8::DenseOrder S; S.init(PL, WppT + (size_t)l * DM * PW, NTOK, DM, PW, G, bx);
              pg8::EpiGate<1> E{PROJ + 3072, T1, MG};
              pg8::gemm_phase<pg8::EpiGate<1>, pg8::DenseOrder, 0, false>(lds, PW, S, E); }
        }
        SEAM(pb + 3);
        if (EN(4) && IN(pb + 4)) {
            asm volatile("; PHASE_MARK 4");
            LAYER_PTRS;
            pg8::DenseOrder S; S.init(MG, WoT + (size_t)l * DM * DM, NTOK, DM, DM, G, bx);
            pg8::EpiResid E{xin, XB};
            pg8::gemm_phase<pg8::EpiResid, pg8::DenseOrder, 0, false>(lds, DM, S, E);
        }
        SEAM(pb + 4);
        if (EN(5) && IN(pb + 5)) {
            asm volatile("; PHASE_MARK 5");
            LAYER_PTRS;
            LAS int* aE = (LAS int*)lds; LAS float* aW = (LAS float*)(lds + 1024); LAS int* bs = (LAS int*)(lds + 2048);
            const float* g2 = ka->in[10] + (size_t)l * DM; const float* wrg = ka->in[11] + (size_t)l * DM * 4; const float* brg = ka->in[12] + (size_t)l * 4;
            const float* wre = ka->in[13] + (size_t)l * 4 * DM * 8; const float* bre = ka->in[14] + (size_t)l * 32;
            for (int chunk = bx; chunk < NTOK / 64; chunk += G) {
                for (int it = 0; it < 8; ++it) {
                    const int ti = wid * 8 + it, tok = chunk * 64 + ti;
                    const float* xr = XB + (size_t)tok * DM;
                    f32x4 v[4]; float ss = 0.f;
#pragma unroll
                    for (int i = 0; i < 4; ++i) { v[i] = *(const f32x4*)(xr + (i * 64 + lane) * 4); ss += (v[i][0] * v[i][0] + v[i][1] * v[i][1]) + (v[i][2] * v[i][2] + v[i][3] * v[i][3]); }
                    ss = wave_sum(ss);
                    const float rstd = rsqrtf(ss * (1.0f / DM) + RMS_EPS);
                    float gl[4] = {0.f, 0.f, 0.f, 0.f};
#pragma unroll
                    for (int i = 0; i < 4; ++i) {
                        const int d0 = (i * 64 + lane) * 4;
                        const f32x4 gv = *(const f32x4*)(g2 + d0);
#pragma unroll
                        for (int j = 0; j < 4; ++j) v[i][j] = v[i][j] * rstd * gv[j];
                        u32x2 w; w.x = pack2(v[i][0], v[i][1]); w.y = pack2(v[i][2], v[i][3]);
                        *(u32x2*)(Hb + (size_t)tok * DM + d0) = w;
#pragma unroll
                        for (int j = 0; j < 4; ++j) { const f32x4 wv = *(const f32x4*)(wrg + (size_t)(d0 + j) * 4);
#pragma unroll
                            for (int o = 0; o < 4; ++o) gl[o] += v[i][j] * wv[o]; }
                    }
#pragma unroll
                    for (int o = 0; o < 4; ++o) gl[o] = wave_sum(gl[o]) + brg[o];
                    int gs = 0; float gm = gl[0];
#pragma unroll
                    for (int o = 1; o < 4; ++o) if (gl[o] > gm) { gm = gl[o]; gs = o; }
                    gs = __builtin_amdgcn_readfirstlane(gs);
                    float gden = 0.f;
#pragma unroll
                    for (int o = 0; o < 4; ++o) gden += __expf(gl[o] - gm);
                    const float ggate = 1.0f / gden;
                    float el[8];
#pragma unroll
                    for (int o = 0; o < 8; ++o) el[o] = 0.f;
                    const float* we = wre + (size_t)gs * DM * 8;
#pragma unroll
                    for (int i = 0; i < 4; ++i) {
                        const int d0 = (i * 64 + lane) * 4;
#pragma unroll
                        for (int j = 0; j < 4; ++j) { const f32x4 w0 = *(const f32x4*)(we + (size_t)(d0 + j) * 8), w1 = *(const f32x4*)(we + (size_t)(d0 + j) * 8 + 4);
#pragma unroll
                            for (int o = 0; o < 4; ++o) { el[o] += v[i][j] * w0[o]; el[4 + o] += v[i][j] * w1[o]; } }
                    }
#pragma unroll
                    for (int o = 0; o < 8; ++o) el[o] = wave_sum(el[o]) + bre[gs * 8 + o];
                    int i0 = 0; float m0 = el[0];
#pragma unroll
                    for (int o = 1; o < 8; ++o) if (el[o] > m0) { m0 = el[o]; i0 = o; }
                    int i1 = 0; float m1 = -3.0e38f;
#pragma unroll
                    for (int o = 0; o < 8; ++o) if (o != i0 && el[o] > m1) { m1 = el[o]; i1 = o; }
                    const float e1 = __expf(m1 - m0);
                    if (lane == 0) { aE[2 * ti] = gs * 8 + i0; aE[2 * ti + 1] = gs * 8 + i1; aW[2 * ti] = ggate / (1.0f + e1); aW[2 * ti + 1] = ggate * e1 / (1.0f + e1); }
                }
                __syncthreads();
                int myE = 0, rank = 0;
                if (tid < 128) { myE = aE[tid]; for (int a = 0; a < tid; ++a) rank += (aE[a] == myE) ? 1 : 0; }
                if (tid < NEXP) { int c = 0; for (int a = 0; a < 128; ++a) c += (aE[a] == tid) ? 1 : 0;
                    bs[tid] = c ? (int)__hip_atomic_fetch_add(cnt + tid * 64, (unsigned)c, __ATOMIC_RELAXED, __HIP_MEMORY_SCOPE_AGENT) : 0; }
                __syncthreads();
                if (tid < 128) { const int slot = bs[myE] + rank, tok = chunk * 64 + (tid >> 1);
                    tokE[(size_t)myE * ECAP + slot] = tok; tokW[(size_t)myE * ECAP + slot] = aW[tid]; asg[tok * 2 + (tid & 1)] = myE * ECAP + slot; }
                __syncthreads();
            }
        }
        SEAM(pb + 5);
        if (EN(6) && IN(pb + 6)) {
            asm volatile("; PHASE_MARK 6");
            LAYER_PTRS;
            build_moe_tables(LC, cnt);
            pg8::MoeOrder S{(const char*)Hb, (const char*)WguT, (size_t)DM * DM * 2, DM, LC + LI_TB, LC + LI_PS, LC + LI_CN, tokE, G, vcu, true};
            pg8::EpiSwiGLU E{ACT};
            pg8::gemm_phase<pg8::EpiSwiGLU, pg8::MoeOrder, 0, true>(lds, DM, S, E);
        }
        SEAM(pb + 6);
        if (EN(7) && IN(pb + 7)) {
            asm volatile("; PHASE_MARK 7");
            LAYER_PTRS;
            build_moe_tables(LC, cnt);
            pg8::MoeOrder S{(const char*)ACT, (const char*)WdT, (size_t)DM * EH * 2, EH, LC + LI_TB, LC + LI_PS, LC + LI_CN, tokE, G, vcu, false};
            pg8::EpiDown E{YB, tokW};
            pg8::gemm_phase<pg8::EpiDown, pg8::MoeOrder, 0, false>(lds, EH, S, E);
        }
        SEAM(pb + 7);
        if (EN(8) && IN(pb + 8)) {
            asm volatile("; PHASE_MARK 8");
            LAYER_PTRS;
            build_moe_tables(LC, cnt);
            const bool lastl = (l == DEPTH - 1);
            const float* g1n = ka->in[1] + (size_t)(lastl ? 0 : (l + 1)) * DM;
            for (int tok = gw; tok < NTOK; tok += NGW) {
                const int i0 = asg[tok * 2], i1 = asg[tok * 2 + 1];
                const size_t s0 = (size_t)(LC[LI_PS + (i0 >> 14)] + (i0 & (ECAP - 1))), s1 = (size_t)(LC[LI_PS + (i1 >> 14)] + (i1 & (ECAP - 1)));
                f32x4 v[4]; float ss = 0.f;
#pragma unroll
                for (int i = 0; i < 4; ++i) {
                    const int d0 = (i * 64 + lane) * 4;
                    const f32x4 xv = *(const f32x4*)(XB + (size_t)tok * DM + d0);
                    const u32x2 a = *(const u32x2*)(YB + s0 * DM + d0), b = *(const u32x2*)(YB + s1 * DM + d0);
                    v[i][0] = xv[0] + bflo(a.x) + bflo(b.x); v[i][1] = xv[1] + bfhi(a.x) + bfhi(b.x); v[i][2] = xv[2] + bflo(a.y) + bflo(b.y); v[i][3] = xv[3] + bfhi(a.y) + bfhi(b.y);
                    ss += (v[i][0] * v[i][0] + v[i][1] * v[i][1]) + (v[i][2] * v[i][2] + v[i][3] * v[i][3]);
                    *(f32x4*)((lastl ? ka->out : XB) + (size_t)tok * DM + d0) = v[i];
                }
                if (!lastl) {
                    ss = wave_sum(ss);
                    const float rstd = rsqrtf(ss * (1.0f / DM) + RMS_EPS);
#pragma unroll
                    for (int i = 0; i < 4; ++i) { const int d0 = (i * 64 + lane) * 4; const f32x4 gv = *(const f32x4*)(g1n + d0);
                        u32x2 w; w.x = pack2(v[i][0] * rstd * gv[0], v[i][1] * rstd * gv[1]); w.y = pack2(v[i][2] * rstd * gv[2], v[i][3] * rstd * gv[3]);
                        *(u32x2*)(Hb + (size_t)tok * DM + d0) = w; }
                }
            }
            if (!lastl) {
                __syncthreads();
                convert_experts((LAS float*)lds, ka->in[15] + (size_t)(l + 1) * NEXP * DM * EH, ka->in[16] + (size_t)(l + 1) * NEXP * DM * EH, ka->in[17] + (size_t)(l + 1) * NEXP * EH * DM, WguT, WdT, G, bx);
            }
        }
        if (l + 1 < DEPTH) SEAM(pb + 8);
    }
#undef IN
#undef SEAM
}

extern "C" void kernel_launch(void* const* d_in, const int* in_sizes, int n_in, void* d_out, int out_size, void* d_ws, size_t ws_size, hipStream_t stream) {
    (void)in_sizes; (void)out_size;
    static int grid = 0;
    if (grid == 0) {
        int dev = 0, cus = 0;
        if (hipGetDevice(&dev) != hipSuccess || hipDeviceGetAttribute(&cus, hipDeviceAttributeMultiprocessorCount, dev) != hipSuccess) { grid = -1; return; }
        if (hipFuncSetAttribute((const void*)fwd_kernel, hipFuncAttributeMaxDynamicSharedMemorySize, LDS_BYTES) != hipSuccess) { grid = -1; return; }
        int per_cu = 0;
        (void)hipOccupancyMaxActiveBlocksPerMultiprocessor(&per_cu, (const void*)fwd_kernel, NTHREADS, LDS_BYTES);
        (void)hipGetLastError();
        grid = cus;
        if (n_in != 18 || ws_size < WS_NEED) { fprintf(stderr, "kernel_launch: unexpected inputs (n_in %d, ws %zu)\n", n_in, ws_size); grid = -1; return; }
    }
    if (grid < 0) return;
    (void)hipMemsetAsync((char*)d_ws + OFF_CTRL, 0, CTRL_BYTES, stream);
    Args a{};
    for (int i = 0; i < 18; ++i) a.in[i] = (const float*)d_in[i];
    a.out = (float*)d_out; a.ws = (unsigned char*)d_ws;
    constexpr int NPH = 1 + 9 * DEPTH;
    if (MK_N_LAUNCHES == 1) { a.ph_lo = 0; a.ph_hi = NPH; hipLaunchKernelGGL(fwd_kernel, dim3(grid), dim3(NTHREADS), LDS_BYTES, stream, a); }
    else { for (int p = 0; p < NPH; ++p) { a.ph_lo = p; a.ph_hi = p + 1; hipLaunchKernelGGL(fwd_kernel, dim3(grid), dim3(NTHREADS), LDS_BYTES, stream, a); } }
}
```

```cpp
#include <hip/hip_runtime.h>
#include <stdint.h>
#include <stdio.h>

#define LAS __attribute__((address_space(3)))
typedef unsigned short bf16_t;
typedef short bf16x8 __attribute__((ext_vector_type(8)));
typedef float f32x2 __attribute__((ext_vector_type(2)));
typedef float f32x4 __attribute__((ext_vector_type(4)));
typedef float f32x16 __attribute__((ext_vector_type(16)));
typedef unsigned u32x2 __attribute__((ext_vector_type(2)));
typedef unsigned u32x4 __attribute__((ext_vector_type(4)));
typedef __bf16 bfv2 __attribute__((ext_vector_type(2)));

#ifndef MK_N_LAUNCHES
#define MK_N_LAUNCHES 1
#endif

constexpr int DM = 1024, SEQ = 4096, NTOK = 16384, DEPTH = 2;
constexpr int HD = 64, AW = 512, PW = 512, INW = 4096;
constexpr int NEXP = 32, EH = 512, ECAP = NTOK;
constexpr float RMS_EPS = 1e-6f;
constexpr int NTHREADS = 512, NWAVES = 8;

constexpr size_t MB = 1024 * 1024;
constexpr size_t OFF_CTRL = 0, CTRL_BYTES = 65536;
constexpr size_t OFF_WIN  = 1 * MB;
constexpr size_t OFF_WA   = OFF_WIN + 16 * MB;
constexpr size_t OFF_WPP  = OFF_WA + 2 * MB;
constexpr size_t OFF_WO   = OFF_WPP + 2 * MB;
constexpr size_t OFF_WGU  = OFF_WO + 4 * MB;
constexpr size_t OFF_WD   = OFF_WGU + 64 * MB;
constexpr size_t OFF_H    = OFF_WD + 32 * MB;
constexpr size_t OFF_PROJ = OFF_H + 32 * MB;
constexpr size_t OFF_ACT  = OFF_PROJ;
constexpr size_t OFF_YB   = OFF_PROJ + 40 * MB;
constexpr size_t OFF_AC   = OFF_PROJ + 128 * MB;
constexpr size_t OFF_PL   = OFF_AC + 16 * MB;
constexpr size_t OFF_OG   = OFF_PL + 16 * MB;
constexpr size_t OFF_T1   = OFF_OG;
constexpr size_t OFF_ML   = OFF_OG + 48 * MB;
constexpr size_t OFF_XB   = OFF_ML + 4 * MB;
constexpr size_t OFF_TOKE = OFF_XB + 64 * MB;
constexpr size_t OFF_TOKW = OFF_TOKE + 2 * MB;
constexpr size_t OFF_ASG  = OFF_TOKW + 2 * MB;
constexpr size_t WS_NEED  = OFF_ASG + 1 * MB;
constexpr int CW_CNT = 1024;
constexpr int CW_BAR = 8192;
constexpr int RING_BYTES = 131072, LCTL_OFF = RING_BYTES, LDS_BYTES = RING_BYTES + 1024;
constexpr int LI_BAR = 0, LI_TB = 16, LI_PS = 64, LI_CN = 112;

__device__ __forceinline__ float bflo(unsigned w) { return __uint_as_float(w << 16); }
__device__ __forceinline__ float bfhi(unsigned w) { return __uint_as_float(w & 0xffff0000u); }
__device__ __forceinline__ unsigned pack2(float lo, float hi) { f32x2 v = {lo, hi}; return __builtin_bit_cast(unsigned, __builtin_convertvector(v, bfv2)); }
__device__ __forceinline__ bf16_t f2bf(float f) { return (bf16_t)(pack2(f, 0.f) & 0xffffu); }
__device__ __forceinline__ float wave_sum(float v) {
#pragma unroll
    for (int o = 32; o >= 1; o >>= 1) v += __shfl_xor(v, o);
    return v;
}
__device__ __forceinline__ int opaque_tid() { int t = (int)threadIdx.x; asm volatile("" : "+v"(t)); return t; }
__device__ __forceinline__ float sigmoidf_(float v) { return 1.0f / (1.0f + __expf(-v)); }

#define XB_TMO      128
#define XB_XCNT(j)  (256  + 64 * (j))
#define XB_XSUB(j)  (1280 + 64 * (j))
#define XB_XGEN(j)  (2304 + 64 * (j))
#define XB_TOP      3328
#define XB_TOPGEN   3392
#define XCD_BAR_WORDS 3456
#define XB_SPIN_CAP (1u << 18)
__device__ __forceinline__ unsigned xb_ld(unsigned* p)              { return __hip_atomic_load(p, __ATOMIC_RELAXED, __HIP_MEMORY_SCOPE_AGENT); }
__device__ __forceinline__ unsigned xb_add(unsigned* p, unsigned v) { return __hip_atomic_fetch_add(p, v, __ATOMIC_RELAXED, __HIP_MEMORY_SCOPE_AGENT); }
__device__ __forceinline__ unsigned xb_xcc_id() { return (unsigned)__builtin_amdgcn_s_getreg((3 << 11) | 20) & 0xFu; }
#define XB_SPIN(cond, bar) do { unsigned _sp = 0; while (cond) { __builtin_amdgcn_s_sleep(1); \
    if ((++_sp & 255u) == 0u) { if (xb_ld(&(bar)[XB_TMO])) break; if (_sp > XB_SPIN_CAP) { atomicAdd(&(bar)[XB_TMO], 1u); break; } } } } while (0)
struct XcdBarrier { unsigned* bar; unsigned x; volatile LAS unsigned* st; };
__device__ __forceinline__ XcdBarrier xcd_barrier_post(unsigned* bar, volatile LAS unsigned* st) {
    XcdBarrier b; b.bar = bar; b.x = xb_xcc_id(); b.st = st;
    if (threadIdx.x == 0) (void)xb_add(&bar[XB_XCNT(b.x)], 1u);
    return b;
}
__device__ __forceinline__ void xcd_barrier_complete(unsigned* bar, unsigned x, unsigned& nloc, unsigned& nx) {
    const unsigned G = gridDim.x * gridDim.y * gridDim.z;
    unsigned sum, cnt, mine, sp = 0u;
    for (;;) {
        sum = 0u; cnt = 0u; mine = 0u;
#pragma unroll
        for (unsigned j = 0; j < 16; ++j) { const unsigned c = xb_ld(&bar[XB_XCNT(j)]); sum += c; cnt += (c > 0u) ? 1u : 0u; mine = (j == x) ? c : mine; }
        if (sum == G) break;
        __builtin_amdgcn_s_sleep(1);
        if ((++sp & 255u) == 0u) { if (xb_ld(&bar[XB_TMO])) break; if (sp > XB_SPIN_CAP) { atomicAdd(&bar[XB_TMO], 1u); break; } }
    }
    nloc = mine > 0u ? mine : 1u; nx = cnt > 0u ? cnt : 1u;
}
__device__ __forceinline__ void xcd_barrier(const XcdBarrier& b) {
    asm volatile("s_waitcnt vmcnt(0)" ::: "memory");
    __syncthreads();
    if (threadIdx.x == 0) {
        unsigned* bar = b.bar;
        __builtin_amdgcn_s_waitcnt(0);
        unsigned nloc = b.st[0], nx = b.st[1];
        if (nloc == 0u) { xcd_barrier_complete(bar, b.x, nloc, nx); b.st[0] = nloc; b.st[1] = nx; }
        const unsigned old = xb_add(&bar[XB_XSUB(b.x)], 1u);
        const unsigned gen = old / nloc;
        if (old + 1u == (gen + 1u) * nloc) {
            __builtin_amdgcn_fence(__ATOMIC_RELEASE, "agent");
            asm volatile("s_waitcnt vmcnt(0)" ::: "memory");
            const unsigned og = xb_add(&bar[XB_TOP], 1u);
            const unsigned tg = og / nx;
            if (og + 1u == (tg + 1u) * nx) xb_add(&bar[XB_TOPGEN], 1u);
            else XB_SPIN(xb_ld(&bar[XB_TOPGEN]) == tg, bar);
            __builtin_amdgcn_fence(__ATOMIC_ACQUIRE, "agent");
            xb_add(&bar[XB_XGEN(b.x)], 1u);
            asm volatile("s_waitcnt vmcnt(0)" ::: "memory");
        } else {
            XB_SPIN(xb_ld(&bar[XB_XGEN(b.x)]) == gen, bar);
            __builtin_amdgcn_fence(__ATOMIC_ACQUIRE, "agent");
            asm volatile("s_waitcnt vmcnt(0)" ::: "memory");
        }
    }
    __syncthreads();
}

namespace pg8 {
constexpr int BM = 256, BK = 64, HALF = 128, HTB = HALF * BK * 2, NXCD = 8, WGM = 8;
__device__ __forceinline__ int lds_byte(int r, int c) { const int st = (r >> 4) * 2 + (c >> 5), rr = r & 15, cc = c & 31, ob = rr * 64 + cc * 2; return st * 1024 + (ob ^ (((ob >> 9) & 1) << 5)); }
__device__ __forceinline__ void stage_rc(int b, int& R, int& C) { const int st = b / 1024, sb = b % 1024, swz = sb ^ (((sb >> 9) & 1) << 5); R = (st >> 1) * 16 + swz / 64; C = (st & 1) * 32 + (swz % 64) / 2; }
__device__ __forceinline__ int perm32(int rho) { const int n = rho >> 4, i = rho & 15; return 8 * (i >> 2) + 4 * n + (i & 3); }

struct Unit { const char* A; const char* B; int row0, col0, e, nvalid, j0; };

struct DenseOrder {
    const char* A; const char* Bt; int K, nM, nN, nwg, G, c;
    __device__ __forceinline__ void init(const void* A_, const void* Bt_, int M, int N, int K_, int G_, int c_) { A = (const char*)A_; Bt = (const char*)Bt_; K = K_; nM = M / BM; nN = N / BM; nwg = nM * nN; G = G_; c = c_; }
    __device__ __forceinline__ bool next(int i, Unit& u) const {
        const long L = (long)i * G + c; if (L >= nwg) return false;
        int wgid = (int)L; { const int q = nwg / NXCD, r = nwg % NXCD, xcd = wgid % NXCD, off = wgid / NXCD; wgid = (xcd < r ? xcd * (q + 1) : r * (q + 1) + (xcd - r) * q) + off; }
        const int nig = WGM * nN, gid = wgid / nig, fm = gid * WGM, gsz = (nM - fm) < WGM ? (nM - fm) : WGM;
        const int pm = fm + ((wgid % nig) % gsz), pn = (wgid % nig) / gsz;
        u.A = A + (size_t)pm * BM * K * 2; u.B = Bt + (size_t)pn * BM * K * 2; u.row0 = pm * BM; u.col0 = pn * BM; u.e = 0; u.nvalid = BM; u.j0 = 0; return true;
    }
    __device__ __forceinline__ unsigned row_off(const Unit&, int) const { return 0u; }
};
struct MoeOrder {
    const char* A; const char* Bt; size_t bExp; int K; const LAS int* tb; const LAS int* ps; const LAS int* cn; const int* tokE; int G, c; bool gather;
    __device__ __forceinline__ bool next(int i, Unit& u) const {
        const int L = i * G + c, total = tb[NEXP] * 4; if (L >= total) return false;
        const int rt = L >> 2, pn = L & 3;
        int e = 0;
        while (e < NEXP - 1 && tb[e + 1] <= rt) ++e;
        e = __builtin_amdgcn_readfirstlane(e);
        const int j = rt - __builtin_amdgcn_readfirstlane(tb[e]);
        const int pse = __builtin_amdgcn_readfirstlane(ps[e]), cne = __builtin_amdgcn_readfirstlane(cn[e]);
        u.e = e; u.row0 = pse + BM * j; u.col0 = pn * BM; u.nvalid = min(BM, cne - BM * j); u.j0 = e * ECAP + BM * j;
        u.B = Bt + (size_t)e * bExp + (size_t)pn * BM * K * 2;
        u.A = gather ? A : A + (size_t)u.row0 * K * 2;
        return true;
    }
    __device__ __forceinline__ unsigned row_off(const Unit& u, int R) const { const int t = R < u.nvalid ? tokE[u.j0 + R] : 0; return (unsigned)t * (unsigned)(K * 2); }
};

template <class Epi, class Sched, int BMODE, bool GATHER>
__device__ __forceinline__ void gemm_phase(LAS unsigned char* lds, const int K, const Sched& S, const Epi& E) {
    const int tid = opaque_tid(), wid = __builtin_amdgcn_readfirstlane(tid >> 6), lane = tid & 63, wr = wid >> 2, wc = wid & 3, fr = lane & 15, fq = lane >> 4;
    const int nt = K / BK;
    unsigned voffA[2][2], voffAn[2][2], voffB[2]; int RA[2], CA[2];
#pragma unroll
    for (int i = 0; i < 2; ++i) { int R, C; stage_rc(tid * 16 + i * 8192, R, C); RA[i] = R; CA[i] = C;
        const int Rb = (BMODE == 1) ? (64 * (R >> 5) + perm32(R & 31)) : (Epi::PERM ? ((R & ~31) + perm32(R & 31)) : R);
        voffB[i] = (unsigned)(Rb * K + C) * 2u;
#pragma unroll
        for (int h = 0; h < 2; ++h) { voffA[h][i] = (unsigned)((h * HALF + R) * K + C) * 2u; voffAn[h][i] = voffA[h][i]; } }
    const size_t kstep = (size_t)(BK * 2);
    const size_t hstepB = (size_t)((BMODE == 1) ? 32 : HALF) * K * 2;
    const unsigned ldsw = (unsigned)wid * 1024u;
    const int aoff = lds_byte(wr * 64 + fr, fq * 8), boff = lds_byte(wc * 32 + fr, fq * 8);
#define PG8_SA(b, h) (((b) * 2 + (h)) * HTB)
#define PG8_SB(b, h) ((4 + (b) * 2 + (h)) * HTB)
#define PG8_STAGE2(bufoff, gbase, v0, v1) do { \
        __builtin_amdgcn_global_load_lds((const unsigned*)((const char*)(gbase) + (v0)), (LAS unsigned*)(lds + (bufoff) + ldsw), 16, 0, 0); \
        __builtin_amdgcn_global_load_lds((const unsigned*)((const char*)(gbase) + (v1)), (LAS unsigned*)(lds + (bufoff) + ldsw + 8192), 16, 0, 0); } while (0)
#define PG8_STAGEB(bufoff, gbase) PG8_STAGE2(bufoff, gbase, voffB[0], voffB[1])
#define PG8_STAGEA(bufoff, gbase, h, nx) PG8_STAGE2(bufoff, gbase, ((GATHER && (nx)) ? voffAn[h][0] : voffA[h][0]), ((GATHER && (nx)) ? voffAn[h][1] : voffA[h][1]))
#define PG8_LDA(dst, b, h) do { _Pragma("unroll") for (int m = 0; m < 4; ++m) _Pragma("unroll") for (int k = 0; k < 2; ++k) dst[m][k] = *(const LAS bf16x8*)(lds + PG8_SA(b, h) + aoff + m * 2048 + k * 1024); } while (0)
#define PG8_LDB(dst, b, h) do { _Pragma("unroll") for (int n = 0; n < 2; ++n) _Pragma("unroll") for (int k = 0; k < 2; ++k) dst[n][k] = *(const LAS bf16x8*)(lds + PG8_SB(b, h) + boff + n * 2048 + k * 1024); } while (0)
#define PG8_MMA(ai, bj, At, Bt) do { __builtin_amdgcn_s_setprio(1); _Pragma("unroll") for (int m = 0; m < 4; ++m) _Pragma("unroll") for (int n = 0; n < 2; ++n) _Pragma("unroll") for (int k = 0; k < 2; ++k) \
        acc[ai][bj][m][n] = __builtin_amdgcn_mfma_f32_16x16x32_bf16(Bt[n][k], At[m][k], acc[ai][bj][m][n], 0, 0, 0); __builtin_amdgcn_s_setprio(0); } while (0)
#define PG8_WAIT_V(n) asm volatile("s_waitcnt vmcnt(" #n ")" ::: "memory")
#define PG8_WAIT_L(n) asm volatile("s_waitcnt lgkmcnt(" #n ")" ::: "memory")
#define PG8_BAR __builtin_amdgcn_s_barrier()
#define PG8_SCHED __builtin_amdgcn_sched_barrier(0)
    Unit cur, nxt; int ui = 0;
    if (!S.next(0, cur)) return;
    if (GATHER) {
#pragma unroll
        for (int h = 0; h < 2; ++h)
#pragma unroll
            for (int i = 0; i < 2; ++i) voffA[h][i] = S.row_off(cur, h * HALF + RA[i]) + (unsigned)CA[i] * 2u;
    }
    f32x4 acc[2][2][4][2];
#pragma unroll
    for (int a = 0; a < 2; ++a)
#pragma unroll
        for (int b = 0; b < 2; ++b)
#pragma unroll
            for (int m = 0; m < 4; ++m)
#pragma unroll
                for (int n = 0; n < 2; ++n) acc[a][b][m][n] = (f32x4){0.f, 0.f, 0.f, 0.f};
    bf16x8 At[4][2], B0[2][2], B1[2][2];
    const char* cA = cur.A; const char* cB = cur.B;
    PG8_STAGEB(PG8_SB(0, 0), cB); PG8_STAGEB(PG8_SB(0, 1), cB + hstepB); PG8_STAGEA(PG8_SA(0, 0), cA, 0, false); PG8_STAGEA(PG8_SA(0, 1), cA, 1, false);
    if (wr == 1) PG8_BAR;
    PG8_WAIT_V(2); PG8_BAR;
    PG8_STAGEB(PG8_SB(1, 0), cB + kstep); PG8_STAGEA(PG8_SA(1, 0), cA + kstep, 0, false); PG8_STAGEB(PG8_SB(1, 1), cB + hstepB + kstep);
    PG8_WAIT_V(6); PG8_BAR;
    for (;;) {
        const bool has_next = S.next(ui + 1, nxt);
        if (GATHER) {
#pragma unroll
            for (int h = 0; h < 2; ++h)
#pragma unroll
                for (int i = 0; i < 2; ++i) voffAn[h][i] = has_next ? (S.row_off(nxt, h * HALF + RA[i]) + (unsigned)CA[i] * 2u) : voffA[h][i];
        }
        const char* nA = has_next ? nxt.A : cA; const char* nB = has_next ? nxt.B : cB;
        for (int t = 0; t < nt; t += 2) {
            const bool last = (t == nt - 2);
            const char* a1 = cA + (size_t)(t + 1) * kstep;
            const char* a2 = last ? nA : cA + (size_t)(t + 2) * kstep; const char* b2 = last ? nB : cB + (size_t)(t + 2) * kstep;
            const char* a3 = a2 + kstep; const char* b3 = b2 + kstep;
            PG8_LDB(B0, 0, 0); PG8_LDB(B1, 0, 1); PG8_SCHED; PG8_LDA(At, 0, 0); PG8_STAGEA(PG8_SA(1, 1), a1, 1, false);
            PG8_WAIT_V(8); PG8_WAIT_L(0); PG8_BAR; PG8_MMA(0, 0, At, B0); PG8_MMA(0, 1, At, B1); PG8_BAR; PG8_SCHED;
            PG8_LDA(At, 0, 1); PG8_STAGEB(PG8_SB(0, 0), b2); PG8_STAGEB(PG8_SB(0, 1), b2 + hstepB); PG8_STAGEA(PG8_SA(0, 0), a2, 0, last);
            PG8_WAIT_V(8); PG8_WAIT_L(0); PG8_BAR; PG8_MMA(1, 0, At, B0); PG8_MMA(1, 1, At, B1); PG8_BAR; PG8_SCHED;
            PG8_LDB(B0, 1, 0); PG8_LDB(B1, 1, 1); PG8_SCHED; PG8_LDA(At, 1, 0); PG8_STAGEA(PG8_SA(0, 1), a2, 1, last);
            PG8_WAIT_V(8); PG8_WAIT_L(0); PG8_BAR; PG8_MMA(0, 0, At, B0); PG8_MMA(0, 1, At, B1); PG8_BAR; PG8_SCHED;
            PG8_LDA(At, 1, 1); PG8_STAGEB(PG8_SB(1, 0), b3); PG8_STAGEB(PG8_SB(1, 1), b3 + hstepB); PG8_STAGEA(PG8_SA(1, 0), a3, 0, last);
            PG8_WAIT_V(8); PG8_WAIT_L(0); PG8_BAR; PG8_MMA(1, 0, At, B0); PG8_MMA(1, 1, At, B1); PG8_BAR; PG8_SCHED;
        }
        if (wr == 0) PG8_BAR;
        E(acc, cur, wr, wc, fr, fq);
        if (!has_next) break;
#pragma unroll
        for (int a = 0; a < 2; ++a)
#pragma unroll
            for (int b = 0; b < 2; ++b)
#pragma unroll
                for (int m = 0; m < 4; ++m)
#pragma unroll
                    for (int n = 0; n < 2; ++n) acc[a][b][m][n] = (f32x4){0.f, 0.f, 0.f, 0.f};
        cur = nxt; cA = nA; cB = nB; ++ui;
        if (GATHER) {
#pragma unroll
            for (int h = 0; h < 2; ++h)
#pragma unroll
                for (int i = 0; i < 2; ++i) voffA[h][i] = voffAn[h][i];
        }
        if (wr == 1) PG8_BAR;
    }
    PG8_WAIT_V(0);
    PG8_BAR;
#undef PG8_SA
#undef PG8_SB
#undef PG8_STAGE2
#undef PG8_STAGEA
#undef PG8_STAGEB
#undef PG8_LDA
#undef PG8_LDB
#undef PG8_MMA
#undef PG8_WAIT_V
#undef PG8_WAIT_L
#undef PG8_BAR
#undef PG8_SCHED
}

struct EpiProj {
    static constexpr bool PERM = true;
    bf16_t* out; const float* gq; const float* gk;
    __device__ __forceinline__ void operator()(const f32x4 (&acc)[2][2][4][2], const Unit& u, int wr, int wc, int fr, int fq) const {
        const int pn = u.col0 >> 8;
        const int row0 = u.row0 + wr * 64 + fr, colb = u.col0 + 64 * wc + 8 * fq;
        if (pn < 4) {
            const float* g = (pn < 2) ? gq : gk; const float post = (pn < 2) ? 0.125f : 1.0f;
            f32x4 gv[2][2];
#pragma unroll
            for (int bj = 0; bj < 2; ++bj)
#pragma unroll
                for (int n = 0; n < 2; ++n) gv[bj][n] = *(const f32x4*)(g + 32 * bj + 8 * fq + 4 * n) * post;
#pragma unroll
            for (int ai = 0; ai < 2; ++ai)
#pragma unroll
                for (int m = 0; m < 4; ++m) {
                    float ss = 0.f;
#pragma unroll
                    for (int bj = 0; bj < 2; ++bj)
#pragma unroll
                        for (int n = 0; n < 2; ++n) { const f32x4 x = acc[ai][bj][m][n]; ss += (x[0] * x[0] + x[1] * x[1]) + (x[2] * x[2] + x[3] * x[3]); }
                    ss += __shfl_xor(ss, 16); ss += __shfl_xor(ss, 32);
                    const float rstd = rsqrtf(ss * (1.0f / HD) + RMS_EPS);
                    bf16_t* rowp = out + (size_t)(row0 + ai * HALF + m * 16) * INW + colb;
#pragma unroll
                    for (int bj = 0; bj < 2; ++bj) { const f32x4 v0 = acc[ai][bj][m][0] * rstd * gv[bj][0], v1 = acc[ai][bj][m][1] * rstd * gv[bj][1];
                        u32x4 w; w.x = pack2(v0[0], v0[1]); w.y = pack2(v0[2], v0[3]); w.z = pack2(v1[0], v1[1]); w.w = pack2(v1[2], v1[3]);
                        *(u32x4*)(rowp + 32 * bj) = w; }
                }
        } else {
            const bool sg = pn >= 8;
#pragma unroll
            for (int ai = 0; ai < 2; ++ai)
#pragma unroll
                for (int m = 0; m < 4; ++m) {
                    bf16_t* rowp = out + (size_t)(row0 + ai * HALF + m * 16) * INW + colb;
#pragma unroll
                    for (int bj = 0; bj < 2; ++bj) { f32x4 v0 = acc[ai][bj][m][0], v1 = acc[ai][bj][m][1];
                        if (sg) {
#pragma unroll
                            for (int j = 0; j < 4; ++j) { v0[j] = sigmoidf_(v0[j]); v1[j] = sigmoidf_(v1[j]); } }
                        u32x4 w; w.x = pack2(v0[0], v0[1]); w.y = pack2(v0[2], v0[3]); w.z = pack2(v1[0], v1[1]); w.w = pack2(v1[2], v1[3]);
                        *(u32x4*)(rowp + 32 * bj) = w; }
                }
        }
    }
};
template <int MODE> struct EpiGate {
    static constexpr bool PERM = true;
    const bf16_t* gate; const bf16_t* t1in; bf16_t* out;
    __device__ __forceinline__ void operator()(const f32x4 (&acc)[2][2][4][2], const Unit& u, int wr, int wc, int fr, int fq) const {
        const int row0 = u.row0 + wr * 64 + fr, col0 = u.col0 + wc * 32 + 8 * fq;
#pragma unroll
        for (int ai = 0; ai < 2; ++ai)
#pragma unroll
            for (int m = 0; m < 4; ++m) {
                const size_t r = (size_t)(row0 + ai * HALF + m * 16);
#pragma unroll
                for (int bj = 0; bj < 2; ++bj) {
                    const int c = col0 + bj * HALF;
                    const u32x4 g = *(const u32x4*)(gate + r * INW + c);
                    const f32x4 a0 = acc[ai][bj][m][0], a1 = acc[ai][bj][m][1];
                    float o[8] = {a0[0] * bflo(g.x), a0[1] * bfhi(g.x), a0[2] * bflo(g.y), a0[3] * bfhi(g.y), a1[0] * bflo(g.z), a1[1] * bfhi(g.z), a1[2] * bflo(g.w), a1[3] * bfhi(g.w)};
                    if (MODE == 1) { const u32x4 t = *(const u32x4*)(t1in + r * DM + c);
                        o[0] += bflo(t.x); o[1] += bfhi(t.x); o[2] += bflo(t.y); o[3] += bfhi(t.y); o[4] += bflo(t.z); o[5] += bfhi(t.z); o[6] += bflo(t.w); o[7] += bfhi(t.w); }
                    u32x4 w; w.x = pack2(o[0], o[1]); w.y = pack2(o[2], o[3]); w.z = pack2(o[4], o[5]); w.w = pack2(o[6], o[7]);
                    *(u32x4*)(out + r * DM + c) = w;
                }
            }
    }
};
struct EpiResid {
    static constexpr bool PERM = false;
    const float* xin; float* xout;
    __device__ __forceinline__ void operator()(const f32x4 (&acc)[2][2][4][2], const Unit& u, int wr, int wc, int fr, int fq) const {
        const int row0 = u.row0 + wr * 64 + fr, col0 = u.col0 + wc * 32 + 4 * fq;
#pragma unroll
        for (int ai = 0; ai < 2; ++ai)
#pragma unroll
            for (int m = 0; m < 4; ++m) { const size_t off = (size_t)(row0 + ai * HALF + m * 16) * DM + col0;
#pragma unroll
                for (int bj = 0; bj < 2; ++bj)
#pragma unroll
                    for (int n = 0; n < 2; ++n) { const f32x4 x = *(const f32x4*)(xin + off + bj * HALF + n * 16); *(f32x4*)(xout + off + bj * HALF + n * 16) = x + acc[ai][bj][m][n]; } }
    }
};
struct EpiSwiGLU {
    static constexpr bool PERM = true;
    bf16_t* act;
    __device__ __forceinline__ void operator()(const f32x4 (&acc)[2][2][4][2], const Unit& u, int wr, int wc, int fr, int fq) const {
        const int row0 = u.row0 + wr * 64 + fr, col0 = (u.col0 >> 1) + wc * 32 + 8 * fq;
#pragma unroll
        for (int ai = 0; ai < 2; ++ai)
#pragma unroll
            for (int m = 0; m < 4; ++m) {
                float o[8];
#pragma unroll
                for (int n = 0; n < 2; ++n)
#pragma unroll
                    for (int j = 0; j < 4; ++j) { const float a = acc[ai][0][m][n][j], b = acc[ai][1][m][n][j]; o[4 * n + j] = a * sigmoidf_(a) * b; }
                u32x4 w; w.x = pack2(o[0], o[1]); w.y = pack2(o[2], o[3]); w.z = pack2(o[4], o[5]); w.w = pack2(o[6], o[7]);
                *(u32x4*)(act + (size_t)(row0 + ai * HALF + m * 16) * EH + col0) = w;
            }
    }
};
struct EpiDown {
    static constexpr bool PERM = true;
    bf16_t* yb; const float* tokW;
    __device__ __forceinline__ void operator()(const f32x4 (&acc)[2][2][4][2], const Unit& u, int wr, int wc, int fr, int fq) const {
        const int col0 = u.col0 + wc * 32 + 8 * fq;
#pragma unroll
        for (int ai = 0; ai < 2; ++ai)
#pragma unroll
            for (int m = 0; m < 4; ++m) {
                const int rl = wr * 64 + fr + ai * HALF + m * 16;
                const float w = rl < u.nvalid ? tokW[u.j0 + rl] : 0.f;
#pragma unroll
                for (int bj = 0; bj < 2; ++bj) { const f32x4 v0 = acc[ai][bj][m][0] * w, v1 = acc[ai][bj][m][1] * w;
                    u32x4 o; o.x = pack2(v0[0], v0[1]); o.y = pack2(v0[2], v0[3]); o.z = pack2(v1[0], v1[1]); o.w = pack2(v1[2], v1[3]);
                    *(u32x4*)(yb + (size_t)(u.row0 + rl) * DM + col0 + bj * HALF) = o; }
            }
    }
};
}

constexpr int ATT_K_OFF = 0, ATT_V_OFF = 49152;
__device__ __forceinline__ unsigned kv_off(unsigned row, unsigned ch) { return row * 128u + 16u * (ch ^ (((row >> 1) & 7u) ^ ((row & 2u) << 1))); }

__device__ __forceinline__ void attn_unit(LAS unsigned char* lds, const bf16_t* __restrict__ proj, bf16_t* __restrict__ og, f32x2* __restrict__ ml, int uidx) {
    const int tid = opaque_tid(), wid = __builtin_amdgcn_readfirstlane(tid >> 6), lane = tid & 63;
    const int bh = uidx / 48, r48 = uidx % 48, g = r48 >> 4, rr = r48 & 15;
    const int b = bh >> 3, h = bh & 7;
    const int d = (g == 0) ? 1 : (g == 1 ? 4 : 16);
    const int c = (g == 0) ? 0 : (g == 1 ? (rr >> 2) : rr);
    const int blk = (g == 0) ? rr : (g == 1 ? (rr & 3) : 0);
    const int tok0 = b * SEQ + c;
    const int kbase = 256 * blk - 128;
    const int kr_min = (blk == 0) ? 128 : 0;
#pragma unroll
    for (int i = 0; i < 6; ++i) {
        const int idx = tid + NTHREADS * i, row = idx >> 3, ch = idx & 7;
        if (row >= kr_min) {
            const size_t t = (size_t)(tok0 + (kbase + row) * d);
            const u32x4 kv = *(const u32x4*)(proj + t * INW + AW + h * HD + ch * 8);
            const u32x4 vv = *(const u32x4*)(proj + t * INW + 2 * AW + h * HD + ch * 8);
            *(LAS u32x4*)(lds + ATT_K_OFF + kv_off(row, ch)) = kv;
            *(LAS u32x4*)(lds + ATT_V_OFF + kv_off(row, ch)) = vv;
        }
    }
    const int qn = 256 * blk + 32 * wid + (lane & 31);
    const size_t qt = (size_t)(tok0 + qn * d);
    bf16x8 qf[4];
#pragma unroll
    for (int ks = 0; ks < 4; ++ks) qf[ks] = *(const bf16x8*)(proj + qt * INW + h * HD + 16 * ks + 8 * (lane >> 5));
    __syncthreads();
    const int kt_min = (blk == 0) ? max(0, 4 - wid) : 0;
    const int hq = lane >> 5, qi = lane & 31;
    f32x16 S[5];
#pragma unroll
    for (int kt = 0; kt < 5; ++kt) {
#pragma unroll
        for (int i = 0; i < 16; ++i) S[kt][i] = 0.f;
        if (kt >= kt_min) {
            const unsigned krow = (unsigned)(32 * wid + 32 * kt + qi);
#pragma unroll
            for (int ks = 0; ks < 4; ++ks) {
                const bf16x8 kf = *(const LAS bf16x8*)(lds + ATT_K_OFF + kv_off(krow, (unsigned)(2 * ks + hq)));
                S[kt] = __builtin_amdgcn_mfma_f32_32x32x16_bf16(kf, qf[ks], S[kt], 0, 0, 0);
            }
        }
    }
    float mx = -3.0e38f;
#pragma unroll
    for (int kt = 0; kt < 5; ++kt)
#pragma unroll
        for (int i = 0; i < 16; ++i) {
            const int row = (i & 3) + 8 * (i >> 2) + 4 * hq;
            bool valid = kt >= kt_min;
            if (kt == 0) valid = valid && (row >= qi);
            if (kt == 4) valid = valid && (row <= qi);
            S[kt][i] = valid ? S[kt][i] : -3.0e38f;
            mx = fmaxf(mx, S[kt][i]);
        }
    mx = fmaxf(mx, __shfl_xor(mx, 32));
    float lsum = 0.f;
#pragma unroll
    for (int kt = 0; kt < 5; ++kt)
#pragma unroll
        for (int i = 0; i < 16; ++i) { const float p = (S[kt][i] > -1.0e38f) ? __expf(S[kt][i] - mx) : 0.f; S[kt][i] = p; lsum += p; }
    lsum += __shfl_xor(lsum, 32);
    f32x16 O[2];
#pragma unroll
    for (int dt = 0; dt < 2; ++dt)
#pragma unroll
        for (int i = 0; i < 16; ++i) O[dt][i] = 0.f;
    const unsigned blkq = (lane >> 4) & 1, q4 = (lane & 15) >> 2, p4 = lane & 3;
    const unsigned vbase = (unsigned)(size_t)(lds + ATT_V_OFF);
#pragma unroll
    for (int kt = 0; kt < 5; ++kt) {
        if (kt >= kt_min) {
#pragma unroll
            for (int s = 0; s < 2; ++s) {
                u32x4 pw;
                pw.x = pack2(S[kt][8 * s + 0], S[kt][8 * s + 1]); pw.y = pack2(S[kt][8 * s + 2], S[kt][8 * s + 3]);
                pw.z = pack2(S[kt][8 * s + 4], S[kt][8 * s + 5]); pw.w = pack2(S[kt][8 * s + 6], S[kt][8 * s + 7]);
                const bf16x8 pf = __builtin_bit_cast(bf16x8, pw);
                u32x2 v00, v01, v10, v11;
                const unsigned r0 = (unsigned)(32 * wid + 32 * kt + 16 * s + 4 * hq) + q4, r1 = r0 + 8;
                const unsigned a00 = vbase + kv_off(r0, 0u + 2 * blkq + (p4 >> 1)) + 8 * (p4 & 1), a01 = vbase + kv_off(r1, 0u + 2 * blkq + (p4 >> 1)) + 8 * (p4 & 1);
                const unsigned a10 = vbase + kv_off(r0, 4u + 2 * blkq + (p4 >> 1)) + 8 * (p4 & 1), a11 = vbase + kv_off(r1, 4u + 2 * blkq + (p4 >> 1)) + 8 * (p4 & 1);
                asm volatile("ds_read_b64_tr_b16 %0, %4\n\tds_read_b64_tr_b16 %1, %5\n\tds_read_b64_tr_b16 %2, %6\n\tds_read_b64_tr_b16 %3, %7\n\ts_waitcnt lgkmcnt(0)"
                             : "=&v"(v00), "=&v"(v01), "=&v"(v10), "=&v"(v11) : "v"(a00), "v"(a01), "v"(a10), "v"(a11) : "memory");
                u32x4 f0; f0.x = v00.x; f0.y = v00.y; f0.z = v01.x; f0.w = v01.y;
                u32x4 f1; f1.x = v10.x; f1.y = v10.y; f1.z = v11.x; f1.w = v11.y;
                O[0] = __builtin_amdgcn_mfma_f32_32x32x16_bf16(__builtin_bit_cast(bf16x8, f0), pf, O[0], 0, 0, 0);
                O[1] = __builtin_amdgcn_mfma_f32_32x32x16_bf16(__builtin_bit_cast(bf16x8, f1), pf, O[1], 0, 0, 0);
            }
        }
    }
    const float inv = 1.0f / lsum;
    bf16_t* orow = og + ((size_t)g * NTOK + qt) * AW + h * HD;
#pragma unroll
    for (int dt = 0; dt < 2; ++dt)
#pragma unroll
        for (int gq4 = 0; gq4 < 4; ++gq4) {
            u32x2 w; w.x = pack2(O[dt][4 * gq4 + 0] * inv, O[dt][4 * gq4 + 1] * inv); w.y = pack2(O[dt][4 * gq4 + 2] * inv, O[dt][4 * gq4 + 3] * inv);
            *(u32x2*)(orow + 32 * dt + 8 * gq4 + 4 * hq) = w;
        }
    if (lane < 32) ml[((size_t)g * NTOK + qt) * 8 + h] = (f32x2){mx, lsum};
    __syncthreads();
}

__device__ __forceinline__ void tr_item(LAS float* t, const float* __restrict__ src, bf16_t* __restrict__ dst, int K, int N, int mode, int item) {
    const int nb = N / 64, kb = item / nb, n0 = (item % nb) * 64, k0 = kb * 64;
    const int tt = opaque_tid(), tx = tt & 63, ty = tt >> 6;
#pragma unroll
    for (int i = 0; i < 8; ++i) { const int k = ty + 8 * i; t[k * 65 + tx] = src[(size_t)(k0 + k) * N + n0 + tx]; }
    __syncthreads();
#pragma unroll
    for (int i = 0; i < 8; ++i) {
        const int n = n0 + ty + 8 * i;
        int nn = n;
        if (mode == 1) nn = (n >> 7) * 256 + (n & 127);
        if (mode == 2) nn = (n >> 7) * 256 + 128 + (n & 127);
        dst[(size_t)nn * K + k0 + tx] = f2bf(t[tx * 65 + ty + 8 * i]);
    }
    __syncthreads();
}
__device__ __forceinline__ void convert_experts(LAS float* t, const float* weg, const float* weu, const float* wed, bf16_t* WguT, bf16_t* WdT, int G, int c) {
    constexpr int IT = (DM / 64) * (EH / 64);
    for (int it = c; it < 3 * NEXP * IT; it += G) {
        const int which = it / (NEXP * IT), r = it % (NEXP * IT), e = r / IT, item = r % IT;
        if (which == 0) tr_item(t, weg + (size_t)e * DM * EH, WguT + (size_t)e * DM * DM, DM, EH, 1, item);
        else if (which == 1) tr_item(t, weu + (size_t)e * DM * EH, WguT + (size_t)e * DM * DM, DM, EH, 2, item);
        else tr_item(t, wed + (size_t)e * EH * DM, WdT + (size_t)e * DM * EH, EH, DM, 0, item);
    }
}
__device__ __forceinline__ void norm_row(const float* __restrict__ xr, const float* __restrict__ g, bf16_t* __restrict__ hr, int lane) {
    f32x4 v[4]; float ss = 0.f;
#pragma unroll
    for (int i = 0; i < 4; ++i) { v[i] = *(const f32x4*)(xr + (i * 64 + lane) * 4); ss += (v[i][0] * v[i][0] + v[i][1] * v[i][1]) + (v[i][2] * v[i][2] + v[i][3] * v[i][3]); }
    ss = wave_sum(ss);
    const float rstd = rsqrtf(ss * (1.0f / DM) + RMS_EPS);
#pragma unroll
    for (int i = 0; i < 4; ++i) {
        const f32x4 gv = *(const f32x4*)(g + (i * 64 + lane) * 4);
        u32x2 w; w.x = pack2(v[i][0] * rstd * gv[0], v[i][1] * rstd * gv[1]); w.y = pack2(v[i][2] * rstd * gv[2], v[i][3] * rstd * gv[3]);
        *(u32x2*)(hr + (i * 64 + lane) * 4) = w;
    }
}
__device__ __forceinline__ void build_moe_tables(LAS int* L, const unsigned* cnt) {
    if (threadIdx.x == 0) {
        int t = 0, p = 0;
        for (int e = 0; e < NEXP; ++e) { const int c = (int)__hip_atomic_load(cnt + e * 64, __ATOMIC_RELAXED, __HIP_MEMORY_SCOPE_AGENT); L[LI_TB + e] = t; L[LI_PS + e] = p; L[LI_CN + e] = c; const int nt = (c + 255) >> 8; t += nt; p += nt * 256; }
        L[LI_TB + NEXP] = t; L[LI_PS + NEXP] = p;
    }
    __syncthreads();
}

struct Args { const float* in[18]; float* out; unsigned char* ws; int ph_lo, ph_hi; };
typedef const __attribute__((address_space(4))) Args* CArgsP;
__device__ __forceinline__ CArgsP kargs() { unsigned long long p = (unsigned long long)__builtin_amdgcn_kernarg_segment_ptr(); asm volatile("" : "+s"(p)); return (CArgsP)p; }
#define PHASE_PTRS \
    const CArgsP ka = kargs(); unsigned char* const ws = ka->ws; \
    unsigned* const ctrl = (unsigned*)(ws + OFF_CTRL); const float* const x_in = ka->in[0]; \
    bf16_t* const WinT = (bf16_t*)(ws + OFF_WIN); bf16_t* const WaT = (bf16_t*)(ws + OFF_WA); bf16_t* const WppT = (bf16_t*)(ws + OFF_WPP); bf16_t* const WoT = (bf16_t*)(ws + OFF_WO); \
    bf16_t* const WguT = (bf16_t*)(ws + OFF_WGU); bf16_t* const WdT = (bf16_t*)(ws + OFF_WD); \
    bf16_t* const Hb = (bf16_t*)(ws + OFF_H); bf16_t* const MG = Hb; bf16_t* const PROJ = (bf16_t*)(ws + OFF_PROJ); bf16_t* const ACT = (bf16_t*)(ws + OFF_ACT); bf16_t* const YB = (bf16_t*)(ws + OFF_YB); \
    bf16_t* const AC = (bf16_t*)(ws + OFF_AC); bf16_t* const PL = (bf16_t*)(ws + OFF_PL); bf16_t* const OG = (bf16_t*)(ws + OFF_OG); bf16_t* const T1 = (bf16_t*)(ws + OFF_T1); \
    f32x2* const ML = (f32x2*)(ws + OFF_ML); float* const XB = (float*)(ws + OFF_XB); int* const tokE = (int*)(ws + OFF_TOKE); float* const tokW = (float*)(ws + OFF_TOKW); int* const asg = (int*)(ws + OFF_ASG); \
    (void)ctrl; (void)x_in; (void)WinT; (void)WaT; (void)WppT; (void)WoT; (void)WguT; (void)WdT; (void)Hb; (void)MG; (void)PROJ; (void)ACT; (void)YB; (void)AC; (void)PL; (void)OG; (void)T1; (void)ML; (void)XB; (void)tokE; (void)tokW; (void)asg
#define LAYER_PTRS PHASE_PTRS; const int tid = opaque_tid(), lane = tid & 63, wid = __builtin_amdgcn_readfirstlane(tid >> 6), gw = vcu * NWAVES + wid; (void)lane; (void)gw; const float* const xin = (l == 0) ? x_in : XB; unsigned* const cnt = ctrl + CW_CNT + l * 2048; (void)xin; (void)cnt

__global__ void __launch_bounds__(NTHREADS, 2) fwd_kernel(Args args) {
    extern __shared__ __attribute__((aligned(16))) unsigned char lds_raw[];
    LAS unsigned char* lds = (LAS unsigned char*)lds_raw;
    LAS int* LC = (LAS int*)(lds + LCTL_OFF);
    const int G = gridDim.x, bx = blockIdx.x;
    const int vcu = (G % 8 == 0) ? (bx % 8) * (G / 8) + bx / 8 : bx;
    if (threadIdx.x < 4) LC[LI_BAR + threadIdx.x] = 0;
    __syncthreads();
    XcdBarrier bar; bar.bar = (unsigned*)(args.ws + OFF_CTRL) + CW_BAR; bar.x = 0; bar.st = nullptr;
    if (MK_N_LAUNCHES == 1) bar = xcd_barrier_post(bar.bar, (volatile LAS unsigned*)(LC + LI_BAR));
    const int lo = args.ph_lo, hi = args.ph_hi;
#ifndef PHASE_MASK
#define PHASE_MASK 0x3ff
#endif
#define EN(j) (((PHASE_MASK) >> (j)) & 1)
#define IN(k) (lo <= (k) && (k) < hi)
#define SEAM(k) do { if (IN(k) && IN((k) + 1)) xcd_barrier(bar); } while (0)
    const int NGW = G * NWAVES;

    if (EN(9) && IN(0)) {
        asm volatile("; PHASE_MARK 9");
        PHASE_PTRS; const int tid = opaque_tid(), lane = tid & 63, wid = __builtin_amdgcn_readfirstlane(tid >> 6), gw = vcu * NWAVES + wid;
        LAS float* t = (LAS float*)lds;
        for (int it = bx; it < 2 * (1024 + 128 + 256); it += G) {
            const int l = it / 1408, r = it % 1408;
            if (r < 1024) tr_item(t, ka->in[2] + (size_t)l * DM * INW, WinT + (size_t)l * INW * DM, DM, INW, 0, r);
            else if (r < 1152) tr_item(t, ka->in[5] + (size_t)l * AW * DM, WaT + (size_t)l * DM * AW, AW, DM, 0, r - 1024);
            else tr_item(t, ka->in[9] + (size_t)l * DM * DM, WoT + (size_t)l * DM * DM, DM, DM, 0, r - 1152);
        }
        for (int o = bx * NTHREADS + tid; o < DEPTH * PW * DM; o += G * NTHREADS) {
            const int l = o / (PW * DM), r = o % (PW * DM), k = r / DM, n = r % DM, g = k >> 7;
            const float* wm = ka->in[6] + (size_t)l * 4 * 128 * 128 + (size_t)k * 128;
            const float* sc = ka->in[7] + (size_t)l * PW + g * 128;
            const float* wp = ka->in[8] + (size_t)l * PW * DM + (size_t)(g * 128) * DM + n;
            float a = 0.f;
            for (int dd = 0; dd < 128; ++dd) a += wm[dd] * sc[dd] * wp[(size_t)dd * DM];
            WppT[(size_t)l * DM * PW + (size_t)n * PW + k] = f2bf(a);
        }
        convert_experts(t, ka->in[15], ka->in[16], ka->in[17], WguT, WdT, G, bx);
        for (int m = gw; m < NTOK; m += NGW) norm_row(x_in + (size_t)m * DM, ka->in[1], Hb + (size_t)m * DM, lane);
    }
    SEAM(0);

    for (int l = 0; l < DEPTH; ++l) {
        const int pb = 1 + 9 * l;
        if (EN(0) && IN(pb + 0)) {
            asm volatile("; PHASE_MARK 0");
            LAYER_PTRS;
            pg8::DenseOrder S; S.init(Hb, WinT + (size_t)l * INW * DM, NTOK, INW, DM, G, bx);
            pg8::EpiProj E{PROJ, ka->in[3] + (size_t)l * HD, ka->in[4] + (size_t)l * HD};
            pg8::gemm_phase<pg8::EpiProj, pg8::DenseOrder, 1, false>(lds, DM, S, E);
        }
        SEAM(pb + 0);
        if (EN(1) && IN(pb + 1)) {
            asm volatile("; PHASE_MARK 1");
            LAYER_PTRS;
            for (int u = vcu; u < 1536; u += G) attn_unit(lds, PROJ, OG, ML, u);
        }
        SEAM(pb + 1);
        if (EN(2) && IN(pb + 2)) {
            asm volatile("; PHASE_MARK 2");
            LAYER_PTRS;
            for (int tok = gw; tok < NTOK; tok += NGW) {
                const int c0 = 8 * lane, hh = lane >> 3;
                f32x2 s[3]; float M = -3.0e38f;
#pragma unroll
                for (int g = 0; g < 3; ++g) { s[g] = ML[((size_t)g * NTOK + tok) * 8 + hh]; M = fmaxf(M, s[g][0]); }
                float w[3], W = 0.f;
#pragma unroll
                for (int g = 0; g < 3; ++g) { w[g] = s[g][1] * __expf(s[g][0] - M); W += w[g]; }
                const float iw = 1.0f / W;
                float o[8] = {0.f, 0.f, 0.f, 0.f, 0.f, 0.f, 0.f, 0.f};
#pragma unroll
                for (int g = 0; g < 3; ++g) { const u32x4 v = *(const u32x4*)(OG + ((size_t)g * NTOK + tok) * AW + c0); const float f = w[g] * iw;
                    o[0] += f * bflo(v.x); o[1] += f * bfhi(v.x); o[2] += f * bflo(v.y); o[3] += f * bfhi(v.y); o[4] += f * bflo(v.z); o[5] += f * bfhi(v.z); o[6] += f * bflo(v.w); o[7] += f * bfhi(v.w); }
                u32x4 ow; ow.x = pack2(o[0], o[1]); ow.y = pack2(o[2], o[3]); ow.z = pack2(o[4], o[5]); ow.w = pack2(o[6], o[7]);
                *(u32x4*)(AC + (size_t)tok * AW + c0) = ow;
                const int pos = tok & (SEQ - 1), wnd = 2 << (lane >> 4), cntp = min(pos + 1, wnd);
                float sm[8] = {0.f, 0.f, 0.f, 0.f, 0.f, 0.f, 0.f, 0.f};
                u32x4 u0 = {0u, 0u, 0u, 0u};
                for (int j = 0; j < cntp; ++j) { const u32x4 v = *(const u32x4*)(PROJ + (size_t)(tok - j) * INW + 3 * AW + c0); if (j == 0) u0 = v;
                    sm[0] += bflo(v.x); sm[1] += bfhi(v.x); sm[2] += bflo(v.y); sm[3] += bfhi(v.y); sm[4] += bflo(v.z); sm[5] += bfhi(v.z); sm[6] += bflo(v.w); sm[7] += bfhi(v.w); }
                const float ic = 1.0f / (float)cntp;
                u32x4 pw; pw.x = pack2(sm[0] * ic - bflo(u0.x), sm[1] * ic - bfhi(u0.x)); pw.y = pack2(sm[2] * ic - bflo(u0.y), sm[3] * ic - bfhi(u0.y));
                pw.z = pack2(sm[4] * ic - bflo(u0.z), sm[5] * ic - bfhi(u0.z)); pw.w = pack2(sm[6] * ic - bflo(u0.w), sm[7] * ic - bfhi(u0.w));
                *(u32x4*)(PL + (size_t)tok * PW + c0) = pw;
            }
        }
        SEAM(pb + 2);
        if (EN(3) && IN(pb + 3)) {
            asm volatile("; PHASE_MARK 3");
            LAYER_PTRS;
            { pg8::DenseOrder S; S.init(AC, WaT + (size_t)l * DM * AW, NTOK, DM, AW, G, bx);
              pg8::EpiGate<0> E{PROJ + 2048, nullptr, T1};
              pg8::gemm_phase<pg8::EpiGate<0>, pg8::DenseOrder, 0, false>(lds, AW, S, E); }
            { pg8::DenseOrder S; S.init(PL, WppT + (size_t)l * DM * PW, NTOK, DM, PW, G, bx);
              pg8::EpiGate<1> E{PROJ + 3072, T1, MG};
              pg8::gemm_phase<pg8::EpiGate<1>, pg8::DenseOrder, 0, false>(lds, PW, S, E); }
        }
        SEAM(pb + 3);
        if (EN(4) && IN(pb + 4)) {
            asm volatile("; PHASE_MARK 4");
            LAYER_PTRS;
            pg8::DenseOrder S; S.init(MG, WoT + (size_t)l * DM * DM, NTOK, DM, DM, G, bx);
            pg8::EpiResid E{xin, XB};
            pg8::gemm_phase<pg8::EpiResid, pg8::DenseOrder, 0, false>(lds, DM, S, E);
        }
        SEAM(pb + 4);
        if (EN(5) && IN(pb + 5)) {
            asm volatile("; PHASE_MARK 5");
            LAYER_PTRS;
            LAS int* aE = (LAS int*)lds; LAS float* aW = (LAS float*)(lds + 1024); LAS int* bs = (LAS int*)(lds + 2048);
            const float* g2 = ka->in[10] + (size_t)l * DM; const float* wrg = ka->in[11] + (size_t)l * DM * 4; const float* brg = ka->in[12] + (size_t)l * 4;
            const float* wre = ka->in[13] + (size_t)l * 4 * DM * 8; const float* bre = ka->in[14] + (size_t)l * 32;
            for (int chunk = bx; chunk < NTOK / 64; chunk += G) {
                for (int it = 0; it < 8; ++it) {
                    const int ti = wid * 8 + it, tok = chunk * 64 + ti;
                    const float* xr = XB + (size_t)tok * DM;
                    f32x4 v[4]; float ss = 0.f;
#pragma unroll
                    for (int i = 0; i < 4; ++i) { v[i] = *(const f32x4*)(xr + (i * 64 + lane) * 4); ss += (v[i][0] * v[i][0] + v[i][1] * v[i][1]) + (v[i][2] * v[i][2] + v[i][3] * v[i][3]); }
                    ss = wave_sum(ss);
                    const float rstd = rsqrtf(ss * (1.0f / DM) + RMS_EPS);
                    float gl[4] = {0.f, 0.f, 0.f, 0.f};
#pragma unroll
                    for (int i = 0; i < 4; ++i) {
                        const int d0 = (i * 64 + lane) * 4;
                        const f32x4 gv = *(const f32x4*)(g2 + d0);
#pragma unroll
                        for (int j = 0; j < 4; ++j) v[i][j] = v[i][j] * rstd * gv[j];
                        u32x2 w; w.x = pack2(v[i][0], v[i][1]); w.y = pack2(v[i][2], v[i][3]);
                        *(u32x2*)(Hb + (size_t)tok * DM + d0) = w;
#pragma unroll
                        for (int j = 0; j < 4; ++j) { const f32x4 wv = *(const f32x4*)(wrg + (size_t)(d0 + j) * 4);
#pragma unroll
                            for (int o = 0; o < 4; ++o) gl[o] += v[i][j] * wv[o]; }
                    }
#pragma unroll
                    for (int o = 0; o < 4; ++o) gl[o] = wave_sum(gl[o]) + brg[o];
                    int gs = 0; float gm = gl[0];
#pragma unroll
                    for (int o = 1; o < 4; ++o) if (gl[o] > gm) { gm = gl[o]; gs = o; }
                    gs = __builtin_amdgcn_readfirstlane(gs);
                    float gden = 0.f;
#pragma unroll
                    for (int o = 0; o < 4; ++o) gden += __expf(gl[o] - gm);
                    const float ggate = 1.0f / gden;
                    float el[8];
#pragma unroll
                    for (int o = 0; o < 8; ++o) el[o] = 0.f;
                    const float* we = wre + (size_t)gs * DM * 8;
#pragma unroll
                    for (int i = 0; i < 4; ++i) {
                        const int d0 = (i * 64 + lane) * 4;
#pragma unroll
                        for (int j = 0; j < 4; ++j) { const f32x4 w0 = *(const f32x4*)(we + (size_t)(d0 + j) * 8), w1 = *(const f32x4*)(we + (size_t)(d0 + j) * 8 + 4);
#pragma unroll
                            for (int o = 0; o < 4; ++o) { el[o] += v[i][j] * w0[o]; el[4 + o] += v[i][j] * w1[o]; } }
                    }
#pragma unroll
                    for (int o = 0; o < 8; ++o) el[o] = wave_sum(el[o]) + bre[gs * 8 + o];
                    int i0 = 0; float m0 = el[0];
#pragma unroll
                    for (int o = 1; o < 8; ++o) if (el[o] > m0) { m0 = el[o]; i0 = o; }
                    int i1 = 0; float m1 = -3.0e38f;
#pragma unroll
                    for (int o = 0; o < 8; ++o) if (o != i0 && el[o] > m1) { m1 = el[o]; i1 = o; }
                    const float e1 = __expf(m1 - m0);
                    if (lane == 0) { aE[2 * ti] = gs * 8 + i0; aE[2 * ti + 1] = gs * 8 + i1; aW[2 * ti] = ggate / (1.0f + e1); aW[2 * ti + 1] = ggate * e1 / (1.0f + e1); }
                }
                __syncthreads();
                int myE = 0, rank = 0;
                if (tid < 128) { myE = aE[tid]; for (int a = 0; a < tid; ++a) rank += (aE[a] == myE) ? 1 : 0; }
                if (tid < NEXP) { int c = 0; for (int a = 0; a < 128; ++a) c += (aE[a] == tid) ? 1 : 0;
                    bs[tid] = c ? (int)__hip_atomic_fetch_add(cnt + tid * 64, (unsigned)c, __ATOMIC_RELAXED, __HIP_MEMORY_SCOPE_AGENT) : 0; }
                __syncthreads();
                if (tid < 128) { const int slot = bs[myE] + rank, tok = chunk * 64 + (tid >> 1);
                    tokE[(size_t)myE * ECAP + slot] = tok; tokW[(size_t)myE * ECAP + slot] = aW[tid]; asg[tok * 2 + (tid & 1)] = myE * ECAP + slot; }
                __syncthreads();
            }
        }
        SEAM(pb + 5);
        if (EN(6) && IN(pb + 6)) {
            asm volatile("; PHASE_MARK 6");
            LAYER_PTRS;
            build_moe_tables(LC, cnt);
            pg8::MoeOrder S{(const char*)Hb, (const char*)WguT, (size_t)DM * DM * 2, DM, LC + LI_TB, LC + LI_PS, LC + LI_CN, tokE, G, vcu, true};
            pg8::EpiSwiGLU E{ACT};
            pg8::gemm_phase<pg8::EpiSwiGLU, pg8::MoeOrder, 0, true>(lds, DM, S, E);
        }
        SEAM(pb + 6);
        if (EN(7) && IN(pb + 7)) {
            asm volatile("; PHASE_MARK 7");
            LAYER_PTRS;
            build_moe_tables(LC, cnt);
            pg8::MoeOrder S{(const char*)ACT, (const char*)WdT, (size_t)DM * EH * 2, EH, LC + LI_TB, LC + LI_PS, LC + LI_CN, tokE, G, vcu, false};
            pg8::EpiDown E{YB, tokW};
            pg8::gemm_phase<pg8::EpiDown, pg8::MoeOrder, 0, false>(lds, EH, S, E);
        }
        SEAM(pb + 7);
        if (EN(8) && IN(pb + 8)) {
            asm volatile("; PHASE_MARK 8");
            LAYER_PTRS;
            build_moe_tables(LC, cnt);
            const bool lastl = (l == DEPTH - 1);
            const float* g1n = ka->in[1] + (size_t)(lastl ? 0 : (l + 1)) * DM;
            for (int tok = gw; tok < NTOK; tok += NGW) {
                const int i0 = asg[tok * 2], i1 = asg[tok * 2 + 1];
                const size_t s0 = (size_t)(LC[LI_PS + (i0 >> 14)] + (i0 & (ECAP - 1))), s1 = (size_t)(LC[LI_PS + (i1 >> 14)] + (i1 & (ECAP - 1)));
                f32x4 v[4]; float ss = 0.f;
#pragma unroll
                for (int i = 0; i < 4; ++i) {
                    const int d0 = (i * 64 + lane) * 4;
                    const f32x4 xv = *(const f32x4*)(XB + (size_t)tok * DM + d0);
                    const u32x2 a = *(const u32x2*)(YB + s0 * DM + d0), b = *(const u32x2*)(YB + s1 * DM + d0);
                    v[i][0] = xv[0] + bflo(a.x) + bflo(b.x); v[i][1] = xv[1] + bfhi(a.x) + bfhi(b.x); v[i][2] = xv[2] + bflo(a.y) + bflo(b.y); v[i][3] = xv[3] + bfhi(a.y) + bfhi(b.y);
                    ss += (v[i][0] * v[i][0] + v[i][1] * v[i][1]) + (v[i][2] * v[i][2] + v[i][3] * v[i][3]);
                    *(f32x4*)((lastl ? ka->out : XB) + (size_t)tok * DM + d0) = v[i];
                }
                if (!lastl) {
                    ss = wave_sum(ss);
                    const float rstd = rsqrtf(ss * (1.0f / DM) + RMS_EPS);
#pragma unroll
                    for (int i = 0; i < 4; ++i) { const int d0 = (i * 64 + lane) * 4; const f32x4 gv = *(const f32x4*)(g1n + d0);
                        u32x2 w; w.x = pack2(v[i][0] * rstd * gv[0], v[i][1] * rstd * gv[1]); w.y = pack2(v[i][2] * rstd * gv[2], v[i][3] * rstd * gv[3]);
                        *(u32x2*)(Hb + (size_t)tok * DM + d0) = w; }
                }
            }
            if (!lastl) {
                __syncthreads();
                convert_experts((LAS float*)lds, ka->in[15] + (size_t)(l + 1) * NEXP * DM * EH, ka->in[16] + (size_t)(l + 1) * NEXP * DM * EH, ka->in[17] + (size_t)(l + 1) * NEXP * EH * DM, WguT, WdT, G, bx);
            }
        }
        if (l + 1 < DEPTH) SEAM(pb + 8);
    }
#undef IN
#undef SEAM
}

extern "C" void kernel_launch(void* const* d_in, const int* in_sizes, int n_in, void* d_out, int out_size, void* d_ws, size_t ws_size, hipStream_t stream) {
    (void)in_sizes; (void)out_size;
    static int grid = 0;
    if (grid == 0) {
        int dev = 0, cus = 0;
        if (hipGetDevice(&dev) != hipSuccess || hipDeviceGetAttribute(&cus, hipDeviceAttributeMultiprocessorCount, dev) != hipSuccess) { grid = -1; return; }
        if (hipFuncSetAttribute((const void*)fwd_kernel, hipFuncAttributeMaxDynamicSharedMemorySize, LDS_BYTES) != hipSuccess) { grid = -1; return; }
        int per_cu = 0;
        (void)hipOccupancyMaxActiveBlocksPerMultiprocessor(&per_cu, (const void*)fwd_kernel, NTHREADS, LDS_BYTES);
        (void)hipGetLastError();
        grid = cus;
        if (n_in != 18 || ws_size < WS_NEED) { fprintf(stderr, "kernel_launch: unexpected inputs (n_in %d, ws %zu)\n", n_in, ws_size); grid = -1; return; }
    }
    if (grid < 0) return;
    (void)hipMemsetAsync((char*)d_ws + OFF_CTRL, 0, CTRL_BYTES, stream);
    Args a{};
    for (int i = 0; i < 18; ++i) a.in[i] = (const float*)d_in[i];
    a.out = (float*)d_out; a.ws = (unsigned char*)d_ws;
    constexpr int NPH = 1 + 9 * DEPTH;
    if (MK_N_LAUNCHES == 1) { a.ph_lo = 0; a.ph_hi = NPH; hipLaunchKernelGGL(fwd_kernel, dim3(grid), dim3(NTHREADS), LDS_BYTES, stream, a); }
    else { for (int p = 0; p < NPH; ++p) { a.ph_lo = p; a.ph_hi = p + 1; hipLaunchKernelGGL(fwd_kernel, dim3(grid), dim3(NTHREADS), LDS_BYTES, stream, a); } }
}
```

```cpp
#include <hip/hip_runtime.h>
#include <stdint.h>
#include <stdio.h>

#define LAS __attribute__((address_space(3)))
typedef unsigned short bf16_t;
typedef short bf16x8 __attribute__((ext_vector_type(8)));
typedef float f32x2 __attribute__((ext_vector_type(2)));
typedef float f32x4 __attribute__((ext_vector_type(4)));
typedef float f32x16 __attribute__((ext_vector_type(16)));
typedef unsigned u32x2 __attribute__((ext_vector_type(2)));
typedef unsigned u32x4 __attribute__((ext_vector_type(4)));
typedef __bf16 bfv2 __attribute__((ext_vector_type(2)));

#ifndef MK_N_LAUNCHES
#define MK_N_LAUNCHES 1
#endif

constexpr int DM = 1024, SEQ = 4096, NTOK = 16384, DEPTH = 2;
constexpr int HD = 64, AW = 512, PW = 512, INW = 4096;
constexpr int NEXP = 32, EH = 512, ECAP = NTOK;
constexpr float RMS_EPS = 1e-6f;
constexpr int NTHREADS = 512, NWAVES = 8;

constexpr size_t MB = 1024 * 1024;
constexpr size_t OFF_CTRL = 0, CTRL_BYTES = 65536;
constexpr size_t OFF_WIN  = 1 * MB;
constexpr size_t OFF_WA   = OFF_WIN + 16 * MB;
constexpr size_t OFF_WPP  = OFF_WA + 2 * MB;
constexpr size_t OFF_WO   = OFF_WPP + 2 * MB;
constexpr size_t OFF_WGU  = OFF_WO + 4 * MB;
constexpr size_t OFF_WD   = OFF_WGU + 64 * MB;
constexpr size_t OFF_H    = OFF_WD + 32 * MB;
constexpr size_t OFF_PROJ = OFF_H + 32 * MB;
constexpr size_t OFF_ACT  = OFF_PROJ;
constexpr size_t OFF_YB   = OFF_PROJ + 40 * MB;
constexpr size_t OFF_AC   = OFF_PROJ + 128 * MB;
constexpr size_t OFF_PL   = OFF_AC + 16 * MB;
constexpr size_t OFF_OG   = OFF_PL + 16 * MB;
constexpr size_t OFF_T1   = OFF_OG;
constexpr size_t OFF_ML   = OFF_OG + 48 * MB;
constexpr size_t OFF_XB   = OFF_ML + 4 * MB;
constexpr size_t OFF_TOKE = OFF_XB + 64 * MB;
constexpr size_t OFF_TOKW = OFF_TOKE + 2 * MB;
constexpr size_t OFF_ASG  = OFF_TOKW + 2 * MB;
constexpr size_t WS_NEED  = OFF_ASG + 1 * MB;
constexpr int CW_CNT = 1024;
constexpr int CW_BAR = 8192;
constexpr int RING_BYTES = 131072, LCTL_OFF = RING_BYTES, LDS_BYTES = RING_BYTES + 1024;
constexpr int LI_BAR = 0, LI_TB = 16, LI_PS = 64, LI_CN = 112;

__device__ __forceinline__ float bflo(unsigned w) { return __uint_as_float(w << 16); }
__device__ __forceinline__ float bfhi(unsigned w) { return __uint_as_float(w & 0xffff0000u); }
__device__ __forceinline__ unsigned pack2(float lo, float hi) { f32x2 v = {lo, hi}; return __builtin_bit_cast(unsigned, __builtin_convertvector(v, bfv2)); }
__device__ __forceinline__ bf16_t f2bf(float f) { return (bf16_t)(pack2(f, 0.f) & 0xffffu); }
__device__ __forceinline__ float wave_sum(float v) {
#pragma unroll
    for (int o = 32; o >= 1; o >>= 1) v += __shfl_xor(v, o);
    return v;
}
__device__ __forceinline__ int opaque_tid() { int t = (int)threadIdx.x; asm volatile("" : "+v"(t)); return t; }
__device__ __forceinline__ float sigmoidf_(float v) { return 1.0f / (1.0f + __expf(-v)); }

#define XB_TMO      128
#define XB_XCNT(j)  (256  + 64 * (j))
#define XB_XSUB(j)  (1280 + 64 * (j))
#define XB_XGEN(j)  (2304 + 64 * (j))
#define XB_TOP      3328
#define XB_TOPGEN   3392
#define XCD_BAR_WORDS 3456
#define XB_SPIN_CAP (1u << 18)
__device__ __forceinline__ unsigned xb_ld(unsigned* p)              { return __hip_atomic_load(p, __ATOMIC_RELAXED, __HIP_MEMORY_SCOPE_AGENT); }
__device__ __forceinline__ unsigned xb_add(unsigned* p, unsigned v) { return __hip_atomic_fetch_add(p, v, __ATOMIC_RELAXED, __HIP_MEMORY_SCOPE_AGENT); }
__device__ __forceinline__ unsigned xb_xcc_id() { return (unsigned)__builtin_amdgcn_s_getreg((3 << 11) | 20) & 0xFu; }
#define XB_SPIN(cond, bar) do { unsigned _sp = 0; while (cond) { __builtin_amdgcn_s_sleep(1); \
    if ((++_sp & 255u) == 0u) { if (xb_ld(&(bar)[XB_TMO])) break; if (_sp > XB_SPIN_CAP) { atomicAdd(&(bar)[XB_TMO], 1u); break; } } } } while (0)
struct XcdBarrier { unsigned* bar; unsigned x; volatile LAS unsigned* st; };
__device__ __forceinline__ XcdBarrier xcd_barrier_post(unsigned* bar, volatile LAS unsigned* st) {
    XcdBarrier b; b.bar = bar; b.x = xb_xcc_id(); b.st = st;
    if (threadIdx.x == 0) (void)xb_add(&bar[XB_XCNT(b.x)], 1u);
    return b;
}
__device__ __forceinline__ void xcd_barrier_complete(unsigned* bar, unsigned x, unsigned& nloc, unsigned& nx) {
    const unsigned G = gridDim.x * gridDim.y * gridDim.z;
    unsigned sum, cnt, mine, sp = 0u;
    for (;;) {
        sum = 0u; cnt = 0u; mine = 0u;
#pragma unroll
        for (unsigned j = 0; j < 16; ++j) { const unsigned c = xb_ld(&bar[XB_XCNT(j)]); sum += c; cnt += (c > 0u) ? 1u : 0u; mine = (j == x) ? c : mine; }
        if (sum == G) break;
        __builtin_amdgcn_s_sleep(1);
        if ((++sp & 255u) == 0u) { if (xb_ld(&bar[XB_TMO])) break; if (sp > XB_SPIN_CAP) { atomicAdd(&bar[XB_TMO], 1u); break; } }
    }
    nloc = mine > 0u ? mine : 1u; nx = cnt > 0u ? cnt : 1u;
}
__device__ __forceinline__ void xcd_barrier(const XcdBarrier& b) {
    asm volatile("s_waitcnt vmcnt(0)" ::: "memory");
    __syncthreads();
    if (threadIdx.x == 0) {
        unsigned* bar = b.bar;
        __builtin_amdgcn_s_waitcnt(0);
        unsigned nloc = b.st[0], nx = b.st[1];
        if (nloc == 0u) { xcd_barrier_complete(bar, b.x, nloc, nx); b.st[0] = nloc; b.st[1] = nx; }
        const unsigned old = xb_add(&bar[XB_XSUB(b.x)], 1u);
        const unsigned gen = old / nloc;
        if (old + 1u == (gen + 1u) * nloc) {
            __builtin_amdgcn_fence(__ATOMIC_RELEASE, "agent");
            asm volatile("s_waitcnt vmcnt(0)" ::: "memory");
            const unsigned og = xb_add(&bar[XB_TOP], 1u);
            const unsigned tg = og / nx;
            if (og + 1u == (tg + 1u) * nx) xb_add(&bar[XB_TOPGEN], 1u);
            else XB_SPIN(xb_ld(&bar[XB_TOPGEN]) == tg, bar);
            __builtin_amdgcn_fence(__ATOMIC_ACQUIRE, "agent");
            xb_add(&bar[XB_XGEN(b.x)], 1u);
            asm volatile("s_waitcnt vmcnt(0)" ::: "memory");
        } else {
            XB_SPIN(xb_ld(&bar[XB_XGEN(b.x)]) == gen, bar);
            __builtin_amdgcn_fence(__ATOMIC_ACQUIRE, "agent");
            asm volatile("s_waitcnt vmcnt(0)" ::: "memory");
        }
    }
    __syncthreads();
}

namespace pg8 {
constexpr int BM = 256, BK = 64, HALF = 128, HTB = HALF * BK * 2, NXCD = 8, WGM = 8;
__device__ __forceinline__ int lds_byte(int r, int c) { const int st = (r >> 4) * 2 + (c >> 5), rr = r & 15, cc = c & 31, ob = rr * 64 + cc * 2; return st * 1024 + (ob ^ (((ob >> 9) & 1) << 5)); }
__device__ __forceinline__ void stage_rc(int b, int& R, int& C) { const int st = b / 1024, sb = b % 1024, swz = sb ^ (((sb >> 9) & 1) << 5); R = (st >> 1) * 16 + swz / 64; C = (st & 1) * 32 + (swz % 64) / 2; }
__device__ __forceinline__ int perm32(int rho) { const int n = rho >> 4, i = rho & 15; return 8 * (i >> 2) + 4 * n + (i & 3); }

struct Unit { const char* A; const char* B; int row0, col0, e, nvalid, j0; };

struct DenseOrder {
    const char* A; const char* Bt; int K, nM, nN, nwg, G, c;
    __device__ __forceinline__ void init(const void* A_, const void* Bt_, int M, int N, int K_, int G_, int c_) { A = (const char*)A_; Bt = (const char*)Bt_; K = K_; nM = M / BM; nN = N / BM; nwg = nM * nN; G = G_; c = c_; }
    __device__ __forceinline__ bool next(int i, Unit& u) const {
        const long L = (long)i * G + c; if (L >= nwg) return false;
        int wgid = (int)L; { const int q = nwg / NXCD, r = nwg % NXCD, xcd = wgid % NXCD, off = wgid / NXCD; wgid = (xcd < r ? xcd * (q + 1) : r * (q + 1) + (xcd - r) * q) + off; }
        const int nig = WGM * nN, gid = wgid / nig, fm = gid * WGM, gsz = (nM - fm) < WGM ? (nM - fm) : WGM;
        const int pm = fm + ((wgid % nig) % gsz), pn = (wgid % nig) / gsz;
        u.A = A + (size_t)pm * BM * K * 2; u.B = Bt + (size_t)pn * BM * K * 2; u.row0 = pm * BM; u.col0 = pn * BM; u.e = 0; u.nvalid = BM; u.j0 = 0; return true;
    }
    __device__ __forceinline__ unsigned row_off(const Unit&, int) const { return 0u; }
};
struct MoeOrder {
    const char* A; const char* Bt; size_t bExp; int K; const LAS int* tb; const LAS int* ps; const LAS int* cn; const int* tokE; int G, c; bool gather;
    __device__ __forceinline__ bool next(int i, Unit& u) const {
        const int L = i * G + c, total = tb[NEXP] * 4; if (L >= total) return false;
        const int rt = L >> 2, pn = L & 3;
        int e = 0;
        while (e < NEXP - 1 && tb[e + 1] <= rt) ++e;
        e = __builtin_amdgcn_readfirstlane(e);
        const int j = rt - __builtin_amdgcn_readfirstlane(tb[e]);
        const int pse = __builtin_amdgcn_readfirstlane(ps[e]), cne = __builtin_amdgcn_readfirstlane(cn[e]);
        u.e = e; u.row0 = pse + BM * j; u.col0 = pn * BM; u.nvalid = min(BM, cne - BM * j); u.j0 = e * ECAP + BM * j;
        u.B = Bt + (size_t)e * bExp + (size_t)pn * BM * K * 2;
        u.A = gather ? A : A + (size_t)u.row0 * K * 2;
        return true;
    }
    __device__ __forceinline__ unsigned row_off(const Unit& u, int R) const { const int t = R < u.nvalid ? tokE[u.j0 + R] : 0; return (unsigned)t * (unsigned)(K * 2); }
};

template <class Epi, class Sched, int BMODE, bool GATHER>
__device__ __forceinline__ void gemm_phase(LAS unsigned char* lds, const int K, const Sched& S, const Epi& E) {
    const int tid = opaque_tid(), wid = __builtin_amdgcn_readfirstlane(tid >> 6), lane = tid & 63, wr = wid >> 2, wc = wid & 3, fr = lane & 15, fq = lane >> 4;
    const int nt = K / BK;
    unsigned voffA[2][2], voffAn[2][2], voffB[2]; int RA[2], CA[2];
#pragma unroll
    for (int i = 0; i < 2; ++i) { int R, C; stage_rc(tid * 16 + i * 8192, R, C); RA[i] = R; CA[i] = C;
        const int Rb = (BMODE == 1) ? (64 * (R >> 5) + perm32(R & 31)) : (Epi::PERM ? ((R & ~31) + perm32(R & 31)) : R);
        voffB[i] = (unsigned)(Rb * K + C) * 2u;
#pragma unroll
        for (int h = 0; h < 2; ++h) { voffA[h][i] = (unsigned)((h * HALF + R) * K + C) * 2u; voffAn[h][i] = voffA[h][i]; } }
    const size_t kstep = (size_t)(BK * 2);
    const size_t hstepB = (size_t)((BMODE == 1) ? 32 : HALF) * K * 2;
    const unsigned ldsw = (unsigned)wid * 1024u;
    const int aoff = lds_byte(wr * 64 + fr, fq * 8), boff = lds_byte(wc * 32 + fr, fq * 8);
#define PG8_SA(b, h) (((b) * 2 + (h)) * HTB)
#define PG8_SB(b, h) ((4 + (b) * 2 + (h)) * HTB)
#define PG8_STAGE2(bufoff, gbase, v0, v1) do { \
        __builtin_amdgcn_global_load_lds((const unsigned*)((const char*)(gbase) + (v0)), (LAS unsigned*)(lds + (bufoff) + ldsw), 16, 0, 0); \
        __builtin_amdgcn_global_load_lds((const unsigned*)((const char*)(gbase) + (v1)), (LAS unsigned*)(lds + (bufoff) + ldsw + 8192), 16, 0, 0); } while (0)
#define PG8_STAGEB(bufoff, gbase) PG8_STAGE2(bufoff, gbase, voffB[0], voffB[1])
#define PG8_STAGEA(bufoff, gbase, h, nx) PG8_STAGE2(bufoff, gbase, ((GATHER && (nx)) ? voffAn[h][0] : voffA[h][0]), ((GATHER && (nx)) ? voffAn[h][1] : voffA[h][1]))
#define PG8_LDA(dst, b, h) do { _Pragma("unroll") for (int m = 0; m < 4; ++m) _Pragma("unroll") for (int k = 0; k < 2; ++k) dst[m][k] = *(const LAS bf16x8*)(lds + PG8_SA(b, h) + aoff + m * 2048 + k * 1024); } while (0)
#define PG8_LDB(dst, b, h) do { _Pragma("unroll") for (int n = 0; n < 2; ++n) _Pragma("unroll") for (int k = 0; k < 2; ++k) dst[n][k] = *(const LAS bf16x8*)(lds + PG8_SB(b, h) + boff + n * 2048 + k * 1024); } while (0)
#define PG8_MMA(ai, bj, At, Bt) do { __builtin_amdgcn_s_setprio(1); _Pragma("unroll") for (int m = 0; m < 4; ++m) _Pragma("unroll") for (int n = 0; n < 2; ++n) _Pragma("unroll") for (int k = 0; k < 2; ++k) \
        acc[ai][bj][m][n] = __builtin_amdgcn_mfma_f32_16x16x32_bf16(Bt[n][k], At[m][k], acc[ai][bj][m][n], 0, 0, 0); __builtin_amdgcn_s_setprio(0); } while (0)
#define PG8_WAIT_V(n) asm volatile("s_waitcnt vmcnt(" #n ")" ::: "memory")
#define PG8_WAIT_L(n) asm volatile("s_waitcnt lgkmcnt(" #n ")" ::: "memory")
#define PG8_BAR __builtin_amdgcn_s_barrier()
#define PG8_SCHED __builtin_amdgcn_sched_barrier(0)
    Unit cur, nxt; int ui = 0;
    if (!S.next(0, cur)) return;
    if (GATHER) {
#pragma unroll
        for (int h = 0; h < 2; ++h)
#pragma unroll
            for (int i = 0; i < 2; ++i) voffA[h][i] = S.row_off(cur, h * HALF + RA[i]) + (unsigned)CA[i] * 2u;
    }
    f32x4 acc[2][2][4][2];
#pragma unroll
    for (int a = 0; a < 2; ++a)
#pragma unroll
        for (int b = 0; b < 2; ++b)
#pragma unroll
            for (int m = 0; m < 4; ++m)
#pragma unroll
                for (int n = 0; n < 2; ++n) acc[a][b][m][n] = (f32x4){0.f, 0.f, 0.f, 0.f};
    bf16x8 At[4][2], B0[2][2], B1[2][2];
    const char* cA = cur.A; const char* cB = cur.B;
    PG8_STAGEB(PG8_SB(0, 0), cB); PG8_STAGEB(PG8_SB(0, 1), cB + hstepB); PG8_STAGEA(PG8_SA(0, 0), cA, 0, false); PG8_STAGEA(PG8_SA(0, 1), cA, 1, false);
    if (wr == 1) PG8_BAR;
    PG8_WAIT_V(2); PG8_BAR;
    PG8_STAGEB(PG8_SB(1, 0), cB + kstep); PG8_STAGEA(PG8_SA(1, 0), cA + kstep, 0, false); PG8_STAGEB(PG8_SB(1, 1), cB + hstepB + kstep);
    PG8_WAIT_V(6); PG8_BAR;
    for (;;) {
        const bool has_next = S.next(ui + 1, nxt);
        if (GATHER) {
#pragma unroll
            for (int h = 0; h < 2; ++h)
#pragma unroll
                for (int i = 0; i < 2; ++i) voffAn[h][i] = has_next ? (S.row_off(nxt, h * HALF + RA[i]) + (unsigned)CA[i] * 2u) : voffA[h][i];
        }
        const char* nA = has_next ? nxt.A : cA; const char* nB = has_next ? nxt.B : cB;
        for (int t = 0; t < nt; t += 2) {
            const bool last = (t == nt - 2);
            const char* a1 = cA + (size_t)(t + 1) * kstep;
            const char* a2 = last ? nA : cA + (size_t)(t + 2) * kstep; const char* b2 = last ? nB : cB + (size_t)(t + 2) * kstep;
            const char* a3 = a2 + kstep; const char* b3 = b2 + kstep;
            PG8_LDB(B0, 0, 0); PG8_LDB(B1, 0, 1); PG8_SCHED; PG8_LDA(At, 0, 0); PG8_STAGEA(PG8_SA(1, 1), a1, 1, false);
            PG8_WAIT_V(8); PG8_WAIT_L(0); PG8_BAR; PG8_MMA(0, 0, At, B0); PG8_MMA(0, 1, At, B1); PG8_BAR; PG8_SCHED;
            PG8_LDA(At, 0, 1); PG8_STAGEB(PG8_SB(0, 0), b2); PG8_STAGEB(PG8_SB(0, 1), b2 + hstepB); PG8_STAGEA(PG8_SA(0, 0), a2, 0, last);
            PG8_WAIT_V(8); PG8_WAIT_L(0); PG8_BAR; PG8_MMA(1, 0, At, B0); PG8_MMA(1, 1, At, B1); PG8_BAR; PG8_SCHED;
            PG8_LDB(B0, 1, 0); PG8_LDB(B1, 1, 1); PG8_SCHED; PG8_LDA(At, 1, 0); PG8_STAGEA(PG8_SA(0, 1), a2, 1, last);
            PG8_WAIT_V(8); PG8_WAIT_L(0); PG8_BAR; PG8_MMA(0, 0, At, B0); PG8_MMA(0, 1, At, B1); PG8_BAR; PG8_SCHED;
            PG8_LDA(At, 1, 1); PG8_STAGEB(PG8_SB(1, 0), b3); PG8_STAGEB(PG8_SB(1, 1), b3 + hstepB); PG8_STAGEA(PG8_SA(1, 0), a3, 0, last);
            PG8_WAIT_V(8); PG8_WAIT_L(0); PG8_BAR; PG8_MMA(1, 0, At, B0); PG8_MMA(1, 1, At, B1); PG8_BAR; PG8_SCHED;
        }
        if (wr == 0) PG8_BAR;
        E(acc, cur, wr, wc, fr, fq);
        if (!has_next) break;
#pragma unroll
        for (int a = 0; a < 2; ++a)
#pragma unroll
            for (int b = 0; b < 2; ++b)
#pragma unroll
                for (int m = 0; m < 4; ++m)
#pragma unroll
                    for (int n = 0; n < 2; ++n) acc[a][b][m][n] = (f32x4){0.f, 0.f, 0.f, 0.f};
        cur = nxt; cA = nA; cB = nB; ++ui;
        if (GATHER) {
#pragma unroll
            for (int h = 0; h < 2; ++h)
#pragma unroll
                for (int i = 0; i < 2; ++i) voffA[h][i] = voffAn[h][i];
        }
        if (wr == 1) PG8_BAR;
    }
    PG8_WAIT_V(0);
    PG8_BAR;
#undef PG8_SA
#undef PG8_SB
#undef PG8_STAGE2
#undef PG8_STAGEA
#undef PG8_STAGEB
#undef PG8_LDA
#undef PG8_LDB
#undef PG8_MMA
#undef PG8_WAIT_V
#undef PG8_WAIT_L
#undef PG8_BAR
#undef PG8_SCHED
}

struct EpiProj {
    static constexpr bool PERM = true;
    bf16_t* out; const float* gq; const float* gk;
    __device__ __forceinline__ void operator()(const f32x4 (&acc)[2][2][4][2], const Unit& u, int wr, int wc, int fr, int fq) const {
        const int pn = u.col0 >> 8;
        const int row0 = u.row0 + wr * 64 + fr, colb = u.col0 + 64 * wc + 8 * fq;
        if (pn < 4) {
            const float* g = (pn < 2) ? gq : gk; const float post = (pn < 2) ? 0.125f : 1.0f;
            f32x4 gv[2][2];
#pragma unroll
            for (int bj = 0; bj < 2; ++bj)
#pragma unroll
                for (int n = 0; n < 2; ++n) gv[bj][n] = *(const f32x4*)(g + 32 * bj + 8 * fq + 4 * n) * post;
#pragma unroll
            for (int ai = 0; ai < 2; ++ai)
#pragma unroll
                for (int m = 0; m < 4; ++m) {
                    float ss = 0.f;
#pragma unroll
                    for (int bj = 0; bj < 2; ++bj)
#pragma unroll
                        for (int n = 0; n < 2; ++n) { const f32x4 x = acc[ai][bj][m][n]; ss += (x[0] * x[0] + x[1] * x[1]) + (x[2] * x[2] + x[3] * x[3]); }
                    ss += __shfl_xor(ss, 16); ss += __shfl_xor(ss, 32);
                    const float rstd = rsqrtf(ss * (1.0f / HD) + RMS_EPS);
                    bf16_t* rowp = out + (size_t)(row0 + ai * HALF + m * 16) * INW + colb;
#pragma unroll
                    for (int bj = 0; bj < 2; ++bj) { const f32x4 v0 = acc[ai][bj][m][0] * rstd * gv[bj][0], v1 = acc[ai][bj][m][1] * rstd * gv[bj][1];
                        u32x4 w; w.x = pack2(v0[0], v0[1]); w.y = pack2(v0[2], v0[3]); w.z = pack2(v1[0], v1[1]); w.w = pack2(v1[2], v1[3]);
                        *(u32x4*)(rowp + 32 * bj) = w; }
                }
        } else {
            const bool sg = pn >= 8;
#pragma unroll
            for (int ai = 0; ai < 2; ++ai)
#pragma unroll
                for (int m = 0; m < 4; ++m) {
                    bf16_t* rowp = out + (size_t)(row0 + ai * HALF + m * 16) * INW + colb;
#pragma unroll
                    for (int bj = 0; bj < 2; ++bj) { f32x4 v0 = acc[ai][bj][m][0], v1 = acc[ai][bj][m][1];
                        if (sg) {
#pragma unroll
                            for (int j = 0; j < 4; ++j) { v0[j] = sigmoidf_(v0[j]); v1[j] = sigmoidf_(v1[j]); } }
                        u32x4 w; w.x = pack2(v0[0], v0[1]); w.y = pack2(v0[2], v0[3]); w.z = pack2(v1[0], v1[1]); w.w = pack2(v1[2], v1[3]);
                        *(u32x4*)(rowp + 32 * bj) = w; }
                }
        }
    }
};
template <int MODE> struct EpiGate {
    static constexpr bool PERM = true;
    const bf16_t* gate; const bf16_t* t1in; bf16_t* out;
    __device__ __forceinline__ void operator()(const f32x4 (&acc)[2][2][4][2], const Unit& u, int wr, int wc, int fr, int fq) const {
        const int row0 = u.row0 + wr * 64 + fr, col0 = u.col0 + wc * 32 + 8 * fq;
#pragma unroll
        for (int ai = 0; ai < 2; ++ai)
#pragma unroll
            for (int m = 0; m < 4; ++m) {
                const size_t r = (size_t)(row0 + ai * HALF + m * 16);
#pragma unroll
                for (int bj = 0; bj < 2; ++bj) {
                    const int c = col0 + bj * HALF;
                    const u32x4 g = *(const u32x4*)(gate + r * INW + c);
                    const f32x4 a0 = acc[ai][bj][m][0], a1 = acc[ai][bj][m][1];
                    float o[8] = {a0[0] * bflo(g.x), a0[1] * bfhi(g.x), a0[2] * bflo(g.y), a0[3] * bfhi(g.y), a1[0] * bflo(g.z), a1[1] * bfhi(g.z), a1[2] * bflo(g.w), a1[3] * bfhi(g.w)};
                    if (MODE == 1) { const u32x4 t = *(const u32x4*)(t1in + r * DM + c);
                        o[0] += bflo(t.x); o[1] += bfhi(t.x); o[2] += bflo(t.y); o[3] += bfhi(t.y); o[4] += bflo(t.z); o[5] += bfhi(t.z); o[6] += bflo(t.w); o[7] += bfhi(t.w); }
                    u32x4 w; w.x = pack2(o[0], o[1]); w.y = pack2(o[2], o[3]); w.z = pack2(o[4], o[5]); w.w = pack2(o[6], o[7]);
                    *(u32x4*)(out + r * DM + c) = w;
                }
            }
    }
};
struct EpiResid {
    static constexpr bool PERM = false;
    const float* xin; float* xout;
    __device__ __forceinline__ void operator()(const f32x4 (&acc)[2][2][4][2], const Unit& u, int wr, int wc, int fr, int fq) const {
        const int row0 = u.row0 + wr * 64 + fr, col0 = u.col0 + wc * 32 + 4 * fq;
#pragma unroll
        for (int ai = 0; ai < 2; ++ai)
#pragma unroll
            for (int m = 0; m < 4; ++m) { const size_t off = (size_t)(row0 + ai * HALF + m * 16) * DM + col0;
#pragma unroll
                for (int bj = 0; bj < 2; ++bj)
#pragma unroll
                    for (int n = 0; n < 2; ++n) { const f32x4 x = *(const f32x4*)(xin + off + bj * HALF + n * 16); *(f32x4*)(xout + off + bj * HALF + n * 16) = x + acc[ai][bj][m][n]; } }
    }
};
struct EpiSwiGLU {
    static constexpr bool PERM = true;
    bf16_t* act;
    __device__ __forceinline__ void operator()(const f32x4 (&acc)[2][2][4][2], const Unit& u, int wr, int wc, int fr, int fq) const {
        const int row0 = u.row0 + wr * 64 + fr, col0 = (u.col0 >> 1) + wc * 32 + 8 * fq;
#pragma unroll
        for (int ai = 0; ai < 2; ++ai)
#pragma unroll
            for (int m = 0; m < 4; ++m) {
                float o[8];
#pragma unroll
                for (int n = 0; n < 2; ++n)
#pragma unroll
                    for (int j = 0; j < 4; ++j) { const float a = acc[ai][0][m][n][j], b = acc[ai][1][m][n][j]; o[4 * n + j] = a * sigmoidf_(a) * b; }
                u32x4 w; w.x = pack2(o[0], o[1]); w.y = pack2(o[2], o[3]); w.z = pack2(o[4], o[5]); w.w = pack2(o[6], o[7]);
                *(u32x4*)(act + (size_t)(row0 + ai * HALF + m * 16) * EH + col0) = w;
            }
    }
};
struct EpiDown {
    static constexpr bool PERM = true;
    bf16_t* yb; const float* tokW;
    __device__ __forceinline__ void operator()(const f32x4 (&acc)[2][2][4][2], const Unit& u, int wr, int wc, int fr, int fq) const {
        const int col0 = u.col0 + wc * 32 + 8 * fq;
#pragma unroll
        for (int ai = 0; ai < 2; ++ai)
#pragma unroll
            for (int m = 0; m < 4; ++m) {
                const int rl = wr * 64 + fr + ai * HALF + m * 16;
                const float w = rl < u.nvalid ? tokW[u.j0 + rl] : 0.f;
#pragma unroll
                for (int bj = 0; bj < 2; ++bj) { const f32x4 v0 = acc[ai][bj][m][0] * w, v1 = acc[ai][bj][m][1] * w;
                    u32x4 o; o.x = pack2(v0[0], v0[1]); o.y = pack2(v0[2], v0[3]); o.z = pack2(v1[0], v1[1]); o.w = pack2(v1[2], v1[3]);
                    *(u32x4*)(yb + (size_t)(u.row0 + rl) * DM + col0 + bj * HALF) = o; }
            }
    }
};
}

constexpr int ATT_K_OFF = 0, ATT_V_OFF = 49152;
__device__ __forceinline__ unsigned kv_off(unsigned row, unsigned ch) { return row * 128u + 16u * (ch ^ (((row >> 1) & 7u) ^ ((row & 2u) << 1))); }

__device__ __forceinline__ void attn_unit(LAS unsigned char* lds, const bf16_t* __restrict__ proj, bf16_t* __restrict__ og, f32x2* __restrict__ ml, int uidx) {
    const int tid = opaque_tid(), wid = __builtin_amdgcn_readfirstlane(tid >> 6), lane = tid & 63;
    const int bh = uidx / 48, r48 = uidx % 48, g = r48 >> 4, rr = r48 & 15;
    const int b = bh >> 3, h = bh & 7;
    const int d = (g == 0) ? 1 : (g == 1 ? 4 : 16);
    const int c = (g == 0) ? 0 : (g == 1 ? (rr >> 2) : rr);
    const int blk = (g == 0) ? rr : (g == 1 ? (rr & 3) : 0);
    const int tok0 = b * SEQ + c;
    const int kbase = 256 * blk - 128;
    const int kr_min = (blk == 0) ? 128 : 0;
#pragma unroll
    for (int i = 0; i < 6; ++i) {
        const int idx = tid + NTHREADS * i, row = idx >> 3, ch = idx & 7;
        if (row >= kr_min) {
            const size_t t = (size_t)(tok0 + (kbase + row) * d);
            const u32x4 kv = *(const u32x4*)(proj + t * INW + AW + h * HD + ch * 8);
            const u32x4 vv = *(const u32x4*)(proj + t * INW + 2 * AW + h * HD + ch * 8);
            *(LAS u32x4*)(lds + ATT_K_OFF + kv_off(row, ch)) = kv;
            *(LAS u32x4*)(lds + ATT_V_OFF + kv_off(row, ch)) = vv;
        }
    }
    const int qn = 256 * blk + 32 * wid + (lane & 31);
    const size_t qt = (size_t)(tok0 + qn * d);
    bf16x8 qf[4];
#pragma unroll
    for (int ks = 0; ks < 4; ++ks) qf[ks] = *(const bf16x8*)(proj + qt * INW + h * HD + 16 * ks + 8 * (lane >> 5));
    __syncthreads();
    const int kt_min = (blk == 0) ? max(0, 4 - wid) : 0;
    const int hq = lane >> 5, qi = lane & 31;
    f32x16 S[5];
#pragma unroll
    for (int kt = 0; kt < 5; ++kt) {
#pragma unroll
        for (int i = 0; i < 16; ++i) S[kt][i] = 0.f;
        if (kt >= kt_min) {
            const unsigned krow = (unsigned)(32 * wid + 32 * kt + qi);
#pragma unroll
            for (int ks = 0; ks < 4; ++ks) {
                const bf16x8 kf = *(const LAS bf16x8*)(lds + ATT_K_OFF + kv_off(krow, (unsigned)(2 * ks + hq)));
                S[kt] = __builtin_amdgcn_mfma_f32_32x32x16_bf16(kf, qf[ks], S[kt], 0, 0, 0);
            }
        }
    }
    float mx = -3.0e38f;
#pragma unroll
    for (int kt = 0; kt < 5; ++kt)
#pragma unroll
        for (int i = 0; i < 16; ++i) {
            const int row = (i & 3) + 8 * (i >> 2) + 4 * hq;
            bool valid = kt >= kt_min;
            if (kt == 0) valid = valid && (row >= qi);
            if (kt == 4) valid = valid && (row <= qi);
            S[kt][i] = valid ? S[kt][i] : -3.0e38f;
            mx = fmaxf(mx, S[kt][i]);
        }
    mx = fmaxf(mx, __shfl_xor(mx, 32));
    float lsum = 0.f;
#pragma unroll
    for (int kt = 0; kt < 5; ++kt)
#pragma unroll
        for (int i = 0; i < 16; ++i) { const float p = (S[kt][i] > -1.0e38f) ? __expf(S[kt][i] - mx) : 0.f; S[kt][i] = p; lsum += p; }
    lsum += __shfl_xor(lsum, 32);
    f32x16 O[2];
#pragma unroll
    for (int dt = 0; dt < 2; ++dt)
#pragma unroll
        for (int i = 0; i < 16; ++i) O[dt][i] = 0.f;
    const unsigned blkq = (lane >> 4) & 1, q4 = (lane & 15) >> 2, p4 = lane & 3;
    const unsigned vbase = (unsigned)(size_t)(lds + ATT_V_OFF);
#pragma unroll
    for (int kt = 0; kt < 5; ++kt) {
        if (kt >= kt_min) {
#pragma unroll
            for (int s = 0; s < 2; ++s) {
                u32x4 pw;
                pw.x = pack2(S[kt][8 * s + 0], S[kt][8 * s + 1]); pw.y = pack2(S[kt][8 * s + 2], S[kt][8 * s + 3]);
                pw.z = pack2(S[kt][8 * s + 4], S[kt][8 * s + 5]); pw.w = pack2(S[kt][8 * s + 6], S[kt][8 * s + 7]);
                const bf16x8 pf = __builtin_bit_cast(bf16x8, pw);
                u32x2 v00, v01, v10, v11;
                const unsigned r0 = (unsigned)(32 * wid + 32 * kt + 16 * s + 4 * hq) + q4, r1 = r0 + 8;
                const unsigned a00 = vbase + kv_off(r0, 0u + 2 * blkq + (p4 >> 1)) + 8 * (p4 & 1), a01 = vbase + kv_off(r1, 0u + 2 * blkq + (p4 >> 1)) + 8 * (p4 & 1);
                const unsigned a10 = vbase + kv_off(r0, 4u + 2 * blkq + (p4 >> 1)) + 8 * (p4 & 1), a11 = vbase + kv_off(r1, 4u + 2 * blkq + (p4 >> 1)) + 8 * (p4 & 1);
                asm volatile("ds_read_b64_tr_b16 %0, %4\n\tds_read_b64_tr_b16 %1, %5\n\tds_read_b64_tr_b16 %2, %6\n\tds_read_b64_tr_b16 %3, %7\n\ts_waitcnt lgkmcnt(0)"
                             : "=&v"(v00), "=&v"(v01), "=&v"(v10), "=&v"(v11) : "v"(a00), "v"(a01), "v"(a10), "v"(a11) : "memory");
                u32x4 f0; f0.x = v00.x; f0.y = v00.y; f0.z = v01.x; f0.w = v01.y;
                u32x4 f1; f1.x = v10.x; f1.y = v10.y; f1.z = v11.x; f1.w = v11.y;
                O[0] = __builtin_amdgcn_mfma_f32_32x32x16_bf16(__builtin_bit_cast(bf16x8, f0), pf, O[0], 0, 0, 0);
                O[1] = __builtin_amdgcn_mfma_f32_32x32x16_bf16(__builtin_bit_cast(bf16x8, f1), pf, O[1], 0, 0, 0);
            }
        }
    }
    const float inv = 1.0f / lsum;
    bf16_t* orow = og + ((size_t)g * NTOK + qt) * AW + h * HD;
#pragma unroll
    for (int dt = 0; dt < 2; ++dt)
#pragma unroll
        for (int gq4 = 0; gq4 < 4; ++gq4) {
            u32x2 w; w.x = pack2(O[dt][4 * gq4 + 0] * inv, O[dt][4 * gq4 + 1] * inv); w.y = pack2(O[dt][4 * gq4 + 2] * inv, O[dt][4 * gq4 + 3] * inv);
            *(u32x2*)(orow + 32 * dt + 8 * gq4 + 4 * hq) = w;
        }
    if (lane < 32) ml[((size_t)g * NTOK + qt) * 8 + h] = (f32x2){mx, lsum};
    __syncthreads();
}

struct TrDesc { const float* src; bf16_t* dst; int N, K; };
__device__ __forceinline__ void tr_load(const TrDesc& d, int lane, f32x4 (&r)[8]) {
#pragma unroll
    for (int i = 0; i < 8; ++i) r[i] = __builtin_nontemporal_load((const f32x4*)(d.src + (size_t)((lane >> 3) + 8 * i) * d.N + 4 * (lane & 7)));
}
__device__ __forceinline__ void tr_store(const TrDesc& d, LAS float* scr, int lane, const f32x4 (&r)[8]) {
#pragma unroll
    for (int i = 0; i < 8; ++i) { LAS float* p = scr + ((lane >> 3) + 8 * i) * 33 + 4 * (lane & 7); p[0] = r[i][0]; p[1] = r[i][1]; p[2] = r[i][2]; p[3] = r[i][3]; }
    const int c = lane & 7;
#pragma unroll
    for (int j = 0; j < 4; ++j) { const int n = (lane >> 3) + 8 * j; const LAS float* q = scr + (8 * c) * 33 + n;
        u32x4 o; o.x = pack2(q[0 * 33], q[1 * 33]); o.y = pack2(q[2 * 33], q[3 * 33]); o.z = pack2(q[4 * 33], q[5 * 33]); o.w = pack2(q[6 * 33], q[7 * 33]);
        *(u32x4*)(d.dst + (size_t)n * d.K + 8 * c) = o; }
}
struct ExpertItems {
    const float* weg; const float* weu; const float* wed; bf16_t* WguT; bf16_t* WdT;
    static constexpr int TOTAL = 3 * NEXP * 256;
    __device__ __forceinline__ TrDesc operator()(int it) const {
        const int which = it >> 13, r = it & 8191, e = r >> 8, item = r & 255; TrDesc d;
        if (which < 2) { const int kb = item >> 4, nb = item & 15, k0 = 64 * kb, n0 = 32 * nb, nn0 = (n0 >> 7) * 256 + which * 128 + (n0 & 127);
            d.src = (which == 0 ? weg : weu) + (size_t)e * DM * EH + (size_t)k0 * EH + n0; d.dst = WguT + (size_t)e * DM * DM + (size_t)nn0 * DM + k0; d.N = EH; d.K = DM; }
        else { const int kb = item >> 5, nb = item & 31, k0 = 64 * kb, n0 = 32 * nb;
            d.src = wed + (size_t)e * EH * DM + (size_t)k0 * DM + n0; d.dst = WdT + (size_t)e * DM * EH + (size_t)n0 * EH + k0; d.N = DM; d.K = EH; }
        return d;
    }
};
struct SmallItems {
    const float* win; const float* wa; const float* wo; bf16_t* WinT; bf16_t* WaT; bf16_t* WoT;
    static constexpr int TOTAL = 2 * 2816;
    __device__ __forceinline__ TrDesc operator()(int it) const {
        const int l = it / 2816, r = it % 2816; TrDesc d;
        if (r < 2048) { const int kb = r >> 7, nb = r & 127; d.src = win + (size_t)l * DM * INW + (size_t)(64 * kb) * INW + 32 * nb; d.dst = WinT + (size_t)l * INW * DM + (size_t)(32 * nb) * DM + 64 * kb; d.N = INW; d.K = DM; }
        else if (r < 2304) { const int q = r - 2048, kb = q >> 5, nb = q & 31; d.src = wa + (size_t)l * AW * DM + (size_t)(64 * kb) * DM + 32 * nb; d.dst = WaT + (size_t)l * DM * AW + (size_t)(32 * nb) * AW + 64 * kb; d.N = DM; d.K = AW; }
        else { const int q = r - 2304, kb = q >> 5, nb = q & 31; d.src = wo + (size_t)l * DM * DM + (size_t)(64 * kb) * DM + 32 * nb; d.dst = WoT + (size_t)l * DM * DM + (size_t)(32 * nb) * DM + 64 * kb; d.N = DM; d.K = DM; }
        return d;
    }
};
template <class Items>
__device__ __forceinline__ void convert_items(const Items& I, LAS float* scr, int lane, int gw, int NGW) {
    f32x4 ra[8], rb[8];
    int it = gw;
    if (it >= Items::TOTAL) return;
    TrDesc da = I(it), db = da;
    tr_load(da, lane, ra);
    for (;;) {
        int it2 = it + NGW;
        if (it2 < Items::TOTAL) { db = I(it2); tr_load(db, lane, rb); }
        tr_store(da, scr, lane, ra);
        it = it2; if (it >= Items::TOTAL) break;
        it2 = it + NGW;
        if (it2 < Items::TOTAL) { da = I(it2); tr_load(da, lane, ra); }
        tr_store(db, scr, lane, rb);
        it = it2; if (it >= Items::TOTAL) break;
    }
}
__device__ __forceinline__ void norm_row(const float* __restrict__ xr, const float* __restrict__ g, bf16_t* __restrict__ hr, int lane) {
    f32x4 v[4]; float ss = 0.f;
#pragma unroll
    for (int i = 0; i < 4; ++i) { v[i] = *(const f32x4*)(xr + (i * 64 + lane) * 4); ss += (v[i][0] * v[i][0] + v[i][1] * v[i][1]) + (v[i][2] * v[i][2] + v[i][3] * v[i][3]); }
    ss = wave_sum(ss);
    const float rstd = rsqrtf(ss * (1.0f / DM) + RMS_EPS);
#pragma unroll
    for (int i = 0; i < 4; ++i) {
        const f32x4 gv = *(const f32x4*)(g + (i * 64 + lane) * 4);
        u32x2 w; w.x = pack2(v[i][0] * rstd * gv[0], v[i][1] * rstd * gv[1]); w.y = pack2(v[i][2] * rstd * gv[2], v[i][3] * rstd * gv[3]);
        *(u32x2*)(hr + (i * 64 + lane) * 4) = w;
    }
}
typedef const __attribute__((address_space(4))) float* cfp;
typedef const __attribute__((address_space(4))) f32x2* cf2p;
__device__ __forceinline__ void unpack8(const u32x4 v, float (&f)[8]) { f[0] = bflo(v.x); f[1] = bfhi(v.x); f[2] = bflo(v.y); f[3] = bfhi(v.y); f[4] = bflo(v.z); f[5] = bfhi(v.z); f[6] = bflo(v.w); f[7] = bfhi(v.w); }
template <int W>
__device__ __forceinline__ void pool_path(const u32x4 (&r)[23], int pos0, bf16_t* __restrict__ pl, size_t t0, int c0) {
    float sum[8] = {0.f, 0.f, 0.f, 0.f, 0.f, 0.f, 0.f, 0.f}, f[8];
#pragma unroll
    for (int j = 1; j < W; ++j) { unpack8(r[15 - j], f);
#pragma unroll
        for (int c = 0; c < 8; ++c) sum[c] += f[c]; }
#pragma unroll
    for (int i = 0; i < 8; ++i) {
        float u[8]; unpack8(r[15 + i], u);
        if (i > 0) { unpack8(r[15 + i - W], f);
#pragma unroll
            for (int c = 0; c < 8; ++c) sum[c] -= f[c]; }
#pragma unroll
        for (int c = 0; c < 8; ++c) sum[c] += u[c];
        const float ic = 1.0f / (float)min(pos0 + i + 1, W);
        u32x4 o; o.x = pack2(sum[0] * ic - u[0], sum[1] * ic - u[1]); o.y = pack2(sum[2] * ic - u[2], sum[3] * ic - u[3]);
        o.z = pack2(sum[4] * ic - u[4], sum[5] * ic - u[5]); o.w = pack2(sum[6] * ic - u[6], sum[7] * ic - u[7]);
        *(u32x4*)(pl + (t0 + i) * PW + c0) = o;
    }
}
__device__ __forceinline__ void build_moe_tables(LAS int* L, const unsigned* cnt) {
    if (threadIdx.x == 0) {
        int t = 0, p = 0;
        for (int e = 0; e < NEXP; ++e) { const int c = (int)__hip_atomic_load(cnt + e * 64, __ATOMIC_RELAXED, __HIP_MEMORY_SCOPE_AGENT); L[LI_TB + e] = t; L[LI_PS + e] = p; L[LI_CN + e] = c; const int nt = (c + 255) >> 8; t += nt; p += nt * 256; }
        L[LI_TB + NEXP] = t; L[LI_PS + NEXP] = p;
    }
    __syncthreads();
}

struct Args { const float* in[18]; float* out; unsigned char* ws; int ph_lo, ph_hi; };
typedef const __attribute__((address_space(4))) Args* CArgsP;
__device__ __forceinline__ CArgsP kargs() { unsigned long long p = (unsigned long long)__builtin_amdgcn_kernarg_segment_ptr(); asm volatile("" : "+s"(p)); return (CArgsP)p; }
#define PHASE_PTRS \
    const CArgsP ka = kargs(); unsigned char* const ws = ka->ws; \
    unsigned* const ctrl = (unsigned*)(ws + OFF_CTRL); const float* const x_in = ka->in[0]; \
    bf16_t* const WinT = (bf16_t*)(ws + OFF_WIN); bf16_t* const WaT = (bf16_t*)(ws + OFF_WA); bf16_t* const WppT = (bf16_t*)(ws + OFF_WPP); bf16_t* const WoT = (bf16_t*)(ws + OFF_WO); \
    bf16_t* const WguT = (bf16_t*)(ws + OFF_WGU); bf16_t* const WdT = (bf16_t*)(ws + OFF_WD); \
    bf16_t* const Hb = (bf16_t*)(ws + OFF_H); bf16_t* const MG = Hb; bf16_t* const PROJ = (bf16_t*)(ws + OFF_PROJ); bf16_t* const ACT = (bf16_t*)(ws + OFF_ACT); bf16_t* const YB = (bf16_t*)(ws + OFF_YB); \
    bf16_t* const AC = (bf16_t*)(ws + OFF_AC); bf16_t* const PL = (bf16_t*)(ws + OFF_PL); bf16_t* const OG = (bf16_t*)(ws + OFF_OG); bf16_t* const T1 = (bf16_t*)(ws + OFF_T1); \
    f32x2* const ML = (f32x2*)(ws + OFF_ML); float* const XB = (float*)(ws + OFF_XB); int* const tokE = (int*)(ws + OFF_TOKE); float* const tokW = (float*)(ws + OFF_TOKW); int* const asg = (int*)(ws + OFF_ASG); \
    (void)ctrl; (void)x_in; (void)WinT; (void)WaT; (void)WppT; (void)WoT; (void)WguT; (void)WdT; (void)Hb; (void)MG; (void)PROJ; (void)ACT; (void)YB; (void)AC; (void)PL; (void)OG; (void)T1; (void)ML; (void)XB; (void)tokE; (void)tokW; (void)asg
#define LAYER_PTRS PHASE_PTRS; const int tid = opaque_tid(), lane = tid & 63, wid = __builtin_amdgcn_readfirstlane(tid >> 6), gw = vcu * NWAVES + wid; (void)lane; (void)gw; const float* const xin = (l == 0) ? x_in : XB; unsigned* const cnt = ctrl + CW_CNT + l * 2048; (void)xin; (void)cnt

__global__ void __launch_bounds__(NTHREADS, 2) fwd_kernel(Args args) {
    extern __shared__ __attribute__((aligned(16))) unsigned char lds_raw[];
    LAS unsigned char* lds = (LAS unsigned char*)lds_raw;
    LAS int* LC = (LAS int*)(lds + LCTL_OFF);
    const int G = gridDim.x, bx = blockIdx.x;
    const int vcu = (G % 8 == 0) ? (bx % 8) * (G / 8) + bx / 8 : bx;
    if (threadIdx.x < 4) LC[LI_BAR + threadIdx.x] = 0;
    __syncthreads();
    XcdBarrier bar; bar.bar = (unsigned*)(args.ws + OFF_CTRL) + CW_BAR; bar.x = 0; bar.st = nullptr;
    if (MK_N_LAUNCHES == 1) bar = xcd_barrier_post(bar.bar, (volatile LAS unsigned*)(LC + LI_BAR));
    const int lo = args.ph_lo, hi = args.ph_hi;
#ifndef PHASE_MASK
#define PHASE_MASK 0x3ff
#endif
#define EN(j) (((PHASE_MASK) >> (j)) & 1)
#ifndef REP_MASK
#define REP_MASK 0
#endif
#define REPS(j) (1 + (((REP_MASK) >> (j)) & 1))
#define IN(k) (lo <= (k) && (k) < hi)
#ifndef PROBE_A
#define PROBE_A -1
#define PROBE_B -1
#endif
    unsigned long long ts0 = 0ull, ts1 = 0ull;
#define STAMP_BEGIN(k) do { if (PROBE_A == (k)) ts0 = __builtin_amdgcn_s_memrealtime(); } while (0)
#define SEAM(k) do { if (IN(k) && IN((k) + 1)) xcd_barrier(bar); if (PROBE_B == (k)) ts1 = __builtin_amdgcn_s_memrealtime(); } while (0)
    const int NGW = G * NWAVES;

    STAMP_BEGIN(0);
    for (int rep = 0; rep < REPS(9); ++rep) if (EN(9) && IN(0)) {
        asm volatile("; PHASE_MARK 9");
        PHASE_PTRS; const int tid = opaque_tid(), lane = tid & 63, wid = __builtin_amdgcn_readfirstlane(tid >> 6), gw = vcu * NWAVES + wid;
        LAS float* scr = (LAS float*)(lds + wid * 8704);
        { SmallItems I{ka->in[2], ka->in[5], ka->in[9], WinT, WaT, WoT}; convert_items(I, scr, lane, gw, NGW); }
        for (int o = bx * NTHREADS + tid; o < DEPTH * PW * DM; o += G * NTHREADS) {
            const int l = o / (PW * DM), r = o % (PW * DM), k = r / DM, n = r % DM, g = k >> 7;
            const float* wm = ka->in[6] + (size_t)l * 4 * 128 * 128 + (size_t)k * 128;
            const float* sc = ka->in[7] + (size_t)l * PW + g * 128;
            const float* wp = ka->in[8] + (size_t)l * PW * DM + (size_t)(g * 128) * DM + n;
            float a = 0.f;
            for (int dd = 0; dd < 128; ++dd) a += wm[dd] * sc[dd] * wp[(size_t)dd * DM];
            WppT[(size_t)l * DM * PW + (size_t)n * PW + k] = f2bf(a);
        }
        { ExpertItems I{ka->in[15], ka->in[16], ka->in[17], WguT, WdT}; convert_items(I, scr, lane, gw, NGW); }
        for (int m = gw; m < NTOK; m += NGW) norm_row(x_in + (size_t)m * DM, ka->in[1], Hb + (size_t)m * DM, lane);
    }
    SEAM(0);

    for (int l = 0; l < DEPTH; ++l) {
        const int pb = 1 + 9 * l;
        STAMP_BEGIN(pb + 0);
        for (int rep = 0; rep < REPS(0); ++rep) if (EN(0) && IN(pb + 0)) {
            asm volatile("; PHASE_MARK 0");
            LAYER_PTRS;
            pg8::DenseOrder S; S.init(Hb, WinT + (size_t)l * INW * DM, NTOK, INW, DM, G, bx);
            pg8::EpiProj E{PROJ, ka->in[3] + (size_t)l * HD, ka->in[4] + (size_t)l * HD};
            pg8::gemm_phase<pg8::EpiProj, pg8::DenseOrder, 1, false>(lds, DM, S, E);
        }
        SEAM(pb + 0);
        STAMP_BEGIN(pb + 1);
        for (int rep = 0; rep < REPS(1); ++rep) if (EN(1) && IN(pb + 1)) {
            asm volatile("; PHASE_MARK 1");
            LAYER_PTRS;
            for (int u = vcu; u < 1536; u += G) attn_unit(lds, PROJ, OG, ML, u);
        }
        SEAM(pb + 1);
        STAMP_BEGIN(pb + 2);
        for (int rep = 0; rep < REPS(2); ++rep) if (EN(2) && IN(pb + 2)) {
            asm volatile("; PHASE_MARK 2");
            LAYER_PTRS;
            for (int grp = gw; grp < NTOK / 8; grp += NGW) {
                const size_t t0 = (size_t)grp * 8; const int c0 = 8 * lane, hh = lane >> 3;
                {
                    f32x2 sm[8][3]; u32x4 v[8][3];
#pragma unroll
                    for (int i = 0; i < 8; ++i)
#pragma unroll
                        for (int g = 0; g < 3; ++g) { sm[i][g] = ML[((size_t)g * NTOK + t0 + i) * 8 + hh]; v[i][g] = *(const u32x4*)(OG + ((size_t)g * NTOK + t0 + i) * AW + c0); }
#pragma unroll
                    for (int i = 0; i < 8; ++i) {
                        const float M = fmaxf(fmaxf(sm[i][0][0], sm[i][1][0]), sm[i][2][0]);
                        float w[3], W = 0.f;
#pragma unroll
                        for (int g = 0; g < 3; ++g) { w[g] = sm[i][g][1] * __expf(sm[i][g][0] - M); W += w[g]; }
                        const float iw = 1.0f / W;
                        float o[8] = {0.f, 0.f, 0.f, 0.f, 0.f, 0.f, 0.f, 0.f}, f[8];
#pragma unroll
                        for (int g = 0; g < 3; ++g) { unpack8(v[i][g], f); const float q = w[g] * iw;
#pragma unroll
                            for (int c = 0; c < 8; ++c) o[c] += q * f[c]; }
                        u32x4 ow; ow.x = pack2(o[0], o[1]); ow.y = pack2(o[2], o[3]); ow.z = pack2(o[4], o[5]); ow.w = pack2(o[6], o[7]);
                        *(u32x4*)(AC + (t0 + i) * AW + c0) = ow;
                    }
                }
                {
                    const int pos0 = (int)(t0 & (SEQ - 1)), g4 = lane >> 4, wnd = 2 << g4;
                    u32x4 r[23];
#pragma unroll
                    for (int k = 0; k < 23; ++k) { const bool need = (k >= 16 - wnd) && (pos0 - 15 + k >= 0);
                        r[k] = need ? *(const u32x4*)(PROJ + (t0 - 15 + k) * INW + 3 * AW + c0) : (u32x4){0u, 0u, 0u, 0u}; }
                    if (g4 == 0) pool_path<2>(r, pos0, PL, t0, c0);
                    else if (g4 == 1) pool_path<4>(r, pos0, PL, t0, c0);
                    else if (g4 == 2) pool_path<8>(r, pos0, PL, t0, c0);
                    else pool_path<16>(r, pos0, PL, t0, c0);
                }
            }
        }
        SEAM(pb + 2);
        STAMP_BEGIN(pb + 3);
        for (int rep = 0; rep < REPS(3); ++rep) if (EN(3) && IN(pb + 3)) {
            asm volatile("; PHASE_MARK 3");
            LAYER_PTRS;
            { pg8::DenseOrder S; S.init(AC, WaT + (size_t)l * DM * AW, NTOK, DM, AW, G, bx);
              pg8::EpiGate<0> E{PROJ + 2048, nullptr, T1};
              pg8::gemm_phase<pg8::EpiGate<0>, pg8::DenseOrder, 0, false>(lds, AW, S, E); }
            { pg8::DenseOrder S; S.init(PL, WppT + (size_t)l * DM * PW, NTOK, DM, PW, G, bx);
              pg8::EpiGate<1> E{PROJ + 3072, T1, MG};
              pg8::gemm_phase<pg8::EpiGate<1>, pg8::DenseOrder, 0, false>(lds, PW, S, E); }
        }
        SEAM(pb + 3);
        STAMP_BEGIN(pb + 4);
        if (EN(4) && IN(pb + 4)) {
            asm volatile("; PHASE_MARK 4");
            LAYER_PTRS;
            pg8::DenseOrder S; S.init(MG, WoT + (size_t)l * DM * DM, NTOK, DM, DM, G, bx);
            pg8::EpiResid E{xin, XB};
            pg8::gemm_phase<pg8::EpiResid, pg8::DenseOrder, 0, false>(lds, DM, S, E);
        }
        SEAM(pb + 4);
        STAMP_BEGIN(pb + 5);
        if (EN(5) && IN(pb + 5)) {
            asm volatile("; PHASE_MARK 5");
            LAYER_PTRS;
            LAS float* part = (LAS float*)lds;
            LAS float* lg = (LAS float*)(lds + 77824);
            LAS int* aE = (LAS int*)(lds + 90112); LAS float* aW = (LAS float*)(lds + 90112 + 512); LAS int* bs = (LAS int*)(lds + 90112 + 1024); LAS float* rs = (LAS float*)(lds + 90112 + 1536);
            const float* g2 = ka->in[10] + (size_t)l * DM; const float* brg = ka->in[12] + (size_t)l * 4; const float* bre = ka->in[14] + (size_t)l * 32;
            const cfp g2c = (cfp)(unsigned long long)g2, wrgc = (cfp)(unsigned long long)(ka->in[11] + (size_t)l * DM * 4), wrec = (cfp)(unsigned long long)(ka->in[13] + (size_t)l * 4 * DM * 8);
            for (int chunk = bx; chunk < NTOK / 64; chunk += G) {
                {
                    const float* xr = XB + (size_t)(chunk * 64 + lane) * DM + 128 * wid;
                    f32x2 acc[18]; float ss = 0.f;
#pragma unroll
                    for (int i = 0; i < 18; ++i) acc[i] = (f32x2){0.f, 0.f};
                    for (int dc = 0; dc < 128; dc += 4) {
                        const f32x4 xv = *(const f32x4*)(xr + dc);
#pragma unroll
                        for (int j = 0; j < 4; ++j) {
                            const int d = 128 * wid + dc + j; const float x = xv[j]; ss += x * x;
                            const float xg = x * g2c[d]; const f32x2 xx = {xg, xg};
                            acc[0] += xx * *(cf2p)(wrgc + d * 4); acc[1] += xx * *(cf2p)(wrgc + d * 4 + 2);
#pragma unroll
                            for (int g = 0; g < 4; ++g)
#pragma unroll
                                for (int o2 = 0; o2 < 4; ++o2) acc[2 + 4 * g + o2] += xx * *(cf2p)(wrec + ((size_t)g * DM + d) * 8 + 2 * o2);
                        }
                    }
#pragma unroll
                    for (int i = 0; i < 18; ++i) { part[(wid * 37 + 2 * i) * 64 + lane] = acc[i][0]; part[(wid * 37 + 2 * i + 1) * 64 + lane] = acc[i][1]; }
                    part[(wid * 37 + 36) * 64 + lane] = ss;
                }
                __syncthreads();
                for (int o = tid >> 6; o < 37; o += 8) { float sum = 0.f;
#pragma unroll
                    for (int w = 0; w < 8; ++w) sum += part[(w * 37 + o) * 64 + lane];
                    lg[o * 64 + lane] = sum; }
                __syncthreads();
                if (tid < 64) {
                    const float rstd = rsqrtf(lg[36 * 64 + tid] * (1.0f / DM) + RMS_EPS); rs[tid] = rstd;
                    float gl[4];
#pragma unroll
                    for (int o = 0; o < 4; ++o) gl[o] = lg[o * 64 + tid] * rstd + brg[o];
                    int gs = 0; float gm = gl[0];
#pragma unroll
                    for (int o = 1; o < 4; ++o) if (gl[o] > gm) { gm = gl[o]; gs = o; }
                    float gden = 0.f;
#pragma unroll
                    for (int o = 0; o < 4; ++o) gden += __expf(gl[o] - gm);
                    const float ggate = 1.0f / gden;
                    float el[8];
#pragma unroll
                    for (int o = 0; o < 8; ++o) el[o] = lg[(4 + 8 * gs + o) * 64 + tid] * rstd + bre[gs * 8 + o];
                    int i0 = 0; float m0 = el[0];
#pragma unroll
                    for (int o = 1; o < 8; ++o) if (el[o] > m0) { m0 = el[o]; i0 = o; }
                    int i1 = 0; float m1 = -3.0e38f;
#pragma unroll
                    for (int o = 0; o < 8; ++o) if (o != i0 && el[o] > m1) { m1 = el[o]; i1 = o; }
                    const float e1 = __expf(m1 - m0);
                    aE[2 * tid] = gs * 8 + i0; aE[2 * tid + 1] = gs * 8 + i1; aW[2 * tid] = ggate / (1.0f + e1); aW[2 * tid + 1] = ggate * e1 / (1.0f + e1);
                }
                __syncthreads();
                int myE = 0, rank = 0;
                if (tid < 128) { myE = aE[tid]; for (int a = 0; a < tid; ++a) rank += (aE[a] == myE) ? 1 : 0; }
                if (tid < NEXP) { int c = 0; for (int a = 0; a < 128; ++a) c += (aE[a] == tid) ? 1 : 0;
                    bs[tid] = c ? (int)__hip_atomic_fetch_add(cnt + tid * 64, (unsigned)c, __ATOMIC_RELAXED, __HIP_MEMORY_SCOPE_AGENT) : 0; }
#pragma unroll 2
                for (int it = 0; it < 8; ++it) {
                    const int ti = wid * 8 + it; const size_t tok = (size_t)chunk * 64 + ti; const float rstd = rs[ti];
#pragma unroll
                    for (int i = 0; i < 4; ++i) { const int d0 = (i * 64 + lane) * 4; const f32x4 xv = *(const f32x4*)(XB + tok * DM + d0), gv = *(const f32x4*)(g2 + d0);
                        u32x2 w; w.x = pack2(xv[0] * rstd * gv[0], xv[1] * rstd * gv[1]); w.y = pack2(xv[2] * rstd * gv[2], xv[3] * rstd * gv[3]);
                        *(u32x2*)(Hb + tok * DM + d0) = w; }
                }
                __syncthreads();
                if (tid < 128) { const int slot = bs[myE] + rank, tok = chunk * 64 + (tid >> 1);
                    tokE[(size_t)myE * ECAP + slot] = tok; tokW[(size_t)myE * ECAP + slot] = aW[tid]; asg[tok * 2 + (tid & 1)] = myE * ECAP + slot; }
                __syncthreads();
            }
        }
        SEAM(pb + 5);
        STAMP_BEGIN(pb + 6);
        for (int rep = 0; rep < REPS(6); ++rep) if (EN(6) && IN(pb + 6)) {
            asm volatile("; PHASE_MARK 6");
            LAYER_PTRS;
            build_moe_tables(LC, cnt);
            pg8::MoeOrder S{(const char*)Hb, (const char*)WguT, (size_t)DM * DM * 2, DM, LC + LI_TB, LC + LI_PS, LC + LI_CN, tokE, G, vcu, true};
            pg8::EpiSwiGLU E{ACT};
            pg8::gemm_phase<pg8::EpiSwiGLU, pg8::MoeOrder, 0, true>(lds, DM, S, E);
        }
        SEAM(pb + 6);
        STAMP_BEGIN(pb + 7);
        for (int rep = 0; rep < REPS(7); ++rep) if (EN(7) && IN(pb + 7)) {
            asm volatile("; PHASE_MARK 7");
            LAYER_PTRS;
            build_moe_tables(LC, cnt);
            pg8::MoeOrder S{(const char*)ACT, (const char*)WdT, (size_t)DM * EH * 2, EH, LC + LI_TB, LC + LI_PS, LC + LI_CN, tokE, G, vcu, false};
            pg8::EpiDown E{YB, tokW};
            pg8::gemm_phase<pg8::EpiDown, pg8::MoeOrder, 0, false>(lds, EH, S, E);
        }
        SEAM(pb + 7);
        STAMP_BEGIN(pb + 8);
        if (EN(8) && IN(pb + 8)) {
            asm volatile("; PHASE_MARK 8");
            LAYER_PTRS;
            build_moe_tables(LC, cnt);
            const bool lastl = (l == DEPTH - 1);
            const float* g1n = ka->in[1] + (size_t)(lastl ? 0 : (l + 1)) * DM;
            float* const xo = lastl ? ka->out : XB;
            for (int grp = gw; grp < NTOK / 4; grp += NGW) {
                const size_t t0 = (size_t)grp * 4;
                const int myasg = (lane < 8) ? asg[t0 * 2 + lane] : 0;
                f32x4 xv[4][4]; u32x2 ya[4][4], yb[4][4];
#pragma unroll
                for (int q = 0; q < 4; ++q) {
                    const int i0 = __builtin_amdgcn_readlane(myasg, 2 * q), i1 = __builtin_amdgcn_readlane(myasg, 2 * q + 1);
                    const size_t s0 = (size_t)(LC[LI_PS + (i0 >> 14)] + (i0 & (ECAP - 1))), s1 = (size_t)(LC[LI_PS + (i1 >> 14)] + (i1 & (ECAP - 1)));
#pragma unroll
                    for (int i = 0; i < 4; ++i) { const int d0 = (i * 64 + lane) * 4;
                        xv[q][i] = *(const f32x4*)(XB + (t0 + q) * DM + d0); ya[q][i] = *(const u32x2*)(YB + s0 * DM + d0); yb[q][i] = *(const u32x2*)(YB + s1 * DM + d0); }
                }
#pragma unroll
                for (int q = 0; q < 4; ++q) {
                    f32x4 v[4]; float ss = 0.f;
#pragma unroll
                    for (int i = 0; i < 4; ++i) { const int d0 = (i * 64 + lane) * 4; const u32x2 a = ya[q][i], b = yb[q][i]; const f32x4 x4 = xv[q][i];
                        v[i][0] = x4[0] + bflo(a.x) + bflo(b.x); v[i][1] = x4[1] + bfhi(a.x) + bfhi(b.x); v[i][2] = x4[2] + bflo(a.y) + bflo(b.y); v[i][3] = x4[3] + bfhi(a.y) + bfhi(b.y);
                        ss += (v[i][0] * v[i][0] + v[i][1] * v[i][1]) + (v[i][2] * v[i][2] + v[i][3] * v[i][3]);
                        *(f32x4*)(xo + (t0 + q) * DM + d0) = v[i]; }
                    if (!lastl) {
                        ss = wave_sum(ss);
                        const float rstd = rsqrtf(ss * (1.0f / DM) + RMS_EPS);
#pragma unroll
                        for (int i = 0; i < 4; ++i) { const int d0 = (i * 64 + lane) * 4; const f32x4 gv = *(const f32x4*)(g1n + d0);
                            u32x2 w; w.x = pack2(v[i][0] * rstd * gv[0], v[i][1] * rstd * gv[1]); w.y = pack2(v[i][2] * rstd * gv[2], v[i][3] * rstd * gv[3]);
                            *(u32x2*)(Hb + (t0 + q) * DM + d0) = w; }
                    }
                }
            }
            if (!lastl) {
                __syncthreads();
                ExpertItems I{ka->in[15] + (size_t)(l + 1) * NEXP * DM * EH, ka->in[16] + (size_t)(l + 1) * NEXP * DM * EH, ka->in[17] + (size_t)(l + 1) * NEXP * EH * DM, WguT, WdT};
                convert_items(I, (LAS float*)(lds + wid * 8704), lane, gw, NGW);
            }
        }
        if (l + 1 < DEPTH) SEAM(pb + 8); else if (PROBE_B == pb + 8) ts1 = __builtin_amdgcn_s_memrealtime();
    }
    if (PROBE_A >= 0 && blockIdx.x == 0) { const unsigned long long d = (ts1 - ts0) * 4ull, t0 = __builtin_amdgcn_s_memrealtime(); while (__builtin_amdgcn_s_memrealtime() - t0 < d) __builtin_amdgcn_s_sleep(8); }
#undef IN
#undef SEAM
}

extern "C" void kernel_launch(void* const* d_in, const int* in_sizes, int n_in, void* d_out, int out_size, void* d_ws, size_t ws_size, hipStream_t stream) {
    (void)in_sizes; (void)out_size;
    static int grid = 0;
    if (grid == 0) {
        int dev = 0, cus = 0;
        if (hipGetDevice(&dev) != hipSuccess || hipDeviceGetAttribute(&cus, hipDeviceAttributeMultiprocessorCount, dev) != hipSuccess) { grid = -1; return; }
        if (hipFuncSetAttribute((const void*)fwd_kernel, hipFuncAttributeMaxDynamicSharedMemorySize, LDS_BYTES) != hipSuccess) { grid = -1; return; }
        int per_cu = 0;
        (void)hipOccupancyMaxActiveBlocksPerMultiprocessor(&per_cu, (const void*)fwd_kernel, NTHREADS, LDS_BYTES);
        (void)hipGetLastError();
        grid = cus;
        if (n_in != 18 || ws_size < WS_NEED) { fprintf(stderr, "kernel_launch: unexpected inputs (n_in %d, ws %zu)\n", n_in, ws_size); grid = -1; return; }
    }
    if (grid < 0) return;
    (void)hipMemsetAsync((char*)d_ws + OFF_CTRL, 0, CTRL_BYTES, stream);
    Args a{};
    for (int i = 0; i < 18; ++i) a.in[i] = (const float*)d_in[i];
    a.out = (float*)d_out; a.ws = (unsigned char*)d_ws;
    constexpr int NPH = 1 + 9 * DEPTH;
    if (MK_N_LAUNCHES == 1) { a.ph_lo = 0; a.ph_hi = NPH; hipLaunchKernelGGL(fwd_kernel, dim3(grid), dim3(NTHREADS), LDS_BYTES, stream, a); }
    else { for (int p = 0; p < NPH; ++p) { a.ph_lo = p; a.ph_hi = p + 1; hipLaunchKernelGGL(fwd_kernel, dim3(grid), dim3(NTHREADS), LDS_BYTES, stream, a); } }
}
```

```cpp
#include <hip/hip_runtime.h>
#include <stdint.h>
#include <stdio.h>

#define LAS __attribute__((address_space(3)))
typedef unsigned short bf16_t;
typedef short bf16x8 __attribute__((ext_vector_type(8)));
typedef float f32x2 __attribute__((ext_vector_type(2)));
typedef float f32x4 __attribute__((ext_vector_type(4)));
typedef float f32x16 __attribute__((ext_vector_type(16)));
typedef unsigned u32x2 __attribute__((ext_vector_type(2)));
typedef unsigned u32x4 __attribute__((ext_vector_type(4)));
typedef __bf16 bfv2 __attribute__((ext_vector_type(2)));

#ifndef MK_N_LAUNCHES
#define MK_N_LAUNCHES 1
#endif

constexpr int DM = 1024, SEQ = 4096, NTOK = 16384, DEPTH = 2;
constexpr int HD = 64, AW = 512, PW = 512, INW = 4096;
constexpr int NEXP = 32, EH = 512, ECAP = NTOK;
constexpr float RMS_EPS = 1e-6f;
constexpr int NTHREADS = 512, NWAVES = 8;

constexpr size_t MB = 1024 * 1024;
constexpr size_t OFF_CTRL = 0, CTRL_BYTES = 65536;
constexpr size_t OFF_WIN  = 1 * MB;
constexpr size_t OFF_WA   = OFF_WIN + 16 * MB;
constexpr size_t OFF_WPP  = OFF_WA + 2 * MB;
constexpr size_t OFF_WO   = OFF_WPP + 2 * MB;
constexpr size_t OFF_WGU  = OFF_WO + 4 * MB;
constexpr size_t OFF_WD   = OFF_WGU + 64 * MB;
constexpr size_t OFF_H    = OFF_WD + 32 * MB;
constexpr size_t OFF_PROJ = OFF_H + 32 * MB;
constexpr size_t OFF_ACT  = OFF_PROJ;
constexpr size_t OFF_YB   = OFF_PROJ + 40 * MB;
constexpr size_t OFF_AC   = OFF_PROJ + 128 * MB;
constexpr size_t OFF_PL   = OFF_AC + 16 * MB;
constexpr size_t OFF_OG   = OFF_PL + 16 * MB;
constexpr size_t OFF_T1   = OFF_OG;
constexpr size_t OFF_ML   = OFF_OG + 48 * MB;
constexpr size_t OFF_XB   = OFF_ML + 4 * MB;
constexpr size_t OFF_TOKE = OFF_XB + 64 * MB;
constexpr size_t OFF_TOKW = OFF_TOKE + 2 * MB;
constexpr size_t OFF_ASG  = OFF_TOKW + 2 * MB;
constexpr size_t OFF_WRH  = OFF_ASG + 1 * MB;
constexpr size_t OFF_WRL  = OFF_WRH + 256 * 1024;
constexpr size_t WS_NEED  = OFF_WRL + 256 * 1024;
constexpr int CW_CNT = 1024;
constexpr int CW_BAR = 8192;
constexpr int RING_BYTES = 131072, LCTL_OFF = RING_BYTES, LDS_BYTES = RING_BYTES + 1024;
constexpr int LI_BAR = 0, LI_TB = 16, LI_PS = 64, LI_CN = 112;

__device__ __forceinline__ float bflo(unsigned w) { return __uint_as_float(w << 16); }
__device__ __forceinline__ float bfhi(unsigned w) { return __uint_as_float(w & 0xffff0000u); }
__device__ __forceinline__ unsigned pack2(float lo, float hi) { f32x2 v = {lo, hi}; return __builtin_bit_cast(unsigned, __builtin_convertvector(v, bfv2)); }
__device__ __forceinline__ bf16_t f2bf(float f) { return (bf16_t)(pack2(f, 0.f) & 0xffffu); }
__device__ __forceinline__ float wave_sum(float v) {
#pragma unroll
    for (int o = 32; o >= 1; o >>= 1) v += __shfl_xor(v, o);
    return v;
}
__device__ __forceinline__ int opaque_tid() { int t = (int)threadIdx.x; asm volatile("" : "+v"(t)); return t; }
__device__ __forceinline__ int opaque_s(int v) { asm volatile("" : "+s"(v)); return v; }
__device__ __forceinline__ float sigmoidf_(float v) { return 1.0f / (1.0f + __expf(-v)); }

#define XB_TMO      128
#define XB_XCNT(j)  (256  + 64 * (j))
#define XB_XSUB(j)  (1280 + 64 * (j))
#define XB_XGEN(j)  (2304 + 64 * (j))
#define XB_TOP      3328
#define XB_TOPGEN   3392
#define XCD_BAR_WORDS 3456
#define XB_SPIN_CAP (1u << 18)
__device__ __forceinline__ unsigned xb_ld(unsigned* p)              { return __hip_atomic_load(p, __ATOMIC_RELAXED, __HIP_MEMORY_SCOPE_AGENT); }
__device__ __forceinline__ unsigned xb_add(unsigned* p, unsigned v) { return __hip_atomic_fetch_add(p, v, __ATOMIC_RELAXED, __HIP_MEMORY_SCOPE_AGENT); }
__device__ __forceinline__ unsigned xb_xcc_id() { return (unsigned)__builtin_amdgcn_s_getreg((3 << 11) | 20) & 0xFu; }
#define XB_SPIN(cond, bar) do { unsigned _sp = 0; while (cond) { __builtin_amdgcn_s_sleep(1); \
    if ((++_sp & 255u) == 0u) { if (xb_ld(&(bar)[XB_TMO])) break; if (_sp > XB_SPIN_CAP) { atomicAdd(&(bar)[XB_TMO], 1u); break; } } } } while (0)
struct XcdBarrier { unsigned* bar; unsigned x; volatile LAS unsigned* st; };
__device__ __forceinline__ XcdBarrier xcd_barrier_post(unsigned* bar, volatile LAS unsigned* st) {
    XcdBarrier b; b.bar = bar; b.x = xb_xcc_id(); b.st = st;
    if (threadIdx.x == 0) (void)xb_add(&bar[XB_XCNT(b.x)], 1u);
    return b;
}
__device__ __forceinline__ void xcd_barrier_complete(unsigned* bar, unsigned x, unsigned& nloc, unsigned& nx) {
    const unsigned G = gridDim.x * gridDim.y * gridDim.z;
    unsigned sum, cnt, mine, sp = 0u;
    for (;;) {
        sum = 0u; cnt = 0u; mine = 0u;
#pragma unroll
        for (unsigned j = 0; j < 16; ++j) { const unsigned c = xb_ld(&bar[XB_XCNT(j)]); sum += c; cnt += (c > 0u) ? 1u : 0u; mine = (j == x) ? c : mine; }
        if (sum == G) break;
        __builtin_amdgcn_s_sleep(1);
        if ((++sp & 255u) == 0u) { if (xb_ld(&bar[XB_TMO])) break; if (sp > XB_SPIN_CAP) { atomicAdd(&bar[XB_TMO], 1u); break; } }
    }
    nloc = mine > 0u ? mine : 1u; nx = cnt > 0u ? cnt : 1u;
}
__device__ __forceinline__ void xcd_barrier(const XcdBarrier& b) {
    asm volatile("s_waitcnt vmcnt(0)" ::: "memory");
    __syncthreads();
    if (threadIdx.x == 0) {
        unsigned* bar = b.bar;
        __builtin_amdgcn_s_waitcnt(0);
        unsigned nloc = b.st[0], nx = b.st[1];
        if (nloc == 0u) { xcd_barrier_complete(bar, b.x, nloc, nx); b.st[0] = nloc; b.st[1] = nx; }
        const unsigned old = xb_add(&bar[XB_XSUB(b.x)], 1u);
        const unsigned gen = old / nloc;
        if (old + 1u == (gen + 1u) * nloc) {
            __builtin_amdgcn_fence(__ATOMIC_RELEASE, "agent");
            asm volatile("s_waitcnt vmcnt(0)" ::: "memory");
            const unsigned og = xb_add(&bar[XB_TOP], 1u);
            const unsigned tg = og / nx;
            if (og + 1u == (tg + 1u) * nx) xb_add(&bar[XB_TOPGEN], 1u);
            else XB_SPIN(xb_ld(&bar[XB_TOPGEN]) == tg, bar);
            __builtin_amdgcn_fence(__ATOMIC_ACQUIRE, "agent");
            xb_add(&bar[XB_XGEN(b.x)], 1u);
            asm volatile("s_waitcnt vmcnt(0)" ::: "memory");
        } else {
            XB_SPIN(xb_ld(&bar[XB_XGEN(b.x)]) == gen, bar);
            __builtin_amdgcn_fence(__ATOMIC_ACQUIRE, "agent");
            asm volatile("s_waitcnt vmcnt(0)" ::: "memory");
        }
    }
    __syncthreads();
}

namespace pg8 {
constexpr int BM = 256, BK = 64, HALF = 128, HTB = HALF * BK * 2, NXCD = 8, WGM = 8;
__device__ __forceinline__ int lds_byte(int r, int c) { const int st = (r >> 4) * 2 + (c >> 5), rr = r & 15, cc = c & 31, ob = rr * 64 + cc * 2; return st * 1024 + (ob ^ (((ob >> 9) & 1) << 5)); }
__device__ __forceinline__ void stage_rc(int b, int& R, int& C) { const int st = b / 1024, sb = b % 1024, swz = sb ^ (((sb >> 9) & 1) << 5); R = (st >> 1) * 16 + swz / 64; C = (st & 1) * 32 + (swz % 64) / 2; }
__device__ __forceinline__ int perm32(int rho) { const int n = rho >> 4, i = rho & 15; return 8 * (i >> 2) + 4 * n + (i & 3); }

struct Unit { const char* A; const char* B; int row0, col0, e, nvalid, j0; };

struct DenseOrder {
    const char* A; const char* Bt; int K, nM, nN, nwg, G, c;
    __device__ __forceinline__ void init(const void* A_, const void* Bt_, int M, int N, int K_, int G_, int c_) { A = (const char*)A_; Bt = (const char*)Bt_; K = K_; nM = M / BM; nN = N / BM; nwg = nM * nN; G = G_; c = c_; }
    __device__ __forceinline__ bool next(int i, Unit& u) const {
        const long L = (long)i * G + c; if (L >= nwg) return false;
        int wgid = (int)L; { const int q = nwg / NXCD, r = nwg % NXCD, xcd = wgid % NXCD, off = wgid / NXCD; wgid = (xcd < r ? xcd * (q + 1) : r * (q + 1) + (xcd - r) * q) + off; }
        const int nig = WGM * nN, gid = wgid / nig, fm = gid * WGM, gsz = (nM - fm) < WGM ? (nM - fm) : WGM;
        const int pm = fm + ((wgid % nig) % gsz), pn = (wgid % nig) / gsz;
        u.A = A + (size_t)pm * BM * K * 2; u.B = Bt + (size_t)pn * BM * K * 2; u.row0 = pm * BM; u.col0 = pn * BM; u.e = 0; u.nvalid = BM; u.j0 = 0; return true;
    }
    __device__ __forceinline__ unsigned row_off(const Unit&, int) const { return 0u; }
};
struct MoeOrder {
    const char* A; const char* Bt; size_t bExp; int K; const LAS int* tb; const LAS int* ps; const LAS int* cn; const int* tokE; int G, c; bool gather;
    __device__ __forceinline__ bool next(int i, Unit& u) const {
        const int L = i * G + c, total = tb[NEXP] * 4; if (L >= total) return false;
        const int rt = L >> 2, pn = L & 3;
        int e = 0;
        while (e < NEXP - 1 && tb[e + 1] <= rt) ++e;
        e = __builtin_amdgcn_readfirstlane(e);
        const int j = rt - __builtin_amdgcn_readfirstlane(tb[e]);
        const int pse = __builtin_amdgcn_readfirstlane(ps[e]), cne = __builtin_amdgcn_readfirstlane(cn[e]);
        u.e = e; u.row0 = pse + BM * j; u.col0 = pn * BM; u.nvalid = min(BM, cne - BM * j); u.j0 = e * ECAP + BM * j;
        u.B = Bt + (size_t)e * bExp + (size_t)pn * BM * K * 2;
        u.A = gather ? A : A + (size_t)u.row0 * K * 2;
        return true;
    }
    __device__ __forceinline__ unsigned row_off(const Unit& u, int R) const { const int t = R < u.nvalid ? tokE[u.j0 + R] : 0; return (unsigned)t * (unsigned)(K * 2); }
};

template <class Epi, class Sched, int BMODE, bool GATHER>
__device__ __forceinline__ void gemm_phase(LAS unsigned char* lds, const int K, const Sched& S, const Epi& E) {
    const int tid = opaque_tid(), wid = __builtin_amdgcn_readfirstlane(tid >> 6), lane = tid & 63, wr = wid >> 2, wc = wid & 3, fr = lane & 15, fq = lane >> 4;
    const int nt = K / BK;
    unsigned voffA[2][2], voffAn[2][2], voffB[2]; int RA[2], CA[2];
#pragma unroll
    for (int i = 0; i < 2; ++i) { int R, C; stage_rc(tid * 16 + i * 8192, R, C); RA[i] = R; CA[i] = C;
        const int Rb = (BMODE == 1) ? (64 * (R >> 5) + perm32(R & 31)) : (Epi::PERM ? ((R & ~31) + perm32(R & 31)) : R);
        voffB[i] = (unsigned)(Rb * K + C) * 2u;
#pragma unroll
        for (int h = 0; h < 2; ++h) { voffA[h][i] = (unsigned)((h * HALF + R) * K + C) * 2u; voffAn[h][i] = voffA[h][i]; } }
    const size_t kstep = (size_t)(BK * 2);
    const size_t hstepB = (size_t)((BMODE == 1) ? 32 : HALF) * K * 2;
    const unsigned ldsw = (unsigned)wid * 1024u;
    const int aoff = lds_byte(wr * 64 + fr, fq * 8), boff = lds_byte(wc * 32 + fr, fq * 8);
#define PG8_SA(b, h) (((b) * 2 + (h)) * HTB)
#define PG8_SB(b, h) ((4 + (b) * 2 + (h)) * HTB)
#define PG8_STAGE2(bufoff, gbase, v0, v1) do { \
        __builtin_amdgcn_global_load_lds((const unsigned*)((const char*)(gbase) + (v0)), (LAS unsigned*)(lds + (bufoff) + ldsw), 16, 0, 0); \
        __builtin_amdgcn_global_load_lds((const unsigned*)((const char*)(gbase) + (v1)), (LAS unsigned*)(lds + (bufoff) + ldsw + 8192), 16, 0, 0); } while (0)
#define PG8_STAGEB(bufoff, gbase) PG8_STAGE2(bufoff, gbase, voffB[0], voffB[1])
#define PG8_STAGEA(bufoff, gbase, h, nx) PG8_STAGE2(bufoff, gbase, ((GATHER && (nx)) ? voffAn[h][0] : voffA[h][0]), ((GATHER && (nx)) ? voffAn[h][1] : voffA[h][1]))
#define PG8_LDA(dst, b, h) do { _Pragma("unroll") for (int m = 0; m < 4; ++m) _Pragma("unroll") for (int k = 0; k < 2; ++k) dst[m][k] = *(const LAS bf16x8*)(lds + PG8_SA(b, h) + aoff + m * 2048 + k * 1024); } while (0)
#define PG8_LDB(dst, b, h) do { _Pragma("unroll") for (int n = 0; n < 2; ++n) _Pragma("unroll") for (int k = 0; k < 2; ++k) dst[n][k] = *(const LAS bf16x8*)(lds + PG8_SB(b, h) + boff + n * 2048 + k * 1024); } while (0)
#define PG8_MMA(ai, bj, At, Bt) do { __builtin_amdgcn_s_setprio(1); _Pragma("unroll") for (int m = 0; m < 4; ++m) _Pragma("unroll") for (int n = 0; n < 2; ++n) _Pragma("unroll") for (int k = 0; k < 2; ++k) \
        acc[ai][bj][m][n] = __builtin_amdgcn_mfma_f32_16x16x32_bf16(Bt[n][k], At[m][k], acc[ai][bj][m][n], 0, 0, 0); __builtin_amdgcn_s_setprio(0); } while (0)
#define PG8_WAIT_V(n) asm volatile("s_waitcnt vmcnt(" #n ")" ::: "memory")
#define PG8_WAIT_L(n) asm volatile("s_waitcnt lgkmcnt(" #n ")" ::: "memory")
#define PG8_BAR __builtin_amdgcn_s_barrier()
#define PG8_SCHED __builtin_amdgcn_sched_barrier(0)
    Unit cur, nxt; int ui = 0;
    if (!S.next(0, cur)) return;
    if (GATHER) {
#pragma unroll
        for (int h = 0; h < 2; ++h)
#pragma unroll
            for (int i = 0; i < 2; ++i) voffA[h][i] = S.row_off(cur, h * HALF + RA[i]) + (unsigned)CA[i] * 2u;
    }
    f32x4 acc[2][2][4][2];
#pragma unroll
    for (int a = 0; a < 2; ++a)
#pragma unroll
        for (int b = 0; b < 2; ++b)
#pragma unroll
            for (int m = 0; m < 4; ++m)
#pragma unroll
                for (int n = 0; n < 2; ++n) acc[a][b][m][n] = (f32x4){0.f, 0.f, 0.f, 0.f};
    bf16x8 At[4][2], B0[2][2], B1[2][2];
    const char* cA = cur.A; const char* cB = cur.B;
    PG8_STAGEB(PG8_SB(0, 0), cB); PG8_STAGEB(PG8_SB(0, 1), cB + hstepB); PG8_STAGEA(PG8_SA(0, 0), cA, 0, false); PG8_STAGEA(PG8_SA(0, 1), cA, 1, false);
    if (wr == 1) PG8_BAR;
    PG8_WAIT_V(2); PG8_BAR;
    PG8_STAGEB(PG8_SB(1, 0), cB + kstep); PG8_STAGEA(PG8_SA(1, 0), cA + kstep, 0, false); PG8_STAGEB(PG8_SB(1, 1), cB + hstepB + kstep);
    PG8_WAIT_V(6); PG8_BAR;
    for (;;) {
        const bool has_next = S.next(ui + 1, nxt);
        if (GATHER) {
#pragma unroll
            for (int h = 0; h < 2; ++h)
#pragma unroll
                for (int i = 0; i < 2; ++i) voffAn[h][i] = has_next ? (S.row_off(nxt, h * HALF + RA[i]) + (unsigned)CA[i] * 2u) : voffA[h][i];
        }
        const char* nA = has_next ? nxt.A : cA; const char* nB = has_next ? nxt.B : cB;
        for (int t = 0; t < nt; t += 2) {
            const bool last = (t == nt - 2);
            const char* a1 = cA + (size_t)(t + 1) * kstep;
            const char* a2 = last ? nA : cA + (size_t)(t + 2) * kstep; const char* b2 = last ? nB : cB + (size_t)(t + 2) * kstep;
            const char* a3 = a2 + kstep; const char* b3 = b2 + kstep;
            PG8_LDB(B0, 0, 0); PG8_LDB(B1, 0, 1); PG8_SCHED; PG8_LDA(At, 0, 0); PG8_STAGEA(PG8_SA(1, 1), a1, 1, false);
            PG8_WAIT_V(8); PG8_WAIT_L(0); PG8_BAR; PG8_MMA(0, 0, At, B0); PG8_MMA(0, 1, At, B1); PG8_BAR; PG8_SCHED;
            PG8_LDA(At, 0, 1); PG8_STAGEB(PG8_SB(0, 0), b2); PG8_STAGEB(PG8_SB(0, 1), b2 + hstepB); PG8_STAGEA(PG8_SA(0, 0), a2, 0, last);
            PG8_WAIT_V(8); PG8_WAIT_L(0); PG8_BAR; PG8_MMA(1, 0, At, B0); PG8_MMA(1, 1, At, B1); PG8_BAR; PG8_SCHED;
            PG8_LDB(B0, 1, 0); PG8_LDB(B1, 1, 1); PG8_SCHED; PG8_LDA(At, 1, 0); PG8_STAGEA(PG8_SA(0, 1), a2, 1, last);
            PG8_WAIT_V(8); PG8_WAIT_L(0); PG8_BAR; PG8_MMA(0, 0, At, B0); PG8_MMA(0, 1, At, B1); PG8_BAR; PG8_SCHED;
            PG8_LDA(At, 1, 1); PG8_STAGEB(PG8_SB(1, 0), b3); PG8_STAGEB(PG8_SB(1, 1), b3 + hstepB); PG8_STAGEA(PG8_SA(1, 0), a3, 0, last);
            PG8_WAIT_V(8); PG8_WAIT_L(0); PG8_BAR; PG8_MMA(1, 0, At, B0); PG8_MMA(1, 1, At, B1); PG8_BAR; PG8_SCHED;
        }
        if (wr == 0) PG8_BAR;
        E(acc, cur, wr, wc, fr, fq);
        if (!has_next) break;
#pragma unroll
        for (int a = 0; a < 2; ++a)
#pragma unroll
            for (int b = 0; b < 2; ++b)
#pragma unroll
                for (int m = 0; m < 4; ++m)
#pragma unroll
                    for (int n = 0; n < 2; ++n) acc[a][b][m][n] = (f32x4){0.f, 0.f, 0.f, 0.f};
        cur = nxt; cA = nA; cB = nB; ++ui;
        if (GATHER) {
#pragma unroll
            for (int h = 0; h < 2; ++h)
#pragma unroll
                for (int i = 0; i < 2; ++i) voffA[h][i] = voffAn[h][i];
        }
        if (wr == 1) PG8_BAR;
    }
    PG8_WAIT_V(0);
    PG8_BAR;
#undef PG8_SA
#undef PG8_SB
#undef PG8_STAGE2
#undef PG8_STAGEA
#undef PG8_STAGEB
#undef PG8_LDA
#undef PG8_LDB
#undef PG8_MMA
#undef PG8_WAIT_V
#undef PG8_WAIT_L
#undef PG8_BAR
#undef PG8_SCHED
}

struct EpiProj {
    static constexpr bool PERM = true;
    bf16_t* out; const float* gq; const float* gk;
    __device__ __forceinline__ void operator()(const f32x4 (&acc)[2][2][4][2], const Unit& u, int wr, int wc, int fr, int fq) const {
        const int pn = u.col0 >> 8;
        const int row0 = u.row0 + wr * 64 + fr, colb = u.col0 + 64 * wc + 8 * fq;
        if (pn < 4) {
            const float* g = (pn < 2) ? gq : gk; const float post = (pn < 2) ? 0.125f : 1.0f;
            f32x4 gv[2][2];
#pragma unroll
            for (int bj = 0; bj < 2; ++bj)
#pragma unroll
                for (int n = 0; n < 2; ++n) gv[bj][n] = *(const f32x4*)(g + 32 * bj + 8 * fq + 4 * n) * post;
#pragma unroll
            for (int ai = 0; ai < 2; ++ai)
#pragma unroll
                for (int m = 0; m < 4; ++m) {
                    float ss = 0.f;
#pragma unroll
                    for (int bj = 0; bj < 2; ++bj)
#pragma unroll
                        for (int n = 0; n < 2; ++n) { const f32x4 x = acc[ai][bj][m][n]; ss += (x[0] * x[0] + x[1] * x[1]) + (x[2] * x[2] + x[3] * x[3]); }
                    ss += __shfl_xor(ss, 16); ss += __shfl_xor(ss, 32);
                    const float rstd = rsqrtf(ss * (1.0f / HD) + RMS_EPS);
                    bf16_t* rowp = out + (size_t)(row0 + ai * HALF + m * 16) * INW + colb;
#pragma unroll
                    for (int bj = 0; bj < 2; ++bj) { const f32x4 v0 = acc[ai][bj][m][0] * rstd * gv[bj][0], v1 = acc[ai][bj][m][1] * rstd * gv[bj][1];
                        u32x4 w; w.x = pack2(v0[0], v0[1]); w.y = pack2(v0[2], v0[3]); w.z = pack2(v1[0], v1[1]); w.w = pack2(v1[2], v1[3]);
                        *(u32x4*)(rowp + 32 * bj) = w; }
                }
        } else {
            const bool sg = pn >= 8;
#pragma unroll
            for (int ai = 0; ai < 2; ++ai)
#pragma unroll
                for (int m = 0; m < 4; ++m) {
                    bf16_t* rowp = out + (size_t)(row0 + ai * HALF + m * 16) * INW + colb;
#pragma unroll
                    for (int bj = 0; bj < 2; ++bj) { f32x4 v0 = acc[ai][bj][m][0], v1 = acc[ai][bj][m][1];
                        if (sg) {
#pragma unroll
                            for (int j = 0; j < 4; ++j) { v0[j] = sigmoidf_(v0[j]); v1[j] = sigmoidf_(v1[j]); } }
                        u32x4 w; w.x = pack2(v0[0], v0[1]); w.y = pack2(v0[2], v0[3]); w.z = pack2(v1[0], v1[1]); w.w = pack2(v1[2], v1[3]);
                        *(u32x4*)(rowp + 32 * bj) = w; }
                }
        }
    }
};
template <int MODE> struct EpiGate {
    static constexpr bool PERM = true;
    const bf16_t* gate; const bf16_t* t1in; bf16_t* out;
    __device__ __forceinline__ void operator()(const f32x4 (&acc)[2][2][4][2], const Unit& u, int wr, int wc, int fr, int fq) const {
        const int row0 = u.row0 + wr * 64 + fr, col0 = u.col0 + wc * 32 + 8 * fq;
#pragma unroll
        for (int ai = 0; ai < 2; ++ai)
#pragma unroll
            for (int m = 0; m < 4; ++m) {
                const size_t r = (size_t)(row0 + ai * HALF + m * 16);
#pragma unroll
                for (int bj = 0; bj < 2; ++bj) {
                    const int c = col0 + bj * HALF;
                    const u32x4 g = *(const u32x4*)(gate + r * INW + c);
                    const f32x4 a0 = acc[ai][bj][m][0], a1 = acc[ai][bj][m][1];
                    float o[8] = {a0[0] * bflo(g.x), a0[1] * bfhi(g.x), a0[2] * bflo(g.y), a0[3] * bfhi(g.y), a1[0] * bflo(g.z), a1[1] * bfhi(g.z), a1[2] * bflo(g.w), a1[3] * bfhi(g.w)};
                    if (MODE == 1) { const u32x4 t = *(const u32x4*)(t1in + r * DM + c);
                        o[0] += bflo(t.x); o[1] += bfhi(t.x); o[2] += bflo(t.y); o[3] += bfhi(t.y); o[4] += bflo(t.z); o[5] += bfhi(t.z); o[6] += bflo(t.w); o[7] += bfhi(t.w); }
                    u32x4 w; w.x = pack2(o[0], o[1]); w.y = pack2(o[2], o[3]); w.z = pack2(o[4], o[5]); w.w = pack2(o[6], o[7]);
                    *(u32x4*)(out + r * DM + c) = w;
                }
            }
    }
};
struct EpiResid {
    static constexpr bool PERM = false;
    const float* xin; float* xout;
    __device__ __forceinline__ void operator()(const f32x4 (&acc)[2][2][4][2], const Unit& u, int wr, int wc, int fr, int fq) const {
        const int row0 = u.row0 + wr * 64 + fr, col0 = u.col0 + wc * 32 + 4 * fq;
#pragma unroll
        for (int ai = 0; ai < 2; ++ai)
#pragma unroll
            for (int m = 0; m < 4; ++m) { const size_t off = (size_t)(row0 + ai * HALF + m * 16) * DM + col0;
#pragma unroll
                for (int bj = 0; bj < 2; ++bj)
#pragma unroll
                    for (int n = 0; n < 2; ++n) { const f32x4 x = *(const f32x4*)(xin + off + bj * HALF + n * 16); *(f32x4*)(xout + off + bj * HALF + n * 16) = x + acc[ai][bj][m][n]; } }
    }
};
struct EpiSwiGLU {
    static constexpr bool PERM = true;
    bf16_t* act;
    __device__ __forceinline__ void operator()(const f32x4 (&acc)[2][2][4][2], const Unit& u, int wr, int wc, int fr, int fq) const {
        const int row0 = u.row0 + wr * 64 + fr, col0 = (u.col0 >> 1) + wc * 32 + 8 * fq;
#pragma unroll
        for (int ai = 0; ai < 2; ++ai)
#pragma unroll
            for (int m = 0; m < 4; ++m) {
                float o[8];
#pragma unroll
                for (int n = 0; n < 2; ++n)
#pragma unroll
                    for (int j = 0; j < 4; ++j) { const float a = acc[ai][0][m][n][j], b = acc[ai][1][m][n][j]; o[4 * n + j] = a * sigmoidf_(a) * b; }
                u32x4 w; w.x = pack2(o[0], o[1]); w.y = pack2(o[2], o[3]); w.z = pack2(o[4], o[5]); w.w = pack2(o[6], o[7]);
                *(u32x4*)(act + (size_t)(row0 + ai * HALF + m * 16) * EH + col0) = w;
            }
    }
};
struct EpiDown {
    static constexpr bool PERM = true;
    bf16_t* yb; const float* tokW;
    __device__ __forceinline__ void operator()(const f32x4 (&acc)[2][2][4][2], const Unit& u, int wr, int wc, int fr, int fq) const {
        const int col0 = u.col0 + wc * 32 + 8 * fq;
#pragma unroll
        for (int ai = 0; ai < 2; ++ai)
#pragma unroll
            for (int m = 0; m < 4; ++m) {
                const int rl = wr * 64 + fr + ai * HALF + m * 16;
                const float w = rl < u.nvalid ? tokW[u.j0 + rl] : 0.f;
#pragma unroll
                for (int bj = 0; bj < 2; ++bj) { const f32x4 v0 = acc[ai][bj][m][0] * w, v1 = acc[ai][bj][m][1] * w;
                    u32x4 o; o.x = pack2(v0[0], v0[1]); o.y = pack2(v0[2], v0[3]); o.z = pack2(v1[0], v1[1]); o.w = pack2(v1[2], v1[3]);
                    *(u32x4*)(yb + (size_t)(u.row0 + rl) * DM + col0 + bj * HALF) = o; }
            }
    }
};
}

constexpr int ATT_K_OFF = 0, ATT_V_OFF = 49152;
__device__ __forceinline__ unsigned kv_off(unsigned row, unsigned ch) { return row * 128u + 16u * (ch ^ (((row >> 1) & 7u) ^ ((row & 2u) << 1))); }

__device__ __forceinline__ void attn_unit(LAS unsigned char* lds, const bf16_t* __restrict__ proj, bf16_t* __restrict__ og, f32x2* __restrict__ ml, int uidx) {
    const int tid = opaque_tid(), wid = __builtin_amdgcn_readfirstlane(tid >> 6), lane = tid & 63;
    const int bh = uidx / 48, r48 = uidx % 48, g = r48 >> 4, rr = r48 & 15;
    const int b = bh >> 3, h = bh & 7;
    const int d = (g == 0) ? 1 : (g == 1 ? 4 : 16);
    const int c = (g == 0) ? 0 : (g == 1 ? (rr >> 2) : rr);
    const int blk = (g == 0) ? rr : (g == 1 ? (rr & 3) : 0);
    const int tok0 = b * SEQ + c;
    const int kbase = 256 * blk - 128;
    const int kr_min = (blk == 0) ? 128 : 0;
#pragma unroll
    for (int i = 0; i < 6; ++i) {
        const int idx = tid + NTHREADS * i, row = idx >> 3, ch = idx & 7;
        if (row >= kr_min) {
            const size_t t = (size_t)(tok0 + (kbase + row) * d);
            const u32x4 kv = *(const u32x4*)(proj + t * INW + AW + h * HD + ch * 8);
            const u32x4 vv = *(const u32x4*)(proj + t * INW + 2 * AW + h * HD + ch * 8);
            *(LAS u32x4*)(lds + ATT_K_OFF + kv_off(row, ch)) = kv;
            *(LAS u32x4*)(lds + ATT_V_OFF + kv_off(row, ch)) = vv;
        }
    }
    const int qn = 256 * blk + 32 * wid + (lane & 31);
    const size_t qt = (size_t)(tok0 + qn * d);
    bf16x8 qf[4];
#pragma unroll
    for (int ks = 0; ks < 4; ++ks) qf[ks] = *(const bf16x8*)(proj + qt * INW + h * HD + 16 * ks + 8 * (lane >> 5));
    __syncthreads();
    const int kt_min = (blk == 0) ? max(0, 4 - wid) : 0;
    const int hq = lane >> 5, qi = lane & 31;
    f32x16 S[5];
#pragma unroll
    for (int kt = 0; kt < 5; ++kt) {
#pragma unroll
        for (int i = 0; i < 16; ++i) S[kt][i] = 0.f;
        if (kt >= kt_min) {
            const unsigned krow = (unsigned)(32 * wid + 32 * kt + qi);
#pragma unroll
            for (int ks = 0; ks < 4; ++ks) {
                const bf16x8 kf = *(const LAS bf16x8*)(lds + ATT_K_OFF + kv_off(krow, (unsigned)(2 * ks + hq)));
                S[kt] = __builtin_amdgcn_mfma_f32_32x32x16_bf16(kf, qf[ks], S[kt], 0, 0, 0);
            }
        }
    }
    float mx = -3.0e38f;
#pragma unroll
    for (int kt = 0; kt < 5; ++kt)
#pragma unroll
        for (int i = 0; i < 16; ++i) {
            const int row = (i & 3) + 8 * (i >> 2) + 4 * hq;
            bool valid = kt >= kt_min;
            if (kt == 0) valid = valid && (row >= qi);
            if (kt == 4) valid = valid && (row <= qi);
            S[kt][i] = valid ? S[kt][i] : -3.0e38f;
            mx = fmaxf(mx, S[kt][i]);
        }
    mx = fmaxf(mx, __shfl_xor(mx, 32));
    float lsum = 0.f;
#pragma unroll
    for (int kt = 0; kt < 5; ++kt)
#pragma unroll
        for (int i = 0; i < 16; ++i) { const float p = (S[kt][i] > -1.0e38f) ? __expf(S[kt][i] - mx) : 0.f; S[kt][i] = p; lsum += p; }
    lsum += __shfl_xor(lsum, 32);
    f32x16 O[2];
#pragma unroll
    for (int dt = 0; dt < 2; ++dt)
#pragma unroll
        for (int i = 0; i < 16; ++i) O[dt][i] = 0.f;
    const unsigned blkq = (lane >> 4) & 1, q4 = (lane & 15) >> 2, p4 = lane & 3;
    const unsigned vbase = (unsigned)(size_t)(lds + ATT_V_OFF);
#pragma unroll
    for (int kt = 0; kt < 5; ++kt) {
        if (kt >= kt_min) {
#pragma unroll
            for (int s = 0; s < 2; ++s) {
                u32x4 pw;
                pw.x = pack2(S[kt][8 * s + 0], S[kt][8 * s + 1]); pw.y = pack2(S[kt][8 * s + 2], S[kt][8 * s + 3]);
                pw.z = pack2(S[kt][8 * s + 4], S[kt][8 * s + 5]); pw.w = pack2(S[kt][8 * s + 6], S[kt][8 * s + 7]);
                const bf16x8 pf = __builtin_bit_cast(bf16x8, pw);
                u32x2 v00, v01, v10, v11;
                const unsigned r0 = (unsigned)(32 * wid + 32 * kt + 16 * s + 4 * hq) + q4, r1 = r0 + 8;
                const unsigned a00 = vbase + kv_off(r0, 0u + 2 * blkq + (p4 >> 1)) + 8 * (p4 & 1), a01 = vbase + kv_off(r1, 0u + 2 * blkq + (p4 >> 1)) + 8 * (p4 & 1);
                const unsigned a10 = vbase + kv_off(r0, 4u + 2 * blkq + (p4 >> 1)) + 8 * (p4 & 1), a11 = vbase + kv_off(r1, 4u + 2 * blkq + (p4 >> 1)) + 8 * (p4 & 1);
                asm volatile("ds_read_b64_tr_b16 %0, %4\n\tds_read_b64_tr_b16 %1, %5\n\tds_read_b64_tr_b16 %2, %6\n\tds_read_b64_tr_b16 %3, %7\n\ts_waitcnt lgkmcnt(0)"
                             : "=&v"(v00), "=&v"(v01), "=&v"(v10), "=&v"(v11) : "v"(a00), "v"(a01), "v"(a10), "v"(a11) : "memory");
                u32x4 f0; f0.x = v00.x; f0.y = v00.y; f0.z = v01.x; f0.w = v01.y;
                u32x4 f1; f1.x = v10.x; f1.y = v10.y; f1.z = v11.x; f1.w = v11.y;
                O[0] = __builtin_amdgcn_mfma_f32_32x32x16_bf16(__builtin_bit_cast(bf16x8, f0), pf, O[0], 0, 0, 0);
                O[1] = __builtin_amdgcn_mfma_f32_32x32x16_bf16(__builtin_bit_cast(bf16x8, f1), pf, O[1], 0, 0, 0);
            }
        }
    }
    const float inv = 1.0f / lsum;
    bf16_t* orow = og + ((size_t)g * NTOK + qt) * AW + h * HD;
#pragma unroll
    for (int dt = 0; dt < 2; ++dt)
#pragma unroll
        for (int gq4 = 0; gq4 < 4; ++gq4) {
            u32x2 w; w.x = pack2(O[dt][4 * gq4 + 0] * inv, O[dt][4 * gq4 + 1] * inv); w.y = pack2(O[dt][4 * gq4 + 2] * inv, O[dt][4 * gq4 + 3] * inv);
            *(u32x2*)(orow + 32 * dt + 8 * gq4 + 4 * hq) = w;
        }
    if (lane < 32) ml[((size_t)g * NTOK + qt) * 8 + h] = (f32x2){mx, lsum};
    __syncthreads();
}

struct TrDesc { const float* src; bf16_t* dst; int N, K; };
__device__ __forceinline__ void tr_load(const TrDesc& d, int lane, f32x4 (&r)[8]) {
#pragma unroll
    for (int i = 0; i < 8; ++i) r[i] = __builtin_nontemporal_load((const f32x4*)(d.src + (size_t)((lane >> 3) + 8 * i) * d.N + 4 * (lane & 7)));
}
__device__ __forceinline__ void tr_store(const TrDesc& d, LAS float* scr, int lane, const f32x4 (&r)[8]) {
#pragma unroll
    for (int i = 0; i < 8; ++i) { LAS float* p = scr + ((lane >> 3) + 8 * i) * 33 + 4 * (lane & 7); p[0] = r[i][0]; p[1] = r[i][1]; p[2] = r[i][2]; p[3] = r[i][3]; }
    const int c = lane & 7;
#pragma unroll
    for (int j = 0; j < 4; ++j) { const int n = (lane >> 3) + 8 * j; const LAS float* q = scr + (8 * c) * 33 + n;
        u32x4 o; o.x = pack2(q[0 * 33], q[1 * 33]); o.y = pack2(q[2 * 33], q[3 * 33]); o.z = pack2(q[4 * 33], q[5 * 33]); o.w = pack2(q[6 * 33], q[7 * 33]);
        *(u32x4*)(d.dst + (size_t)n * d.K + 8 * c) = o; }
}
struct ExpertItems {
    const float* weg; const float* weu; const float* wed; bf16_t* WguT; bf16_t* WdT;
    static constexpr int TOTAL = 3 * NEXP * 256;
    __device__ __forceinline__ TrDesc operator()(int it) const {
        const int which = it >> 13, r = it & 8191, e = r >> 8, item = r & 255; TrDesc d;
        if (which < 2) { const int kb = item >> 4, nb = item & 15, k0 = 64 * kb, n0 = 32 * nb, nn0 = (n0 >> 7) * 256 + which * 128 + (n0 & 127);
            d.src = (which == 0 ? weg : weu) + (size_t)e * DM * EH + (size_t)k0 * EH + n0; d.dst = WguT + (size_t)e * DM * DM + (size_t)nn0 * DM + k0; d.N = EH; d.K = DM; }
        else { const int kb = item >> 5, nb = item & 31, k0 = 64 * kb, n0 = 32 * nb;
            d.src = wed + (size_t)e * EH * DM + (size_t)k0 * DM + n0; d.dst = WdT + (size_t)e * DM * EH + (size_t)n0 * EH + k0; d.N = DM; d.K = EH; }
        return d;
    }
};
struct SmallItems {
    const float* win; const float* wa; const float* wo; bf16_t* WinT; bf16_t* WaT; bf16_t* WoT;
    static constexpr int TOTAL = 2 * 2816;
    __device__ __forceinline__ TrDesc operator()(int it) const {
        const int l = it / 2816, r = it % 2816; TrDesc d;
        if (r < 2048) { const int kb = r >> 7, nb = r & 127; d.src = win + (size_t)l * DM * INW + (size_t)(64 * kb) * INW + 32 * nb; d.dst = WinT + (size_t)l * INW * DM + (size_t)(32 * nb) * DM + 64 * kb; d.N = INW; d.K = DM; }
        else if (r < 2304) { const int q = r - 2048, kb = q >> 5, nb = q & 31; d.src = wa + (size_t)l * AW * DM + (size_t)(64 * kb) * DM + 32 * nb; d.dst = WaT + (size_t)l * DM * AW + (size_t)(32 * nb) * AW + 64 * kb; d.N = DM; d.K = AW; }
        else { const int q = r - 2304, kb = q >> 5, nb = q & 31; d.src = wo + (size_t)l * DM * DM + (size_t)(64 * kb) * DM + 32 * nb; d.dst = WoT + (size_t)l * DM * DM + (size_t)(32 * nb) * DM + 64 * kb; d.N = DM; d.K = DM; }
        return d;
    }
};
template <class Items>
__device__ __forceinline__ void convert_items(const Items& I, LAS float* scr, int lane, int gw, int NGW) {
    f32x4 ra[8], rb[8];
    int it = gw;
    if (it >= Items::TOTAL) return;
    TrDesc da = I(it), db = da;
    tr_load(da, lane, ra);
    for (;;) {
        int it2 = it + NGW;
        if (it2 < Items::TOTAL) { db = I(it2); tr_load(db, lane, rb); }
        tr_store(da, scr, lane, ra);
        it = it2; if (it >= Items::TOTAL) break;
        it2 = it + NGW;
        if (it2 < Items::TOTAL) { da = I(it2); tr_load(da, lane, ra); }
        tr_store(db, scr, lane, rb);
        it = it2; if (it >= Items::TOTAL) break;
    }
}
__device__ __forceinline__ void norm_row(const float* __restrict__ xr, const float* __restrict__ g, bf16_t* __restrict__ hr, int lane) {
    f32x4 v[4]; float ss = 0.f;
#pragma unroll
    for (int i = 0; i < 4; ++i) { v[i] = *(const f32x4*)(xr + (i * 64 + lane) * 4); ss += (v[i][0] * v[i][0] + v[i][1] * v[i][1]) + (v[i][2] * v[i][2] + v[i][3] * v[i][3]); }
    ss = wave_sum(ss);
    const float rstd = rsqrtf(ss * (1.0f / DM) + RMS_EPS);
#pragma unroll
    for (int i = 0; i < 4; ++i) {
        const f32x4 gv = *(const f32x4*)(g + (i * 64 + lane) * 4);
        u32x2 w; w.x = pack2(v[i][0] * rstd * gv[0], v[i][1] * rstd * gv[1]); w.y = pack2(v[i][2] * rstd * gv[2], v[i][3] * rstd * gv[3]);
        *(u32x2*)(hr + (i * 64 + lane) * 4) = w;
    }
}
typedef const __attribute__((address_space(4))) float* cfp;
typedef const __attribute__((address_space(4))) f32x2* cf2p;
__device__ __forceinline__ void unpack8(const u32x4 v, float (&f)[8]) { f[0] = bflo(v.x); f[1] = bfhi(v.x); f[2] = bflo(v.y); f[3] = bfhi(v.y); f[4] = bflo(v.z); f[5] = bfhi(v.z); f[6] = bflo(v.w); f[7] = bfhi(v.w); }
template <int W>
__device__ __forceinline__ void pool_path(const u32x4 (&r)[23], int pos0, bf16_t* __restrict__ pl, size_t t0, int c0) {
    float sum[8] = {0.f, 0.f, 0.f, 0.f, 0.f, 0.f, 0.f, 0.f}, f[8];
#pragma unroll
    for (int j = 1; j < W; ++j) { unpack8(r[15 - j], f);
#pragma unroll
        for (int c = 0; c < 8; ++c) sum[c] += f[c]; }
#pragma unroll
    for (int i = 0; i < 8; ++i) {
        float u[8]; unpack8(r[15 + i], u);
        if (i > 0) { unpack8(r[15 + i - W], f);
#pragma unroll
            for (int c = 0; c < 8; ++c) sum[c] -= f[c]; }
#pragma unroll
        for (int c = 0; c < 8; ++c) sum[c] += u[c];
        const float ic = 1.0f / (float)min(pos0 + i + 1, W);
        u32x4 o; o.x = pack2(sum[0] * ic - u[0], sum[1] * ic - u[1]); o.y = pack2(sum[2] * ic - u[2], sum[3] * ic - u[3]);
        o.z = pack2(sum[4] * ic - u[4], sum[5] * ic - u[5]); o.w = pack2(sum[6] * ic - u[6], sum[7] * ic - u[7]);
        *(u32x4*)(pl + (t0 + i) * PW + c0) = o;
    }
}
__device__ __forceinline__ void build_moe_tables(LAS int* L, const unsigned* cnt) {
    { unsigned a_ = (unsigned)(size_t)L; asm volatile("" : "+s"(a_)); L = (LAS int*)(size_t)a_; }
    if (threadIdx.x == 0) {
        int t = 0, p = 0;
#pragma unroll 1
        for (int e = 0; e < NEXP; ++e) { const int c = (int)__hip_atomic_load(cnt + e * 64, __ATOMIC_RELAXED, __HIP_MEMORY_SCOPE_AGENT); L[LI_TB + e] = t; L[LI_PS + e] = p; L[LI_CN + e] = c; const int nt = (c + 255) >> 8; t += nt; p += nt * 256; }
        L[LI_TB + NEXP] = t; L[LI_PS + NEXP] = p;
    }
    __syncthreads();
}

struct Args { const float* in[18]; float* out; unsigned char* ws; int ph_lo, ph_hi; };
typedef const __attribute__((address_space(4))) Args* CArgsP;
__device__ __forceinline__ CArgsP kargs() { unsigned long long p = (unsigned long long)__builtin_amdgcn_kernarg_segment_ptr(); asm volatile("" : "+s"(p)); return (CArgsP)p; }
#define PHASE_PTRS \
    const int G = opaque_s(G0), bx = opaque_s(bx0), vcu = opaque_s(vcu0), NGW = G * NWAVES; (void)bx; (void)vcu; (void)NGW; \
    const CArgsP ka = kargs(); unsigned char* const ws = ka->ws; \
    unsigned* const ctrl = (unsigned*)(ws + OFF_CTRL); const float* const x_in = ka->in[0]; \
    bf16_t* const WinT = (bf16_t*)(ws + OFF_WIN); bf16_t* const WaT = (bf16_t*)(ws + OFF_WA); bf16_t* const WppT = (bf16_t*)(ws + OFF_WPP); bf16_t* const WoT = (bf16_t*)(ws + OFF_WO); \
    bf16_t* const WguT = (bf16_t*)(ws + OFF_WGU); bf16_t* const WdT = (bf16_t*)(ws + OFF_WD); \
    bf16_t* const Hb = (bf16_t*)(ws + OFF_H); bf16_t* const MG = Hb; bf16_t* const PROJ = (bf16_t*)(ws + OFF_PROJ); bf16_t* const ACT = (bf16_t*)(ws + OFF_ACT); bf16_t* const YB = (bf16_t*)(ws + OFF_YB); \
    bf16_t* const AC = (bf16_t*)(ws + OFF_AC); bf16_t* const PL = (bf16_t*)(ws + OFF_PL); bf16_t* const OG = (bf16_t*)(ws + OFF_OG); bf16_t* const T1 = (bf16_t*)(ws + OFF_T1); \
    f32x2* const ML = (f32x2*)(ws + OFF_ML); float* const XB = (float*)(ws + OFF_XB); int* const tokE = (int*)(ws + OFF_TOKE); float* const tokW = (float*)(ws + OFF_TOKW); int* const asg = (int*)(ws + OFF_ASG); \
    (void)ctrl; (void)x_in; (void)WinT; (void)WaT; (void)WppT; (void)WoT; (void)WguT; (void)WdT; (void)Hb; (void)MG; (void)PROJ; (void)ACT; (void)YB; (void)AC; (void)PL; (void)OG; (void)T1; (void)ML; (void)XB; (void)tokE; (void)tokW; (void)asg
#define LAYER_PTRS PHASE_PTRS; const int tid = opaque_tid(), lane = tid & 63, wid = __builtin_amdgcn_readfirstlane(tid >> 6), gw = vcu * NWAVES + wid; (void)lane; (void)gw; const float* const xin = (l == 0) ? x_in : XB; unsigned* const cnt = ctrl + CW_CNT + l * 2048; (void)xin; (void)cnt

#ifndef PHASE_MASK
#define PHASE_MASK 0x3ff
#endif
#define EN(j) (((PHASE_MASK) >> (j)) & 1)
#ifndef REP_MASK
#define REP_MASK 0
#endif
#define REPS(j) (1 + (((REP_MASK) >> (j)) & 1))
#define IN(k) (MK_N_LAUNCHES == 1 || (lo <= (k) && (k) < hi))
#ifndef PROBE_A
#define PROBE_A -1
#define PROBE_B -1
#endif
#define STAMP_BEGIN(k) do { if (PROBE_A == (k)) ts0 = __builtin_amdgcn_s_memrealtime(); } while (0)
#define SEAM(k) do { if (IN(k) && IN((k) + 1)) { XcdBarrier b2_ = bar; unsigned long long p_ = (unsigned long long)b2_.bar; asm volatile("" : "+s"(p_)); b2_.bar = (unsigned*)p_; xcd_barrier(b2_); } if (PROBE_B == (k)) ts1 = __builtin_amdgcn_s_memrealtime(); } while (0)

template <int l>
__device__ __forceinline__ void layer_body(const XcdBarrier& bar, LAS unsigned char* lds, LAS int* LC, const int G0, const int bx0, const int vcu0, const int lo, const int hi, unsigned long long& ts0, unsigned long long& ts1) {
        const int pb = 1 + 9 * l;
        STAMP_BEGIN(pb + 0);
        for (int rep = 0; rep < REPS(0); ++rep) if (EN(0) && IN(pb + 0)) {
            asm volatile("; PHASE_MARK 0");
            LAYER_PTRS;
            pg8::DenseOrder S; S.init(Hb, WinT + (size_t)l * INW * DM, NTOK, INW, DM, G, bx);
            pg8::EpiProj E{PROJ, ka->in[3] + (size_t)l * HD, ka->in[4] + (size_t)l * HD};
            pg8::gemm_phase<pg8::EpiProj, pg8::DenseOrder, 1, false>(lds, DM, S, E);
        }
        SEAM(pb + 0);
        STAMP_BEGIN(pb + 1);
        for (int rep = 0; rep < REPS(1); ++rep) if (EN(1) && IN(pb + 1)) {
            asm volatile("; PHASE_MARK 1");
            LAYER_PTRS;
            for (int u = vcu; u < 1536; u += G) attn_unit(lds, PROJ, OG, ML, u);
        }
        SEAM(pb + 1);
        STAMP_BEGIN(pb + 2);
        for (int rep = 0; rep < REPS(2); ++rep) if (EN(2) && IN(pb + 2)) {
            asm volatile("; PHASE_MARK 2");
            LAYER_PTRS;
            for (int grp = gw; grp < NTOK / 8; grp += NGW) {
                const size_t t0 = (size_t)grp * 8; const int c0 = 8 * lane, hh = lane >> 3;
                {
                    f32x2 sm[8][3]; u32x4 v[8][3];
#pragma unroll
                    for (int i = 0; i < 8; ++i)
#pragma unroll
                        for (int g = 0; g < 3; ++g) { sm[i][g] = ML[((size_t)g * NTOK + t0 + i) * 8 + hh]; v[i][g] = *(const u32x4*)(OG + ((size_t)g * NTOK + t0 + i) * AW + c0); }
#pragma unroll
                    for (int i = 0; i < 8; ++i) {
                        const float M = fmaxf(fmaxf(sm[i][0][0], sm[i][1][0]), sm[i][2][0]);
                        float w[3], W = 0.f;
#pragma unroll
                        for (int g = 0; g < 3; ++g) { w[g] = sm[i][g][1] * __expf(sm[i][g][0] - M); W += w[g]; }
                        const float iw = 1.0f / W;
                        float o[8] = {0.f, 0.f, 0.f, 0.f, 0.f, 0.f, 0.f, 0.f}, f[8];
#pragma unroll
                        for (int g = 0; g < 3; ++g) { unpack8(v[i][g], f); const float q = w[g] * iw;
#pragma unroll
                            for (int c = 0; c < 8; ++c) o[c] += q * f[c]; }
                        u32x4 ow; ow.x = pack2(o[0], o[1]); ow.y = pack2(o[2], o[3]); ow.z = pack2(o[4], o[5]); ow.w = pack2(o[6], o[7]);
                        *(u32x4*)(AC + (t0 + i) * AW + c0) = ow;
                    }
                }
                {
                    const int pos0 = (int)(t0 & (SEQ - 1)), g4 = lane >> 4, wnd = 2 << g4;
                    u32x4 r[23];
#pragma unroll
                    for (int k = 0; k < 23; ++k) { const bool need = (k >= 16 - wnd) && (pos0 - 15 + k >= 0);
                        r[k] = need ? *(const u32x4*)(PROJ + (t0 - 15 + k) * INW + 3 * AW + c0) : (u32x4){0u, 0u, 0u, 0u}; }
                    if (g4 == 0) pool_path<2>(r, pos0, PL, t0, c0);
                    else if (g4 == 1) pool_path<4>(r, pos0, PL, t0, c0);
                    else if (g4 == 2) pool_path<8>(r, pos0, PL, t0, c0);
                    else pool_path<16>(r, pos0, PL, t0, c0);
                }
            }
        }
        SEAM(pb + 2);
        STAMP_BEGIN(pb + 3);
        for (int rep = 0; rep < REPS(3); ++rep) if (EN(3) && IN(pb + 3)) {
            asm volatile("; PHASE_MARK 3");
            LAYER_PTRS;
            { pg8::DenseOrder S; S.init(AC, WaT + (size_t)l * DM * AW, NTOK, DM, AW, G, bx);
              pg8::EpiGate<0> E{PROJ + 2048, nullptr, T1};
              pg8::gemm_phase<pg8::EpiGate<0>, pg8::DenseOrder, 0, false>(lds, AW, S, E); }
            { pg8::DenseOrder S; S.init(PL, WppT + (size_t)l * DM * PW, NTOK, DM, PW, G, bx);
              pg8::EpiGate<1> E{PROJ + 3072, T1, MG};
              pg8::gemm_phase<pg8::EpiGate<1>, pg8::DenseOrder, 0, false>(lds, PW, S, E); }
        }
        SEAM(pb + 3);
        STAMP_BEGIN(pb + 4);
        if (EN(4) && IN(pb + 4)) {
            asm volatile("; PHASE_MARK 4");
            LAYER_PTRS;
            pg8::DenseOrder S; S.init(MG, WoT + (size_t)l * DM * DM, NTOK, DM, DM, G, bx);
            pg8::EpiResid E{xin, XB};
            pg8::gemm_phase<pg8::EpiResid, pg8::DenseOrder, 0, false>(lds, DM, S, E);
        }
        SEAM(pb + 4);
        STAMP_BEGIN(pb + 5);
        if (EN(5) && IN(pb + 5)) {
            asm volatile("; PHASE_MARK 5");
            LAYER_PTRS;
            LAS float* part = (LAS float*)lds;
            LAS float* lg = (LAS float*)(lds + 100352);
            LAS int* aE = (LAS int*)(lds + 110592); LAS float* aW = (LAS float*)(lds + 110592 + 512); LAS int* bs = (LAS int*)(lds + 110592 + 1024); LAS float* rs = (LAS float*)(lds + 110592 + 1536);
            const float* g2 = ka->in[10] + (size_t)l * DM; const float* brg = ka->in[12] + (size_t)l * 4; const float* bre = ka->in[14] + (size_t)l * 32;
            const bf16_t* Wh = (const bf16_t*)(ws + OFF_WRH) + (size_t)l * 48 * DM; const bf16_t* Wl = (const bf16_t*)(ws + OFF_WRL) + (size_t)l * 48 * DM;
            for (int chunk = bx; chunk < NTOK / 64; chunk += G) {
                {
                    const int fr = lane & 15, fq = lane >> 4;
                    f32x4 acc[4][3]; float ssl[4] = {0.f, 0.f, 0.f, 0.f};
#pragma unroll
                    for (int mt = 0; mt < 4; ++mt)
#pragma unroll
                        for (int nt = 0; nt < 3; ++nt) acc[mt][nt] = (f32x4){0.f, 0.f, 0.f, 0.f};
#pragma unroll 1
                    for (int ks = 0; ks < 4; ++ks) {
                        const int d0 = 128 * wid + 32 * ks + 8 * fq;
                        bf16x8 bh[3], bl[3];
#pragma unroll
                        for (int nt = 0; nt < 3; ++nt) { bh[nt] = *(const bf16x8*)(Wh + (size_t)(16 * nt + fr) * DM + d0); bl[nt] = *(const bf16x8*)(Wl + (size_t)(16 * nt + fr) * DM + d0); }
#pragma unroll
                        for (int mt = 0; mt < 4; ++mt) {
                            const float* xp = XB + (size_t)(chunk * 64 + 16 * mt + fr) * DM + d0;
                            const f32x4 x0 = *(const f32x4*)xp, x1 = *(const f32x4*)(xp + 4);
                            ssl[mt] += (x0[0] * x0[0] + x0[1] * x0[1]) + (x0[2] * x0[2] + x0[3] * x0[3]) + (x1[0] * x1[0] + x1[1] * x1[1]) + (x1[2] * x1[2] + x1[3] * x1[3]);
                            u32x4 hw; hw.x = pack2(x0[0], x0[1]); hw.y = pack2(x0[2], x0[3]); hw.z = pack2(x1[0], x1[1]); hw.w = pack2(x1[2], x1[3]);
                            u32x4 lw; lw.x = pack2(x0[0] - bflo(hw.x), x0[1] - bfhi(hw.x)); lw.y = pack2(x0[2] - bflo(hw.y), x0[3] - bfhi(hw.y));
                            lw.z = pack2(x1[0] - bflo(hw.z), x1[1] - bfhi(hw.z)); lw.w = pack2(x1[2] - bflo(hw.w), x1[3] - bfhi(hw.w));
                            const bf16x8 ah = __builtin_bit_cast(bf16x8, hw), al = __builtin_bit_cast(bf16x8, lw);
#pragma unroll
                            for (int nt = 0; nt < 3; ++nt) {
                                acc[mt][nt] = __builtin_amdgcn_mfma_f32_16x16x32_bf16(ah, bh[nt], acc[mt][nt], 0, 0, 0);
                                acc[mt][nt] = __builtin_amdgcn_mfma_f32_16x16x32_bf16(al, bh[nt], acc[mt][nt], 0, 0, 0);
                                acc[mt][nt] = __builtin_amdgcn_mfma_f32_16x16x32_bf16(ah, bl[nt], acc[mt][nt], 0, 0, 0);
                            }
                        }
                        asm volatile("" ::: "memory");
                    }
#pragma unroll
                    for (int mt = 0; mt < 4; ++mt) {
#pragma unroll
                        for (int nt = 0; nt < 3; ++nt) *(LAS f32x4*)(part + (wid * 49 + 16 * nt + fr) * 64 + 16 * mt + 4 * fq) = acc[mt][nt];
                        float sq = ssl[mt]; sq += __shfl_xor(sq, 16); sq += __shfl_xor(sq, 32);
                        if (fq == 0) part[(wid * 49 + 48) * 64 + 16 * mt + fr] = sq;
                    }
                }
                __syncthreads();
                for (int o = tid >> 6; o < 37; o += 8) { float sum = 0.f; const int po = (o == 36) ? 48 : o;
#pragma unroll
                    for (int w = 0; w < 8; ++w) sum += part[(w * 49 + po) * 64 + lane];
                    lg[o * 64 + lane] = sum; }
                __syncthreads();
                if (tid < 64) {
                    const float rstd = rsqrtf(lg[36 * 64 + tid] * (1.0f / DM) + RMS_EPS); rs[tid] = rstd;
                    float gl[4];
#pragma unroll
                    for (int o = 0; o < 4; ++o) gl[o] = lg[o * 64 + tid] * rstd + brg[o];
                    int gs = 0; float gm = gl[0];
#pragma unroll
                    for (int o = 1; o < 4; ++o) if (gl[o] > gm) { gm = gl[o]; gs = o; }
                    float gden = 0.f;
#pragma unroll
                    for (int o = 0; o < 4; ++o) gden += __expf(gl[o] - gm);
                    const float ggate = 1.0f / gden;
                    float el[8];
#pragma unroll
                    for (int o = 0; o < 8; ++o) el[o] = lg[(4 + 8 * gs + o) * 64 + tid] * rstd + bre[gs * 8 + o];
                    int i0 = 0; float m0 = el[0];
#pragma unroll
                    for (int o = 1; o < 8; ++o) if (el[o] > m0) { m0 = el[o]; i0 = o; }
                    int i1 = 0; float m1 = -3.0e38f;
#pragma unroll
                    for (int o = 0; o < 8; ++o) if (o != i0 && el[o] > m1) { m1 = el[o]; i1 = o; }
                    const float e1 = __expf(m1 - m0);
                    aE[2 * tid] = gs * 8 + i0; aE[2 * tid + 1] = gs * 8 + i1; aW[2 * tid] = ggate / (1.0f + e1); aW[2 * tid + 1] = ggate * e1 / (1.0f + e1);
                }
                __syncthreads();
                int myE = 0, rank = 0;
                if (tid < 128) { myE = aE[tid]; for (int a = 0; a < tid; ++a) rank += (aE[a] == myE) ? 1 : 0; }
                if (tid < NEXP) { int c = 0; for (int a = 0; a < 128; ++a) c += (aE[a] == tid) ? 1 : 0;
                    bs[tid] = c ? (int)__hip_atomic_fetch_add(cnt + tid * 64, (unsigned)c, __ATOMIC_RELAXED, __HIP_MEMORY_SCOPE_AGENT) : 0; }
#pragma unroll 2
                for (int it = 0; it < 8; ++it) {
                    const int ti = wid * 8 + it; const size_t tok = (size_t)chunk * 64 + ti; const float rstd = rs[ti];
#pragma unroll
                    for (int i = 0; i < 4; ++i) { const int d0 = (i * 64 + lane) * 4; const f32x4 xv = *(const f32x4*)(XB + tok * DM + d0), gv = *(const f32x4*)(g2 + d0);
                        u32x2 w; w.x = pack2(xv[0] * rstd * gv[0], xv[1] * rstd * gv[1]); w.y = pack2(xv[2] * rstd * gv[2], xv[3] * rstd * gv[3]);
                        *(u32x2*)(Hb + tok * DM + d0) = w; }
                }
                __syncthreads();
                if (tid < 128) { const int slot = bs[myE] + rank, tok = chunk * 64 + (tid >> 1);
                    tokE[(size_t)myE * ECAP + slot] = tok; tokW[(size_t)myE * ECAP + slot] = aW[tid]; asg[tok * 2 + (tid & 1)] = myE * ECAP + slot; }
                __syncthreads();
            }
        }
        SEAM(pb + 5);
        STAMP_BEGIN(pb + 6);
        for (int rep = 0; rep < REPS(6); ++rep) if (EN(6) && IN(pb + 6)) {
            asm volatile("; PHASE_MARK 6");
            LAYER_PTRS;
            build_moe_tables(LC, cnt);
            pg8::MoeOrder S{(const char*)Hb, (const char*)WguT, (size_t)DM * DM * 2, DM, LC + LI_TB, LC + LI_PS, LC + LI_CN, tokE, G, vcu, true};
            pg8::EpiSwiGLU E{ACT};
            pg8::gemm_phase<pg8::EpiSwiGLU, pg8::MoeOrder, 0, true>(lds, DM, S, E);
        }
        SEAM(pb + 6);
        STAMP_BEGIN(pb + 7);
        for (int rep = 0; rep < REPS(7); ++rep) if (EN(7) && IN(pb + 7)) {
            asm volatile("; PHASE_MARK 7");
            LAYER_PTRS;
            build_moe_tables(LC, cnt);
            pg8::MoeOrder S{(const char*)ACT, (const char*)WdT, (size_t)DM * EH * 2, EH, LC + LI_TB, LC + LI_PS, LC + LI_CN, tokE, G, vcu, false};
            pg8::EpiDown E{YB, tokW};
            pg8::gemm_phase<pg8::EpiDown, pg8::MoeOrder, 0, false>(lds, EH, S, E);
        }
        SEAM(pb + 7);
        STAMP_BEGIN(pb + 8);
        if (EN(8) && IN(pb + 8)) {
            asm volatile("; PHASE_MARK 8");
            LAYER_PTRS;
            build_moe_tables(LC, cnt);
            const bool lastl = (l == DEPTH - 1);
            const float* g1n = ka->in[1] + (size_t)(lastl ? 0 : (l + 1)) * DM;
            float* const xo = lastl ? ka->out : XB;
            for (int grp = gw; grp < NTOK / 4; grp += NGW) {
                const size_t t0 = (size_t)grp * 4;
                const int myasg = (lane < 8) ? asg[t0 * 2 + lane] : 0;
                f32x4 xv[4][4]; u32x2 ya[4][4], yb[4][4];
#pragma unroll
                for (int q = 0; q < 4; ++q) {
                    const int i0 = __builtin_amdgcn_readlane(myasg, 2 * q), i1 = __builtin_amdgcn_readlane(myasg, 2 * q + 1);
                    const size_t s0 = (size_t)(LC[LI_PS + (i0 >> 14)] + (i0 & (ECAP - 1))), s1 = (size_t)(LC[LI_PS + (i1 >> 14)] + (i1 & (ECAP - 1)));
#pragma unroll
                    for (int i = 0; i < 4; ++i) { const int d0 = (i * 64 + lane) * 4;
                        xv[q][i] = *(const f32x4*)(XB + (t0 + q) * DM + d0); ya[q][i] = *(const u32x2*)(YB + s0 * DM + d0); yb[q][i] = *(const u32x2*)(YB + s1 * DM + d0); }
                }
#pragma unroll
                for (int q = 0; q < 4; ++q) {
                    f32x4 v[4]; float ss = 0.f;
#pragma unroll
                    for (int i = 0; i < 4; ++i) { const int d0 = (i * 64 + lane) * 4; const u32x2 a = ya[q][i], b = yb[q][i]; const f32x4 x4 = xv[q][i];
                        v[i][0] = x4[0] + bflo(a.x) + bflo(b.x); v[i][1] = x4[1] + bfhi(a.x) + bfhi(b.x); v[i][2] = x4[2] + bflo(a.y) + bflo(b.y); v[i][3] = x4[3] + bfhi(a.y) + bfhi(b.y);
                        ss += (v[i][0] * v[i][0] + v[i][1] * v[i][1]) + (v[i][2] * v[i][2] + v[i][3] * v[i][3]);
                        *(f32x4*)(xo + (t0 + q) * DM + d0) = v[i]; }
                    if (!lastl) {
                        ss = wave_sum(ss);
                        const float rstd = rsqrtf(ss * (1.0f / DM) + RMS_EPS);
#pragma unroll
                        for (int i = 0; i < 4; ++i) { const int d0 = (i * 64 + lane) * 4; const f32x4 gv = *(const f32x4*)(g1n + d0);
                            u32x2 w; w.x = pack2(v[i][0] * rstd * gv[0], v[i][1] * rstd * gv[1]); w.y = pack2(v[i][2] * rstd * gv[2], v[i][3] * rstd * gv[3]);
                            *(u32x2*)(Hb + (t0 + q) * DM + d0) = w; }
                    }
                }
            }
            if (!lastl) {
                __syncthreads();
                ExpertItems I{ka->in[15] + (size_t)(l + 1) * NEXP * DM * EH, ka->in[16] + (size_t)(l + 1) * NEXP * DM * EH, ka->in[17] + (size_t)(l + 1) * NEXP * EH * DM, WguT, WdT};
                convert_items(I, (LAS float*)(lds + wid * 8704), lane, gw, NGW);
            }
        }
        if (l + 1 < DEPTH) SEAM(pb + 8); else if (PROBE_B == pb + 8) ts1 = __builtin_amdgcn_s_memrealtime();
    }

__global__ void __launch_bounds__(NTHREADS, 2) fwd_kernel(Args args) {
    extern __shared__ __attribute__((aligned(16))) unsigned char lds_raw[];
    LAS unsigned char* lds = (LAS unsigned char*)lds_raw;
    LAS int* LC = (LAS int*)(lds + LCTL_OFF);
    const int G0 = gridDim.x, bx0 = blockIdx.x;
    const int vcu0 = (G0 % 8 == 0) ? (bx0 % 8) * (G0 / 8) + bx0 / 8 : bx0;
    if (threadIdx.x < 4) LC[LI_BAR + threadIdx.x] = 0;
    __syncthreads();
    XcdBarrier bar; bar.bar = (unsigned*)(args.ws + OFF_CTRL) + CW_BAR; bar.x = 0; bar.st = nullptr;
    if (MK_N_LAUNCHES == 1) bar = xcd_barrier_post(bar.bar, (volatile LAS unsigned*)(LC + LI_BAR));
    const int lo = args.ph_lo, hi = args.ph_hi;
    unsigned long long ts0 = 0ull, ts1 = 0ull;
    STAMP_BEGIN(0);
    for (int rep = 0; rep < REPS(9); ++rep) if (EN(9) && IN(0)) {
        asm volatile("; PHASE_MARK 9");
        PHASE_PTRS; const int tid = opaque_tid(), lane = tid & 63, wid = __builtin_amdgcn_readfirstlane(tid >> 6), gw = vcu * NWAVES + wid;
        LAS float* scr = (LAS float*)(lds + wid * 8704);
        { SmallItems I{ka->in[2], ka->in[5], ka->in[9], WinT, WaT, WoT}; convert_items(I, scr, lane, gw, NGW); }
        for (int o = gw; o < DEPTH * (DM / 64) * (PW / 8); o += NGW) {
            const int l = o / ((DM / 64) * (PW / 8)), r = o % ((DM / 64) * (PW / 8)), kb = r / (DM / 64), n = (r % (DM / 64)) * 64 + lane, k0 = kb * 8, g = k0 >> 7;
            const cfp wm = (cfp)(unsigned long long)(ka->in[6] + (size_t)l * 4 * 128 * 128 + (size_t)k0 * 128);
            const cfp sc = (cfp)(unsigned long long)(ka->in[7] + (size_t)l * PW + g * 128);
            const float* wp = ka->in[8] + (size_t)l * PW * DM + (size_t)(g * 128) * DM + n;
            float a[8] = {0.f, 0.f, 0.f, 0.f, 0.f, 0.f, 0.f, 0.f};
#pragma unroll 8
            for (int dd = 0; dd < 128; ++dd) { const float w = wp[(size_t)dd * DM] * sc[dd];
#pragma unroll
                for (int c = 0; c < 8; ++c) a[c] += w * wm[c * 128 + dd]; }
            u32x4 ow; ow.x = pack2(a[0], a[1]); ow.y = pack2(a[2], a[3]); ow.z = pack2(a[4], a[5]); ow.w = pack2(a[6], a[7]);
            *(u32x4*)(WppT + (size_t)l * DM * PW + (size_t)n * PW + k0) = ow;
        }
        for (int o = bx * NTHREADS + tid; o < DEPTH * 48 * DM; o += G * NTHREADS) {
            const int l = o / (48 * DM), r = o % (48 * DM), oo = r / DM, d = r % DM;
            float w = 0.f;
            if (oo < 4) w = ka->in[11][(size_t)l * DM * 4 + (size_t)d * 4 + oo];
            else if (oo < 36) w = ka->in[13][(size_t)l * 4 * DM * 8 + ((size_t)((oo - 4) >> 3) * DM + d) * 8 + ((oo - 4) & 7)];
            w *= ka->in[10][(size_t)l * DM + d];
            const bf16_t hi = f2bf(w); const float hf = __uint_as_float((unsigned)hi << 16);
            ((bf16_t*)(ws + OFF_WRH))[o] = hi; ((bf16_t*)(ws + OFF_WRL))[o] = f2bf(w - hf);
        }
        { ExpertItems I{ka->in[15], ka->in[16], ka->in[17], WguT, WdT}; convert_items(I, scr, lane, gw, NGW); }
        for (int m = gw; m < NTOK; m += NGW) norm_row(x_in + (size_t)m * DM, ka->in[1], Hb + (size_t)m * DM, lane);
    }
    SEAM(0);

    layer_body<0>(bar, lds, LC, G0, bx0, vcu0, lo, hi, ts0, ts1);
    layer_body<1>(bar, lds, LC, G0, bx0, vcu0, lo, hi, ts0, ts1);
    if (PROBE_A >= 0 && blockIdx.x == 0) { const unsigned long long d = (ts1 - ts0) * 4ull, t0 = __builtin_amdgcn_s_memrealtime(); while (__builtin_amdgcn_s_memrealtime() - t0 < d) __builtin_amdgcn_s_sleep(8); }
#undef IN
#undef SEAM
}

extern "C" void kernel_launch(void* const* d_in, const int* in_sizes, int n_in, void* d_out, int out_size, void* d_ws, size_t ws_size, hipStream_t stream) {
    (void)in_sizes; (void)out_size;
    static int grid = 0;
    if (grid == 0) {
        int dev = 0, cus = 0;
        if (hipGetDevice(&dev) != hipSuccess || hipDeviceGetAttribute(&cus, hipDeviceAttributeMultiprocessorCount, dev) != hipSuccess) { grid = -1; return; }
        if (hipFuncSetAttribute((const void*)fwd_kernel, hipFuncAttributeMaxDynamicSharedMemorySize, LDS_BYTES) != hipSuccess) { grid = -1; return; }
        int per_cu = 0;
        (void)hipOccupancyMaxActiveBlocksPerMultiprocessor(&per_cu, (const void*)fwd_kernel, NTHREADS, LDS_BYTES);
        (void)hipGetLastError();
        grid = cus;
        if (n_in != 18 || ws_size < WS_NEED) { fprintf(stderr, "kernel_launch: unexpected inputs (n_in %d, ws %zu)\n", n_in, ws_size); grid = -1; return; }
    }
    if (grid < 0) return;
    (void)hipMemsetAsync((char*)d_ws + OFF_CTRL, 0, CTRL_BYTES, stream);
    Args a{};
    for (int i = 0; i < 18; ++i) a.in[i] = (const float*)d_in[i];
    a.out = (float*)d_out; a.ws = (unsigned char*)d_ws;
    constexpr int NPH = 1 + 9 * DEPTH;
    if (MK_N_LAUNCHES == 1) { a.ph_lo = 0; a.ph_hi = NPH; hipLaunchKernelGGL(fwd_kernel, dim3(grid), dim3(NTHREADS), LDS_BYTES, stream, a); }
    else { for (int p = 0; p < NPH; ++p) { a.ph_lo = p; a.ph_hi = p + 1; hipLaunchKernelGGL(fwd_kernel, dim3(grid), dim3(NTHREADS), LDS_BYTES, stream, a); } }
}
```

```cpp
#include <hip/hip_runtime.h>
#include <stdint.h>
#include <stdio.h>

#define LAS __attribute__((address_space(3)))
typedef unsigned short bf16_t;
typedef short bf16x8 __attribute__((ext_vector_type(8)));
typedef float f32x2 __attribute__((ext_vector_type(2)));
typedef float f32x4 __attribute__((ext_vector_type(4)));
typedef float f32x16 __attribute__((ext_vector_type(16)));
typedef unsigned u32x2 __attribute__((ext_vector_type(2)));
typedef unsigned u32x4 __attribute__((ext_vector_type(4)));
typedef __bf16 bfv2 __attribute__((ext_vector_type(2)));

#ifndef MK_N_LAUNCHES
#define MK_N_LAUNCHES 1
#endif

constexpr int DM = 1024, SEQ = 4096, NTOK = 16384, DEPTH = 2;
constexpr int HD = 64, AW = 512, PW = 512, INW = 4096;
constexpr int NEXP = 32, EH = 512, ECAP = NTOK;
constexpr float RMS_EPS = 1e-6f;
constexpr int NTHREADS = 512, NWAVES = 8;

constexpr size_t MB = 1024 * 1024;
constexpr size_t OFF_CTRL = 0, CTRL_BYTES = 65536;
constexpr size_t OFF_WIN  = 1 * MB;
constexpr size_t OFF_WA   = OFF_WIN + 16 * MB;
constexpr size_t OFF_WPP  = OFF_WA + 2 * MB;
constexpr size_t OFF_WO   = OFF_WPP + 2 * MB;
constexpr size_t OFF_WGU  = OFF_WO + 4 * MB;
constexpr size_t OFF_WD   = OFF_WGU + 64 * MB;
constexpr size_t OFF_H    = OFF_WD + 32 * MB;
constexpr size_t OFF_PROJ = OFF_H + 32 * MB;
constexpr size_t OFF_ACT  = OFF_PROJ;
constexpr size_t OFF_YB   = OFF_PROJ + 40 * MB;
constexpr size_t OFF_AC   = OFF_PROJ + 128 * MB;
constexpr size_t OFF_PL   = OFF_AC + 16 * MB;
constexpr size_t OFF_OG   = OFF_PL + 16 * MB;
constexpr size_t OFF_T1   = OFF_OG;
constexpr size_t OFF_ML   = OFF_OG + 48 * MB;
constexpr size_t OFF_XB   = OFF_ML + 4 * MB;
constexpr size_t OFF_TOKE = OFF_XB + 64 * MB;
constexpr size_t OFF_TOKW = OFF_TOKE + 2 * MB;
constexpr size_t OFF_ASG  = OFF_TOKW + 2 * MB;
constexpr size_t OFF_WRH  = OFF_ASG + 1 * MB;
constexpr size_t OFF_WRL  = OFF_WRH + 256 * 1024;
constexpr size_t WS_NEED  = OFF_WRL + 256 * 1024;
constexpr int CW_CNT = 1024;
constexpr int CW_BAR = 8192;
constexpr int RING_BYTES = 131072, LCTL_OFF = RING_BYTES, LDS_BYTES = RING_BYTES + 2048;
constexpr int LI_BAR = 0, LI_TB = 16, LI_PS = 64, LI_CN = 112, LI_NT = 15, LI_ORD = 144;

__device__ __forceinline__ float bflo(unsigned w) { return __uint_as_float(w << 16); }
__device__ __forceinline__ float bfhi(unsigned w) { return __uint_as_float(w & 0xffff0000u); }
__device__ __forceinline__ unsigned pack2(float lo, float hi) { f32x2 v = {lo, hi}; return __builtin_bit_cast(unsigned, __builtin_convertvector(v, bfv2)); }
__device__ __forceinline__ bf16_t f2bf(float f) { return (bf16_t)(pack2(f, 0.f) & 0xffffu); }
__device__ __forceinline__ float wave_sum(float v) {
#pragma unroll
    for (int o = 32; o >= 1; o >>= 1) v += __shfl_xor(v, o);
    return v;
}
__device__ __forceinline__ int opaque_tid() { int t = (int)threadIdx.x; asm volatile("" : "+v"(t)); return t; }
__device__ __forceinline__ int opaque_s(int v) { asm volatile("" : "+s"(v)); return v; }
__device__ __forceinline__ float sigmoidf_(float v) { return 1.0f / (1.0f + __expf(-v)); }

#define XB_TMO      128
#define XB_XCNT(j)  (256  + 64 * (j))
#define XB_XSUB(j)  (1280 + 64 * (j))
#define XB_XGEN(j)  (2304 + 64 * (j))
#define XB_TOP      3328
#define XB_TOPGEN   3392
#define XCD_BAR_WORDS 3456
#define XB_SPIN_CAP (1u << 18)
__device__ __forceinline__ unsigned xb_ld(unsigned* p)              { return __hip_atomic_load(p, __ATOMIC_RELAXED, __HIP_MEMORY_SCOPE_AGENT); }
__device__ __forceinline__ unsigned xb_add(unsigned* p, unsigned v) { return __hip_atomic_fetch_add(p, v, __ATOMIC_RELAXED, __HIP_MEMORY_SCOPE_AGENT); }
__device__ __forceinline__ unsigned xb_xcc_id() { return (unsigned)__builtin_amdgcn_s_getreg((3 << 11) | 20) & 0xFu; }
#define XB_SPIN(cond, bar) do { unsigned _sp = 0; while (cond) { __builtin_amdgcn_s_sleep(1); \
    if ((++_sp & 255u) == 0u) { if (xb_ld(&(bar)[XB_TMO])) break; if (_sp > XB_SPIN_CAP) { atomicAdd(&(bar)[XB_TMO], 1u); break; } } } } while (0)
struct XcdBarrier { unsigned* bar; unsigned x; volatile LAS unsigned* st; };
__device__ __forceinline__ XcdBarrier xcd_barrier_post(unsigned* bar, volatile LAS unsigned* st) {
    XcdBarrier b; b.bar = bar; b.x = xb_xcc_id(); b.st = st;
    if (threadIdx.x == 0) (void)xb_add(&bar[XB_XCNT(b.x)], 1u);
    return b;
}
__device__ __forceinline__ void xcd_barrier_complete(unsigned* bar, unsigned x, unsigned& nloc, unsigned& nx) {
    const unsigned G = gridDim.x * gridDim.y * gridDim.z;
    unsigned sum, cnt, mine, sp = 0u;
    for (;;) {
        sum = 0u; cnt = 0u; mine = 0u;
#pragma unroll
        for (unsigned j = 0; j < 16; ++j) { const unsigned c = xb_ld(&bar[XB_XCNT(j)]); sum += c; cnt += (c > 0u) ? 1u : 0u; mine = (j == x) ? c : mine; }
        if (sum == G) break;
        __builtin_amdgcn_s_sleep(1);
        if ((++sp & 255u) == 0u) { if (xb_ld(&bar[XB_TMO])) break; if (sp > XB_SPIN_CAP) { atomicAdd(&bar[XB_TMO], 1u); break; } }
    }
    nloc = mine > 0u ? mine : 1u; nx = cnt > 0u ? cnt : 1u;
}
__device__ __forceinline__ void xcd_barrier(const XcdBarrier& b) {
    asm volatile("s_waitcnt vmcnt(0)" ::: "memory");
    __syncthreads();
    if (threadIdx.x == 0) {
        unsigned* bar = b.bar;
        __builtin_amdgcn_s_waitcnt(0);
        unsigned nloc = b.st[0], nx = b.st[1];
        if (nloc == 0u) { xcd_barrier_complete(bar, b.x, nloc, nx); b.st[0] = nloc; b.st[1] = nx; }
        const unsigned old = xb_add(&bar[XB_XSUB(b.x)], 1u);
        const unsigned gen = old / nloc;
        if (old + 1u == (gen + 1u) * nloc) {
            __builtin_amdgcn_fence(__ATOMIC_RELEASE, "agent");
            asm volatile("s_waitcnt vmcnt(0)" ::: "memory");
            const unsigned og = xb_add(&bar[XB_TOP], 1u);
            const unsigned tg = og / nx;
            if (og + 1u == (tg + 1u) * nx) xb_add(&bar[XB_TOPGEN], 1u);
            else XB_SPIN(xb_ld(&bar[XB_TOPGEN]) == tg, bar);
            __builtin_amdgcn_fence(__ATOMIC_ACQUIRE, "agent");
            xb_add(&bar[XB_XGEN(b.x)], 1u);
            asm volatile("s_waitcnt vmcnt(0)" ::: "memory");
        } else {
            XB_SPIN(xb_ld(&bar[XB_XGEN(b.x)]) == gen, bar);
            __builtin_amdgcn_fence(__ATOMIC_ACQUIRE, "agent");
            asm volatile("s_waitcnt vmcnt(0)" ::: "memory");
        }
    }
    __syncthreads();
}

namespace pg8 {
constexpr int BM = 256, BK = 64, HALF = 128, HTB = HALF * BK * 2, NXCD = 8, WGM = 8;
__device__ __forceinline__ int lds_byte(int r, int c) { const int st = (r >> 4) * 2 + (c >> 5), rr = r & 15, cc = c & 31, ob = rr * 64 + cc * 2; return st * 1024 + (ob ^ (((ob >> 9) & 1) << 5)); }
__device__ __forceinline__ void stage_rc(int b, int& R, int& C) { const int st = b / 1024, sb = b % 1024, swz = sb ^ (((sb >> 9) & 1) << 5); R = (st >> 1) * 16 + swz / 64; C = (st & 1) * 32 + (swz % 64) / 2; }
__device__ __forceinline__ int perm32(int rho) { const int n = rho >> 4, i = rho & 15; return 8 * (i >> 2) + 4 * n + (i & 3); }

struct Unit { const char* A; const char* B; int row0, col0, e, nvalid, j0; };

struct DenseOrder {
    const char* A; const char* Bt; int K, nM, nN, nwg, G, c;
    __device__ __forceinline__ void init(const void* A_, const void* Bt_, int M, int N, int K_, int G_, int c_) { A = (const char*)A_; Bt = (const char*)Bt_; K = K_; nM = M / BM; nN = N / BM; nwg = nM * nN; G = G_; c = c_; }
    __device__ __forceinline__ bool next(int i, Unit& u) const {
        const long L = (long)i * G + c; if (L >= nwg) return false;
        int wgid = (int)L; { const int q = nwg / NXCD, r = nwg % NXCD, xcd = wgid % NXCD, off = wgid / NXCD; wgid = (xcd < r ? xcd * (q + 1) : r * (q + 1) + (xcd - r) * q) + off; }
        const int nig = WGM * nN, gid = wgid / nig, fm = gid * WGM, gsz = (nM - fm) < WGM ? (nM - fm) : WGM;
        const int pm = fm + ((wgid % nig) % gsz), pn = (wgid % nig) / gsz;
        u.A = A + (size_t)pm * BM * K * 2; u.B = Bt + (size_t)pn * BM * K * 2; u.row0 = pm * BM; u.col0 = pn * BM; u.e = 0; u.nvalid = BM; u.j0 = 0; return true;
    }
    __device__ __forceinline__ unsigned row_off(const Unit&, int) const { return 0u; }
};
struct MoeOrder {
    const char* A; const char* Bt; size_t bExp; int K; const LAS int* tb; const LAS int* ps; const LAS int* cn; const LAS int* ord; const int* tokE; int G, c; bool gather;
    __device__ __forceinline__ bool next(int i, Unit& u) const {
        const int L = i * G + c, total = tb[NEXP] * 4; if (L >= total) return false;
        const int rt = L >> 2, pn = L & 3;
        const int ej = __builtin_amdgcn_readfirstlane(ord[rt]);
        const int e = ej >> 8, j = ej & 255;
        const int pse = __builtin_amdgcn_readfirstlane(ps[e]), cne = __builtin_amdgcn_readfirstlane(cn[e]);
        u.e = e; u.row0 = pse + BM * j; u.col0 = pn * BM; u.nvalid = min(BM, cne - BM * j); u.j0 = e * ECAP + BM * j;
        u.B = Bt + (size_t)e * bExp + (size_t)pn * BM * K * 2;
        u.A = gather ? A : A + (size_t)u.row0 * K * 2;
        return true;
    }
    __device__ __forceinline__ unsigned row_off(const Unit& u, int R) const { const int t = R < u.nvalid ? tokE[u.j0 + R] : 0; return (unsigned)t * (unsigned)(K * 2); }
};

template <class Epi, class Sched, int BMODE, bool GATHER, bool LIGHT = false>
__device__ __forceinline__ void gemm_phase(LAS unsigned char* lds, const int K, const Sched& S, const Epi& E) {
    const int tid = opaque_tid(), wid = __builtin_amdgcn_readfirstlane(tid >> 6), lane = tid & 63, wr = wid >> 2, wc = wid & 3, fr = lane & 15, fq = lane >> 4;
    const int nt = K / BK;
    unsigned voffA[2][2], voffAn[2][2], voffB[2]; int RA[2], CA[2];
#pragma unroll
    for (int i = 0; i < 2; ++i) { int R, C; stage_rc(tid * 16 + i * 8192, R, C); RA[i] = R; CA[i] = C;
        const int Rb = (BMODE == 1) ? (64 * (R >> 5) + perm32(R & 31)) : (Epi::PERM ? ((R & ~31) + perm32(R & 31)) : R);
        voffB[i] = (unsigned)(Rb * K + C) * 2u;
#pragma unroll
        for (int h = 0; h < 2; ++h) { voffA[h][i] = (unsigned)((h * HALF + R) * K + C) * 2u; voffAn[h][i] = voffA[h][i]; } }
    const size_t kstep = (size_t)(BK * 2);
    const size_t hstepB = (size_t)((BMODE == 1) ? 32 : HALF) * K * 2;
    const unsigned ldsw = (unsigned)wid * 1024u;
    const int aoff = lds_byte(wr * 64 + fr, fq * 8), boff = lds_byte(wc * 32 + fr, fq * 8);
#define PG8_SA(b, h) (((b) * 2 + (h)) * HTB)
#define PG8_SB(b, h) ((4 + (b) * 2 + (h)) * HTB)
#define PG8_STAGE2(bufoff, gbase, v0, v1) do { \
        __builtin_amdgcn_global_load_lds((const unsigned*)((const char*)(gbase) + (v0)), (LAS unsigned*)(lds + (bufoff) + ldsw), 16, 0, 0); \
        __builtin_amdgcn_global_load_lds((const unsigned*)((const char*)(gbase) + (v1)), (LAS unsigned*)(lds + (bufoff) + ldsw + 8192), 16, 0, 0); } while (0)
#define PG8_STAGEB(bufoff, gbase) PG8_STAGE2(bufoff, gbase, voffB[0], voffB[1])
#define PG8_STAGEA(bufoff, gbase, h, nx) PG8_STAGE2(bufoff, gbase, ((GATHER && (nx)) ? voffAn[h][0] : voffA[h][0]), ((GATHER && (nx)) ? voffAn[h][1] : voffA[h][1]))
#define PG8_LDA(dst, b, h) do { _Pragma("unroll") for (int m = 0; m < 4; ++m) _Pragma("unroll") for (int k = 0; k < 2; ++k) dst[m][k] = *(const LAS bf16x8*)(lds + PG8_SA(b, h) + aoff + m * 2048 + k * 1024); } while (0)
#define PG8_LDB(dst, b, h) do { _Pragma("unroll") for (int n = 0; n < 2; ++n) _Pragma("unroll") for (int k = 0; k < 2; ++k) dst[n][k] = *(const LAS bf16x8*)(lds + PG8_SB(b, h) + boff + n * 2048 + k * 1024); } while (0)
#define PG8_MMA(ai, bj, At, Bt) do { __builtin_amdgcn_s_setprio(1); _Pragma("unroll") for (int m = 0; m < 4; ++m) _Pragma("unroll") for (int n = 0; n < 2; ++n) _Pragma("unroll") for (int k = 0; k < 2; ++k) \
        acc[ai][bj][m][n] = __builtin_amdgcn_mfma_f32_16x16x32_bf16(Bt[n][k], At[m][k], acc[ai][bj][m][n], 0, 0, 0); __builtin_amdgcn_s_setprio(0); } while (0)
#define PG8_WAIT_V(n) asm volatile("s_waitcnt vmcnt(" #n ")" ::: "memory")
#define PG8_WAIT_L(n) asm volatile("s_waitcnt lgkmcnt(" #n ")" ::: "memory")
#define PG8_BAR __builtin_amdgcn_s_barrier()
#define PG8_SCHED __builtin_amdgcn_sched_barrier(0)
    Unit cur, nxt; int ui = 0;
    if (!S.next(0, cur)) return;
    if (GATHER) {
#pragma unroll
        for (int h = 0; h < 2; ++h)
#pragma unroll
            for (int i = 0; i < 2; ++i) voffA[h][i] = S.row_off(cur, h * HALF + RA[i]) + (unsigned)CA[i] * 2u;
    }
    f32x4 acc[2][2][4][2];
#pragma unroll
    for (int a = 0; a < 2; ++a)
#pragma unroll
        for (int b = 0; b < 2; ++b)
#pragma unroll
            for (int m = 0; m < 4; ++m)
#pragma unroll
                for (int n = 0; n < 2; ++n) acc[a][b][m][n] = (f32x4){0.f, 0.f, 0.f, 0.f};
    bf16x8 At[4][2], B0[2][2], B1[2][2];
    const char* cA = cur.A; const char* cB = cur.B;
    PG8_STAGEB(PG8_SB(0, 0), cB); PG8_STAGEB(PG8_SB(0, 1), cB + hstepB); PG8_STAGEA(PG8_SA(0, 0), cA, 0, false); PG8_STAGEA(PG8_SA(0, 1), cA, 1, false);
    if (wr == 1) PG8_BAR;
    PG8_WAIT_V(2); PG8_BAR;
    PG8_STAGEB(PG8_SB(1, 0), cB + kstep); PG8_STAGEA(PG8_SA(1, 0), cA + kstep, 0, false); PG8_STAGEB(PG8_SB(1, 1), cB + hstepB + kstep);
    PG8_WAIT_V(6); PG8_BAR;
    for (;;) {
        const bool has_next = S.next(ui + 1, nxt);
        if (GATHER) {
#pragma unroll
            for (int h = 0; h < 2; ++h)
#pragma unroll
                for (int i = 0; i < 2; ++i) voffAn[h][i] = has_next ? (S.row_off(nxt, h * HALF + RA[i]) + (unsigned)CA[i] * 2u) : voffA[h][i];
        }
        const char* nA = has_next ? nxt.A : cA; const char* nB = has_next ? nxt.B : cB;
        const bool full = cur.nvalid > HALF;
        for (int t = 0; t < nt; t += 2) {
            const bool last = (t == nt - 2);
            const char* a1 = cA + (size_t)(t + 1) * kstep;
            const char* a2 = last ? nA : cA + (size_t)(t + 2) * kstep; const char* b2 = last ? nB : cB + (size_t)(t + 2) * kstep;
            const char* a3 = a2 + kstep; const char* b3 = b2 + kstep;
            PG8_LDB(B0, 0, 0); PG8_LDB(B1, 0, 1); PG8_SCHED; PG8_LDA(At, 0, 0); PG8_STAGEA(PG8_SA(1, 1), a1, 1, false);
            PG8_WAIT_V(8); PG8_WAIT_L(0); PG8_BAR; PG8_MMA(0, 0, At, B0); PG8_MMA(0, 1, At, B1); PG8_BAR; PG8_SCHED;
            PG8_LDA(At, 0, 1); PG8_STAGEB(PG8_SB(0, 0), b2); PG8_STAGEB(PG8_SB(0, 1), b2 + hstepB); PG8_STAGEA(PG8_SA(0, 0), a2, 0, last);
            PG8_WAIT_V(8); PG8_WAIT_L(0); PG8_BAR; if (!LIGHT || full) { PG8_MMA(1, 0, At, B0); PG8_MMA(1, 1, At, B1); } PG8_BAR; PG8_SCHED;
            PG8_LDB(B0, 1, 0); PG8_LDB(B1, 1, 1); PG8_SCHED; PG8_LDA(At, 1, 0); PG8_STAGEA(PG8_SA(0, 1), a2, 1, last);
            PG8_WAIT_V(8); PG8_WAIT_L(0); PG8_BAR; PG8_MMA(0, 0, At, B0); PG8_MMA(0, 1, At, B1); PG8_BAR; PG8_SCHED;
            PG8_LDA(At, 1, 1); PG8_STAGEB(PG8_SB(1, 0), b3); PG8_STAGEB(PG8_SB(1, 1), b3 + hstepB); PG8_STAGEA(PG8_SA(1, 0), a3, 0, last);
            PG8_WAIT_V(8); PG8_WAIT_L(0); PG8_BAR; if (!LIGHT || full) { PG8_MMA(1, 0, At, B0); PG8_MMA(1, 1, At, B1); } PG8_BAR; PG8_SCHED;
        }
        if (wr == 0) PG8_BAR;
        E(acc, cur, wr, wc, fr, fq);
        if (!has_next) break;
#pragma unroll
        for (int a = 0; a < 2; ++a)
#pragma unroll
            for (int b = 0; b < 2; ++b)
#pragma unroll
                for (int m = 0; m < 4; ++m)
#pragma unroll
                    for (int n = 0; n < 2; ++n) acc[a][b][m][n] = (f32x4){0.f, 0.f, 0.f, 0.f};
        cur = nxt; cA = nA; cB = nB; ++ui;
        if (GATHER) {
#pragma unroll
            for (int h = 0; h < 2; ++h)
#pragma unroll
                for (int i = 0; i < 2; ++i) voffA[h][i] = voffAn[h][i];
        }
        if (wr == 1) PG8_BAR;
    }
    PG8_WAIT_V(0);
    PG8_BAR;
#undef PG8_SA
#undef PG8_SB
#undef PG8_STAGE2
#undef PG8_STAGEA
#undef PG8_STAGEB
#undef PG8_LDA
#undef PG8_LDB
#undef PG8_MMA
#undef PG8_WAIT_V
#undef PG8_WAIT_L
#undef PG8_BAR
#undef PG8_SCHED
}

struct EpiProj {
    static constexpr bool PERM = true;
    bf16_t* out; const float* gq; const float* gk;
    __device__ __forceinline__ void operator()(const f32x4 (&acc)[2][2][4][2], const Unit& u, int wr, int wc, int fr, int fq) const {
        const int pn = u.col0 >> 8;
        const int row0 = u.row0 + wr * 64 + fr, colb = u.col0 + 64 * wc + 8 * fq;
        if (pn < 4) {
            const float* g = (pn < 2) ? gq : gk; const float post = (pn < 2) ? 0.125f : 1.0f;
            f32x4 gv[2][2];
#pragma unroll
            for (int bj = 0; bj < 2; ++bj)
#pragma unroll
                for (int n = 0; n < 2; ++n) gv[bj][n] = *(const f32x4*)(g + 32 * bj + 8 * fq + 4 * n) * post;
#pragma unroll
            for (int ai = 0; ai < 2; ++ai)
#pragma unroll
                for (int m = 0; m < 4; ++m) {
                    float ss = 0.f;
#pragma unroll
                    for (int bj = 0; bj < 2; ++bj)
#pragma unroll
                        for (int n = 0; n < 2; ++n) { const f32x4 x = acc[ai][bj][m][n]; ss += (x[0] * x[0] + x[1] * x[1]) + (x[2] * x[2] + x[3] * x[3]); }
                    ss += __shfl_xor(ss, 16); ss += __shfl_xor(ss, 32);
                    const float rstd = rsqrtf(ss * (1.0f / HD) + RMS_EPS);
                    bf16_t* rowp = out + (size_t)(row0 + ai * HALF + m * 16) * INW + colb;
#pragma unroll
                    for (int bj = 0; bj < 2; ++bj) { const f32x4 v0 = acc[ai][bj][m][0] * rstd * gv[bj][0], v1 = acc[ai][bj][m][1] * rstd * gv[bj][1];
                        u32x4 w; w.x = pack2(v0[0], v0[1]); w.y = pack2(v0[2], v0[3]); w.z = pack2(v1[0], v1[1]); w.w = pack2(v1[2], v1[3]);
                        *(u32x4*)(rowp + 32 * bj) = w; }
                }
        } else {
            const bool sg = pn >= 8;
#pragma unroll
            for (int ai = 0; ai < 2; ++ai)
#pragma unroll
                for (int m = 0; m < 4; ++m) {
                    bf16_t* rowp = out + (size_t)(row0 + ai * HALF + m * 16) * INW + colb;
#pragma unroll
                    for (int bj = 0; bj < 2; ++bj) { f32x4 v0 = acc[ai][bj][m][0], v1 = acc[ai][bj][m][1];
                        if (sg) {
#pragma unroll
                            for (int j = 0; j < 4; ++j) { v0[j] = sigmoidf_(v0[j]); v1[j] = sigmoidf_(v1[j]); } }
                        u32x4 w; w.x = pack2(v0[0], v0[1]); w.y = pack2(v0[2], v0[3]); w.z = pack2(v1[0], v1[1]); w.w = pack2(v1[2], v1[3]);
                        *(u32x4*)(rowp + 32 * bj) = w; }
                }
        }
    }
};
template <int MODE> struct EpiGate {
    static constexpr bool PERM = true;
    const bf16_t* gate; const bf16_t* t1in; bf16_t* out;
    __device__ __forceinline__ void operator()(const f32x4 (&acc)[2][2][4][2], const Unit& u, int wr, int wc, int fr, int fq) const {
        const int row0 = u.row0 + wr * 64 + fr, col0 = u.col0 + wc * 32 + 8 * fq;
#pragma unroll
        for (int ai = 0; ai < 2; ++ai)
#pragma unroll
            for (int m = 0; m < 4; ++m) {
                const size_t r = (size_t)(row0 + ai * HALF + m * 16);
#pragma unroll
                for (int bj = 0; bj < 2; ++bj) {
                    const int c = col0 + bj * HALF;
                    const u32x4 g = *(const u32x4*)(gate + r * INW + c);
                    const f32x4 a0 = acc[ai][bj][m][0], a1 = acc[ai][bj][m][1];
                    float o[8] = {a0[0] * bflo(g.x), a0[1] * bfhi(g.x), a0[2] * bflo(g.y), a0[3] * bfhi(g.y), a1[0] * bflo(g.z), a1[1] * bfhi(g.z), a1[2] * bflo(g.w), a1[3] * bfhi(g.w)};
                    if (MODE == 1) { const u32x4 t = *(const u32x4*)(t1in + r * DM + c);
                        o[0] += bflo(t.x); o[1] += bfhi(t.x); o[2] += bflo(t.y); o[3] += bfhi(t.y); o[4] += bflo(t.z); o[5] += bfhi(t.z); o[6] += bflo(t.w); o[7] += bfhi(t.w); }
                    u32x4 w; w.x = pack2(o[0], o[1]); w.y = pack2(o[2], o[3]); w.z = pack2(o[4], o[5]); w.w = pack2(o[6], o[7]);
                    *(u32x4*)(out + r * DM + c) = w;
                }
            }
    }
};
struct EpiResid {
    static constexpr bool PERM = false;
    const float* xin; float* xout;
    __device__ __forceinline__ void operator()(const f32x4 (&acc)[2][2][4][2], const Unit& u, int wr, int wc, int fr, int fq) const {
        const int row0 = u.row0 + wr * 64 + fr, col0 = u.col0 + wc * 32 + 4 * fq;
#pragma unroll
        for (int ai = 0; ai < 2; ++ai)
#pragma unroll
            for (int m = 0; m < 4; ++m) { const size_t off = (size_t)(row0 + ai * HALF + m * 16) * DM + col0;
#pragma unroll
                for (int bj = 0; bj < 2; ++bj)
#pragma unroll
                    for (int n = 0; n < 2; ++n) { const f32x4 x = *(const f32x4*)(xin + off + bj * HALF + n * 16); *(f32x4*)(xout + off + bj * HALF + n * 16) = x + acc[ai][bj][m][n]; } }
    }
};
struct EpiSwiGLU {
    static constexpr bool PERM = true;
    bf16_t* act;
    __device__ __forceinline__ void operator()(const f32x4 (&acc)[2][2][4][2], const Unit& u, int wr, int wc, int fr, int fq) const {
        const int row0 = u.row0 + wr * 64 + fr, col0 = (u.col0 >> 1) + wc * 32 + 8 * fq;
#pragma unroll
        for (int ai = 0; ai < 2; ++ai)
#pragma unroll
            for (int m = 0; m < 4; ++m) {
                float o[8];
#pragma unroll
                for (int n = 0; n < 2; ++n)
#pragma unroll
                    for (int j = 0; j < 4; ++j) { const float a = acc[ai][0][m][n][j], b = acc[ai][1][m][n][j]; o[4 * n + j] = a * sigmoidf_(a) * b; }
                u32x4 w; w.x = pack2(o[0], o[1]); w.y = pack2(o[2], o[3]); w.z = pack2(o[4], o[5]); w.w = pack2(o[6], o[7]);
                *(u32x4*)(act + (size_t)(row0 + ai * HALF + m * 16) * EH + col0) = w;
            }
    }
};
struct EpiDown {
    static constexpr bool PERM = true;
    bf16_t* yb; const float* tokW;
    __device__ __forceinline__ void operator()(const f32x4 (&acc)[2][2][4][2], const Unit& u, int wr, int wc, int fr, int fq) const {
        const int col0 = u.col0 + wc * 32 + 8 * fq;
#pragma unroll
        for (int ai = 0; ai < 2; ++ai)
#pragma unroll
            for (int m = 0; m < 4; ++m) {
                const int rl = wr * 64 + fr + ai * HALF + m * 16;
                const float w = rl < u.nvalid ? tokW[u.j0 + rl] : 0.f;
#pragma unroll
                for (int bj = 0; bj < 2; ++bj) { const f32x4 v0 = acc[ai][bj][m][0] * w, v1 = acc[ai][bj][m][1] * w;
                    u32x4 o; o.x = pack2(v0[0], v0[1]); o.y = pack2(v0[2], v0[3]); o.z = pack2(v1[0], v1[1]); o.w = pack2(v1[2], v1[3]);
                    *(u32x4*)(yb + (size_t)(u.row0 + rl) * DM + col0 + bj * HALF) = o; }
            }
    }
};
}

constexpr int ATT_K_OFF = 0, ATT_V_OFF = 49152;
__device__ __forceinline__ unsigned kv_off(unsigned row, unsigned ch) { return row * 128u + 16u * (ch ^ (((row >> 1) & 7u) ^ ((row & 2u) << 1))); }

struct AttnU { int tok0, d, blk, g, h; };
__device__ __forceinline__ AttnU attn_decode(int uidx) {
    const int bh = uidx / 48, r48 = uidx % 48, g = r48 >> 4, rr = r48 & 15;
    AttnU U; U.g = g; U.h = bh & 7;
    U.d = (g == 0) ? 1 : (g == 1 ? 4 : 16);
    const int c = (g == 0) ? 0 : (g == 1 ? (rr >> 2) : rr);
    U.blk = (g == 0) ? rr : (g == 1 ? (rr & 3) : 0);
    U.tok0 = (bh >> 3) * SEQ + c;
    return U;
}
__device__ __forceinline__ void attn_load_q(const AttnU& U, const bf16_t* __restrict__ proj, int wid, int lane, bf16x8 (&qn)[4]) {
    const size_t qt = (size_t)(U.tok0 + (256 * U.blk + 32 * wid + (lane & 31)) * U.d);
#pragma unroll
    for (int ks = 0; ks < 4; ++ks) qn[ks] = *(const bf16x8*)(proj + qt * INW + U.h * HD + 16 * ks + 8 * (lane >> 5));
}
__device__ __forceinline__ void attn_load(const AttnU& U, const bf16_t* __restrict__ proj, int tid, u32x4 (&kr)[6], u32x4 (&vr)[6]) {
    const int kbase = 256 * U.blk - 128, kr_min = (U.blk == 0) ? 128 : 0;
#pragma unroll
    for (int i = 0; i < 6; ++i) {
        const int idx = tid + NTHREADS * i, row = idx >> 3, ch = idx & 7;
        if (row >= kr_min) {
            const size_t t = (size_t)(U.tok0 + (kbase + row) * U.d);
            kr[i] = *(const u32x4*)(proj + t * INW + AW + U.h * HD + ch * 8);
            vr[i] = *(const u32x4*)(proj + t * INW + 2 * AW + U.h * HD + ch * 8);
        }
    }
}
__device__ __forceinline__ void attn_lds_store(const AttnU& U, LAS unsigned char* lds, int tid, const u32x4 (&kr)[6], const u32x4 (&vr)[6]) {
    const int kr_min = (U.blk == 0) ? 128 : 0;
#pragma unroll
    for (int i = 0; i < 6; ++i) {
        const int idx = tid + NTHREADS * i, row = idx >> 3, ch = idx & 7;
        if (row >= kr_min) { *(LAS u32x4*)(lds + ATT_K_OFF + kv_off(row, ch)) = kr[i]; *(LAS u32x4*)(lds + ATT_V_OFF + kv_off(row, ch)) = vr[i]; }
    }
}
__device__ __forceinline__ void attn_compute(const AttnU& U, LAS unsigned char* lds, const bf16x8 (&qf)[4], bf16_t* __restrict__ og, f32x2* __restrict__ ml, int wid, int lane) {
    const int blk = U.blk, g = U.g, h = U.h;
    const size_t qt = (size_t)(U.tok0 + (256 * blk + 32 * wid + (lane & 31)) * U.d);
    const int kt_min = (blk == 0) ? max(0, 4 - wid) : 0;
    const int hq = lane >> 5, qi = lane & 31;
    f32x16 S[5];
#pragma unroll
    for (int kt = 0; kt < 5; ++kt) {
#pragma unroll
        for (int i = 0; i < 16; ++i) S[kt][i] = 0.f;
        if (kt >= kt_min) {
            const unsigned krow = (unsigned)(32 * wid + 32 * kt + qi);
#pragma unroll
            for (int ks = 0; ks < 4; ++ks) {
                const bf16x8 kf = *(const LAS bf16x8*)(lds + ATT_K_OFF + kv_off(krow, (unsigned)(2 * ks + hq)));
                S[kt] = __builtin_amdgcn_mfma_f32_32x32x16_bf16(kf, qf[ks], S[kt], 0, 0, 0);
            }
        }
    }
    float mx = -3.0e38f;
#pragma unroll
    for (int kt = 0; kt < 5; ++kt)
#pragma unroll
        for (int i = 0; i < 16; ++i) {
            const int row = (i & 3) + 8 * (i >> 2) + 4 * hq;
            bool valid = kt >= kt_min;
            if (kt == 0) valid = valid && (row >= qi);
            if (kt == 4) valid = valid && (row <= qi);
            S[kt][i] = valid ? S[kt][i] : -3.0e38f;
            mx = fmaxf(mx, S[kt][i]);
        }
    mx = fmaxf(mx, __shfl_xor(mx, 32));
    float lsum = 0.f;
#pragma unroll
    for (int kt = 0; kt < 5; ++kt)
#pragma unroll
        for (int i = 0; i < 16; ++i) { const float p = (S[kt][i] > -1.0e38f) ? __expf(S[kt][i] - mx) : 0.f; S[kt][i] = p; lsum += p; }
    lsum += __shfl_xor(lsum, 32);
    f32x16 O[2];
#pragma unroll
    for (int dt = 0; dt < 2; ++dt)
#pragma unroll
        for (int i = 0; i < 16; ++i) O[dt][i] = 0.f;
    const unsigned blkq = (lane >> 4) & 1, q4 = (lane & 15) >> 2, p4 = lane & 3;
    const unsigned vbase = (unsigned)(size_t)(lds + ATT_V_OFF);
#pragma unroll
    for (int kt = 0; kt < 5; ++kt) {
        if (kt >= kt_min) {
#pragma unroll
            for (int s = 0; s < 2; ++s) {
                u32x4 pw;
                pw.x = pack2(S[kt][8 * s + 0], S[kt][8 * s + 1]); pw.y = pack2(S[kt][8 * s + 2], S[kt][8 * s + 3]);
                pw.z = pack2(S[kt][8 * s + 4], S[kt][8 * s + 5]); pw.w = pack2(S[kt][8 * s + 6], S[kt][8 * s + 7]);
                const bf16x8 pf = __builtin_bit_cast(bf16x8, pw);
                u32x2 v00, v01, v10, v11;
                const unsigned r0 = (unsigned)(32 * wid + 32 * kt + 16 * s + 4 * hq) + q4, r1 = r0 + 8;
                const unsigned a00 = vbase + kv_off(r0, 0u + 2 * blkq + (p4 >> 1)) + 8 * (p4 & 1), a01 = vbase + kv_off(r1, 0u + 2 * blkq + (p4 >> 1)) + 8 * (p4 & 1);
                const unsigned a10 = vbase + kv_off(r0, 4u + 2 * blkq + (p4 >> 1)) + 8 * (p4 & 1), a11 = vbase + kv_off(r1, 4u + 2 * blkq + (p4 >> 1)) + 8 * (p4 & 1);
                asm volatile("ds_read_b64_tr_b16 %0, %4\n\tds_read_b64_tr_b16 %1, %5\n\tds_read_b64_tr_b16 %2, %6\n\tds_read_b64_tr_b16 %3, %7\n\ts_waitcnt lgkmcnt(0)"
                             : "=&v"(v00), "=&v"(v01), "=&v"(v10), "=&v"(v11) : "v"(a00), "v"(a01), "v"(a10), "v"(a11) : "memory");
                u32x4 f0; f0.x = v00.x; f0.y = v00.y; f0.z = v01.x; f0.w = v01.y;
                u32x4 f1; f1.x = v10.x; f1.y = v10.y; f1.z = v11.x; f1.w = v11.y;
                O[0] = __builtin_amdgcn_mfma_f32_32x32x16_bf16(__builtin_bit_cast(bf16x8, f0), pf, O[0], 0, 0, 0);
                O[1] = __builtin_amdgcn_mfma_f32_32x32x16_bf16(__builtin_bit_cast(bf16x8, f1), pf, O[1], 0, 0, 0);
            }
        }
    }
    const float inv = 1.0f / lsum;
    bf16_t* orow = og + ((size_t)g * NTOK + qt) * AW + h * HD;
#pragma unroll
    for (int dt = 0; dt < 2; ++dt)
#pragma unroll
        for (int gq4 = 0; gq4 < 4; ++gq4) {
            u32x2 w; w.x = pack2(O[dt][4 * gq4 + 0] * inv, O[dt][4 * gq4 + 1] * inv); w.y = pack2(O[dt][4 * gq4 + 2] * inv, O[dt][4 * gq4 + 3] * inv);
            *(u32x2*)(orow + 32 * dt + 8 * gq4 + 4 * hq) = w;
        }
    if (lane < 32) ml[((size_t)g * NTOK + qt) * 8 + h] = (f32x2){mx, lsum};
    __syncthreads();
}

struct TrDesc { const float* src; bf16_t* dst; int N, K; };
__device__ __forceinline__ void tr_load(const TrDesc& d, int lane, f32x4 (&r)[8]) {
#pragma unroll
    for (int i = 0; i < 8; ++i) r[i] = __builtin_nontemporal_load((const f32x4*)(d.src + (size_t)((lane >> 3) + 8 * i) * d.N + 4 * (lane & 7)));
}
__device__ __forceinline__ void tr_store(const TrDesc& d, LAS float* scr, int lane, const f32x4 (&r)[8]) {
#pragma unroll
    for (int i = 0; i < 8; ++i) { LAS float* p = scr + ((lane >> 3) + 8 * i) * 33 + 4 * (lane & 7); p[0] = r[i][0]; p[1] = r[i][1]; p[2] = r[i][2]; p[3] = r[i][3]; }
    const int c = lane & 7;
#pragma unroll
    for (int j = 0; j < 4; ++j) { const int n = (lane >> 3) + 8 * j; const LAS float* q = scr + (8 * c) * 33 + n;
        u32x4 o; o.x = pack2(q[0 * 33], q[1 * 33]); o.y = pack2(q[2 * 33], q[3 * 33]); o.z = pack2(q[4 * 33], q[5 * 33]); o.w = pack2(q[6 * 33], q[7 * 33]);
        *(u32x4*)(d.dst + (size_t)n * d.K + 8 * c) = o; }
}
struct ExpertItems {
    const float* weg; const float* weu; const float* wed; bf16_t* WguT; bf16_t* WdT;
    static constexpr int TOTAL = 3 * NEXP * 256;
    __device__ __forceinline__ TrDesc operator()(int it) const {
        const int which = it >> 13, r = it & 8191, e = r >> 8, item = r & 255; TrDesc d;
        if (which < 2) { const int kb = item >> 4, nb = item & 15, k0 = 64 * kb, n0 = 32 * nb, nn0 = (n0 >> 7) * 256 + which * 128 + (n0 & 127);
            d.src = (which == 0 ? weg : weu) + (size_t)e * DM * EH + (size_t)k0 * EH + n0; d.dst = WguT + (size_t)e * DM * DM + (size_t)nn0 * DM + k0; d.N = EH; d.K = DM; }
        else { const int kb = item >> 5, nb = item & 31, k0 = 64 * kb, n0 = 32 * nb;
            d.src = wed + (size_t)e * EH * DM + (size_t)k0 * DM + n0; d.dst = WdT + (size_t)e * DM * EH + (size_t)n0 * EH + k0; d.N = DM; d.K = EH; }
        return d;
    }
};
struct SmallItems {
    const float* win; const float* wa; const float* wo; bf16_t* WinT; bf16_t* WaT; bf16_t* WoT;
    static constexpr int TOTAL = 2 * 2816;
    __device__ __forceinline__ TrDesc operator()(int it) const {
        const int l = it / 2816, r = it % 2816; TrDesc d;
        if (r < 2048) { const int kb = r >> 7, nb = r & 127; d.src = win + (size_t)l * DM * INW + (size_t)(64 * kb) * INW + 32 * nb; d.dst = WinT + (size_t)l * INW * DM + (size_t)(32 * nb) * DM + 64 * kb; d.N = INW; d.K = DM; }
        else if (r < 2304) { const int q = r - 2048, kb = q >> 5, nb = q & 31; d.src = wa + (size_t)l * AW * DM + (size_t)(64 * kb) * DM + 32 * nb; d.dst = WaT + (size_t)l * DM * AW + (size_t)(32 * nb) * AW + 64 * kb; d.N = DM; d.K = AW; }
        else { const int q = r - 2304, kb = q >> 5, nb = q & 31; d.src = wo + (size_t)l * DM * DM + (size_t)(64 * kb) * DM + 32 * nb; d.dst = WoT + (size_t)l * DM * DM + (size_t)(32 * nb) * DM + 64 * kb; d.N = DM; d.K = DM; }
        return d;
    }
};
template <class Items>
__device__ __forceinline__ void convert_items(const Items& I, LAS float* scr, int lane, int gw, int NGW) {
    f32x4 ra[8], rb[8];
    int it = gw;
    if (it >= Items::TOTAL) return;
    TrDesc da = I(it), db = da;
    tr_load(da, lane, ra);
    for (;;) {
        int it2 = it + NGW;
        if (it2 < Items::TOTAL) { db = I(it2); tr_load(db, lane, rb); }
        tr_store(da, scr, lane, ra);
        it = it2; if (it >= Items::TOTAL) break;
        it2 = it + NGW;
        if (it2 < Items::TOTAL) { da = I(it2); tr_load(da, lane, ra); }
        tr_store(db, scr, lane, rb);
        it = it2; if (it >= Items::TOTAL) break;
    }
}
__device__ __forceinline__ void norm_row(const float* __restrict__ xr, const float* __restrict__ g, bf16_t* __restrict__ hr, int lane) {
    f32x4 v[4]; float ss = 0.f;
#pragma unroll
    for (int i = 0; i < 4; ++i) { v[i] = *(const f32x4*)(xr + (i * 64 + lane) * 4); ss += (v[i][0] * v[i][0] + v[i][1] * v[i][1]) + (v[i][2] * v[i][2] + v[i][3] * v[i][3]); }
    ss = wave_sum(ss);
    const float rstd = rsqrtf(ss * (1.0f / DM) + RMS_EPS);
#pragma unroll
    for (int i = 0; i < 4; ++i) {
        const f32x4 gv = *(const f32x4*)(g + (i * 64 + lane) * 4);
        u32x2 w; w.x = pack2(v[i][0] * rstd * gv[0], v[i][1] * rstd * gv[1]); w.y = pack2(v[i][2] * rstd * gv[2], v[i][3] * rstd * gv[3]);
        *(u32x2*)(hr + (i * 64 + lane) * 4) = w;
    }
}
typedef const __attribute__((address_space(4))) float* cfp;
typedef const __attribute__((address_space(4))) f32x2* cf2p;
__device__ __forceinline__ void unpack8(const u32x4 v, float (&f)[8]) { f[0] = bflo(v.x); f[1] = bfhi(v.x); f[2] = bflo(v.y); f[3] = bfhi(v.y); f[4] = bflo(v.z); f[5] = bfhi(v.z); f[6] = bflo(v.w); f[7] = bfhi(v.w); }
template <int W>
__device__ __forceinline__ void pool_path(const u32x4 (&r)[23], int pos0, bf16_t* __restrict__ pl, size_t t0, int c0) {
    float sum[8] = {0.f, 0.f, 0.f, 0.f, 0.f, 0.f, 0.f, 0.f}, f[8];
#pragma unroll
    for (int j = 1; j < W; ++j) { unpack8(r[15 - j], f);
#pragma unroll
        for (int c = 0; c < 8; ++c) sum[c] += f[c]; }
#pragma unroll
    for (int i = 0; i < 8; ++i) {
        float u[8]; unpack8(r[15 + i], u);
        if (i > 0) { unpack8(r[15 + i - W], f);
#pragma unroll
            for (int c = 0; c < 8; ++c) sum[c] -= f[c]; }
#pragma unroll
        for (int c = 0; c < 8; ++c) sum[c] += u[c];
        const float ic = 1.0f / (float)min(pos0 + i + 1, W);
        u32x4 o; o.x = pack2(sum[0] * ic - u[0], sum[1] * ic - u[1]); o.y = pack2(sum[2] * ic - u[2], sum[3] * ic - u[3]);
        o.z = pack2(sum[4] * ic - u[4], sum[5] * ic - u[5]); o.w = pack2(sum[6] * ic - u[6], sum[7] * ic - u[7]);
        *(u32x4*)(pl + (t0 + i) * PW + c0) = o;
    }
}
__device__ __forceinline__ int scan32_excl(int v, int lane, int& total) {
    int inc = v;
#pragma unroll
    for (int o = 1; o < 32; o <<= 1) { const int t = __shfl_up(inc, o, 32); if ((lane & 31) >= o) inc += t; }
    total = __shfl(inc, 31, 32);
    return inc - v;
}
__device__ __forceinline__ void build_moe_tables(LAS int* L, const unsigned* cnt) {
    { unsigned a_ = (unsigned)(size_t)L; asm volatile("" : "+s"(a_)); L = (LAS int*)(size_t)a_; }
    const int tid = opaque_tid();
    if (tid < 64) {
        const int lane = tid, e = lane & 31;
        const int c = (int)__hip_atomic_load(cnt + e * 64, __ATOMIC_RELAXED, __HIP_MEMORY_SCOPE_AGENT);
        const int nt = (c + 255) >> 8, lastv = c - 256 * (nt - 1);
        const int lt = (nt > 0 && lastv <= 128) ? 1 : 0, hv = nt - lt;
        int Tt, Th, Tl;
        const int tbx = scan32_excl(nt, lane, Tt), hx = scan32_excl(hv, lane, Th), lx = scan32_excl(lt, lane, Tl);
        if (lane < 32) {
            L[LI_TB + e] = tbx; L[LI_PS + e] = tbx * 256; L[LI_CN + e] = c;
            for (int j = 0; j < hv; ++j) L[LI_ORD + hx + j] = (e << 8) | j;
            if (lt) L[LI_ORD + Th + lx] = (e << 8) | (nt - 1);
            if (lane == 31) { L[LI_TB + NEXP] = Tt; L[LI_PS + NEXP] = Tt * 256; L[LI_NT] = Tt; }
        }
    }
    __syncthreads();
}

struct Args { const float* in[18]; float* out; unsigned char* ws; int ph_lo, ph_hi; };
typedef const __attribute__((address_space(4))) Args* CArgsP;
__device__ __forceinline__ CArgsP kargs() { unsigned long long p = (unsigned long long)__builtin_amdgcn_kernarg_segment_ptr(); asm volatile("" : "+s"(p)); return (CArgsP)p; }
#define PHASE_PTRS \
    const int G = opaque_s(G0), bx = opaque_s(bx0), vcu = opaque_s(vcu0), NGW = G * NWAVES; (void)bx; (void)vcu; (void)NGW; \
    const CArgsP ka = kargs(); unsigned char* const ws = ka->ws; \
    unsigned* const ctrl = (unsigned*)(ws + OFF_CTRL); const float* const x_in = ka->in[0]; \
    bf16_t* const WinT = (bf16_t*)(ws + OFF_WIN); bf16_t* const WaT = (bf16_t*)(ws + OFF_WA); bf16_t* const WppT = (bf16_t*)(ws + OFF_WPP); bf16_t* const WoT = (bf16_t*)(ws + OFF_WO); \
    bf16_t* const WguT = (bf16_t*)(ws + OFF_WGU); bf16_t* const WdT = (bf16_t*)(ws + OFF_WD); \
    bf16_t* const Hb = (bf16_t*)(ws + OFF_H); bf16_t* const MG = Hb; bf16_t* const PROJ = (bf16_t*)(ws + OFF_PROJ); bf16_t* const ACT = (bf16_t*)(ws + OFF_ACT); bf16_t* const YB = (bf16_t*)(ws + OFF_YB); \
    bf16_t* const AC = (bf16_t*)(ws + OFF_AC); bf16_t* const PL = (bf16_t*)(ws + OFF_PL); bf16_t* const OG = (bf16_t*)(ws + OFF_OG); bf16_t* const T1 = (bf16_t*)(ws + OFF_T1); \
    f32x2* const ML = (f32x2*)(ws + OFF_ML); float* const XB = (float*)(ws + OFF_XB); int* const tokE = (int*)(ws + OFF_TOKE); float* const tokW = (float*)(ws + OFF_TOKW); int* const asg = (int*)(ws + OFF_ASG); \
    (void)ctrl; (void)x_in; (void)WinT; (void)WaT; (void)WppT; (void)WoT; (void)WguT; (void)WdT; (void)Hb; (void)MG; (void)PROJ; (void)ACT; (void)YB; (void)AC; (void)PL; (void)OG; (void)T1; (void)ML; (void)XB; (void)tokE; (void)tokW; (void)asg
#define LAYER_PTRS PHASE_PTRS; const int tid = opaque_tid(), lane = tid & 63, wid = __builtin_amdgcn_readfirstlane(tid >> 6), gw = vcu * NWAVES + wid; (void)lane; (void)gw; const float* const xin = (l == 0) ? x_in : XB; unsigned* const cnt = ctrl + CW_CNT + l * 2048; (void)xin; (void)cnt

#ifndef PHASE_MASK
#define PHASE_MASK 0x3ff
#endif
#define EN(j) (((PHASE_MASK) >> (j)) & 1)
#ifndef REP_MASK
#define REP_MASK 0
#endif
#define REPS(j) (1 + (((REP_MASK) >> (j)) & 1))
#define IN(k) (MK_N_LAUNCHES == 1 || (lo <= (k) && (k) < hi))
#ifndef PROBE_A
#define PROBE_A -1
#define PROBE_B -1
#endif
#define STAMP_BEGIN(k) do { if (PROBE_A == (k)) ts0 = __builtin_amdgcn_s_memrealtime(); } while (0)
#define SEAM(k) do { if (IN(k) && IN((k) + 1)) { XcdBarrier b2_ = bar; unsigned long long p_ = (unsigned long long)b2_.bar; asm volatile("" : "+s"(p_)); b2_.bar = (unsigned*)p_; xcd_barrier(b2_); } if (PROBE_B == (k)) ts1 = __builtin_amdgcn_s_memrealtime(); } while (0)

template <int l>
__device__ __forceinline__ void layer_body(const XcdBarrier& bar, LAS unsigned char* lds, LAS int* LC, const int G0, const int bx0, const int vcu0, const int lo, const int hi, unsigned long long& ts0, unsigned long long& ts1) {
        const int pb = 1 + 9 * l;
        STAMP_BEGIN(pb + 0);
        for (int rep = 0; rep < REPS(0); ++rep) if (EN(0) && IN(pb + 0)) {
            asm volatile("; PHASE_MARK 0");
            LAYER_PTRS;
            pg8::DenseOrder S; S.init(Hb, WinT + (size_t)l * INW * DM, NTOK, INW, DM, G, bx);
            pg8::EpiProj E{PROJ, ka->in[3] + (size_t)l * HD, ka->in[4] + (size_t)l * HD};
            pg8::gemm_phase<pg8::EpiProj, pg8::DenseOrder, 1, false>(lds, DM, S, E);
        }
        SEAM(pb + 0);
        STAMP_BEGIN(pb + 1);
        for (int rep = 0; rep < REPS(1); ++rep) if (EN(1) && IN(pb + 1)) {
            asm volatile("; PHASE_MARK 1");
            LAYER_PTRS;
            int u = vcu;
            if (u < 1536) {
                AttnU cu = attn_decode(u), nu = cu;
                u32x4 kr[6], vr[6]; bf16x8 qf[4];
                attn_load(cu, PROJ, tid, kr, vr);
                for (;;) {
                    attn_load_q(cu, PROJ, wid, lane, qf);
                    attn_lds_store(cu, lds, tid, kr, vr);
                    __syncthreads();
                    const int un = u + G; const bool hn = un < 1536;
                    if (hn) { nu = attn_decode(un); attn_load(nu, PROJ, tid, kr, vr); }
                    attn_compute(cu, lds, qf, OG, ML, wid, lane);
                    if (!hn) break;
                    cu = nu; u = un;
                }
            }
        }
        SEAM(pb + 1);
        STAMP_BEGIN(pb + 2);
        for (int rep = 0; rep < REPS(2); ++rep) if (EN(2) && IN(pb + 2)) {
            asm volatile("; PHASE_MARK 2");
            LAYER_PTRS;
            for (int grp = gw; grp < NTOK / 8; grp += NGW) {
                const size_t t0 = (size_t)grp * 8; const int c0 = 8 * lane, hh = lane >> 3;
                {
                    f32x2 sm[8][3]; u32x4 v[8][3];
#pragma unroll
                    for (int i = 0; i < 8; ++i)
#pragma unroll
                        for (int g = 0; g < 3; ++g) { sm[i][g] = ML[((size_t)g * NTOK + t0 + i) * 8 + hh]; v[i][g] = *(const u32x4*)(OG + ((size_t)g * NTOK + t0 + i) * AW + c0); }
#pragma unroll
                    for (int i = 0; i < 8; ++i) {
                        const float M = fmaxf(fmaxf(sm[i][0][0], sm[i][1][0]), sm[i][2][0]);
                        float w[3], W = 0.f;
#pragma unroll
                        for (int g = 0; g < 3; ++g) { w[g] = sm[i][g][1] * __expf(sm[i][g][0] - M); W += w[g]; }
                        const float iw = 1.0f / W;
                        float o[8] = {0.f, 0.f, 0.f, 0.f, 0.f, 0.f, 0.f, 0.f}, f[8];
#pragma unroll
                        for (int g = 0; g < 3; ++g) { unpack8(v[i][g], f); const float q = w[g] * iw;
#pragma unroll
                            for (int c = 0; c < 8; ++c) o[c] += q * f[c]; }
                        u32x4 ow; ow.x = pack2(o[0], o[1]); ow.y = pack2(o[2], o[3]); ow.z = pack2(o[4], o[5]); ow.w = pack2(o[6], o[7]);
                        *(u32x4*)(AC + (t0 + i) * AW + c0) = ow;
                    }
                }
                {
                    const int pos0 = (int)(t0 & (SEQ - 1)), g4 = lane >> 4, wnd = 2 << g4;
                    u32x4 r[23];
#pragma unroll
                    for (int k = 0; k < 23; ++k) { const bool need = (k >= 16 - wnd) && (pos0 - 15 + k >= 0);
                        r[k] = need ? *(const u32x4*)(PROJ + (t0 - 15 + k) * INW + 3 * AW + c0) : (u32x4){0u, 0u, 0u, 0u}; }
                    if (g4 == 0) pool_path<2>(r, pos0, PL, t0, c0);
                    else if (g4 == 1) pool_path<4>(r, pos0, PL, t0, c0);
                    else if (g4 == 2) pool_path<8>(r, pos0, PL, t0, c0);
                    else pool_path<16>(r, pos0, PL, t0, c0);
                }
            }
        }
        SEAM(pb + 2);
        STAMP_BEGIN(pb + 3);
        for (int rep = 0; rep < REPS(3); ++rep) if (EN(3) && IN(pb + 3)) {
            asm volatile("; PHASE_MARK 3");
            LAYER_PTRS;
            { pg8::DenseOrder S; S.init(AC, WaT + (size_t)l * DM * AW, NTOK, DM, AW, G, bx);
              pg8::EpiGate<0> E{PROJ + 2048, nullptr, T1};
              pg8::gemm_phase<pg8::EpiGate<0>, pg8::DenseOrder, 0, false>(lds, AW, S, E); }
            { pg8::DenseOrder S; S.init(PL, WppT + (size_t)l * DM * PW, NTOK, DM, PW, G, bx);
              pg8::EpiGate<1> E{PROJ + 3072, T1, MG};
              pg8::gemm_phase<pg8::EpiGate<1>, pg8::DenseOrder, 0, false>(lds, PW, S, E); }
        }
        SEAM(pb + 3);
        STAMP_BEGIN(pb + 4);
        if (EN(4) && IN(pb + 4)) {
            asm volatile("; PHASE_MARK 4");
            LAYER_PTRS;
            pg8::DenseOrder S; S.init(MG, WoT + (size_t)l * DM * DM, NTOK, DM, DM, G, bx);
            pg8::EpiResid E{xin, XB};
            pg8::gemm_phase<pg8::EpiResid, pg8::DenseOrder, 0, false>(lds, DM, S, E);
        }
        SEAM(pb + 4);
        STAMP_BEGIN(pb + 5);
        if (EN(5) && IN(pb + 5)) {
            asm volatile("; PHASE_MARK 5");
            LAYER_PTRS;
            LAS float* part = (LAS float*)lds;
            LAS float* lg = (LAS float*)(lds + 100352);
            LAS int* aE = (LAS int*)(lds + 110592); LAS float* aW = (LAS float*)(lds + 110592 + 512); LAS int* bs = (LAS int*)(lds + 110592 + 1024); LAS float* rs = (LAS float*)(lds + 110592 + 1536);
            const float* g2 = ka->in[10] + (size_t)l * DM; const float* brg = ka->in[12] + (size_t)l * 4; const float* bre = ka->in[14] + (size_t)l * 32;
            const bf16_t* Wh = (const bf16_t*)(ws + OFF_WRH) + (size_t)l * 48 * DM; const bf16_t* Wl = (const bf16_t*)(ws + OFF_WRL) + (size_t)l * 48 * DM;
            for (int chunk = bx; chunk < NTOK / 64; chunk += G) {
                {
                    const int fr = lane & 15, fq = lane >> 4;
                    f32x4 acc[4][3]; float ssl[4] = {0.f, 0.f, 0.f, 0.f};
#pragma unroll
                    for (int mt = 0; mt < 4; ++mt)
#pragma unroll
                        for (int nt = 0; nt < 3; ++nt) acc[mt][nt] = (f32x4){0.f, 0.f, 0.f, 0.f};
#pragma unroll 1
                    for (int ks = 0; ks < 4; ++ks) {
                        const int d0 = 128 * wid + 32 * ks + 8 * fq;
                        bf16x8 bh[3], bl[3];
#pragma unroll
                        for (int nt = 0; nt < 3; ++nt) { bh[nt] = *(const bf16x8*)(Wh + (size_t)(16 * nt + fr) * DM + d0); bl[nt] = *(const bf16x8*)(Wl + (size_t)(16 * nt + fr) * DM + d0); }
#pragma unroll
                        for (int mt = 0; mt < 4; ++mt) {
                            const float* xp = XB + (size_t)(chunk * 64 + 16 * mt + fr) * DM + d0;
                            const f32x4 x0 = *(const f32x4*)xp, x1 = *(const f32x4*)(xp + 4);
                            ssl[mt] += (x0[0] * x0[0] + x0[1] * x0[1]) + (x0[2] * x0[2] + x0[3] * x0[3]) + (x1[0] * x1[0] + x1[1] * x1[1]) + (x1[2] * x1[2] + x1[3] * x1[3]);
                            u32x4 hw; hw.x = pack2(x0[0], x0[1]); hw.y = pack2(x0[2], x0[3]); hw.z = pack2(x1[0], x1[1]); hw.w = pack2(x1[2], x1[3]);
                            u32x4 lw; lw.x = pack2(x0[0] - bflo(hw.x), x0[1] - bfhi(hw.x)); lw.y = pack2(x0[2] - bflo(hw.y), x0[3] - bfhi(hw.y));
                            lw.z = pack2(x1[0] - bflo(hw.z), x1[1] - bfhi(hw.z)); lw.w = pack2(x1[2] - bflo(hw.w), x1[3] - bfhi(hw.w));
                            const bf16x8 ah = __builtin_bit_cast(bf16x8, hw), al = __builtin_bit_cast(bf16x8, lw);
#pragma unroll
                            for (int nt = 0; nt < 3; ++nt) {
                                acc[mt][nt] = __builtin_amdgcn_mfma_f32_16x16x32_bf16(ah, bh[nt], acc[mt][nt], 0, 0, 0);
                                acc[mt][nt] = __builtin_amdgcn_mfma_f32_16x16x32_bf16(al, bh[nt], acc[mt][nt], 0, 0, 0);
                                acc[mt][nt] = __builtin_amdgcn_mfma_f32_16x16x32_bf16(ah, bl[nt], acc[mt][nt], 0, 0, 0);
                            }
                        }
                        asm volatile("" ::: "memory");
                    }
#pragma unroll
                    for (int mt = 0; mt < 4; ++mt) {
#pragma unroll
                        for (int nt = 0; nt < 3; ++nt) *(LAS f32x4*)(part + (wid * 49 + 16 * nt + fr) * 64 + 16 * mt + 4 * fq) = acc[mt][nt];
                        float sq = ssl[mt]; sq += __shfl_xor(sq, 16); sq += __shfl_xor(sq, 32);
                        if (fq == 0) part[(wid * 49 + 48) * 64 + 16 * mt + fr] = sq;
                    }
                }
                __syncthreads();
                for (int o = tid >> 6; o < 37; o += 8) { float sum = 0.f; const int po = (o == 36) ? 48 : o;
#pragma unroll
                    for (int w = 0; w < 8; ++w) sum += part[(w * 49 + po) * 64 + lane];
                    lg[o * 64 + lane] = sum; }
                __syncthreads();
                if (tid < 64) {
                    const float rstd = rsqrtf(lg[36 * 64 + tid] * (1.0f / DM) + RMS_EPS); rs[tid] = rstd;
                    float gl[4];
#pragma unroll
                    for (int o = 0; o < 4; ++o) gl[o] = lg[o * 64 + tid] * rstd + brg[o];
                    int gs = 0; float gm = gl[0];
#pragma unroll
                    for (int o = 1; o < 4; ++o) if (gl[o] > gm) { gm = gl[o]; gs = o; }
                    float gden = 0.f;
#pragma unroll
                    for (int o = 0; o < 4; ++o) gden += __expf(gl[o] - gm);
                    const float ggate = 1.0f / gden;
                    float el[8];
#pragma unroll
                    for (int o = 0; o < 8; ++o) el[o] = lg[(4 + 8 * gs + o) * 64 + tid] * rstd + bre[gs * 8 + o];
                    int i0 = 0; float m0 = el[0];
#pragma unroll
                    for (int o = 1; o < 8; ++o) if (el[o] > m0) { m0 = el[o]; i0 = o; }
                    int i1 = 0; float m1 = -3.0e38f;
#pragma unroll
                    for (int o = 0; o < 8; ++o) if (o != i0 && el[o] > m1) { m1 = el[o]; i1 = o; }
                    const float e1 = __expf(m1 - m0);
                    aE[2 * tid] = gs * 8 + i0; aE[2 * tid + 1] = gs * 8 + i1; aW[2 * tid] = ggate / (1.0f + e1); aW[2 * tid + 1] = ggate * e1 / (1.0f + e1);
                }
                __syncthreads();
                int myE = 0, rank = 0;
                if (tid < 128) { myE = aE[tid]; for (int a = 0; a < tid; ++a) rank += (aE[a] == myE) ? 1 : 0; }
                if (tid < NEXP) { int c = 0; for (int a = 0; a < 128; ++a) c += (aE[a] == tid) ? 1 : 0;
                    bs[tid] = c ? (int)__hip_atomic_fetch_add(cnt + tid * 64, (unsigned)c, __ATOMIC_RELAXED, __HIP_MEMORY_SCOPE_AGENT) : 0; }
#pragma unroll 2
                for (int it = 0; it < 8; ++it) {
                    const int ti = wid * 8 + it; const size_t tok = (size_t)chunk * 64 + ti; const float rstd = rs[ti];
#pragma unroll
                    for (int i = 0; i < 4; ++i) { const int d0 = (i * 64 + lane) * 4; const f32x4 xv = *(const f32x4*)(XB + tok * DM + d0), gv = *(const f32x4*)(g2 + d0);
                        u32x2 w; w.x = pack2(xv[0] * rstd * gv[0], xv[1] * rstd * gv[1]); w.y = pack2(xv[2] * rstd * gv[2], xv[3] * rstd * gv[3]);
                        *(u32x2*)(Hb + tok * DM + d0) = w; }
                }
                __syncthreads();
                if (tid < 128) { const int slot = bs[myE] + rank, tok = chunk * 64 + (tid >> 1);
                    tokE[(size_t)myE * ECAP + slot] = tok; tokW[(size_t)myE * ECAP + slot] = aW[tid]; asg[tok * 2 + (tid & 1)] = myE * ECAP + slot; }
                __syncthreads();
            }
        }
        SEAM(pb + 5);
        STAMP_BEGIN(pb + 6);
        for (int rep = 0; rep < REPS(6); ++rep) if (EN(6) && IN(pb + 6)) {
            asm volatile("; PHASE_MARK 6");
            LAYER_PTRS;
            build_moe_tables(LC, cnt);
            pg8::MoeOrder S{(const char*)Hb, (const char*)WguT, (size_t)DM * DM * 2, DM, LC + LI_TB, LC + LI_PS, LC + LI_CN, LC + LI_ORD, tokE, G, vcu, true};
            pg8::EpiSwiGLU E{ACT};
            pg8::gemm_phase<pg8::EpiSwiGLU, pg8::MoeOrder, 0, true, true>(lds, DM, S, E);
        }
        SEAM(pb + 6);
        STAMP_BEGIN(pb + 7);
        for (int rep = 0; rep < REPS(7); ++rep) if (EN(7) && IN(pb + 7)) {
            asm volatile("; PHASE_MARK 7");
            LAYER_PTRS;
            build_moe_tables(LC, cnt);
            pg8::MoeOrder S{(const char*)ACT, (const char*)WdT, (size_t)DM * EH * 2, EH, LC + LI_TB, LC + LI_PS, LC + LI_CN, LC + LI_ORD, tokE, G, vcu, false};
            pg8::EpiDown E{YB, tokW};
            pg8::gemm_phase<pg8::EpiDown, pg8::MoeOrder, 0, false, true>(lds, EH, S, E);
        }
        SEAM(pb + 7);
        STAMP_BEGIN(pb + 8);
        if (EN(8) && IN(pb + 8)) {
            asm volatile("; PHASE_MARK 8");
            LAYER_PTRS;
            build_moe_tables(LC, cnt);
            const bool lastl = (l == DEPTH - 1);
            const float* g1n = ka->in[1] + (size_t)(lastl ? 0 : (l + 1)) * DM;
            float* const xo = lastl ? ka->out : XB;
            for (int grp = gw; grp < NTOK / 4; grp += NGW) {
                const size_t t0 = (size_t)grp * 4;
                const int myasg = (lane < 8) ? asg[t0 * 2 + lane] : 0;
                f32x4 xv[4][4]; u32x2 ya[4][4], yb[4][4];
#pragma unroll
                for (int q = 0; q < 4; ++q) {
                    const int i0 = __builtin_amdgcn_readlane(myasg, 2 * q), i1 = __builtin_amdgcn_readlane(myasg, 2 * q + 1);
                    const size_t s0 = (size_t)(LC[LI_PS + (i0 >> 14)] + (i0 & (ECAP - 1))), s1 = (size_t)(LC[LI_PS + (i1 >> 14)] + (i1 & (ECAP - 1)));
#pragma unroll
                    for (int i = 0; i < 4; ++i) { const int d0 = (i * 64 + lane) * 4;
                        xv[q][i] = *(const f32x4*)(XB + (t0 + q) * DM + d0); ya[q][i] = *(const u32x2*)(YB + s0 * DM + d0); yb[q][i] = *(const u32x2*)(YB + s1 * DM + d0); }
                }
#pragma unroll
                for (int q = 0; q < 4; ++q) {
                    f32x4 v[4]; float ss = 0.f;
#pragma unroll
                    for (int i = 0; i < 4; ++i) { const int d0 = (i * 64 + lane) * 4; const u32x2 a = ya[q][i], b = yb[q][i]; const f32x4 x4 = xv[q][i];
                        v[i][0] = x4[0] + bflo(a.x) + bflo(b.x); v[i][1] = x4[1] + bfhi(a.x) + bfhi(b.x); v[i][2] = x4[2] + bflo(a.y) + bflo(b.y); v[i][3] = x4[3] + bfhi(a.y) + bfhi(b.y);
                        ss += (v[i][0] * v[i][0] + v[i][1] * v[i][1]) + (v[i][2] * v[i][2] + v[i][3] * v[i][3]);
                        *(f32x4*)(xo + (t0 + q) * DM + d0) = v[i]; }
                    if (!lastl) {
                        ss = wave_sum(ss);
                        const float rstd = rsqrtf(ss * (1.0f / DM) + RMS_EPS);
#pragma unroll
                        for (int i = 0; i < 4; ++i) { const int d0 = (i * 64 + lane) * 4; const f32x4 gv = *(const f32x4*)(g1n + d0);
                            u32x2 w; w.x = pack2(v[i][0] * rstd * gv[0], v[i][1] * rstd * gv[1]); w.y = pack2(v[i][2] * rstd * gv[2], v[i][3] * rstd * gv[3]);
                            *(u32x2*)(Hb + (t0 + q) * DM + d0) = w; }
                    }
                }
            }
            if (!lastl) {
                __syncthreads();
                ExpertItems I{ka->in[15] + (size_t)(l + 1) * NEXP * DM * EH, ka->in[16] + (size_t)(l + 1) * NEXP * DM * EH, ka->in[17] + (size_t)(l + 1) * NEXP * EH * DM, WguT, WdT};
                convert_items(I, (LAS float*)(lds + wid * 8704), lane, gw, NGW);
            }
        }
        if (l + 1 < DEPTH) SEAM(pb + 8); else if (PROBE_B == pb + 8) ts1 = __builtin_amdgcn_s_memrealtime();
    }

__global__ void __launch_bounds__(NTHREADS, 2) fwd_kernel(Args args) {
    extern __shared__ __attribute__((aligned(16))) unsigned char lds_raw[];
    LAS unsigned char* lds = (LAS unsigned char*)lds_raw;
    LAS int* LC = (LAS int*)(lds + LCTL_OFF);
    const int G0 = gridDim.x, bx0 = blockIdx.x;
    const int vcu0 = (G0 % 8 == 0) ? (bx0 % 8) * (G0 / 8) + bx0 / 8 : bx0;
    if (threadIdx.x < 4) LC[LI_BAR + threadIdx.x] = 0;
    __syncthreads();
    XcdBarrier bar; bar.bar = (unsigned*)(args.ws + OFF_CTRL) + CW_BAR; bar.x = 0; bar.st = nullptr;
    if (MK_N_LAUNCHES == 1) bar = xcd_barrier_post(bar.bar, (volatile LAS unsigned*)(LC + LI_BAR));
    const int lo = args.ph_lo, hi = args.ph_hi;
    unsigned long long ts0 = 0ull, ts1 = 0ull;
    STAMP_BEGIN(0);
    for (int rep = 0; rep < REPS(9); ++rep) if (EN(9) && IN(0)) {
        asm volatile("; PHASE_MARK 9");
        PHASE_PTRS; const int tid = opaque_tid(), lane = tid & 63, wid = __builtin_amdgcn_readfirstlane(tid >> 6), gw = vcu * NWAVES + wid;
        LAS float* scr = (LAS float*)(lds + wid * 8704);
        { SmallItems I{ka->in[2], ka->in[5], ka->in[9], WinT, WaT, WoT}; convert_items(I, scr, lane, gw, NGW); }
        for (int o = gw; o < DEPTH * (DM / 64) * (PW / 8); o += NGW) {
            const int l = o / ((DM / 64) * (PW / 8)), r = o % ((DM / 64) * (PW / 8)), kb = r / (DM / 64), n = (r % (DM / 64)) * 64 + lane, k0 = kb * 8, g = k0 >> 7;
            const cfp wm = (cfp)(unsigned long long)(ka->in[6] + (size_t)l * 4 * 128 * 128 + (size_t)k0 * 128);
            const cfp sc = (cfp)(unsigned long long)(ka->in[7] + (size_t)l * PW + g * 128);
            const float* wp = ka->in[8] + (size_t)l * PW * DM + (size_t)(g * 128) * DM + n;
            float a[8] = {0.f, 0.f, 0.f, 0.f, 0.f, 0.f, 0.f, 0.f};
#pragma unroll 8
            for (int dd = 0; dd < 128; ++dd) { const float w = wp[(size_t)dd * DM] * sc[dd];
#pragma unroll
                for (int c = 0; c < 8; ++c) a[c] += w * wm[c * 128 + dd]; }
            u32x4 ow; ow.x = pack2(a[0], a[1]); ow.y = pack2(a[2], a[3]); ow.z = pack2(a[4], a[5]); ow.w = pack2(a[6], a[7]);
            *(u32x4*)(WppT + (size_t)l * DM * PW + (size_t)n * PW + k0) = ow;
        }
        for (int o = bx * NTHREADS + tid; o < DEPTH * 48 * DM; o += G * NTHREADS) {
            const int l = o / (48 * DM), r = o % (48 * DM), oo = r / DM, d = r % DM;
            float w = 0.f;
            if (oo < 4) w = ka->in[11][(size_t)l * DM * 4 + (size_t)d * 4 + oo];
            else if (oo < 36) w = ka->in[13][(size_t)l * 4 * DM * 8 + ((size_t)((oo - 4) >> 3) * DM + d) * 8 + ((oo - 4) & 7)];
            w *= ka->in[10][(size_t)l * DM + d];
            const bf16_t hi = f2bf(w); const float hf = __uint_as_float((unsigned)hi << 16);
            ((bf16_t*)(ws + OFF_WRH))[o] = hi; ((bf16_t*)(ws + OFF_WRL))[o] = f2bf(w - hf);
        }
        { ExpertItems I{ka->in[15], ka->in[16], ka->in[17], WguT, WdT}; convert_items(I, scr, lane, gw, NGW); }
        for (int m = gw; m < NTOK; m += NGW) norm_row(x_in + (size_t)m * DM, ka->in[1], Hb + (size_t)m * DM, lane);
    }
    SEAM(0);

    layer_body<0>(bar, lds, LC, G0, bx0, vcu0, lo, hi, ts0, ts1);
    layer_body<1>(bar, lds, LC, G0, bx0, vcu0, lo, hi, ts0, ts1);
    if (PROBE_A >= 0 && blockIdx.x == 0) { const unsigned long long d = (ts1 - ts0) * 4ull, t0 = __builtin_amdgcn_s_memrealtime(); while (__builtin_amdgcn_s_memrealtime() - t0 < d) __builtin_amdgcn_s_sleep(8); }
#undef IN
#undef SEAM
}

extern "C" void kernel_launch(void* const* d_in, const int* in_sizes, int n_in, void* d_out, int out_size, void* d_ws, size_t ws_size, hipStream_t stream) {
    (void)in_sizes; (void)out_size;
    static int grid = 0;
    if (grid == 0) {
        int dev = 0, cus = 0;
        if (hipGetDevice(&dev) != hipSuccess || hipDeviceGetAttribute(&cus, hipDeviceAttributeMultiprocessorCount, dev) != hipSuccess) { grid = -1; return; }
        if (hipFuncSetAttribute((const void*)fwd_kernel, hipFuncAttributeMaxDynamicSharedMemorySize, LDS_BYTES) != hipSuccess) { grid = -1; return; }
        int per_cu = 0;
        (void)hipOccupancyMaxActiveBlocksPerMultiprocessor(&per_cu, (const void*)fwd_kernel, NTHREADS, LDS_BYTES);
        (void)hipGetLastError();
        grid = cus;
        if (n_in != 18 || ws_size < WS_NEED) { fprintf(stderr, "kernel_launch: unexpected inputs (n_in %d, ws %zu)\n", n_in, ws_size); grid = -1; return; }
    }
    if (grid < 0) return;
    (void)hipMemsetAsync((char*)d_ws + OFF_CTRL, 0, CTRL_BYTES, stream);
    Args a{};
    for (int i = 0; i < 18; ++i) a.in[i] = (const float*)d_in[i];
    a.out = (float*)d_out; a.ws = (unsigned char*)d_ws;
    constexpr int NPH = 1 + 9 * DEPTH;
    if (MK_N_LAUNCHES == 1) { a.ph_lo = 0; a.ph_hi = NPH; hipLaunchKernelGGL(fwd_kernel, dim3(grid), dim3(NTHREADS), LDS_BYTES, stream, a); }
    else { for (int p = 0; p < NPH; ++p) { a.ph_lo = p; a.ph_hi = p + 1; hipLaunchKernelGGL(fwd_kernel, dim3(grid), dim3(NTHREADS), LDS_BYTES, stream, a); } }
}
```

```cpp
#include <hip/hip_runtime.h>
#include <stdint.h>
#include <stdio.h>

#define LAS __attribute__((address_space(3)))
typedef unsigned short bf16_t;
typedef short bf16x8 __attribute__((ext_vector_type(8)));
typedef float f32x2 __attribute__((ext_vector_type(2)));
typedef float f32x4 __attribute__((ext_vector_type(4)));
typedef float f32x16 __attribute__((ext_vector_type(16)));
typedef unsigned u32x2 __attribute__((ext_vector_type(2)));
typedef unsigned u32x4 __attribute__((ext_vector_type(4)));
typedef __bf16 bfv2 __attribute__((ext_vector_type(2)));

#ifndef MK_N_LAUNCHES
#define MK_N_LAUNCHES 1
#endif

constexpr int DM = 1024, SEQ = 4096, NTOK = 16384, DEPTH = 2;
constexpr int HD = 64, AW = 512, PW = 512, INW = 4096;
constexpr int NEXP = 32, EH = 512, ECAP = NTOK;
constexpr float RMS_EPS = 1e-6f;
constexpr int NTHREADS = 512, NWAVES = 8;

constexpr size_t MB = 1024 * 1024;
constexpr size_t OFF_CTRL = 0, CTRL_BYTES = 65536;
constexpr size_t OFF_WIN  = 1 * MB;
constexpr size_t OFF_WA   = OFF_WIN + 16 * MB;
constexpr size_t OFF_WPP  = OFF_WA + 2 * MB;
constexpr size_t OFF_WO   = OFF_WPP + 2 * MB;
constexpr size_t OFF_WGU  = OFF_WO + 4 * MB;
constexpr size_t OFF_WD   = OFF_WGU + 64 * MB;
constexpr size_t OFF_H    = OFF_WD + 32 * MB;
constexpr size_t OFF_PROJ = OFF_H + 32 * MB;
constexpr size_t OFF_ACT  = OFF_PROJ;
constexpr size_t OFF_YB   = OFF_PROJ + 40 * MB;
constexpr size_t OFF_AC   = OFF_PROJ + 128 * MB;
constexpr size_t OFF_PL   = OFF_AC + 16 * MB;
constexpr size_t OFF_OG   = OFF_PL + 16 * MB;
constexpr size_t OFF_T1   = OFF_OG;
constexpr size_t OFF_ML   = OFF_OG + 48 * MB;
constexpr size_t OFF_XB   = OFF_ML + 4 * MB;
constexpr size_t OFF_TOKE = OFF_XB + 64 * MB;
constexpr size_t OFF_TOKW = OFF_TOKE + 2 * MB;
constexpr size_t OFF_ASG  = OFF_TOKW + 2 * MB;
constexpr size_t OFF_WRH  = OFF_ASG + 1 * MB;
constexpr size_t OFF_WRL  = OFF_WRH + 256 * 1024;
constexpr size_t WS_NEED  = OFF_WRL + 256 * 1024;
constexpr int CW_CNT = 1024;
constexpr int CW_BAR = 8192;
constexpr int RING_BYTES = 131072, LCTL_OFF = RING_BYTES, LDS_BYTES = RING_BYTES + 2048;
constexpr int LI_BAR = 0, LI_TB = 16, LI_PS = 64, LI_CN = 112, LI_NT = 15, LI_ORD = 144;

__device__ __forceinline__ float bflo(unsigned w) { return __uint_as_float(w << 16); }
__device__ __forceinline__ float bfhi(unsigned w) { return __uint_as_float(w & 0xffff0000u); }
__device__ __forceinline__ unsigned pack2(float lo, float hi) { f32x2 v = {lo, hi}; return __builtin_bit_cast(unsigned, __builtin_convertvector(v, bfv2)); }
__device__ __forceinline__ bf16_t f2bf(float f) { return (bf16_t)(pack2(f, 0.f) & 0xffffu); }
__device__ __forceinline__ float wave_sum(float v) {
#pragma unroll
    for (int o = 32; o >= 1; o >>= 1) v += __shfl_xor(v, o);
    return v;
}
__device__ __forceinline__ int opaque_tid() { int t = (int)threadIdx.x; asm volatile("" : "+v"(t)); return t; }
__device__ __forceinline__ int opaque_s(int v) { asm volatile("" : "+s"(v)); return v; }
__device__ __forceinline__ float sigmoidf_(float v) { return 1.0f / (1.0f + __expf(-v)); }

#define XB_TMO      128
#define XB_XCNT(j)  (256  + 64 * (j))
#define XB_XSUB(j)  (1280 + 64 * (j))
#define XB_XGEN(j)  (2304 + 64 * (j))
#define XB_TOP      3328
#define XB_TOPGEN   3392
#define XCD_BAR_WORDS 3456
#define XB_SPIN_CAP (1u << 18)
__device__ __forceinline__ unsigned xb_ld(unsigned* p)              { return __hip_atomic_load(p, __ATOMIC_RELAXED, __HIP_MEMORY_SCOPE_AGENT); }
__device__ __forceinline__ unsigned xb_add(unsigned* p, unsigned v) { return __hip_atomic_fetch_add(p, v, __ATOMIC_RELAXED, __HIP_MEMORY_SCOPE_AGENT); }
__device__ __forceinline__ unsigned xb_xcc_id() { return (unsigned)__builtin_amdgcn_s_getreg((3 << 11) | 20) & 0xFu; }
#define XB_SPIN(cond, bar) do { unsigned _sp = 0; while (cond) { __builtin_amdgcn_s_sleep(1); \
    if ((++_sp & 255u) == 0u) { if (xb_ld(&(bar)[XB_TMO])) break; if (_sp > XB_SPIN_CAP) { atomicAdd(&(bar)[XB_TMO], 1u); break; } } } } while (0)
struct XcdBarrier { unsigned* bar; unsigned x; volatile LAS unsigned* st; };
__device__ __forceinline__ XcdBarrier xcd_barrier_post(unsigned* bar, volatile LAS unsigned* st) {
    XcdBarrier b; b.bar = bar; b.x = xb_xcc_id(); b.st = st;
    if (threadIdx.x == 0) (void)xb_add(&bar[XB_XCNT(b.x)], 1u);
    return b;
}
__device__ __forceinline__ void xcd_barrier_complete(unsigned* bar, unsigned x, unsigned& nloc, unsigned& nx) {
    const unsigned G = gridDim.x * gridDim.y * gridDim.z;
    unsigned sum, cnt, mine, sp = 0u;
    for (;;) {
        sum = 0u; cnt = 0u; mine = 0u;
#pragma unroll
        for (unsigned j = 0; j < 16; ++j) { const unsigned c = xb_ld(&bar[XB_XCNT(j)]); sum += c; cnt += (c > 0u) ? 1u : 0u; mine = (j == x) ? c : mine; }
        if (sum == G) break;
        __builtin_amdgcn_s_sleep(1);
        if ((++sp & 255u) == 0u) { if (xb_ld(&bar[XB_TMO])) break; if (sp > XB_SPIN_CAP) { atomicAdd(&bar[XB_TMO], 1u); break; } }
    }
    nloc = mine > 0u ? mine : 1u; nx = cnt > 0u ? cnt : 1u;
}
__device__ __forceinline__ void xcd_barrier(const XcdBarrier& b) {
    asm volatile("s_waitcnt vmcnt(0)" ::: "memory");
    __syncthreads();
    if (threadIdx.x == 0) {
        unsigned* bar = b.bar;
        __builtin_amdgcn_s_waitcnt(0);
        unsigned nloc = b.st[0], nx = b.st[1];
        if (nloc == 0u) { xcd_barrier_complete(bar, b.x, nloc, nx); b.st[0] = nloc; b.st[1] = nx; }
        const unsigned old = xb_add(&bar[XB_XSUB(b.x)], 1u);
        const unsigned gen = old / nloc;
        if (old + 1u == (gen + 1u) * nloc) {
            __builtin_amdgcn_fence(__ATOMIC_RELEASE, "agent");
            asm volatile("s_waitcnt vmcnt(0)" ::: "memory");
            const unsigned og = xb_add(&bar[XB_TOP], 1u);
            const unsigned tg = og / nx;
            if (og + 1u == (tg + 1u) * nx) xb_add(&bar[XB_TOPGEN], 1u);
            else XB_SPIN(xb_ld(&bar[XB_TOPGEN]) == tg, bar);
            __builtin_amdgcn_fence(__ATOMIC_ACQUIRE, "agent");
            xb_add(&bar[XB_XGEN(b.x)], 1u);
            asm volatile("s_waitcnt vmcnt(0)" ::: "memory");
        } else {
            XB_SPIN(xb_ld(&bar[XB_XGEN(b.x)]) == gen, bar);
            __builtin_amdgcn_fence(__ATOMIC_ACQUIRE, "agent");
            asm volatile("s_waitcnt vmcnt(0)" ::: "memory");
        }
    }
    __syncthreads();
}

namespace pg8 {
constexpr int BM = 256, BK = 64, HALF = 128, HTB = HALF * BK * 2, NXCD = 8, WGM = 8;
__device__ __forceinline__ int lds_byte(int r, int c) { const int st = (r >> 4) * 2 + (c >> 5), rr = r & 15, cc = c & 31, ob = rr * 64 + cc * 2; return st * 1024 + (ob ^ (((ob >> 9) & 1) << 5)); }
__device__ __forceinline__ void stage_rc(int b, int& R, int& C) { const int st = b / 1024, sb = b % 1024, swz = sb ^ (((sb >> 9) & 1) << 5); R = (st >> 1) * 16 + swz / 64; C = (st & 1) * 32 + (swz % 64) / 2; }
__device__ __forceinline__ int perm32(int rho) { const int n = rho >> 4, i = rho & 15; return 8 * (i >> 2) + 4 * n + (i & 3); }

struct Unit { const char* A; const char* B; int row0, col0, e, nvalid, j0; };

struct DenseOrder {
    const char* A; const char* Bt; int K, nM, nN, nwg, G, c;
    __device__ __forceinline__ void init(const void* A_, const void* Bt_, int M, int N, int K_, int G_, int c_) { A = (const char*)A_; Bt = (const char*)Bt_; K = K_; nM = M / BM; nN = N / BM; nwg = nM * nN; G = G_; c = c_; }
    __device__ __forceinline__ bool next(int i, Unit& u) const {
        const long L = (long)i * G + c; if (L >= nwg) return false;
        int wgid = (int)L; { const int q = nwg / NXCD, r = nwg % NXCD, xcd = wgid % NXCD, off = wgid / NXCD; wgid = (xcd < r ? xcd * (q + 1) : r * (q + 1) + (xcd - r) * q) + off; }
        const int nig = WGM * nN, gid = wgid / nig, fm = gid * WGM, gsz = (nM - fm) < WGM ? (nM - fm) : WGM;
        const int pm = fm + ((wgid % nig) % gsz), pn = (wgid % nig) / gsz;
        u.A = A + (size_t)pm * BM * K * 2; u.B = Bt + (size_t)pn * BM * K * 2; u.row0 = pm * BM; u.col0 = pn * BM; u.e = 0; u.nvalid = BM; u.j0 = 0; return true;
    }
    __device__ __forceinline__ unsigned row_off(const Unit&, int) const { return 0u; }
};
struct MoeOrder {
    const char* A; const char* Bt; size_t bExp; int K; const LAS int* tb; const LAS int* ps; const LAS int* cn; const LAS int* ord; const int* tokE; int G, c; bool gather;
    __device__ __forceinline__ bool next(int i, Unit& u) const {
        const int L = i * G + c, total = tb[NEXP] * 4; if (L >= total) return false;
        const int rt = L >> 2, pn = L & 3;
        const int ej = __builtin_amdgcn_readfirstlane(ord[rt]);
        const int e = ej >> 8, j = ej & 255;
        const int pse = __builtin_amdgcn_readfirstlane(ps[e]), cne = __builtin_amdgcn_readfirstlane(cn[e]);
        u.e = e; u.row0 = pse + BM * j; u.col0 = pn * BM; u.nvalid = min(BM, cne - BM * j); u.j0 = e * ECAP + BM * j;
        u.B = Bt + (size_t)e * bExp + (size_t)pn * BM * K * 2;
        u.A = gather ? A : A + (size_t)u.row0 * K * 2;
        return true;
    }
    __device__ __forceinline__ unsigned row_off(const Unit& u, int R) const { const int t = R < u.nvalid ? tokE[u.j0 + R] : 0; return (unsigned)t * (unsigned)(K * 2); }
};

template <class Epi, class Sched, int BMODE, bool GATHER, bool LIGHT = false>
__device__ __forceinline__ void gemm_phase(LAS unsigned char* lds, const int K, const Sched& S, const Epi& E) {
    const int tid = opaque_tid(), wid = __builtin_amdgcn_readfirstlane(tid >> 6), lane = tid & 63, wr = wid >> 2, wc = wid & 3, fr = lane & 15, fq = lane >> 4;
    const int nt = K / BK;
    unsigned voffA[2][2], voffAn[2][2], voffB[2]; int RA[2], CA[2];
#pragma unroll
    for (int i = 0; i < 2; ++i) { int R, C; stage_rc(tid * 16 + i * 8192, R, C); RA[i] = R; CA[i] = C;
        const int Rb = (BMODE == 1) ? (64 * (R >> 5) + perm32(R & 31)) : (Epi::PERM ? ((R & ~31) + perm32(R & 31)) : R);
        voffB[i] = (unsigned)(Rb * K + C) * 2u;
#pragma unroll
        for (int h = 0; h < 2; ++h) { voffA[h][i] = (unsigned)((h * HALF + R) * K + C) * 2u; voffAn[h][i] = voffA[h][i]; } }
    const size_t kstep = (size_t)(BK * 2);
    const size_t hstepB = (size_t)((BMODE == 1) ? 32 : HALF) * K * 2;
    const unsigned ldsw = (unsigned)wid * 1024u;
    const int aoff = lds_byte(wr * 64 + fr, fq * 8), boff = lds_byte(wc * 32 + fr, fq * 8);
#define PG8_SA(b, h) (((b) * 2 + (h)) * HTB)
#define PG8_SB(b, h) ((4 + (b) * 2 + (h)) * HTB)
#define PG8_STAGE2(bufoff, gbase, v0, v1) do { \
        __builtin_amdgcn_global_load_lds((const unsigned*)((const char*)(gbase) + (v0)), (LAS unsigned*)(lds + (bufoff) + ldsw), 16, 0, 0); \
        __builtin_amdgcn_global_load_lds((const unsigned*)((const char*)(gbase) + (v1)), (LAS unsigned*)(lds + (bufoff) + ldsw + 8192), 16, 0, 0); } while (0)
#define PG8_STAGEB(bufoff, gbase) PG8_STAGE2(bufoff, gbase, voffB[0], voffB[1])
#define PG8_STAGEA(bufoff, gbase, h, nx) PG8_STAGE2(bufoff, gbase, ((GATHER && (nx)) ? voffAn[h][0] : voffA[h][0]), ((GATHER && (nx)) ? voffAn[h][1] : voffA[h][1]))
#define PG8_LDA(dst, b, h) do { _Pragma("unroll") for (int m = 0; m < 4; ++m) _Pragma("unroll") for (int k = 0; k < 2; ++k) dst[m][k] = *(const LAS bf16x8*)(lds + PG8_SA(b, h) + aoff + m * 2048 + k * 1024); } while (0)
#define PG8_LDB(dst, b, h) do { _Pragma("unroll") for (int n = 0; n < 2; ++n) _Pragma("unroll") for (int k = 0; k < 2; ++k) dst[n][k] = *(const LAS bf16x8*)(lds + PG8_SB(b, h) + boff + n * 2048 + k * 1024); } while (0)
#define PG8_MMA(ai, bj, At, Bt) do { __builtin_amdgcn_s_setprio(1); _Pragma("unroll") for (int m = 0; m < 4; ++m) _Pragma("unroll") for (int n = 0; n < 2; ++n) _Pragma("unroll") for (int k = 0; k < 2; ++k) \
        acc[ai][bj][m][n] = __builtin_amdgcn_mfma_f32_16x16x32_bf16(Bt[n][k], At[m][k], acc[ai][bj][m][n], 0, 0, 0); __builtin_amdgcn_s_setprio(0); } while (0)
#define PG8_WAIT_V(n) asm volatile("s_waitcnt vmcnt(" #n ")" ::: "memory")
#define PG8_WAIT_L(n) asm volatile("s_waitcnt lgkmcnt(" #n ")" ::: "memory")
#define PG8_BAR __builtin_amdgcn_s_barrier()
#define PG8_SCHED __builtin_amdgcn_sched_barrier(0)
    Unit cur, nxt; int ui = 0;
    if (!S.next(0, cur)) return;
    if (GATHER) {
#pragma unroll
        for (int h = 0; h < 2; ++h)
#pragma unroll
            for (int i = 0; i < 2; ++i) voffA[h][i] = S.row_off(cur, h * HALF + RA[i]) + (unsigned)CA[i] * 2u;
    }
    f32x4 acc[2][2][4][2];
#pragma unroll
    for (int a = 0; a < 2; ++a)
#pragma unroll
        for (int b = 0; b < 2; ++b)
#pragma unroll
            for (int m = 0; m < 4; ++m)
#pragma unroll
                for (int n = 0; n < 2; ++n) acc[a][b][m][n] = (f32x4){0.f, 0.f, 0.f, 0.f};
    bf16x8 At[4][2], B0[2][2], B1[2][2];
    const char* cA = cur.A; const char* cB = cur.B;
    PG8_STAGEB(PG8_SB(0, 0), cB); PG8_STAGEB(PG8_SB(0, 1), cB + hstepB); PG8_STAGEA(PG8_SA(0, 0), cA, 0, false); PG8_STAGEA(PG8_SA(0, 1), cA, 1, false);
    if (wr == 1) PG8_BAR;
    PG8_WAIT_V(2); PG8_BAR;
    PG8_STAGEB(PG8_SB(1, 0), cB + kstep); PG8_STAGEA(PG8_SA(1, 0), cA + kstep, 0, false); PG8_STAGEB(PG8_SB(1, 1), cB + hstepB + kstep);
    PG8_WAIT_V(6); PG8_BAR;
    for (;;) {
        const bool has_next = S.next(ui + 1, nxt);
        if (GATHER) {
#pragma unroll
            for (int h = 0; h < 2; ++h)
#pragma unroll
                for (int i = 0; i < 2; ++i) voffAn[h][i] = has_next ? (S.row_off(nxt, h * HALF + RA[i]) + (unsigned)CA[i] * 2u) : voffA[h][i];
        }
        const char* nA = has_next ? nxt.A : cA; const char* nB = has_next ? nxt.B : cB;
        const bool full = cur.nvalid > HALF;
        for (int t = 0; t < nt; t += 2) {
            const bool last = (t == nt - 2);
            const char* a1 = cA + (size_t)(t + 1) * kstep;
            const char* a2 = last ? nA : cA + (size_t)(t + 2) * kstep; const char* b2 = last ? nB : cB + (size_t)(t + 2) * kstep;
            const char* a3 = a2 + kstep; const char* b3 = b2 + kstep;
            PG8_LDB(B0, 0, 0); PG8_LDB(B1, 0, 1); PG8_SCHED; PG8_LDA(At, 0, 0); PG8_STAGEA(PG8_SA(1, 1), a1, 1, false);
            PG8_WAIT_V(8); PG8_WAIT_L(0); PG8_BAR; PG8_MMA(0, 0, At, B0); PG8_MMA(0, 1, At, B1); PG8_BAR; PG8_SCHED;
            PG8_LDA(At, 0, 1); PG8_STAGEB(PG8_SB(0, 0), b2); PG8_STAGEB(PG8_SB(0, 1), b2 + hstepB); PG8_STAGEA(PG8_SA(0, 0), a2, 0, last);
            PG8_WAIT_V(8); PG8_WAIT_L(0); PG8_BAR; if (!LIGHT || full) { PG8_MMA(1, 0, At, B0); PG8_MMA(1, 1, At, B1); } PG8_BAR; PG8_SCHED;
            PG8_LDB(B0, 1, 0); PG8_LDB(B1, 1, 1); PG8_SCHED; PG8_LDA(At, 1, 0); PG8_STAGEA(PG8_SA(0, 1), a2, 1, last);
            PG8_WAIT_V(8); PG8_WAIT_L(0); PG8_BAR; PG8_MMA(0, 0, At, B0); PG8_MMA(0, 1, At, B1); PG8_BAR; PG8_SCHED;
            PG8_LDA(At, 1, 1); PG8_STAGEB(PG8_SB(1, 0), b3); PG8_STAGEB(PG8_SB(1, 1), b3 + hstepB); PG8_STAGEA(PG8_SA(1, 0), a3, 0, last);
            PG8_WAIT_V(8); PG8_WAIT_L(0); PG8_BAR; if (!LIGHT || full) { PG8_MMA(1, 0, At, B0); PG8_MMA(1, 1, At, B1); } PG8_BAR; PG8_SCHED;
        }
        if (wr == 0) PG8_BAR;
        E(acc, cur, wr, wc, fr, fq);
        if (!has_next) break;
#pragma unroll
        for (int a = 0; a < 2; ++a)
#pragma unroll
            for (int b = 0; b < 2; ++b)
#pragma unroll
                for (int m = 0; m < 4; ++m)
#pragma unroll
                    for (int n = 0; n < 2; ++n) acc[a][b][m][n] = (f32x4){0.f, 0.f, 0.f, 0.f};
        cur = nxt; cA = nA; cB = nB; ++ui;
        if (GATHER) {
#pragma unroll
            for (int h = 0; h < 2; ++h)
#pragma unroll
                for (int i = 0; i < 2; ++i) voffA[h][i] = voffAn[h][i];
        }
        if (wr == 1) PG8_BAR;
    }
    PG8_WAIT_V(0);
    PG8_BAR;
#undef PG8_SA
#undef PG8_SB
#undef PG8_STAGE2
#undef PG8_STAGEA
#undef PG8_STAGEB
#undef PG8_LDA
#undef PG8_LDB
#undef PG8_MMA
#undef PG8_WAIT_V
#undef PG8_WAIT_L
#undef PG8_BAR
#undef PG8_SCHED
}

struct EpiProj {
    static constexpr bool PERM = true;
    bf16_t* out; const float* gq; const float* gk;
    __device__ __forceinline__ void operator()(const f32x4 (&acc)[2][2][4][2], const Unit& u, int wr, int wc, int fr, int fq) const {
        const int pn = u.col0 >> 8;
        const int row0 = u.row0 + wr * 64 + fr, colb = u.col0 + 64 * wc + 8 * fq;
        if (pn < 4) {
            const float* g = (pn < 2) ? gq : gk; const float post = (pn < 2) ? 0.125f : 1.0f;
            f32x4 gv[2][2];
#pragma unroll
            for (int bj = 0; bj < 2; ++bj)
#pragma unroll
                for (int n = 0; n < 2; ++n) gv[bj][n] = *(const f32x4*)(g + 32 * bj + 8 * fq + 4 * n) * post;
#pragma unroll
            for (int ai = 0; ai < 2; ++ai)
#pragma unroll
                for (int m = 0; m < 4; ++m) {
                    float ss = 0.f;
#pragma unroll
                    for (int bj = 0; bj < 2; ++bj)
#pragma unroll
                        for (int n = 0; n < 2; ++n) { const f32x4 x = acc[ai][bj][m][n]; ss += (x[0] * x[0] + x[1] * x[1]) + (x[2] * x[2] + x[3] * x[3]); }
                    ss += __shfl_xor(ss, 16); ss += __shfl_xor(ss, 32);
                    const float rstd = rsqrtf(ss * (1.0f / HD) + RMS_EPS);
                    bf16_t* rowp = out + (size_t)(row0 + ai * HALF + m * 16) * INW + colb;
#pragma unroll
                    for (int bj = 0; bj < 2; ++bj) { const f32x4 v0 = acc[ai][bj][m][0] * rstd * gv[bj][0], v1 = acc[ai][bj][m][1] * rstd * gv[bj][1];
                        u32x4 w; w.x = pack2(v0[0], v0[1]); w.y = pack2(v0[2], v0[3]); w.z = pack2(v1[0], v1[1]); w.w = pack2(v1[2], v1[3]);
                        *(u32x4*)(rowp + 32 * bj) = w; }
                }
        } else {
            const bool sg = pn >= 8;
#pragma unroll
            for (int ai = 0; ai < 2; ++ai)
#pragma unroll
                for (int m = 0; m < 4; ++m) {
                    bf16_t* rowp = out + (size_t)(row0 + ai * HALF + m * 16) * INW + colb;
#pragma unroll
                    for (int bj = 0; bj < 2; ++bj) { f32x4 v0 = acc[ai][bj][m][0], v1 = acc[ai][bj][m][1];
                        if (sg) {
#pragma unroll
                            for (int j = 0; j < 4; ++j) { v0[j] = sigmoidf_(v0[j]); v1[j] = sigmoidf_(v1[j]); } }
                        u32x4 w; w.x = pack2(v0[0], v0[1]); w.y = pack2(v0[2], v0[3]); w.z = pack2(v1[0], v1[1]); w.w = pack2(v1[2], v1[3]);
                        *(u32x4*)(rowp + 32 * bj) = w; }
                }
        }
    }
};
template <int MODE> struct EpiGate {
    static constexpr bool PERM = true;
    const bf16_t* gate; const bf16_t* t1in; bf16_t* out;
    __device__ __forceinline__ void operator()(const f32x4 (&acc)[2][2][4][2], const Unit& u, int wr, int wc, int fr, int fq) const {
        const int row0 = u.row0 + wr * 64 + fr, col0 = u.col0 + wc * 32 + 8 * fq;
#pragma unroll
        for (int ai = 0; ai < 2; ++ai)
#pragma unroll
            for (int m = 0; m < 4; ++m) {
                const size_t r = (size_t)(row0 + ai * HALF + m * 16);
#pragma unroll
                for (int bj = 0; bj < 2; ++bj) {
                    const int c = col0 + bj * HALF;
                    const u32x4 g = *(const u32x4*)(gate + r * INW + c);
                    const f32x4 a0 = acc[ai][bj][m][0], a1 = acc[ai][bj][m][1];
                    float o[8] = {a0[0] * bflo(g.x), a0[1] * bfhi(g.x), a0[2] * bflo(g.y), a0[3] * bfhi(g.y), a1[0] * bflo(g.z), a1[1] * bfhi(g.z), a1[2] * bflo(g.w), a1[3] * bfhi(g.w)};
                    if (MODE == 1) { const u32x4 t = *(const u32x4*)(t1in + r * DM + c);
                        o[0] += bflo(t.x); o[1] += bfhi(t.x); o[2] += bflo(t.y); o[3] += bfhi(t.y); o[4] += bflo(t.z); o[5] += bfhi(t.z); o[6] += bflo(t.w); o[7] += bfhi(t.w); }
                    u32x4 w; w.x = pack2(o[0], o[1]); w.y = pack2(o[2], o[3]); w.z = pack2(o[4], o[5]); w.w = pack2(o[6], o[7]);
                    *(u32x4*)(out + r * DM + c) = w;
                }
            }
    }
};
template <bool XF32> struct EpiResid {
    static constexpr bool PERM = true;
    const float* xf; bf16_t* xb;
    __device__ __forceinline__ void operator()(const f32x4 (&acc)[2][2][4][2], const Unit& u, int wr, int wc, int fr, int fq) const {
        const int row0 = u.row0 + wr * 64 + fr, col0 = u.col0 + wc * 32 + 8 * fq;
#pragma unroll
        for (int ai = 0; ai < 2; ++ai)
#pragma unroll
            for (int m = 0; m < 4; ++m) { const size_t off = (size_t)(row0 + ai * HALF + m * 16) * DM + col0;
#pragma unroll
                for (int bj = 0; bj < 2; ++bj) {
                    float x[8];
                    if (XF32) { const f32x4 a = *(const f32x4*)(xf + off + bj * HALF), b = *(const f32x4*)(xf + off + bj * HALF + 4);
                        x[0] = a[0]; x[1] = a[1]; x[2] = a[2]; x[3] = a[3]; x[4] = b[0]; x[5] = b[1]; x[6] = b[2]; x[7] = b[3]; }
                    else { const u32x4 t = *(const u32x4*)(xb + off + bj * HALF);
                        x[0] = bflo(t.x); x[1] = bfhi(t.x); x[2] = bflo(t.y); x[3] = bfhi(t.y); x[4] = bflo(t.z); x[5] = bfhi(t.z); x[6] = bflo(t.w); x[7] = bfhi(t.w); }
                    const f32x4 a0 = acc[ai][bj][m][0], a1 = acc[ai][bj][m][1];
                    u32x4 w; w.x = pack2(x[0] + a0[0], x[1] + a0[1]); w.y = pack2(x[2] + a0[2], x[3] + a0[3]); w.z = pack2(x[4] + a1[0], x[5] + a1[1]); w.w = pack2(x[6] + a1[2], x[7] + a1[3]);
                    *(u32x4*)(xb + off + bj * HALF) = w;
                }
            }
    }
};
struct EpiSwiGLU {
    static constexpr bool PERM = true;
    bf16_t* act;
    __device__ __forceinline__ void operator()(const f32x4 (&acc)[2][2][4][2], const Unit& u, int wr, int wc, int fr, int fq) const {
        const int row0 = u.row0 + wr * 64 + fr, col0 = (u.col0 >> 1) + wc * 32 + 8 * fq;
#pragma unroll
        for (int ai = 0; ai < 2; ++ai)
#pragma unroll
            for (int m = 0; m < 4; ++m) {
                float o[8];
#pragma unroll
                for (int n = 0; n < 2; ++n)
#pragma unroll
                    for (int j = 0; j < 4; ++j) { const float a = acc[ai][0][m][n][j], b = acc[ai][1][m][n][j]; o[4 * n + j] = a * sigmoidf_(a) * b; }
                u32x4 w; w.x = pack2(o[0], o[1]); w.y = pack2(o[2], o[3]); w.z = pack2(o[4], o[5]); w.w = pack2(o[6], o[7]);
                *(u32x4*)(act + (size_t)(row0 + ai * HALF + m * 16) * EH + col0) = w;
            }
    }
};
struct EpiDown {
    static constexpr bool PERM = true;
    bf16_t* yb; const float* tokW;
    __device__ __forceinline__ void operator()(const f32x4 (&acc)[2][2][4][2], const Unit& u, int wr, int wc, int fr, int fq) const {
        const int col0 = u.col0 + wc * 32 + 8 * fq;
#pragma unroll
        for (int ai = 0; ai < 2; ++ai)
#pragma unroll
            for (int m = 0; m < 4; ++m) {
                const int rl = wr * 64 + fr + ai * HALF + m * 16;
                const float w = rl < u.nvalid ? tokW[u.j0 + rl] : 0.f;
#pragma unroll
                for (int bj = 0; bj < 2; ++bj) { const f32x4 v0 = acc[ai][bj][m][0] * w, v1 = acc[ai][bj][m][1] * w;
                    u32x4 o; o.x = pack2(v0[0], v0[1]); o.y = pack2(v0[2], v0[3]); o.z = pack2(v1[0], v1[1]); o.w = pack2(v1[2], v1[3]);
                    *(u32x4*)(yb + (size_t)(u.row0 + rl) * DM + col0 + bj * HALF) = o; }
            }
    }
};
}

constexpr int ATT_K_OFF = 0, ATT_V_OFF = 49152;
__device__ __forceinline__ unsigned kv_off(unsigned row, unsigned ch) { return row * 128u + 16u * (ch ^ (((row >> 1) & 7u) ^ ((row & 2u) << 1))); }

struct AttnU { int tok0, d, blk, g, h; };
__device__ __forceinline__ AttnU attn_decode(int uidx) {
    const int bh = uidx / 48, r48 = uidx % 48, g = r48 >> 4, rr = r48 & 15;
    AttnU U; U.g = g; U.h = bh & 7;
    U.d = (g == 0) ? 1 : (g == 1 ? 4 : 16);
    const int c = (g == 0) ? 0 : (g == 1 ? (rr >> 2) : rr);
    U.blk = (g == 0) ? rr : (g == 1 ? (rr & 3) : 0);
    U.tok0 = (bh >> 3) * SEQ + c;
    return U;
}
__device__ __forceinline__ void attn_load_q(const AttnU& U, const bf16_t* __restrict__ proj, int wid, int lane, bf16x8 (&qn)[4]) {
    const size_t qt = (size_t)(U.tok0 + (256 * U.blk + 32 * wid + (lane & 31)) * U.d);
#pragma unroll
    for (int ks = 0; ks < 4; ++ks) qn[ks] = *(const bf16x8*)(proj + qt * INW + U.h * HD + 16 * ks + 8 * (lane >> 5));
}
__device__ __forceinline__ void attn_load(const AttnU& U, const bf16_t* __restrict__ proj, int tid, u32x4 (&kr)[6], u32x4 (&vr)[6]) {
    const int kbase = 256 * U.blk - 128, kr_min = (U.blk == 0) ? 128 : 0;
#pragma unroll
    for (int i = 0; i < 6; ++i) {
        const int idx = tid + NTHREADS * i, row = idx >> 3, ch = idx & 7;
        if (row >= kr_min) {
            const size_t t = (size_t)(U.tok0 + (kbase + row) * U.d);
            kr[i] = *(const u32x4*)(proj + t * INW + AW + U.h * HD + ch * 8);
            vr[i] = *(const u32x4*)(proj + t * INW + 2 * AW + U.h * HD + ch * 8);
        }
    }
}
__device__ __forceinline__ void attn_lds_store(const AttnU& U, LAS unsigned char* lds, int tid, const u32x4 (&kr)[6], const u32x4 (&vr)[6]) {
    const int kr_min = (U.blk == 0) ? 128 : 0;
#pragma unroll
    for (int i = 0; i < 6; ++i) {
        const int idx = tid + NTHREADS * i, row = idx >> 3, ch = idx & 7;
        if (row >= kr_min) { *(LAS u32x4*)(lds + ATT_K_OFF + kv_off(row, ch)) = kr[i]; *(LAS u32x4*)(lds + ATT_V_OFF + kv_off(row, ch)) = vr[i]; }
    }
}
__device__ __forceinline__ void attn_compute(const AttnU& U, LAS unsigned char* lds, const bf16x8 (&qf)[4], bf16_t* __restrict__ og, f32x2* __restrict__ ml, int wid, int lane) {
    const int blk = U.blk, g = U.g, h = U.h;
    const size_t qt = (size_t)(U.tok0 + (256 * blk + 32 * wid + (lane & 31)) * U.d);
    const int kt_min = (blk == 0) ? max(0, 4 - wid) : 0;
    const int hq = lane >> 5, qi = lane & 31;
    f32x16 S[5];
#pragma unroll
    for (int kt = 0; kt < 5; ++kt) {
#pragma unroll
        for (int i = 0; i < 16; ++i) S[kt][i] = 0.f;
        if (kt >= kt_min) {
            const unsigned krow = (unsigned)(32 * wid + 32 * kt + qi);
#pragma unroll
            for (int ks = 0; ks < 4; ++ks) {
                const bf16x8 kf = *(const LAS bf16x8*)(lds + ATT_K_OFF + kv_off(krow, (unsigned)(2 * ks + hq)));
                S[kt] = __builtin_amdgcn_mfma_f32_32x32x16_bf16(kf, qf[ks], S[kt], 0, 0, 0);
            }
        }
    }
    float mx = -3.0e38f;
#pragma unroll
    for (int kt = 0; kt < 5; ++kt)
#pragma unroll
        for (int i = 0; i < 16; ++i) {
            const int row = (i & 3) + 8 * (i >> 2) + 4 * hq;
            bool valid = kt >= kt_min;
            if (kt == 0) valid = valid && (row >= qi);
            if (kt == 4) valid = valid && (row <= qi);
            S[kt][i] = valid ? S[kt][i] : -3.0e38f;
            mx = fmaxf(mx, S[kt][i]);
        }
    mx = fmaxf(mx, __shfl_xor(mx, 32));
    float lsum = 0.f;
#pragma unroll
    for (int kt = 0; kt < 5; ++kt)
#pragma unroll
        for (int i = 0; i < 16; ++i) { const float p = (S[kt][i] > -1.0e38f) ? __expf(S[kt][i] - mx) : 0.f; S[kt][i] = p; lsum += p; }
    lsum += __shfl_xor(lsum, 32);
    f32x16 O[2];
#pragma unroll
    for (int dt = 0; dt < 2; ++dt)
#pragma unroll
        for (int i = 0; i < 16; ++i) O[dt][i] = 0.f;
    const unsigned blkq = (lane >> 4) & 1, q4 = (lane & 15) >> 2, p4 = lane & 3;
    const unsigned vbase = (unsigned)(size_t)(lds + ATT_V_OFF);
#pragma unroll
    for (int kt = 0; kt < 5; ++kt) {
        if (kt >= kt_min) {
#pragma unroll
            for (int s = 0; s < 2; ++s) {
                u32x4 pw;
                pw.x = pack2(S[kt][8 * s + 0], S[kt][8 * s + 1]); pw.y = pack2(S[kt][8 * s + 2], S[kt][8 * s + 3]);
                pw.z = pack2(S[kt][8 * s + 4], S[kt][8 * s + 5]); pw.w = pack2(S[kt][8 * s + 6], S[kt][8 * s + 7]);
                const bf16x8 pf = __builtin_bit_cast(bf16x8, pw);
                u32x2 v00, v01, v10, v11;
                const unsigned r0 = (unsigned)(32 * wid + 32 * kt + 16 * s + 4 * hq) + q4, r1 = r0 + 8;
                const unsigned a00 = vbase + kv_off(r0, 0u + 2 * blkq + (p4 >> 1)) + 8 * (p4 & 1), a01 = vbase + kv_off(r1, 0u + 2 * blkq + (p4 >> 1)) + 8 * (p4 & 1);
                const unsigned a10 = vbase + kv_off(r0, 4u + 2 * blkq + (p4 >> 1)) + 8 * (p4 & 1), a11 = vbase + kv_off(r1, 4u + 2 * blkq + (p4 >> 1)) + 8 * (p4 & 1);
                asm volatile("ds_read_b64_tr_b16 %0, %4\n\tds_read_b64_tr_b16 %1, %5\n\tds_read_b64_tr_b16 %2, %6\n\tds_read_b64_tr_b16 %3, %7\n\ts_waitcnt lgkmcnt(0)"
                             : "=&v"(v00), "=&v"(v01), "=&v"(v10), "=&v"(v11) : "v"(a00), "v"(a01), "v"(a10), "v"(a11) : "memory");
                u32x4 f0; f0.x = v00.x; f0.y = v00.y; f0.z = v01.x; f0.w = v01.y;
                u32x4 f1; f1.x = v10.x; f1.y = v10.y; f1.z = v11.x; f1.w = v11.y;
                O[0] = __builtin_amdgcn_mfma_f32_32x32x16_bf16(__builtin_bit_cast(bf16x8, f0), pf, O[0], 0, 0, 0);
                O[1] = __builtin_amdgcn_mfma_f32_32x32x16_bf16(__builtin_bit_cast(bf16x8, f1), pf, O[1], 0, 0, 0);
            }
        }
    }
    const float inv = 1.0f / lsum;
    bf16_t* orow = og + ((size_t)g * NTOK + qt) * AW + h * HD;
#pragma unroll
    for (int dt = 0; dt < 2; ++dt)
#pragma unroll
        for (int gq4 = 0; gq4 < 4; ++gq4) {
            u32x2 w; w.x = pack2(O[dt][4 * gq4 + 0] * inv, O[dt][4 * gq4 + 1] * inv); w.y = pack2(O[dt][4 * gq4 + 2] * inv, O[dt][4 * gq4 + 3] * inv);
            *(u32x2*)(orow + 32 * dt + 8 * gq4 + 4 * hq) = w;
        }
    if (lane < 32) ml[((size_t)g * NTOK + qt) * 8 + h] = (f32x2){mx, lsum};
    __syncthreads();
}

struct TrDesc { const float* src; bf16_t* dst; int N, K; };
__device__ __forceinline__ void tr_load(const TrDesc& d, int lane, f32x4 (&r)[8]) {
#pragma unroll
    for (int i = 0; i < 8; ++i) r[i] = __builtin_nontemporal_load((const f32x4*)(d.src + (size_t)((lane >> 3) + 8 * i) * d.N + 4 * (lane & 7)));
}
__device__ __forceinline__ void tr_store(const TrDesc& d, LAS float* scr, int lane, const f32x4 (&r)[8]) {
#pragma unroll
    for (int i = 0; i < 8; ++i) { LAS float* p = scr + ((lane >> 3) + 8 * i) * 33 + 4 * (lane & 7); p[0] = r[i][0]; p[1] = r[i][1]; p[2] = r[i][2]; p[3] = r[i][3]; }
    const int c = lane & 7;
#pragma unroll
    for (int j = 0; j < 4; ++j) { const int n = (lane >> 3) + 8 * j; const LAS float* q = scr + (8 * c) * 33 + n;
        u32x4 o; o.x = pack2(q[0 * 33], q[1 * 33]); o.y = pack2(q[2 * 33], q[3 * 33]); o.z = pack2(q[4 * 33], q[5 * 33]); o.w = pack2(q[6 * 33], q[7 * 33]);
        *(u32x4*)(d.dst + (size_t)n * d.K + 8 * c) = o; }
}
struct ExpertItems {
    const float* weg; const float* weu; const float* wed; bf16_t* WguT; bf16_t* WdT;
    static constexpr int TOTAL = 3 * NEXP * 256;
    __device__ __forceinline__ TrDesc operator()(int it) const {
        const int which = it >> 13, r = it & 8191, e = r >> 8, item = r & 255; TrDesc d;
        if (which < 2) { const int kb = item >> 4, nb = item & 15, k0 = 64 * kb, n0 = 32 * nb, nn0 = (n0 >> 7) * 256 + which * 128 + (n0 & 127);
            d.src = (which == 0 ? weg : weu) + (size_t)e * DM * EH + (size_t)k0 * EH + n0; d.dst = WguT + (size_t)e * DM * DM + (size_t)nn0 * DM + k0; d.N = EH; d.K = DM; }
        else { const int kb = item >> 5, nb = item & 31, k0 = 64 * kb, n0 = 32 * nb;
            d.src = wed + (size_t)e * EH * DM + (size_t)k0 * DM + n0; d.dst = WdT + (size_t)e * DM * EH + (size_t)n0 * EH + k0; d.N = DM; d.K = EH; }
        return d;
    }
};
struct SmallItems {
    const float* win; const float* wa; const float* wo; bf16_t* WinT; bf16_t* WaT; bf16_t* WoT;
    static constexpr int TOTAL = 2 * 2816;
    __device__ __forceinline__ TrDesc operator()(int it) const {
        const int l = it / 2816, r = it % 2816; TrDesc d;
        if (r < 2048) { const int kb = r >> 7, nb = r & 127; d.src = win + (size_t)l * DM * INW + (size_t)(64 * kb) * INW + 32 * nb; d.dst = WinT + (size_t)l * INW * DM + (size_t)(32 * nb) * DM + 64 * kb; d.N = INW; d.K = DM; }
        else if (r < 2304) { const int q = r - 2048, kb = q >> 5, nb = q & 31; d.src = wa + (size_t)l * AW * DM + (size_t)(64 * kb) * DM + 32 * nb; d.dst = WaT + (size_t)l * DM * AW + (size_t)(32 * nb) * AW + 64 * kb; d.N = DM; d.K = AW; }
        else { const int q = r - 2304, kb = q >> 5, nb = q & 31; d.src = wo + (size_t)l * DM * DM + (size_t)(64 * kb) * DM + 32 * nb; d.dst = WoT + (size_t)l * DM * DM + (size_t)(32 * nb) * DM + 64 * kb; d.N = DM; d.K = DM; }
        return d;
    }
};
template <class Items>
__device__ __forceinline__ void convert_items(const Items& I, LAS float* scr, int lane, int gw, int NGW) {
    f32x4 ra[8], rb[8];
    int it = gw;
    if (it >= Items::TOTAL) return;
    TrDesc da = I(it), db = da;
    tr_load(da, lane, ra);
    for (;;) {
        int it2 = it + NGW;
        if (it2 < Items::TOTAL) { db = I(it2); tr_load(db, lane, rb); }
        tr_store(da, scr, lane, ra);
        it = it2; if (it >= Items::TOTAL) break;
        it2 = it + NGW;
        if (it2 < Items::TOTAL) { da = I(it2); tr_load(da, lane, ra); }
        tr_store(db, scr, lane, rb);
        it = it2; if (it >= Items::TOTAL) break;
    }
}
__device__ __forceinline__ void norm_row(const float* __restrict__ xr, const float* __restrict__ g, bf16_t* __restrict__ hr, int lane) {
    f32x4 v[4]; float ss = 0.f;
#pragma unroll
    for (int i = 0; i < 4; ++i) { v[i] = *(const f32x4*)(xr + (i * 64 + lane) * 4); ss += (v[i][0] * v[i][0] + v[i][1] * v[i][1]) + (v[i][2] * v[i][2] + v[i][3] * v[i][3]); }
    ss = wave_sum(ss);
    const float rstd = rsqrtf(ss * (1.0f / DM) + RMS_EPS);
#pragma unroll
    for (int i = 0; i < 4; ++i) {
        const f32x4 gv = *(const f32x4*)(g + (i * 64 + lane) * 4);
        u32x2 w; w.x = pack2(v[i][0] * rstd * gv[0], v[i][1] * rstd * gv[1]); w.y = pack2(v[i][2] * rstd * gv[2], v[i][3] * rstd * gv[3]);
        *(u32x2*)(hr + (i * 64 + lane) * 4) = w;
    }
}
typedef const __attribute__((address_space(4))) float* cfp;
typedef const __attribute__((address_space(4))) f32x2* cf2p;
__device__ __forceinline__ void unpack8(const u32x4 v, float (&f)[8]) { f[0] = bflo(v.x); f[1] = bfhi(v.x); f[2] = bflo(v.y); f[3] = bfhi(v.y); f[4] = bflo(v.z); f[5] = bfhi(v.z); f[6] = bflo(v.w); f[7] = bfhi(v.w); }
template <int W>
__device__ __forceinline__ void pool_path(const u32x4 (&r)[23], int pos0, bf16_t* __restrict__ pl, size_t t0, int c0) {
    float sum[8] = {0.f, 0.f, 0.f, 0.f, 0.f, 0.f, 0.f, 0.f}, f[8];
#pragma unroll
    for (int j = 1; j < W; ++j) { unpack8(r[15 - j], f);
#pragma unroll
        for (int c = 0; c < 8; ++c) sum[c] += f[c]; }
#pragma unroll
    for (int i = 0; i < 8; ++i) {
        float u[8]; unpack8(r[15 + i], u);
        if (i > 0) { unpack8(r[15 + i - W], f);
#pragma unroll
            for (int c = 0; c < 8; ++c) sum[c] -= f[c]; }
#pragma unroll
        for (int c = 0; c < 8; ++c) sum[c] += u[c];
        const float ic = 1.0f / (float)min(pos0 + i + 1, W);
        u32x4 o; o.x = pack2(sum[0] * ic - u[0], sum[1] * ic - u[1]); o.y = pack2(sum[2] * ic - u[2], sum[3] * ic - u[3]);
        o.z = pack2(sum[4] * ic - u[4], sum[5] * ic - u[5]); o.w = pack2(sum[6] * ic - u[6], sum[7] * ic - u[7]);
        *(u32x4*)(pl + (t0 + i) * PW + c0) = o;
    }
}
__device__ __forceinline__ int scan32_excl(int v, int lane, int& total) {
    int inc = v;
#pragma unroll
    for (int o = 1; o < 32; o <<= 1) { const int t = __shfl_up(inc, o, 32); if ((lane & 31) >= o) inc += t; }
    total = __shfl(inc, 31, 32);
    return inc - v;
}
__device__ __forceinline__ void build_moe_tables(LAS int* L, const unsigned* cnt) {
    { unsigned a_ = (unsigned)(size_t)L; asm volatile("" : "+s"(a_)); L = (LAS int*)(size_t)a_; }
    const int tid = opaque_tid();
    if (tid < 64) {
        const int lane = tid, e = lane & 31;
        const int c = (int)__hip_atomic_load(cnt + e * 64, __ATOMIC_RELAXED, __HIP_MEMORY_SCOPE_AGENT);
        const int nt = (c + 255) >> 8, lastv = c - 256 * (nt - 1);
        const int lt = (nt > 0 && lastv <= 128) ? 1 : 0, hv = nt - lt;
        int Tt, Th, Tl;
        const int tbx = scan32_excl(nt, lane, Tt), hx = scan32_excl(hv, lane, Th), lx = scan32_excl(lt, lane, Tl);
        if (lane < 32) {
            L[LI_TB + e] = tbx; L[LI_PS + e] = tbx * 256; L[LI_CN + e] = c;
            for (int j = 0; j < hv; ++j) L[LI_ORD + hx + j] = (e << 8) | j;
            if (lt) L[LI_ORD + Th + lx] = (e << 8) | (nt - 1);
            if (lane == 31) { L[LI_TB + NEXP] = Tt; L[LI_PS + NEXP] = Tt * 256; L[LI_NT] = Tt; }
        }
    }
    __syncthreads();
}

struct Args { const float* in[18]; float* out; unsigned char* ws; int ph_lo, ph_hi; };
typedef const __attribute__((address_space(4))) Args* CArgsP;
__device__ __forceinline__ CArgsP kargs() { unsigned long long p = (unsigned long long)__builtin_amdgcn_kernarg_segment_ptr(); asm volatile("" : "+s"(p)); return (CArgsP)p; }
#define PHASE_PTRS \
    const int G = opaque_s(G0), bx = opaque_s(bx0), vcu = opaque_s(vcu0), NGW = G * NWAVES; (void)bx; (void)vcu; (void)NGW; \
    const CArgsP ka = kargs(); unsigned char* const ws = ka->ws; \
    unsigned* const ctrl = (unsigned*)(ws + OFF_CTRL); const float* const x_in = ka->in[0]; \
    bf16_t* const WinT = (bf16_t*)(ws + OFF_WIN); bf16_t* const WaT = (bf16_t*)(ws + OFF_WA); bf16_t* const WppT = (bf16_t*)(ws + OFF_WPP); bf16_t* const WoT = (bf16_t*)(ws + OFF_WO); \
    bf16_t* const WguT = (bf16_t*)(ws + OFF_WGU); bf16_t* const WdT = (bf16_t*)(ws + OFF_WD); \
    bf16_t* const Hb = (bf16_t*)(ws + OFF_H); bf16_t* const MG = Hb; bf16_t* const PROJ = (bf16_t*)(ws + OFF_PROJ); bf16_t* const ACT = (bf16_t*)(ws + OFF_ACT); bf16_t* const YB = (bf16_t*)(ws + OFF_YB); \
    bf16_t* const AC = (bf16_t*)(ws + OFF_AC); bf16_t* const PL = (bf16_t*)(ws + OFF_PL); bf16_t* const OG = (bf16_t*)(ws + OFF_OG); bf16_t* const T1 = (bf16_t*)(ws + OFF_T1); \
    f32x2* const ML = (f32x2*)(ws + OFF_ML); bf16_t* const XB = (bf16_t*)(ws + OFF_XB); int* const tokE = (int*)(ws + OFF_TOKE); float* const tokW = (float*)(ws + OFF_TOKW); int* const asg = (int*)(ws + OFF_ASG); \
    (void)ctrl; (void)x_in; (void)WinT; (void)WaT; (void)WppT; (void)WoT; (void)WguT; (void)WdT; (void)Hb; (void)MG; (void)PROJ; (void)ACT; (void)YB; (void)AC; (void)PL; (void)OG; (void)T1; (void)ML; (void)XB; (void)tokE; (void)tokW; (void)asg
#define LAYER_PTRS PHASE_PTRS; const int tid = opaque_tid(), lane = tid & 63, wid = __builtin_amdgcn_readfirstlane(tid >> 6), gw = vcu * NWAVES + wid; (void)lane; (void)gw; unsigned* const cnt = ctrl + CW_CNT + l * 2048; (void)cnt

#ifndef PHASE_MASK
#define PHASE_MASK 0x3ff
#endif
#define EN(j) (((PHASE_MASK) >> (j)) & 1)
#ifndef REP_MASK
#define REP_MASK 0
#endif
#define REPS(j) (1 + (((REP_MASK) >> (j)) & 1))
#define IN(k) (MK_N_LAUNCHES == 1 || (lo <= (k) && (k) < hi))
#ifndef PROBE_A
#define PROBE_A -1
#define PROBE_B -1
#endif
#define STAMP_BEGIN(k) do { if (PROBE_A == (k)) ts0 = __builtin_amdgcn_s_memrealtime(); } while (0)
#define SEAM(k) do { if (IN(k) && IN((k) + 1)) { XcdBarrier b2_ = bar; unsigned long long p_ = (unsigned long long)b2_.bar; asm volatile("" : "+s"(p_)); b2_.bar = (unsigned*)p_; xcd_barrier(b2_); } if (PROBE_B == (k)) ts1 = __builtin_amdgcn_s_memrealtime(); } while (0)

template <int l>
__device__ __forceinline__ void layer_body(const XcdBarrier& bar, LAS unsigned char* lds, LAS int* LC, const int G0, const int bx0, const int vcu0, const int lo, const int hi, unsigned long long& ts0, unsigned long long& ts1) {
        const int pb = 1 + 9 * l;
        STAMP_BEGIN(pb + 0);
        for (int rep = 0; rep < REPS(0); ++rep) if (EN(0) && IN(pb + 0)) {
            asm volatile("; PHASE_MARK 0");
            LAYER_PTRS;
            pg8::DenseOrder S; S.init(Hb, WinT + (size_t)l * INW * DM, NTOK, INW, DM, G, bx);
            pg8::EpiProj E{PROJ, ka->in[3] + (size_t)l * HD, ka->in[4] + (size_t)l * HD};
            pg8::gemm_phase<pg8::EpiProj, pg8::DenseOrder, 1, false>(lds, DM, S, E);
        }
        SEAM(pb + 0);
        STAMP_BEGIN(pb + 1);
        for (int rep = 0; rep < REPS(1); ++rep) if (EN(1) && IN(pb + 1)) {
            asm volatile("; PHASE_MARK 1");
            LAYER_PTRS;
            int u = vcu;
            if (u < 1536) {
                AttnU cu = attn_decode(u), nu = cu;
                u32x4 kr[6], vr[6]; bf16x8 qf[4];
                attn_load(cu, PROJ, tid, kr, vr);
                for (;;) {
                    attn_load_q(cu, PROJ, wid, lane, qf);
                    attn_lds_store(cu, lds, tid, kr, vr);
                    __syncthreads();
                    const int un = u + G; const bool hn = un < 1536;
                    if (hn) { nu = attn_decode(un); attn_load(nu, PROJ, tid, kr, vr); }
                    attn_compute(cu, lds, qf, OG, ML, wid, lane);
                    if (!hn) break;
                    cu = nu; u = un;
                }
            }
        }
        SEAM(pb + 1);
        STAMP_BEGIN(pb + 2);
        for (int rep = 0; rep < REPS(2); ++rep) if (EN(2) && IN(pb + 2)) {
            asm volatile("; PHASE_MARK 2");
            LAYER_PTRS;
            for (int grp = gw; grp < NTOK / 8; grp += NGW) {
                const size_t t0 = (size_t)grp * 8; const int c0 = 8 * lane, hh = lane >> 3;
                {
                    f32x2 sm[8][3]; u32x4 v[8][3];
#pragma unroll
                    for (int i = 0; i < 8; ++i)
#pragma unroll
                        for (int g = 0; g < 3; ++g) { sm[i][g] = ML[((size_t)g * NTOK + t0 + i) * 8 + hh]; v[i][g] = *(const u32x4*)(OG + ((size_t)g * NTOK + t0 + i) * AW + c0); }
#pragma unroll
                    for (int i = 0; i < 8; ++i) {
                        const float M = fmaxf(fmaxf(sm[i][0][0], sm[i][1][0]), sm[i][2][0]);
                        float w[3], W = 0.f;
#pragma unroll
                        for (int g = 0; g < 3; ++g) { w[g] = sm[i][g][1] * __expf(sm[i][g][0] - M); W += w[g]; }
                        const float iw = 1.0f / W;
                        float o[8] = {0.f, 0.f, 0.f, 0.f, 0.f, 0.f, 0.f, 0.f}, f[8];
#pragma unroll
                        for (int g = 0; g < 3; ++g) { unpack8(v[i][g], f); const float q = w[g] * iw;
#pragma unroll
                            for (int c = 0; c < 8; ++c) o[c] += q * f[c]; }
                        u32x4 ow; ow.x = pack2(o[0], o[1]); ow.y = pack2(o[2], o[3]); ow.z = pack2(o[4], o[5]); ow.w = pack2(o[6], o[7]);
                        *(u32x4*)(AC + (t0 + i) * AW + c0) = ow;
                    }
                }
                {
                    const int pos0 = (int)(t0 & (SEQ - 1)), g4 = lane >> 4, wnd = 2 << g4;
                    u32x4 r[23];
#pragma unroll
                    for (int k = 0; k < 23; ++k) { const bool need = (k >= 16 - wnd) && (pos0 - 15 + k >= 0);
                        r[k] = need ? *(const u32x4*)(PROJ + (t0 - 15 + k) * INW + 3 * AW + c0) : (u32x4){0u, 0u, 0u, 0u}; }
                    if (g4 == 0) pool_path<2>(r, pos0, PL, t0, c0);
                    else if (g4 == 1) pool_path<4>(r, pos0, PL, t0, c0);
                    else if (g4 == 2) pool_path<8>(r, pos0, PL, t0, c0);
                    else pool_path<16>(r, pos0, PL, t0, c0);
                }
            }
        }
        SEAM(pb + 2);
        STAMP_BEGIN(pb + 3);
        for (int rep = 0; rep < REPS(3); ++rep) if (EN(3) && IN(pb + 3)) {
            asm volatile("; PHASE_MARK 3");
            LAYER_PTRS;
            { pg8::DenseOrder S; S.init(AC, WaT + (size_t)l * DM * AW, NTOK, DM, AW, G, bx);
              pg8::EpiGate<0> E{PROJ + 2048, nullptr, T1};
              pg8::gemm_phase<pg8::EpiGate<0>, pg8::DenseOrder, 0, false>(lds, AW, S, E); }
            { pg8::DenseOrder S; S.init(PL, WppT + (size_t)l * DM * PW, NTOK, DM, PW, G, bx);
              pg8::EpiGate<1> E{PROJ + 3072, T1, MG};
              pg8::gemm_phase<pg8::EpiGate<1>, pg8::DenseOrder, 0, false>(lds, PW, S, E); }
        }
        SEAM(pb + 3);
        STAMP_BEGIN(pb + 4);
        if (EN(4) && IN(pb + 4)) {
            asm volatile("; PHASE_MARK 4");
            LAYER_PTRS;
            pg8::DenseOrder S; S.init(MG, WoT + (size_t)l * DM * DM, NTOK, DM, DM, G, bx);
            pg8::EpiResid<l == 0> E{x_in, XB};
            pg8::gemm_phase<pg8::EpiResid<l == 0>, pg8::DenseOrder, 0, false>(lds, DM, S, E);
        }
        SEAM(pb + 4);
        STAMP_BEGIN(pb + 5);
        if (EN(5) && IN(pb + 5)) {
            asm volatile("; PHASE_MARK 5");
            LAYER_PTRS;
            LAS float* part = (LAS float*)lds;
            LAS float* lg = (LAS float*)(lds + 100352);
            LAS int* aE = (LAS int*)(lds + 110592); LAS float* aW = (LAS float*)(lds + 110592 + 512); LAS int* bs = (LAS int*)(lds + 110592 + 1024); LAS float* rs = (LAS float*)(lds + 110592 + 1536);
            const float* g2 = ka->in[10] + (size_t)l * DM; const float* brg = ka->in[12] + (size_t)l * 4; const float* bre = ka->in[14] + (size_t)l * 32;
            const bf16_t* Wh = (const bf16_t*)(ws + OFF_WRH) + (size_t)l * 48 * DM; const bf16_t* Wl = (const bf16_t*)(ws + OFF_WRL) + (size_t)l * 48 * DM;
            for (int chunk = bx; chunk < NTOK / 64; chunk += G) {
                {
                    const int fr = lane & 15, fq = lane >> 4;
                    f32x4 acc[4][3]; float ssl[4] = {0.f, 0.f, 0.f, 0.f};
#pragma unroll
                    for (int mt = 0; mt < 4; ++mt)
#pragma unroll
                        for (int nt = 0; nt < 3; ++nt) acc[mt][nt] = (f32x4){0.f, 0.f, 0.f, 0.f};
#pragma unroll 1
                    for (int ks = 0; ks < 4; ++ks) {
                        const int d0 = 128 * wid + 32 * ks + 8 * fq;
                        bf16x8 bh[3], bl[3];
#pragma unroll
                        for (int nt = 0; nt < 3; ++nt) { bh[nt] = *(const bf16x8*)(Wh + (size_t)(16 * nt + fr) * DM + d0); bl[nt] = *(const bf16x8*)(Wl + (size_t)(16 * nt + fr) * DM + d0); }
#pragma unroll
                        for (int mt = 0; mt < 4; ++mt) {
                            const u32x4 hw = *(const u32x4*)(XB + (size_t)(chunk * 64 + 16 * mt + fr) * DM + d0);
                            { float f[8]; unpack8(hw, f); ssl[mt] += (f[0] * f[0] + f[1] * f[1]) + (f[2] * f[2] + f[3] * f[3]) + (f[4] * f[4] + f[5] * f[5]) + (f[6] * f[6] + f[7] * f[7]); }
                            const bf16x8 ah = __builtin_bit_cast(bf16x8, hw);
#pragma unroll
                            for (int nt = 0; nt < 3; ++nt) {
                                acc[mt][nt] = __builtin_amdgcn_mfma_f32_16x16x32_bf16(ah, bh[nt], acc[mt][nt], 0, 0, 0);
                                acc[mt][nt] = __builtin_amdgcn_mfma_f32_16x16x32_bf16(ah, bl[nt], acc[mt][nt], 0, 0, 0);
                            }
                        }
                        asm volatile("" ::: "memory");
                    }
#pragma unroll
                    for (int mt = 0; mt < 4; ++mt) {
#pragma unroll
                        for (int nt = 0; nt < 3; ++nt) *(LAS f32x4*)(part + (wid * 49 + 16 * nt + fr) * 64 + 16 * mt + 4 * fq) = acc[mt][nt];
                        float sq = ssl[mt]; sq += __shfl_xor(sq, 16); sq += __shfl_xor(sq, 32);
                        if (fq == 0) part[(wid * 49 + 48) * 64 + 16 * mt + fr] = sq;
                    }
                }
                __syncthreads();
                for (int o = tid >> 6; o < 37; o += 8) { float sum = 0.f; const int po = (o == 36) ? 48 : o;
#pragma unroll
                    for (int w = 0; w < 8; ++w) sum += part[(w * 49 + po) * 64 + lane];
                    lg[o * 64 + lane] = sum; }
                __syncthreads();
                if (tid < 64) {
                    const float rstd = rsqrtf(lg[36 * 64 + tid] * (1.0f / DM) + RMS_EPS); rs[tid] = rstd;
                    float gl[4];
#pragma unroll
                    for (int o = 0; o < 4; ++o) gl[o] = lg[o * 64 + tid] * rstd + brg[o];
                    int gs = 0; float gm = gl[0];
#pragma unroll
                    for (int o = 1; o < 4; ++o) if (gl[o] > gm) { gm = gl[o]; gs = o; }
                    float gden = 0.f;
#pragma unroll
                    for (int o = 0; o < 4; ++o) gden += __expf(gl[o] - gm);
                    const float ggate = 1.0f / gden;
                    float el[8];
#pragma unroll
                    for (int o = 0; o < 8; ++o) el[o] = lg[(4 + 8 * gs + o) * 64 + tid] * rstd + bre[gs * 8 + o];
                    int i0 = 0; float m0 = el[0];
#pragma unroll
                    for (int o = 1; o < 8; ++o) if (el[o] > m0) { m0 = el[o]; i0 = o; }
                    int i1 = 0; float m1 = -3.0e38f;
#pragma unroll
                    for (int o = 0; o < 8; ++o) if (o != i0 && el[o] > m1) { m1 = el[o]; i1 = o; }
                    const float e1 = __expf(m1 - m0);
                    aE[2 * tid] = gs * 8 + i0; aE[2 * tid + 1] = gs * 8 + i1; aW[2 * tid] = ggate / (1.0f + e1); aW[2 * tid + 1] = ggate * e1 / (1.0f + e1);
                }
                __syncthreads();
                int myE = 0, rank = 0;
                if (tid < 128) { myE = aE[tid]; for (int a = 0; a < tid; ++a) rank += (aE[a] == myE) ? 1 : 0; }
                if (tid < NEXP) { int c = 0; for (int a = 0; a < 128; ++a) c += (aE[a] == tid) ? 1 : 0;
                    bs[tid] = c ? (int)__hip_atomic_fetch_add(cnt + tid * 64, (unsigned)c, __ATOMIC_RELAXED, __HIP_MEMORY_SCOPE_AGENT) : 0; }
#pragma unroll 2
                for (int it = 0; it < 8; ++it) {
                    const int ti = wid * 8 + it; const size_t tok = (size_t)chunk * 64 + ti; const float rstd = rs[ti];
#pragma unroll
                    for (int i = 0; i < 4; ++i) { const int d0 = (i * 64 + lane) * 4; const u32x2 xw = *(const u32x2*)(XB + tok * DM + d0); const f32x4 gv = *(const f32x4*)(g2 + d0);
                        u32x2 w; w.x = pack2(bflo(xw.x) * rstd * gv[0], bfhi(xw.x) * rstd * gv[1]); w.y = pack2(bflo(xw.y) * rstd * gv[2], bfhi(xw.y) * rstd * gv[3]);
                        *(u32x2*)(Hb + tok * DM + d0) = w; }
                }
                __syncthreads();
                if (tid < 128) { const int slot = bs[myE] + rank, tok = chunk * 64 + (tid >> 1);
                    tokE[(size_t)myE * ECAP + slot] = tok; tokW[(size_t)myE * ECAP + slot] = aW[tid]; asg[tok * 2 + (tid & 1)] = myE * ECAP + slot; }
                __syncthreads();
            }
        }
        SEAM(pb + 5);
        STAMP_BEGIN(pb + 6);
        for (int rep = 0; rep < REPS(6); ++rep) if (EN(6) && IN(pb + 6)) {
            asm volatile("; PHASE_MARK 6");
            LAYER_PTRS;
            build_moe_tables(LC, cnt);
            pg8::MoeOrder S{(const char*)Hb, (const char*)WguT, (size_t)DM * DM * 2, DM, LC + LI_TB, LC + LI_PS, LC + LI_CN, LC + LI_ORD, tokE, G, vcu, true};
            pg8::EpiSwiGLU E{ACT};
            pg8::gemm_phase<pg8::EpiSwiGLU, pg8::MoeOrder, 0, true, true>(lds, DM, S, E);
        }
        SEAM(pb + 6);
        STAMP_BEGIN(pb + 7);
        for (int rep = 0; rep < REPS(7); ++rep) if (EN(7) && IN(pb + 7)) {
            asm volatile("; PHASE_MARK 7");
            LAYER_PTRS;
            build_moe_tables(LC, cnt);
            pg8::MoeOrder S{(const char*)ACT, (const char*)WdT, (size_t)DM * EH * 2, EH, LC + LI_TB, LC + LI_PS, LC + LI_CN, LC + LI_ORD, tokE, G, vcu, false};
            pg8::EpiDown E{YB, tokW};
            pg8::gemm_phase<pg8::EpiDown, pg8::MoeOrder, 0, false, true>(lds, EH, S, E);
        }
        SEAM(pb + 7);
        STAMP_BEGIN(pb + 8);
        if (EN(8) && IN(pb + 8)) {
            asm volatile("; PHASE_MARK 8");
            LAYER_PTRS;
            build_moe_tables(LC, cnt);
            const bool lastl = (l == DEPTH - 1);
            const float* g1n = ka->in[1] + (size_t)(lastl ? 0 : (l + 1)) * DM;
            for (int grp = gw; grp < NTOK / 4; grp += NGW) {
                const size_t t0 = (size_t)grp * 4;
                const int myasg = (lane < 8) ? asg[t0 * 2 + lane] : 0;
                u32x2 xv[4][4], ya[4][4], yb[4][4];
#pragma unroll
                for (int q = 0; q < 4; ++q) {
                    const int i0 = __builtin_amdgcn_readlane(myasg, 2 * q), i1 = __builtin_amdgcn_readlane(myasg, 2 * q + 1);
                    const size_t s0 = (size_t)(LC[LI_PS + (i0 >> 14)] + (i0 & (ECAP - 1))), s1 = (size_t)(LC[LI_PS + (i1 >> 14)] + (i1 & (ECAP - 1)));
#pragma unroll
                    for (int i = 0; i < 4; ++i) { const int d0 = (i * 64 + lane) * 4;
                        xv[q][i] = *(const u32x2*)(XB + (t0 + q) * DM + d0); ya[q][i] = *(const u32x2*)(YB + s0 * DM + d0); yb[q][i] = *(const u32x2*)(YB + s1 * DM + d0); }
                }
#pragma unroll
                for (int q = 0; q < 4; ++q) {
                    f32x4 v[4]; float ss = 0.f;
#pragma unroll
                    for (int i = 0; i < 4; ++i) { const int d0 = (i * 64 + lane) * 4; const u32x2 a = ya[q][i], b = yb[q][i], x4 = xv[q][i];
                        v[i][0] = bflo(x4.x) + bflo(a.x) + bflo(b.x); v[i][1] = bfhi(x4.x) + bfhi(a.x) + bfhi(b.x); v[i][2] = bflo(x4.y) + bflo(a.y) + bflo(b.y); v[i][3] = bfhi(x4.y) + bfhi(a.y) + bfhi(b.y);
                        ss += (v[i][0] * v[i][0] + v[i][1] * v[i][1]) + (v[i][2] * v[i][2] + v[i][3] * v[i][3]);
                        if (lastl) *(f32x4*)(ka->out + (t0 + q) * DM + d0) = v[i];
                        else { u32x2 w; w.x = pack2(v[i][0], v[i][1]); w.y = pack2(v[i][2], v[i][3]); *(u32x2*)(XB + (t0 + q) * DM + d0) = w; } }
                    if (!lastl) {
                        ss = wave_sum(ss);
                        const float rstd = rsqrtf(ss * (1.0f / DM) + RMS_EPS);
#pragma unroll
                        for (int i = 0; i < 4; ++i) { const int d0 = (i * 64 + lane) * 4; const f32x4 gv = *(const f32x4*)(g1n + d0);
                            u32x2 w; w.x = pack2(v[i][0] * rstd * gv[0], v[i][1] * rstd * gv[1]); w.y = pack2(v[i][2] * rstd * gv[2], v[i][3] * rstd * gv[3]);
                            *(u32x2*)(Hb + (t0 + q) * DM + d0) = w; }
                    }
                }
            }
            if (!lastl) {
                __syncthreads();
                ExpertItems I{ka->in[15] + (size_t)(l + 1) * NEXP * DM * EH, ka->in[16] + (size_t)(l + 1) * NEXP * DM * EH, ka->in[17] + (size_t)(l + 1) * NEXP * EH * DM, WguT, WdT};
                convert_items(I, (LAS float*)(lds + wid * 8704), lane, gw, NGW);
            }
        }
        if (l + 1 < DEPTH) SEAM(pb + 8); else if (PROBE_B == pb + 8) ts1 = __builtin_amdgcn_s_memrealtime();
    }

__global__ void __launch_bounds__(NTHREADS, 2) fwd_kernel(Args args) {
    extern __shared__ __attribute__((aligned(16))) unsigned char lds_raw[];
    LAS unsigned char* lds = (LAS unsigned char*)lds_raw;
    LAS int* LC = (LAS int*)(lds + LCTL_OFF);
    const int G0 = gridDim.x, bx0 = blockIdx.x;
    const int vcu0 = (G0 % 8 == 0) ? (bx0 % 8) * (G0 / 8) + bx0 / 8 : bx0;
    if (threadIdx.x < 4) LC[LI_BAR + threadIdx.x] = 0;
    __syncthreads();
    XcdBarrier bar; bar.bar = (unsigned*)(args.ws + OFF_CTRL) + CW_BAR; bar.x = 0; bar.st = nullptr;
    if (MK_N_LAUNCHES == 1) bar = xcd_barrier_post(bar.bar, (volatile LAS unsigned*)(LC + LI_BAR));
    const int lo = args.ph_lo, hi = args.ph_hi;
    unsigned long long ts0 = 0ull, ts1 = 0ull;
    STAMP_BEGIN(0);
    for (int rep = 0; rep < REPS(9); ++rep) if (EN(9) && IN(0)) {
        asm volatile("; PHASE_MARK 9");
        PHASE_PTRS; const int tid = opaque_tid(), lane = tid & 63, wid = __builtin_amdgcn_readfirstlane(tid >> 6), gw = vcu * NWAVES + wid;
        LAS float* scr = (LAS float*)(lds + wid * 8704);
        { SmallItems I{ka->in[2], ka->in[5], ka->in[9], WinT, WaT, WoT}; convert_items(I, scr, lane, gw, NGW); }
        for (int o = gw; o < DEPTH * (DM / 64) * (PW / 8); o += NGW) {
            const int l = o / ((DM / 64) * (PW / 8)), r = o % ((DM / 64) * (PW / 8)), kb = r / (DM / 64), n = (r % (DM / 64)) * 64 + lane, k0 = kb * 8, g = k0 >> 7;
            const cfp wm = (cfp)(unsigned long long)(ka->in[6] + (size_t)l * 4 * 128 * 128 + (size_t)k0 * 128);
            const cfp sc = (cfp)(unsigned long long)(ka->in[7] + (size_t)l * PW + g * 128);
            const float* wp = ka->in[8] + (size_t)l * PW * DM + (size_t)(g * 128) * DM + n;
            float a[8] = {0.f, 0.f, 0.f, 0.f, 0.f, 0.f, 0.f, 0.f};
#pragma unroll 8
            for (int dd = 0; dd < 128; ++dd) { const float w = wp[(size_t)dd * DM] * sc[dd];
#pragma unroll
                for (int c = 0; c < 8; ++c) a[c] += w * wm[c * 128 + dd]; }
            u32x4 ow; ow.x = pack2(a[0], a[1]); ow.y = pack2(a[2], a[3]); ow.z = pack2(a[4], a[5]); ow.w = pack2(a[6], a[7]);
            *(u32x4*)(WppT + (size_t)l * DM * PW + (size_t)n * PW + k0) = ow;
        }
        for (int o = bx * NTHREADS + tid; o < DEPTH * 48 * DM; o += G * NTHREADS) {
            const int l = o / (48 * DM), r = o % (48 * DM), oo = r / DM, d = r % DM;
            float w = 0.f;
            if (oo < 4) w = ka->in[11][(size_t)l * DM * 4 + (size_t)d * 4 + oo];
            else if (oo < 36) w = ka->in[13][(size_t)l * 4 * DM * 8 + ((size_t)((oo - 4) >> 3) * DM + d) * 8 + ((oo - 4) & 7)];
            w *= ka->in[10][(size_t)l * DM + d];
            const bf16_t hi = f2bf(w); const float hf = __uint_as_float((unsigned)hi << 16);
            ((bf16_t*)(ws + OFF_WRH))[o] = hi; ((bf16_t*)(ws + OFF_WRL))[o] = f2bf(w - hf);
        }
        { ExpertItems I{ka->in[15], ka->in[16], ka->in[17], WguT, WdT}; convert_items(I, scr, lane, gw, NGW); }
        for (int m = gw; m < NTOK; m += NGW) norm_row(x_in + (size_t)m * DM, ka->in[1], Hb + (size_t)m * DM, lane);
    }
    SEAM(0);

    layer_body<0>(bar, lds, LC, G0, bx0, vcu0, lo, hi, ts0, ts1);
    layer_body<1>(bar, lds, LC, G0, bx0, vcu0, lo, hi, ts0, ts1);
    if (PROBE_A >= 0 && blockIdx.x == 0) { const unsigned long long d = (ts1 - ts0) * 4ull, t0 = __builtin_amdgcn_s_memrealtime(); while (__builtin_amdgcn_s_memrealtime() - t0 < d) __builtin_amdgcn_s_sleep(8); }
#undef IN
#undef SEAM
}

extern "C" void kernel_launch(void* const* d_in, const int* in_sizes, int n_in, void* d_out, int out_size, void* d_ws, size_t ws_size, hipStream_t stream) {
    (void)in_sizes; (void)out_size;
    static int grid = 0;
    if (grid == 0) {
        int dev = 0, cus = 0;
        if (hipGetDevice(&dev) != hipSuccess || hipDeviceGetAttribute(&cus, hipDeviceAttributeMultiprocessorCount, dev) != hipSuccess) { grid = -1; return; }
        if (hipFuncSetAttribute((const void*)fwd_kernel, hipFuncAttributeMaxDynamicSharedMemorySize, LDS_BYTES) != hipSuccess) { grid = -1; return; }
        int per_cu = 0;
        (void)hipOccupancyMaxActiveBlocksPerMultiprocessor(&per_cu, (const void*)fwd_kernel, NTHREADS, LDS_BYTES);
        (void)hipGetLastError();
        grid = cus;
        if (n_in != 18 || ws_size < WS_NEED) { fprintf(stderr, "kernel_launch: unexpected inputs (n_in %d, ws %zu)\n", n_in, ws_size); grid = -1; return; }
    }
    if (grid < 0) return;
    (void)hipMemsetAsync((char*)d_ws + OFF_CTRL, 0, CTRL_BYTES, stream);
    Args a{};
    for (int i = 0; i < 18; ++i) a.in[i] = (const float*)d_in[i];
    a.out = (float*)d_out; a.ws = (unsigned char*)d_ws;
    constexpr int NPH = 1 + 9 * DEPTH;
    if (MK_N_LAUNCHES == 1) { a.ph_lo = 0; a.ph_hi = NPH; hipLaunchKernelGGL(fwd_kernel, dim3(grid), dim3(NTHREADS), LDS_BYTES, stream, a); }
    else { for (int p = 0; p < NPH; ++p) { a.ph_lo = p; a.ph_hi = p + 1; hipLaunchKernelGGL(fwd_kernel, dim3(grid), dim3(NTHREADS), LDS_BYTES, stream, a); } }
}
```

```cpp
#include <hip/hip_runtime.h>
#include <stdint.h>
#include <stdio.h>

#define LAS __attribute__((address_space(3)))
typedef unsigned short bf16_t;
typedef short bf16x8 __attribute__((ext_vector_type(8)));
typedef float f32x2 __attribute__((ext_vector_type(2)));
typedef float f32x4 __attribute__((ext_vector_type(4)));
typedef float f32x16 __attribute__((ext_vector_type(16)));
typedef unsigned u32x2 __attribute__((ext_vector_type(2)));
typedef unsigned u32x4 __attribute__((ext_vector_type(4)));
typedef __bf16 bfv2 __attribute__((ext_vector_type(2)));
typedef int i32x8 __attribute__((ext_vector_type(8)));
constexpr float W8_SCALE = 32.f, A8_SCALE = 8.f;

#ifndef MOE_FP8
#define MOE_FP8 1
#endif
#ifndef MK_N_LAUNCHES
#define MK_N_LAUNCHES 1
#endif

constexpr int DM = 1024, SEQ = 4096, NTOK = 16384, DEPTH = 2;
constexpr int HD = 64, AW = 512, PW = 512, INW = 4096;
constexpr int NEXP = 32, EH = 512, ECAP = NTOK;
constexpr float RMS_EPS = 1e-6f;
constexpr int NTHREADS = 512, NWAVES = 8;

constexpr size_t MB = 1024 * 1024;
constexpr size_t OFF_CTRL = 0, CTRL_BYTES = 65536;
constexpr size_t OFF_WIN  = 1 * MB;
constexpr size_t OFF_WA   = OFF_WIN + 16 * MB;
constexpr size_t OFF_WPP  = OFF_WA + 2 * MB;
constexpr size_t OFF_WO   = OFF_WPP + 2 * MB;
constexpr size_t OFF_WGU  = OFF_WO + 4 * MB;
constexpr size_t OFF_WD   = OFF_WGU + 64 * MB;
constexpr size_t OFF_H    = OFF_WD + 32 * MB;
constexpr size_t OFF_PROJ = OFF_H + 32 * MB;
constexpr size_t OFF_ACT  = OFF_PROJ;
constexpr size_t OFF_YB   = OFF_PROJ + 40 * MB;
constexpr size_t OFF_AC   = OFF_PROJ + 128 * MB;
constexpr size_t OFF_PL   = OFF_AC + 16 * MB;
constexpr size_t OFF_OG   = OFF_PL + 16 * MB;
constexpr size_t OFF_T1   = OFF_OG;
constexpr size_t OFF_ML   = OFF_OG + 48 * MB;
constexpr size_t OFF_XB   = OFF_ML + 4 * MB;
constexpr size_t OFF_TOKE = OFF_XB + 64 * MB;
constexpr size_t OFF_TOKW = OFF_TOKE + 2 * MB;
constexpr size_t OFF_ASG  = OFF_TOKW + 2 * MB;
constexpr size_t OFF_WRH  = OFF_ASG + 1 * MB;
constexpr size_t OFF_WRL  = OFF_WRH + 256 * 1024;
constexpr size_t WS_NEED  = OFF_WRL + 256 * 1024;
constexpr int CW_CNT = 1024;
constexpr int CW_BAR = 8192;
constexpr int RING_BYTES = 131072, LCTL_OFF = RING_BYTES, LDS_BYTES = RING_BYTES + 2048;
constexpr int LI_BAR = 0, LI_TB = 16, LI_PS = 64, LI_CN = 112, LI_NT = 15, LI_ORD = 144;

__device__ __forceinline__ float bflo(unsigned w) { return __uint_as_float(w << 16); }
__device__ __forceinline__ float bfhi(unsigned w) { return __uint_as_float(w & 0xffff0000u); }
__device__ __forceinline__ unsigned pack2(float lo, float hi) { f32x2 v = {lo, hi}; return __builtin_bit_cast(unsigned, __builtin_convertvector(v, bfv2)); }
__device__ __forceinline__ unsigned pack4_fp8(float a, float b, float c, float d) { unsigned w = 0u; w = __builtin_amdgcn_cvt_pk_fp8_f32(a, b, w, false); w = __builtin_amdgcn_cvt_pk_fp8_f32(c, d, w, true); return w; }
__device__ __forceinline__ bf16_t f2bf(float f) { return (bf16_t)(pack2(f, 0.f) & 0xffffu); }
__device__ __forceinline__ float wave_sum(float v) {
#pragma unroll
    for (int o = 32; o >= 1; o >>= 1) v += __shfl_xor(v, o);
    return v;
}
__device__ __forceinline__ int opaque_tid() { int t = (int)threadIdx.x; asm volatile("" : "+v"(t)); return t; }
__device__ __forceinline__ int opaque_s(int v) { asm volatile("" : "+s"(v)); return v; }
__device__ __forceinline__ float sigmoidf_(float v) { return 1.0f / (1.0f + __expf(-v)); }

#define XB_TMO      128
#define XB_XCNT(j)  (256  + 64 * (j))
#define XB_XSUB(j)  (1280 + 64 * (j))
#define XB_XGEN(j)  (2304 + 64 * (j))
#define XB_TOP      3328
#define XB_TOPGEN   3392
#define XCD_BAR_WORDS 3456
#define XB_SPIN_CAP (1u << 18)
__device__ __forceinline__ unsigned xb_ld(unsigned* p)              { return __hip_atomic_load(p, __ATOMIC_RELAXED, __HIP_MEMORY_SCOPE_AGENT); }
__device__ __forceinline__ unsigned xb_add(unsigned* p, unsigned v) { return __hip_atomic_fetch_add(p, v, __ATOMIC_RELAXED, __HIP_MEMORY_SCOPE_AGENT); }
__device__ __forceinline__ unsigned xb_xcc_id() { return (unsigned)__builtin_amdgcn_s_getreg((3 << 11) | 20) & 0xFu; }
#define XB_SPIN(cond, bar) do { unsigned _sp = 0; while (cond) { __builtin_amdgcn_s_sleep(1); \
    if ((++_sp & 255u) == 0u) { if (xb_ld(&(bar)[XB_TMO])) break; if (_sp > XB_SPIN_CAP) { atomicAdd(&(bar)[XB_TMO], 1u); break; } } } } while (0)
struct XcdBarrier { unsigned* bar; unsigned x; volatile LAS unsigned* st; };
__device__ __forceinline__ XcdBarrier xcd_barrier_post(unsigned* bar, volatile LAS unsigned* st) {
    XcdBarrier b; b.bar = bar; b.x = xb_xcc_id(); b.st = st;
    if (threadIdx.x == 0) (void)xb_add(&bar[XB_XCNT(b.x)], 1u);
    return b;
}
__device__ __forceinline__ void xcd_barrier_complete(unsigned* bar, unsigned x, unsigned& nloc, unsigned& nx) {
    const unsigned G = gridDim.x * gridDim.y * gridDim.z;
    unsigned sum, cnt, mine, sp = 0u;
    for (;;) {
        sum = 0u; cnt = 0u; mine = 0u;
#pragma unroll
        for (unsigned j = 0; j < 16; ++j) { const unsigned c = xb_ld(&bar[XB_XCNT(j)]); sum += c; cnt += (c > 0u) ? 1u : 0u; mine = (j == x) ? c : mine; }
        if (sum == G) break;
        __builtin_amdgcn_s_sleep(1);
        if ((++sp & 255u) == 0u) { if (xb_ld(&bar[XB_TMO])) break; if (sp > XB_SPIN_CAP) { atomicAdd(&bar[XB_TMO], 1u); break; } }
    }
    nloc = mine > 0u ? mine : 1u; nx = cnt > 0u ? cnt : 1u;
}
__device__ __forceinline__ void xcd_barrier(const XcdBarrier& b) {
    asm volatile("s_waitcnt vmcnt(0)" ::: "memory");
    __syncthreads();
    if (threadIdx.x == 0) {
        unsigned* bar = b.bar;
        __builtin_amdgcn_s_waitcnt(0);
        unsigned nloc = b.st[0], nx = b.st[1];
        if (nloc == 0u) { xcd_barrier_complete(bar, b.x, nloc, nx); b.st[0] = nloc; b.st[1] = nx; }
        const unsigned old = xb_add(&bar[XB_XSUB(b.x)], 1u);
        const unsigned gen = old / nloc;
        if (old + 1u == (gen + 1u) * nloc) {
            __builtin_amdgcn_fence(__ATOMIC_RELEASE, "agent");
            asm volatile("s_waitcnt vmcnt(0)" ::: "memory");
            const unsigned og = xb_add(&bar[XB_TOP], 1u);
            const unsigned tg = og / nx;
            if (og + 1u == (tg + 1u) * nx) xb_add(&bar[XB_TOPGEN], 1u);
            else XB_SPIN(xb_ld(&bar[XB_TOPGEN]) == tg, bar);
            __builtin_amdgcn_fence(__ATOMIC_ACQUIRE, "agent");
            xb_add(&bar[XB_XGEN(b.x)], 1u);
            asm volatile("s_waitcnt vmcnt(0)" ::: "memory");
        } else {
            XB_SPIN(xb_ld(&bar[XB_XGEN(b.x)]) == gen, bar);
            __builtin_amdgcn_fence(__ATOMIC_ACQUIRE, "agent");
            asm volatile("s_waitcnt vmcnt(0)" ::: "memory");
        }
    }
    __syncthreads();
}

namespace pg8 {
constexpr int BM = 256, BK = 64, HALF = 128, HTB = HALF * BK * 2, NXCD = 8, WGM = 8;
__device__ __forceinline__ int lds_byte(int r, int c) { const int st = (r >> 4) * 2 + (c >> 5), rr = r & 15, cc = c & 31, ob = rr * 64 + cc * 2; return st * 1024 + (ob ^ (((ob >> 9) & 1) << 5)); }
__device__ __forceinline__ void stage_rc(int b, int& R, int& C) { const int st = b / 1024, sb = b % 1024, swz = sb ^ (((sb >> 9) & 1) << 5); R = (st >> 1) * 16 + swz / 64; C = (st & 1) * 32 + (swz % 64) / 2; }
__device__ __forceinline__ int perm32(int rho) { const int n = rho >> 4, i = rho & 15; return 8 * (i >> 2) + 4 * n + (i & 3); }

struct Unit { const char* A; const char* B; int row0, col0, e, nvalid, j0; };

struct DenseOrder {
    const char* A; const char* Bt; int KB, nM, nN, nwg, G, c;
    __device__ __forceinline__ void init(const void* A_, const void* Bt_, int M, int N, int KB_, int G_, int c_) { A = (const char*)A_; Bt = (const char*)Bt_; KB = KB_; nM = M / BM; nN = N / BM; nwg = nM * nN; G = G_; c = c_; }
    __device__ __forceinline__ bool next(int i, Unit& u) const {
        const long L = (long)i * G + c; if (L >= nwg) return false;
        int wgid = (int)L; { const int q = nwg / NXCD, r = nwg % NXCD, xcd = wgid % NXCD, off = wgid / NXCD; wgid = (xcd < r ? xcd * (q + 1) : r * (q + 1) + (xcd - r) * q) + off; }
        const int nig = WGM * nN, gid = wgid / nig, fm = gid * WGM, gsz = (nM - fm) < WGM ? (nM - fm) : WGM;
        const int pm = fm + ((wgid % nig) % gsz), pn = (wgid % nig) / gsz;
        u.A = A + (size_t)pm * BM * KB; u.B = Bt + (size_t)pn * BM * KB; u.row0 = pm * BM; u.col0 = pn * BM; u.e = 0; u.nvalid = BM; u.j0 = 0; return true;
    }
    __device__ __forceinline__ unsigned row_off(const Unit&, int) const { return 0u; }
};
struct MoeOrder {
    const char* A; const char* Bt; size_t bExp; int KB; const LAS int* tb; const LAS int* ps; const LAS int* cn; const LAS int* ord; const int* tokE; int G, c; bool gather;
    __device__ __forceinline__ bool next(int i, Unit& u) const {
        const int L = i * G + c, total = tb[NEXP] * 4; if (L >= total) return false;
        const int rt = L >> 2, pn = L & 3;
        const int ej = __builtin_amdgcn_readfirstlane(ord[rt]);
        const int e = ej >> 8, j = ej & 255;
        const int pse = __builtin_amdgcn_readfirstlane(ps[e]), cne = __builtin_amdgcn_readfirstlane(cn[e]);
        u.e = e; u.row0 = pse + BM * j; u.col0 = pn * BM; u.nvalid = min(BM, cne - BM * j); u.j0 = e * ECAP + BM * j;
        u.B = Bt + (size_t)e * bExp + (size_t)pn * BM * KB;
        u.A = gather ? A : A + (size_t)u.row0 * KB;
        return true;
    }
    __device__ __forceinline__ unsigned row_off(const Unit& u, int R) const { const int t = R < u.nvalid ? tokE[u.j0 + R] : 0; return (unsigned)t * (unsigned)KB; }
};

template <class Epi, class Sched, int BMODE, bool GATHER, bool LIGHT = false, bool F8 = false>
__device__ __forceinline__ void gemm_phase(LAS unsigned char* lds, const int KB, const Sched& S, const Epi& E) {
    const int tid = opaque_tid(), wid = __builtin_amdgcn_readfirstlane(tid >> 6), lane = tid & 63, wr = wid >> 2, wc = wid & 3, fr = lane & 15, fq = lane >> 4;
    const int nt = KB / (BK * 2);
    unsigned voffA[2][2], voffAn[2][2], voffB[2]; int RA[2], CA[2];
#pragma unroll
    for (int i = 0; i < 2; ++i) { int R, C; stage_rc(tid * 16 + i * 8192, R, C); RA[i] = R; CA[i] = C;
        const int Rb = (BMODE == 1) ? (64 * (R >> 5) + perm32(R & 31)) : (Epi::PERM ? ((R & ~31) + perm32(R & 31)) : R);
        voffB[i] = (unsigned)(Rb * KB + C * 2);
#pragma unroll
        for (int h = 0; h < 2; ++h) { voffA[h][i] = (unsigned)((h * HALF + R) * KB + C * 2); voffAn[h][i] = voffA[h][i]; } }
    const size_t kstep = (size_t)(BK * 2);
    const size_t hstepB = (size_t)((BMODE == 1) ? 32 : HALF) * KB;
    const unsigned ldsw = (unsigned)wid * 1024u;
    const int aoff = lds_byte(wr * 64 + fr, fq * 8), boff = lds_byte(wc * 32 + fr, fq * 8);
#define PG8_SA(b, h) (((b) * 2 + (h)) * HTB)
#define PG8_SB(b, h) ((4 + (b) * 2 + (h)) * HTB)
#define PG8_STAGE2(bufoff, gbase, v0, v1) do { \
        __builtin_amdgcn_global_load_lds((const unsigned*)((const char*)(gbase) + (v0)), (LAS unsigned*)(lds + (bufoff) + ldsw), 16, 0, 0); \
        __builtin_amdgcn_global_load_lds((const unsigned*)((const char*)(gbase) + (v1)), (LAS unsigned*)(lds + (bufoff) + ldsw + 8192), 16, 0, 0); } while (0)
#define PG8_STAGEB(bufoff, gbase) PG8_STAGE2(bufoff, gbase, voffB[0], voffB[1])
#define PG8_STAGEA(bufoff, gbase, h, nx) PG8_STAGE2(bufoff, gbase, ((GATHER && (nx)) ? voffAn[h][0] : voffA[h][0]), ((GATHER && (nx)) ? voffAn[h][1] : voffA[h][1]))
#define PG8_LD32(p) __builtin_bit_cast(i32x8, __builtin_shufflevector(*(const LAS u32x4*)(p), *(const LAS u32x4*)((p) + 1024), 0, 1, 2, 3, 4, 5, 6, 7))
#define PG8_LDA(dst, b, h) do { _Pragma("unroll") for (int m = 0; m < 4; ++m) { if constexpr (F8) dst##8[m] = PG8_LD32(lds + PG8_SA(b, h) + aoff + m * 2048); \
        else { _Pragma("unroll") for (int k = 0; k < 2; ++k) dst[m][k] = *(const LAS bf16x8*)(lds + PG8_SA(b, h) + aoff + m * 2048 + k * 1024); } } } while (0)
#define PG8_LDB(dst, b, h) do { _Pragma("unroll") for (int n = 0; n < 2; ++n) { if constexpr (F8) dst##8[n] = PG8_LD32(lds + PG8_SB(b, h) + boff + n * 2048); \
        else { _Pragma("unroll") for (int k = 0; k < 2; ++k) dst[n][k] = *(const LAS bf16x8*)(lds + PG8_SB(b, h) + boff + n * 2048 + k * 1024); } } } while (0)
#define PG8_MMA(ai, bj, At, Bt) do { __builtin_amdgcn_s_setprio(1); _Pragma("unroll") for (int m = 0; m < 4; ++m) _Pragma("unroll") for (int n = 0; n < 2; ++n) { \
        if constexpr (F8) asm volatile("v_mfma_scale_f32_16x16x128_f8f6f4 %0, %1, %2, %0, %3, %3 op_sel_hi:[0,0,0]" : "+v"(acc[ai][bj][m][n]) : "v"(Bt##8[n]), "v"(At##8[m]), "v"(sc8));   \
        else { _Pragma("unroll") for (int k = 0; k < 2; ++k) acc[ai][bj][m][n] = __builtin_amdgcn_mfma_f32_16x16x32_bf16(Bt[n][k], At[m][k], acc[ai][bj][m][n], 0, 0, 0); } } \
        __builtin_amdgcn_s_setprio(0); } while (0)
#define PG8_WAIT_V(n) asm volatile("s_waitcnt vmcnt(" #n ")" ::: "memory")
#define PG8_WAIT_L(n) asm volatile("s_waitcnt lgkmcnt(" #n ")" ::: "memory")
#define PG8_BAR __builtin_amdgcn_s_barrier()
#define PG8_SCHED __builtin_amdgcn_sched_barrier(0)
    Unit cur, nxt; int ui = 0;
    if (!S.next(0, cur)) return;
    if (GATHER) {
#pragma unroll
        for (int h = 0; h < 2; ++h)
#pragma unroll
            for (int i = 0; i < 2; ++i) voffA[h][i] = S.row_off(cur, h * HALF + RA[i]) + (unsigned)CA[i] * 2u;
    }
    f32x4 acc[2][2][4][2];
#pragma unroll
    for (int a = 0; a < 2; ++a)
#pragma unroll
        for (int b = 0; b < 2; ++b)
#pragma unroll
            for (int m = 0; m < 4; ++m)
#pragma unroll
                for (int n = 0; n < 2; ++n) acc[a][b][m][n] = (f32x4){0.f, 0.f, 0.f, 0.f};
    unsigned sc8 = 0x7f7f7f7fu; asm volatile("" : "+v"(sc8));
    bf16x8 At[4][2], B0[2][2], B1[2][2]; i32x8 At8[4], B08[2], B18[2];
    const char* cA = cur.A; const char* cB = cur.B;
    PG8_STAGEB(PG8_SB(0, 0), cB); PG8_STAGEB(PG8_SB(0, 1), cB + hstepB); PG8_STAGEA(PG8_SA(0, 0), cA, 0, false); PG8_STAGEA(PG8_SA(0, 1), cA, 1, false);
    if (wr == 1) PG8_BAR;
    PG8_WAIT_V(2); PG8_BAR;
    PG8_STAGEB(PG8_SB(1, 0), cB + kstep); PG8_STAGEA(PG8_SA(1, 0), cA + kstep, 0, false); PG8_STAGEB(PG8_SB(1, 1), cB + hstepB + kstep);
    PG8_WAIT_V(6); PG8_BAR;
    for (;;) {
        const bool has_next = S.next(ui + 1, nxt);
        if (GATHER) {
#pragma unroll
            for (int h = 0; h < 2; ++h)
#pragma unroll
                for (int i = 0; i < 2; ++i) voffAn[h][i] = has_next ? (S.row_off(nxt, h * HALF + RA[i]) + (unsigned)CA[i] * 2u) : voffA[h][i];
        }
        const char* nA = has_next ? nxt.A : cA; const char* nB = has_next ? nxt.B : cB;
        const bool full = cur.nvalid > HALF;
        for (int t = 0; t < nt; t += 2) {
            const bool last = (t == nt - 2);
            const char* a1 = cA + (size_t)(t + 1) * kstep;
            const char* a2 = last ? nA : cA + (size_t)(t + 2) * kstep; const char* b2 = last ? nB : cB + (size_t)(t + 2) * kstep;
            const char* a3 = a2 + kstep; const char* b3 = b2 + kstep;
            PG8_LDB(B0, 0, 0); PG8_LDB(B1, 0, 1); PG8_SCHED; PG8_LDA(At, 0, 0); PG8_STAGEA(PG8_SA(1, 1), a1, 1, false);
            PG8_WAIT_V(8); PG8_WAIT_L(0); PG8_BAR; PG8_MMA(0, 0, At, B0); PG8_MMA(0, 1, At, B1); PG8_BAR; PG8_SCHED;
            PG8_LDA(At, 0, 1); PG8_STAGEB(PG8_SB(0, 0), b2); PG8_STAGEB(PG8_SB(0, 1), b2 + hstepB); PG8_STAGEA(PG8_SA(0, 0), a2, 0, last);
            PG8_WAIT_V(8); PG8_WAIT_L(0); PG8_BAR; if (!LIGHT || full) { PG8_MMA(1, 0, At, B0); PG8_MMA(1, 1, At, B1); } PG8_BAR; PG8_SCHED;
            PG8_LDB(B0, 1, 0); PG8_LDB(B1, 1, 1); PG8_SCHED; PG8_LDA(At, 1, 0); PG8_STAGEA(PG8_SA(0, 1), a2, 1, last);
            PG8_WAIT_V(8); PG8_WAIT_L(0); PG8_BAR; PG8_MMA(0, 0, At, B0); PG8_MMA(0, 1, At, B1); PG8_BAR; PG8_SCHED;
            PG8_LDA(At, 1, 1); PG8_STAGEB(PG8_SB(1, 0), b3); PG8_STAGEB(PG8_SB(1, 1), b3 + hstepB); PG8_STAGEA(PG8_SA(1, 0), a3, 0, last);
            PG8_WAIT_V(8); PG8_WAIT_L(0); PG8_BAR; if (!LIGHT || full) { PG8_MMA(1, 0, At, B0); PG8_MMA(1, 1, At, B1); } PG8_BAR; PG8_SCHED;
        }
        if (wr == 0) PG8_BAR;
        if constexpr (F8) asm volatile("s_nop 7\n\ts_nop 7\n\ts_nop 7" ::: "memory");
        E(acc, cur, wr, wc, fr, fq);
        if (!has_next) break;
#pragma unroll
        for (int a = 0; a < 2; ++a)
#pragma unroll
            for (int b = 0; b < 2; ++b)
#pragma unroll
                for (int m = 0; m < 4; ++m)
#pragma unroll
                    for (int n = 0; n < 2; ++n) acc[a][b][m][n] = (f32x4){0.f, 0.f, 0.f, 0.f};
        cur = nxt; cA = nA; cB = nB; ++ui;
        if (GATHER) {
#pragma unroll
            for (int h = 0; h < 2; ++h)
#pragma unroll
                for (int i = 0; i < 2; ++i) voffA[h][i] = voffAn[h][i];
        }
        if (wr == 1) PG8_BAR;
    }
    PG8_WAIT_V(0);
    PG8_BAR;
#undef PG8_SA
#undef PG8_SB
#undef PG8_STAGE2
#undef PG8_STAGEA
#undef PG8_STAGEB
#undef PG8_LDA
#undef PG8_LDB
#undef PG8_MMA
#undef PG8_LD32
#undef PG8_WAIT_V
#undef PG8_WAIT_L
#undef PG8_BAR
#undef PG8_SCHED
}

struct EpiProj {
    static constexpr bool PERM = true;
    bf16_t* out; const float* gq; const float* gk;
    __device__ __forceinline__ void operator()(const f32x4 (&acc)[2][2][4][2], const Unit& u, int wr, int wc, int fr, int fq) const {
        const int pn = u.col0 >> 8;
        const int row0 = u.row0 + wr * 64 + fr, colb = u.col0 + 64 * wc + 8 * fq;
        if (pn < 4) {
            const float* g = (pn < 2) ? gq : gk; const float post = (pn < 2) ? 0.125f : 1.0f;
            f32x4 gv[2][2];
#pragma unroll
            for (int bj = 0; bj < 2; ++bj)
#pragma unroll
                for (int n = 0; n < 2; ++n) gv[bj][n] = *(const f32x4*)(g + 32 * bj + 8 * fq + 4 * n) * post;
#pragma unroll
            for (int ai = 0; ai < 2; ++ai)
#pragma unroll
                for (int m = 0; m < 4; ++m) {
                    float ss = 0.f;
#pragma unroll
                    for (int bj = 0; bj < 2; ++bj)
#pragma unroll
                        for (int n = 0; n < 2; ++n) { const f32x4 x = acc[ai][bj][m][n]; ss += (x[0] * x[0] + x[1] * x[1]) + (x[2] * x[2] + x[3] * x[3]); }
                    ss += __shfl_xor(ss, 16); ss += __shfl_xor(ss, 32);
                    const float rstd = rsqrtf(ss * (1.0f / HD) + RMS_EPS);
                    bf16_t* rowp = out + (size_t)(row0 + ai * HALF + m * 16) * INW + colb;
#pragma unroll
                    for (int bj = 0; bj < 2; ++bj) { const f32x4 v0 = acc[ai][bj][m][0] * rstd * gv[bj][0], v1 = acc[ai][bj][m][1] * rstd * gv[bj][1];
                        u32x4 w; w.x = pack2(v0[0], v0[1]); w.y = pack2(v0[2], v0[3]); w.z = pack2(v1[0], v1[1]); w.w = pack2(v1[2], v1[3]);
                        *(u32x4*)(rowp + 32 * bj) = w; }
                }
        } else {
            const bool sg = pn >= 8;
#pragma unroll
            for (int ai = 0; ai < 2; ++ai)
#pragma unroll
                for (int m = 0; m < 4; ++m) {
                    bf16_t* rowp = out + (size_t)(row0 + ai * HALF + m * 16) * INW + colb;
#pragma unroll
                    for (int bj = 0; bj < 2; ++bj) { f32x4 v0 = acc[ai][bj][m][0], v1 = acc[ai][bj][m][1];
                        if (sg) {
#pragma unroll
                            for (int j = 0; j < 4; ++j) { v0[j] = sigmoidf_(v0[j]); v1[j] = sigmoidf_(v1[j]); } }
                        u32x4 w; w.x = pack2(v0[0], v0[1]); w.y = pack2(v0[2], v0[3]); w.z = pack2(v1[0], v1[1]); w.w = pack2(v1[2], v1[3]);
                        *(u32x4*)(rowp + 32 * bj) = w; }
                }
        }
    }
};
template <int MODE> struct EpiGate {
    static constexpr bool PERM = true;
    const bf16_t* gate; const bf16_t* t1in; bf16_t* out;
    __device__ __forceinline__ void operator()(const f32x4 (&acc)[2][2][4][2], const Unit& u, int wr, int wc, int fr, int fq) const {
        const int row0 = u.row0 + wr * 64 + fr, col0 = u.col0 + wc * 32 + 8 * fq;
#pragma unroll
        for (int ai = 0; ai < 2; ++ai)
#pragma unroll
            for (int m = 0; m < 4; ++m) {
                const size_t r = (size_t)(row0 + ai * HALF + m * 16);
#pragma unroll
                for (int bj = 0; bj < 2; ++bj) {
                    const int c = col0 + bj * HALF;
                    const u32x4 g = *(const u32x4*)(gate + r * INW + c);
                    const f32x4 a0 = acc[ai][bj][m][0], a1 = acc[ai][bj][m][1];
                    float o[8] = {a0[0] * bflo(g.x), a0[1] * bfhi(g.x), a0[2] * bflo(g.y), a0[3] * bfhi(g.y), a1[0] * bflo(g.z), a1[1] * bfhi(g.z), a1[2] * bflo(g.w), a1[3] * bfhi(g.w)};
                    if (MODE == 1) { const u32x4 t = *(const u32x4*)(t1in + r * DM + c);
                        o[0] += bflo(t.x); o[1] += bfhi(t.x); o[2] += bflo(t.y); o[3] += bfhi(t.y); o[4] += bflo(t.z); o[5] += bfhi(t.z); o[6] += bflo(t.w); o[7] += bfhi(t.w); }
                    u32x4 w; w.x = pack2(o[0], o[1]); w.y = pack2(o[2], o[3]); w.z = pack2(o[4], o[5]); w.w = pack2(o[6], o[7]);
                    *(u32x4*)(out + r * DM + c) = w;
                }
            }
    }
};
template <bool XF32> struct EpiResid {
    static constexpr bool PERM = true;
    const float* xf; bf16_t* xb;
    __device__ __forceinline__ void operator()(const f32x4 (&acc)[2][2][4][2], const Unit& u, int wr, int wc, int fr, int fq) const {
        const int row0 = u.row0 + wr * 64 + fr, col0 = u.col0 + wc * 32 + 8 * fq;
#pragma unroll
        for (int ai = 0; ai < 2; ++ai)
#pragma unroll
            for (int m = 0; m < 4; ++m) { const size_t off = (size_t)(row0 + ai * HALF + m * 16) * DM + col0;
#pragma unroll
                for (int bj = 0; bj < 2; ++bj) {
                    float x[8];
                    if (XF32) { const f32x4 a = *(const f32x4*)(xf + off + bj * HALF), b = *(const f32x4*)(xf + off + bj * HALF + 4);
                        x[0] = a[0]; x[1] = a[1]; x[2] = a[2]; x[3] = a[3]; x[4] = b[0]; x[5] = b[1]; x[6] = b[2]; x[7] = b[3]; }
                    else { const u32x4 t = *(const u32x4*)(xb + off + bj * HALF);
                        x[0] = bflo(t.x); x[1] = bfhi(t.x); x[2] = bflo(t.y); x[3] = bfhi(t.y); x[4] = bflo(t.z); x[5] = bfhi(t.z); x[6] = bflo(t.w); x[7] = bfhi(t.w); }
                    const f32x4 a0 = acc[ai][bj][m][0], a1 = acc[ai][bj][m][1];
                    u32x4 w; w.x = pack2(x[0] + a0[0], x[1] + a0[1]); w.y = pack2(x[2] + a0[2], x[3] + a0[3]); w.z = pack2(x[4] + a1[0], x[5] + a1[1]); w.w = pack2(x[6] + a1[2], x[7] + a1[3]);
                    *(u32x4*)(xb + off + bj * HALF) = w;
                }
            }
    }
};
template <bool F8> struct EpiSwiGLU {
    static constexpr bool PERM = true;
    void* act;
    __device__ __forceinline__ void operator()(const f32x4 (&acc)[2][2][4][2], const Unit& u, int wr, int wc, int fr, int fq) const {
        const int row0 = u.row0 + wr * 64 + fr, col0 = (u.col0 >> 1) + wc * 32 + 8 * fq;
        const float si = F8 ? (1.0f / W8_SCALE) : 1.0f, so = F8 ? A8_SCALE : 1.0f;
#pragma unroll
        for (int ai = 0; ai < 2; ++ai)
#pragma unroll
            for (int m = 0; m < 4; ++m) {
                float o[8];
#pragma unroll
                for (int n = 0; n < 2; ++n)
#pragma unroll
                    for (int j = 0; j < 4; ++j) { const float a = acc[ai][0][m][n][j] * si, b = acc[ai][1][m][n][j] * (si * so); o[4 * n + j] = a * sigmoidf_(a) * b; }
                const size_t off = (size_t)(row0 + ai * HALF + m * 16) * EH + col0;
                if (F8) { u32x2 w; w.x = pack4_fp8(o[0], o[1], o[2], o[3]); w.y = pack4_fp8(o[4], o[5], o[6], o[7]); *(u32x2*)((unsigned char*)act + off) = w; }
                else { u32x4 w; w.x = pack2(o[0], o[1]); w.y = pack2(o[2], o[3]); w.z = pack2(o[4], o[5]); w.w = pack2(o[6], o[7]); *(u32x4*)((bf16_t*)act + off) = w; }
            }
    }
};
template <bool F8> struct EpiDown {
    static constexpr bool PERM = true;
    bf16_t* yb; const float* tokW;
    __device__ __forceinline__ void operator()(const f32x4 (&acc)[2][2][4][2], const Unit& u, int wr, int wc, int fr, int fq) const {
        const int col0 = u.col0 + wc * 32 + 8 * fq;
        const float si = F8 ? (1.0f / (W8_SCALE * A8_SCALE)) : 1.0f;
#pragma unroll
        for (int ai = 0; ai < 2; ++ai)
#pragma unroll
            for (int m = 0; m < 4; ++m) {
                const int rl = wr * 64 + fr + ai * HALF + m * 16;
                const float w = rl < u.nvalid ? tokW[u.j0 + rl] * si : 0.f;
#pragma unroll
                for (int bj = 0; bj < 2; ++bj) { const f32x4 v0 = acc[ai][bj][m][0] * w, v1 = acc[ai][bj][m][1] * w;
                    u32x4 o; o.x = pack2(v0[0], v0[1]); o.y = pack2(v0[2], v0[3]); o.z = pack2(v1[0], v1[1]); o.w = pack2(v1[2], v1[3]);
                    *(u32x4*)(yb + (size_t)(u.row0 + rl) * DM + col0 + bj * HALF) = o; }
            }
    }
};
}

constexpr int ATT_K_OFF = 0, ATT_V_OFF = 49152;
__device__ __forceinline__ unsigned kv_off(unsigned row, unsigned ch) { return row * 128u + 16u * (ch ^ (((row >> 1) & 7u) ^ ((row & 2u) << 1))); }

struct AttnU { int tok0, d, blk, g, h; };
__device__ __forceinline__ AttnU attn_decode(int uidx) {
    const int bh = uidx / 48, r48 = uidx % 48, g = r48 >> 4, rr = r48 & 15;
    AttnU U; U.g = g; U.h = bh & 7;
    U.d = (g == 0) ? 1 : (g == 1 ? 4 : 16);
    const int c = (g == 0) ? 0 : (g == 1 ? (rr >> 2) : rr);
    U.blk = (g == 0) ? rr : (g == 1 ? (rr & 3) : 0);
    U.tok0 = (bh >> 3) * SEQ + c;
    return U;
}
__device__ __forceinline__ void attn_load_q(const AttnU& U, const bf16_t* __restrict__ proj, int wid, int lane, bf16x8 (&qn)[4]) {
    const size_t qt = (size_t)(U.tok0 + (256 * U.blk + 32 * wid + (lane & 31)) * U.d);
#pragma unroll
    for (int ks = 0; ks < 4; ++ks) qn[ks] = *(const bf16x8*)(proj + qt * INW + U.h * HD + 16 * ks + 8 * (lane >> 5));
}
__device__ __forceinline__ void attn_load(const AttnU& U, const bf16_t* __restrict__ proj, int tid, u32x4 (&kr)[6], u32x4 (&vr)[6]) {
    const int kbase = 256 * U.blk - 128, kr_min = (U.blk == 0) ? 128 : 0;
#pragma unroll
    for (int i = 0; i < 6; ++i) {
        const int idx = tid + NTHREADS * i, row = idx >> 3, ch = idx & 7;
        if (row >= kr_min) {
            const size_t t = (size_t)(U.tok0 + (kbase + row) * U.d);
            kr[i] = *(const u32x4*)(proj + t * INW + AW + U.h * HD + ch * 8);
            vr[i] = *(const u32x4*)(proj + t * INW + 2 * AW + U.h * HD + ch * 8);
        }
    }
}
__device__ __forceinline__ void attn_lds_store(const AttnU& U, LAS unsigned char* lds, int tid, const u32x4 (&kr)[6], const u32x4 (&vr)[6]) {
    const int kr_min = (U.blk == 0) ? 128 : 0;
#pragma unroll
    for (int i = 0; i < 6; ++i) {
        const int idx = tid + NTHREADS * i, row = idx >> 3, ch = idx & 7;
        if (row >= kr_min) { *(LAS u32x4*)(lds + ATT_K_OFF + kv_off(row, ch)) = kr[i]; *(LAS u32x4*)(lds + ATT_V_OFF + kv_off(row, ch)) = vr[i]; }
    }
}
__device__ __forceinline__ void attn_compute(const AttnU& U, LAS unsigned char* lds, const bf16x8 (&qf)[4], bf16_t* __restrict__ og, f32x2* __restrict__ ml, int wid, int lane) {
    const int blk = U.blk, g = U.g, h = U.h;
    const size_t qt = (size_t)(U.tok0 + (256 * blk + 32 * wid + (lane & 31)) * U.d);
    const int kt_min = (blk == 0) ? max(0, 4 - wid) : 0;
    const int hq = lane >> 5, qi = lane & 31;
    f32x16 S[5];
#pragma unroll
    for (int kt = 0; kt < 5; ++kt) {
#pragma unroll
        for (int i = 0; i < 16; ++i) S[kt][i] = 0.f;
        if (kt >= kt_min) {
            const unsigned krow = (unsigned)(32 * wid + 32 * kt + qi);
#pragma unroll
            for (int ks = 0; ks < 4; ++ks) {
                const bf16x8 kf = *(const LAS bf16x8*)(lds + ATT_K_OFF + kv_off(krow, (unsigned)(2 * ks + hq)));
                S[kt] = __builtin_amdgcn_mfma_f32_32x32x16_bf16(kf, qf[ks], S[kt], 0, 0, 0);
            }
        }
    }
    float mx = -3.0e38f;
#pragma unroll
    for (int kt = 0; kt < 5; ++kt)
#pragma unroll
        for (int i = 0; i < 16; ++i) {
            const int row = (i & 3) + 8 * (i >> 2) + 4 * hq;
            bool valid = kt >= kt_min;
            if (kt == 0) valid = valid && (row >= qi);
            if (kt == 4) valid = valid && (row <= qi);
            S[kt][i] = valid ? S[kt][i] : -3.0e38f;
            mx = fmaxf(mx, S[kt][i]);
        }
    mx = fmaxf(mx, __shfl_xor(mx, 32));
    float lsum = 0.f;
#pragma unroll
    for (int kt = 0; kt < 5; ++kt)
#pragma unroll
        for (int i = 0; i < 16; ++i) { const float p = (S[kt][i] > -1.0e38f) ? __expf(S[kt][i] - mx) : 0.f; S[kt][i] = p; lsum += p; }
    lsum += __shfl_xor(lsum, 32);
    f32x16 O[2];
#pragma unroll
    for (int dt = 0; dt < 2; ++dt)
#pragma unroll
        for (int i = 0; i < 16; ++i) O[dt][i] = 0.f;
    const unsigned blkq = (lane >> 4) & 1, q4 = (lane & 15) >> 2, p4 = lane & 3;
    const unsigned vbase = (unsigned)(size_t)(lds + ATT_V_OFF);
#pragma unroll
    for (int kt = 0; kt < 5; ++kt) {
        if (kt >= kt_min) {
#pragma unroll
            for (int s = 0; s < 2; ++s) {
                u32x4 pw;
                pw.x = pack2(S[kt][8 * s + 0], S[kt][8 * s + 1]); pw.y = pack2(S[kt][8 * s + 2], S[kt][8 * s + 3]);
                pw.z = pack2(S[kt][8 * s + 4], S[kt][8 * s + 5]); pw.w = pack2(S[kt][8 * s + 6], S[kt][8 * s + 7]);
                const bf16x8 pf = __builtin_bit_cast(bf16x8, pw);
                u32x2 v00, v01, v10, v11;
                const unsigned r0 = (unsigned)(32 * wid + 32 * kt + 16 * s + 4 * hq) + q4, r1 = r0 + 8;
                const unsigned a00 = vbase + kv_off(r0, 0u + 2 * blkq + (p4 >> 1)) + 8 * (p4 & 1), a01 = vbase + kv_off(r1, 0u + 2 * blkq + (p4 >> 1)) + 8 * (p4 & 1);
                const unsigned a10 = vbase + kv_off(r0, 4u + 2 * blkq + (p4 >> 1)) + 8 * (p4 & 1), a11 = vbase + kv_off(r1, 4u + 2 * blkq + (p4 >> 1)) + 8 * (p4 & 1);
                asm volatile("ds_read_b64_tr_b16 %0, %4\n\tds_read_b64_tr_b16 %1, %5\n\tds_read_b64_tr_b16 %2, %6\n\tds_read_b64_tr_b16 %3, %7\n\ts_waitcnt lgkmcnt(0)"
                             : "=&v"(v00), "=&v"(v01), "=&v"(v10), "=&v"(v11) : "v"(a00), "v"(a01), "v"(a10), "v"(a11) : "memory");
                u32x4 f0; f0.x = v00.x; f0.y = v00.y; f0.z = v01.x; f0.w = v01.y;
                u32x4 f1; f1.x = v10.x; f1.y = v10.y; f1.z = v11.x; f1.w = v11.y;
                O[0] = __builtin_amdgcn_mfma_f32_32x32x16_bf16(__builtin_bit_cast(bf16x8, f0), pf, O[0], 0, 0, 0);
                O[1] = __builtin_amdgcn_mfma_f32_32x32x16_bf16(__builtin_bit_cast(bf16x8, f1), pf, O[1], 0, 0, 0);
            }
        }
    }
    const float inv = 1.0f / lsum;
    bf16_t* orow = og + ((size_t)g * NTOK + qt) * AW + h * HD;
#pragma unroll
    for (int dt = 0; dt < 2; ++dt)
#pragma unroll
        for (int gq4 = 0; gq4 < 4; ++gq4) {
            u32x2 w; w.x = pack2(O[dt][4 * gq4 + 0] * inv, O[dt][4 * gq4 + 1] * inv); w.y = pack2(O[dt][4 * gq4 + 2] * inv, O[dt][4 * gq4 + 3] * inv);
            *(u32x2*)(orow + 32 * dt + 8 * gq4 + 4 * hq) = w;
        }
    if (lane < 32) ml[((size_t)g * NTOK + qt) * 8 + h] = (f32x2){mx, lsum};
    __syncthreads();
}

struct TrDesc { const float* src; bf16_t* dst; int N, K; };
__device__ __forceinline__ void tr_load(const TrDesc& d, int lane, f32x4 (&r)[8]) {
#pragma unroll
    for (int i = 0; i < 8; ++i) r[i] = __builtin_nontemporal_load((const f32x4*)(d.src + (size_t)((lane >> 3) + 8 * i) * d.N + 4 * (lane & 7)));
}
__device__ __forceinline__ void tr_store(const TrDesc& d, LAS float* scr, int lane, const f32x4 (&r)[8]) {
#pragma unroll
    for (int i = 0; i < 8; ++i) { LAS float* p = scr + ((lane >> 3) + 8 * i) * 33 + 4 * (lane & 7); p[0] = r[i][0]; p[1] = r[i][1]; p[2] = r[i][2]; p[3] = r[i][3]; }
    const int c = lane & 7;
#pragma unroll
    for (int j = 0; j < 4; ++j) { const int n = (lane >> 3) + 8 * j; const LAS float* q = scr + (8 * c) * 33 + n;
        u32x4 o; o.x = pack2(q[0 * 33], q[1 * 33]); o.y = pack2(q[2 * 33], q[3 * 33]); o.z = pack2(q[4 * 33], q[5 * 33]); o.w = pack2(q[6 * 33], q[7 * 33]);
        *(u32x4*)(d.dst + (size_t)n * d.K + 8 * c) = o; }
}
struct ExpertItems {
    const float* weg; const float* weu; const float* wed; bf16_t* WguT; bf16_t* WdT;
    static constexpr int TOTAL = 3 * NEXP * 256;
    __device__ __forceinline__ TrDesc operator()(int it) const {
        const int which = it >> 13, r = it & 8191, e = r >> 8, item = r & 255; TrDesc d;
        if (which < 2) { const int kb = item >> 4, nb = item & 15, k0 = 64 * kb, n0 = 32 * nb, nn0 = (n0 >> 7) * 256 + which * 128 + (n0 & 127);
            d.src = (which == 0 ? weg : weu) + (size_t)e * DM * EH + (size_t)k0 * EH + n0; d.dst = WguT + (size_t)e * DM * DM + (size_t)nn0 * DM + k0; d.N = EH; d.K = DM; }
        else { const int kb = item >> 5, nb = item & 31, k0 = 64 * kb, n0 = 32 * nb;
            d.src = wed + (size_t)e * EH * DM + (size_t)k0 * DM + n0; d.dst = WdT + (size_t)e * DM * EH + (size_t)n0 * EH + k0; d.N = DM; d.K = EH; }
        return d;
    }
};
struct SmallItems {
    const float* win; const float* wa; const float* wo; bf16_t* WinT; bf16_t* WaT; bf16_t* WoT;
    static constexpr int TOTAL = 2 * 2816;
    __device__ __forceinline__ TrDesc operator()(int it) const {
        const int l = it / 2816, r = it % 2816; TrDesc d;
        if (r < 2048) { const int kb = r >> 7, nb = r & 127; d.src = win + (size_t)l * DM * INW + (size_t)(64 * kb) * INW + 32 * nb; d.dst = WinT + (size_t)l * INW * DM + (size_t)(32 * nb) * DM + 64 * kb; d.N = INW; d.K = DM; }
        else if (r < 2304) { const int q = r - 2048, kb = q >> 5, nb = q & 31; d.src = wa + (size_t)l * AW * DM + (size_t)(64 * kb) * DM + 32 * nb; d.dst = WaT + (size_t)l * DM * AW + (size_t)(32 * nb) * AW + 64 * kb; d.N = DM; d.K = AW; }
        else { const int q = r - 2304, kb = q >> 5, nb = q & 31; d.src = wo + (size_t)l * DM * DM + (size_t)(64 * kb) * DM + 32 * nb; d.dst = WoT + (size_t)l * DM * DM + (size_t)(32 * nb) * DM + 64 * kb; d.N = DM; d.K = DM; }
        return d;
    }
};
template <class Items>
__device__ __forceinline__ void convert_items(const Items& I, LAS float* scr, int lane, int gw, int NGW) {
    f32x4 ra[8], rb[8];
    int it = gw;
    if (it >= Items::TOTAL) return;
    TrDesc da = I(it), db = da;
    tr_load(da, lane, ra);
    for (;;) {
        int it2 = it + NGW;
        if (it2 < Items::TOTAL) { db = I(it2); tr_load(db, lane, rb); }
        tr_store(da, scr, lane, ra);
        it = it2; if (it >= Items::TOTAL) break;
        it2 = it + NGW;
        if (it2 < Items::TOTAL) { da = I(it2); tr_load(da, lane, ra); }
        tr_store(db, scr, lane, rb);
        it = it2; if (it >= Items::TOTAL) break;
    }
}
__device__ __forceinline__ int tr8_swz(int k) { return (k & 31) ^ ((k >> 5) << 3); }
__device__ __forceinline__ void tr_load8(const TrDesc& d, int lane, f32x4 (&r)[16]) {
#pragma unroll
    for (int i = 0; i < 16; ++i) r[i] = __builtin_nontemporal_load((const f32x4*)(d.src + (size_t)((lane >> 3) + 8 * i) * d.N + 4 * (lane & 7)));
}
__device__ __forceinline__ void tr_write8(LAS float* scr, int lane, const f32x4 (&r)[16]) {
#pragma unroll
    for (int i = 0; i < 16; ++i) { const int kk = (lane >> 3) + 8 * i, sw = tr8_swz(kk), n4 = 4 * (lane & 7); LAS float* p = scr + kk * 32;
        p[(n4 + 0) ^ sw] = r[i][0]; p[(n4 + 1) ^ sw] = r[i][1]; p[(n4 + 2) ^ sw] = r[i][2]; p[(n4 + 3) ^ sw] = r[i][3]; }
}
__device__ __forceinline__ void tr_out8(const TrDesc& d, const LAS float* scr, int lane) {
    const int c = lane >> 3;
#pragma unroll
    for (int j = 0; j < 4; ++j) { const int n = (lane & 7) + 8 * j; float f[16];
#pragma unroll
        for (int q = 0; q < 16; ++q) { const int k = 16 * c + q; f[q] = scr[k * 32 + (n ^ tr8_swz(k))] * W8_SCALE; }
        u32x4 o; o.x = pack4_fp8(f[0], f[1], f[2], f[3]); o.y = pack4_fp8(f[4], f[5], f[6], f[7]); o.z = pack4_fp8(f[8], f[9], f[10], f[11]); o.w = pack4_fp8(f[12], f[13], f[14], f[15]);
        *(u32x4*)((unsigned char*)d.dst + (size_t)n * d.K + 16 * c) = o; }
}
struct ExpertItems8 {
    const float* weg; const float* weu; const float* wed; unsigned char* WguT; unsigned char* WdT;
    static constexpr int TOTAL = 3 * NEXP * 128;
    __device__ __forceinline__ TrDesc operator()(int it) const {
        const int which = it >> 12, r = it & 4095, e = r >> 7, item = r & 127; TrDesc d;
        if (which < 2) { const int kb = item >> 4, nb = item & 15, k0 = 128 * kb, n0 = 32 * nb, nn0 = (n0 >> 7) * 256 + which * 128 + (n0 & 127);
            d.src = (which == 0 ? weg : weu) + (size_t)e * DM * EH + (size_t)k0 * EH + n0; d.dst = (bf16_t*)(WguT + (size_t)e * DM * DM + (size_t)nn0 * DM + k0); d.N = EH; d.K = DM; }
        else { const int kb = item >> 5, nb = item & 31, k0 = 128 * kb, n0 = 32 * nb;
            d.src = wed + (size_t)e * EH * DM + (size_t)k0 * DM + n0; d.dst = (bf16_t*)(WdT + (size_t)e * DM * EH + (size_t)n0 * EH + k0); d.N = DM; d.K = EH; }
        return d;
    }
};
template <class Items>
__device__ __forceinline__ void convert_items8(const Items& I, LAS float* scr, int lane, int gw, int NGW) {
    f32x4 r[16];
    int it = gw;
    if (it >= Items::TOTAL) return;
    TrDesc d = I(it);
    tr_load8(d, lane, r);
    for (;;) {
        tr_write8(scr, lane, r);
        const int it2 = it + NGW; const bool has = it2 < Items::TOTAL;
        TrDesc dn = d;
        if (has) { dn = I(it2); tr_load8(dn, lane, r); }
        tr_out8(d, scr, lane);
        if (!has) break;
        d = dn; it = it2;
    }
}
__device__ __forceinline__ void norm_row(const float* __restrict__ xr, const float* __restrict__ g, bf16_t* __restrict__ hr, int lane) {
    f32x4 v[4]; float ss = 0.f;
#pragma unroll
    for (int i = 0; i < 4; ++i) { v[i] = *(const f32x4*)(xr + (i * 64 + lane) * 4); ss += (v[i][0] * v[i][0] + v[i][1] * v[i][1]) + (v[i][2] * v[i][2] + v[i][3] * v[i][3]); }
    ss = wave_sum(ss);
    const float rstd = rsqrtf(ss * (1.0f / DM) + RMS_EPS);
#pragma unroll
    for (int i = 0; i < 4; ++i) {
        const f32x4 gv = *(const f32x4*)(g + (i * 64 + lane) * 4);
        u32x2 w; w.x = pack2(v[i][0] * rstd * gv[0], v[i][1] * rstd * gv[1]); w.y = pack2(v[i][2] * rstd * gv[2], v[i][3] * rstd * gv[3]);
        *(u32x2*)(hr + (i * 64 + lane) * 4) = w;
    }
}
typedef const __attribute__((address_space(4))) float* cfp;
typedef const __attribute__((address_space(4))) f32x2* cf2p;
__device__ __forceinline__ void unpack8(const u32x4 v, float (&f)[8]) { f[0] = bflo(v.x); f[1] = bfhi(v.x); f[2] = bflo(v.y); f[3] = bfhi(v.y); f[4] = bflo(v.z); f[5] = bfhi(v.z); f[6] = bflo(v.w); f[7] = bfhi(v.w); }
template <int W>
__device__ __forceinline__ void pool_path(const u32x4 (&r)[23], int pos0, bf16_t* __restrict__ pl, size_t t0, int c0) {
    float sum[8] = {0.f, 0.f, 0.f, 0.f, 0.f, 0.f, 0.f, 0.f}, f[8];
#pragma unroll
    for (int j = 1; j < W; ++j) { unpack8(r[15 - j], f);
#pragma unroll
        for (int c = 0; c < 8; ++c) sum[c] += f[c]; }
#pragma unroll
    for (int i = 0; i < 8; ++i) {
        float u[8]; unpack8(r[15 + i], u);
        if (i > 0) { unpack8(r[15 + i - W], f);
#pragma unroll
            for (int c = 0; c < 8; ++c) sum[c] -= f[c]; }
#pragma unroll
        for (int c = 0; c < 8; ++c) sum[c] += u[c];
        const float ic = 1.0f / (float)min(pos0 + i + 1, W);
        u32x4 o; o.x = pack2(sum[0] * ic - u[0], sum[1] * ic - u[1]); o.y = pack2(sum[2] * ic - u[2], sum[3] * ic - u[3]);
        o.z = pack2(sum[4] * ic - u[4], sum[5] * ic - u[5]); o.w = pack2(sum[6] * ic - u[6], sum[7] * ic - u[7]);
        *(u32x4*)(pl + (t0 + i) * PW + c0) = o;
    }
}
__device__ __forceinline__ int scan32_excl(int v, int lane, int& total) {
    int inc = v;
#pragma unroll
    for (int o = 1; o < 32; o <<= 1) { const int t = __shfl_up(inc, o, 32); if ((lane & 31) >= o) inc += t; }
    total = __shfl(inc, 31, 32);
    return inc - v;
}
__device__ __forceinline__ void build_moe_tables(LAS int* L, const unsigned* cnt) {
    { unsigned a_ = (unsigned)(size_t)L; asm volatile("" : "+s"(a_)); L = (LAS int*)(size_t)a_; }
    const int tid = opaque_tid();
    if (tid < 64) {
        const int lane = tid, e = lane & 31;
        const int c = (int)__hip_atomic_load(cnt + e * 64, __ATOMIC_RELAXED, __HIP_MEMORY_SCOPE_AGENT);
        const int nt = (c + 255) >> 8, lastv = c - 256 * (nt - 1);
        const int lt = (nt > 0 && lastv <= 128) ? 1 : 0, hv = nt - lt;
        int Tt, Th, Tl;
        const int tbx = scan32_excl(nt, lane, Tt), hx = scan32_excl(hv, lane, Th), lx = scan32_excl(lt, lane, Tl);
        if (lane < 32) {
            L[LI_TB + e] = tbx; L[LI_PS + e] = tbx * 256; L[LI_CN + e] = c;
            for (int j = 0; j < hv; ++j) L[LI_ORD + hx + j] = (e << 8) | j;
            if (lt) L[LI_ORD + Th + lx] = (e << 8) | (nt - 1);
            if (lane == 31) { L[LI_TB + NEXP] = Tt; L[LI_PS + NEXP] = Tt * 256; L[LI_NT] = Tt; }
        }
    }
    __syncthreads();
}

struct Args { const float* in[18]; float* out; unsigned char* ws; int ph_lo, ph_hi; };
typedef const __attribute__((address_space(4))) Args* CArgsP;
__device__ __forceinline__ CArgsP kargs() { unsigned long long p = (unsigned long long)__builtin_amdgcn_kernarg_segment_ptr(); asm volatile("" : "+s"(p)); return (CArgsP)p; }
#define PHASE_PTRS \
    const int G = opaque_s(G0), bx = opaque_s(bx0), vcu = opaque_s(vcu0), NGW = G * NWAVES; (void)bx; (void)vcu; (void)NGW; \
    const CArgsP ka = kargs(); unsigned char* const ws = ka->ws; \
    unsigned* const ctrl = (unsigned*)(ws + OFF_CTRL); const float* const x_in = ka->in[0]; \
    bf16_t* const WinT = (bf16_t*)(ws + OFF_WIN); bf16_t* const WaT = (bf16_t*)(ws + OFF_WA); bf16_t* const WppT = (bf16_t*)(ws + OFF_WPP); bf16_t* const WoT = (bf16_t*)(ws + OFF_WO); \
    bf16_t* const WguT = (bf16_t*)(ws + OFF_WGU); bf16_t* const WdT = (bf16_t*)(ws + OFF_WD); \
    bf16_t* const Hb = (bf16_t*)(ws + OFF_H); bf16_t* const MG = Hb; bf16_t* const PROJ = (bf16_t*)(ws + OFF_PROJ); bf16_t* const ACT = (bf16_t*)(ws + OFF_ACT); bf16_t* const YB = (bf16_t*)(ws + OFF_YB); \
    bf16_t* const AC = (bf16_t*)(ws + OFF_AC); bf16_t* const PL = (bf16_t*)(ws + OFF_PL); bf16_t* const OG = (bf16_t*)(ws + OFF_OG); bf16_t* const T1 = (bf16_t*)(ws + OFF_T1); \
    f32x2* const ML = (f32x2*)(ws + OFF_ML); bf16_t* const XB = (bf16_t*)(ws + OFF_XB); int* const tokE = (int*)(ws + OFF_TOKE); float* const tokW = (float*)(ws + OFF_TOKW); int* const asg = (int*)(ws + OFF_ASG); \
    (void)ctrl; (void)x_in; (void)WinT; (void)WaT; (void)WppT; (void)WoT; (void)WguT; (void)WdT; (void)Hb; (void)MG; (void)PROJ; (void)ACT; (void)YB; (void)AC; (void)PL; (void)OG; (void)T1; (void)ML; (void)XB; (void)tokE; (void)tokW; (void)asg
#define LAYER_PTRS PHASE_PTRS; const int tid = opaque_tid(), lane = tid & 63, wid = __builtin_amdgcn_readfirstlane(tid >> 6), gw = vcu * NWAVES + wid; (void)lane; (void)gw; unsigned* const cnt = ctrl + CW_CNT + l * 2048; (void)cnt

#ifndef PHASE_MASK
#define PHASE_MASK 0x3ff
#endif
#define EN(j) (((PHASE_MASK) >> (j)) & 1)
#ifndef REP_MASK
#define REP_MASK 0
#endif
#define REPS(j) (1 + (((REP_MASK) >> (j)) & 1))
#define IN(k) (MK_N_LAUNCHES == 1 || (lo <= (k) && (k) < hi))
#ifndef PROBE_A
#define PROBE_A -1
#define PROBE_B -1
#endif
#define STAMP_BEGIN(k) do { if (PROBE_A == (k)) ts0 = __builtin_amdgcn_s_memrealtime(); } while (0)
#define SEAM(k) do { if (IN(k) && IN((k) + 1)) { XcdBarrier b2_ = bar; unsigned long long p_ = (unsigned long long)b2_.bar; asm volatile("" : "+s"(p_)); b2_.bar = (unsigned*)p_; xcd_barrier(b2_); } if (PROBE_B == (k)) ts1 = __builtin_amdgcn_s_memrealtime(); } while (0)

template <int l>
__device__ __forceinline__ void layer_body(const XcdBarrier& bar, LAS unsigned char* lds, LAS int* LC, const int G0, const int bx0, const int vcu0, const int lo, const int hi, unsigned long long& ts0, unsigned long long& ts1) {
        const int pb = 1 + 9 * l;
        STAMP_BEGIN(pb + 0);
        for (int rep = 0; rep < REPS(0); ++rep) if (EN(0) && IN(pb + 0)) {
            asm volatile("; PHASE_MARK 0");
            LAYER_PTRS;
            pg8::DenseOrder S; S.init(Hb, WinT + (size_t)l * INW * DM, NTOK, INW, DM * 2, G, bx);
            pg8::EpiProj E{PROJ, ka->in[3] + (size_t)l * HD, ka->in[4] + (size_t)l * HD};
            pg8::gemm_phase<pg8::EpiProj, pg8::DenseOrder, 1, false>(lds, DM * 2, S, E);
        }
        SEAM(pb + 0);
        STAMP_BEGIN(pb + 1);
        for (int rep = 0; rep < REPS(1); ++rep) if (EN(1) && IN(pb + 1)) {
            asm volatile("; PHASE_MARK 1");
            LAYER_PTRS;
            int u = vcu;
            if (u < 1536) {
                AttnU cu = attn_decode(u), nu = cu;
                u32x4 kr[6], vr[6]; bf16x8 qf[4];
                attn_load(cu, PROJ, tid, kr, vr);
                for (;;) {
                    attn_load_q(cu, PROJ, wid, lane, qf);
                    attn_lds_store(cu, lds, tid, kr, vr);
                    __syncthreads();
                    const int un = u + G; const bool hn = un < 1536;
                    if (hn) { nu = attn_decode(un); attn_load(nu, PROJ, tid, kr, vr); }
                    attn_compute(cu, lds, qf, OG, ML, wid, lane);
                    if (!hn) break;
                    cu = nu; u = un;
                }
            }
        }
        SEAM(pb + 1);
        STAMP_BEGIN(pb + 2);
        for (int rep = 0; rep < REPS(2); ++rep) if (EN(2) && IN(pb + 2)) {
            asm volatile("; PHASE_MARK 2");
            LAYER_PTRS;
            for (int grp = gw; grp < NTOK / 8; grp += NGW) {
                const size_t t0 = (size_t)grp * 8; const int c0 = 8 * lane, hh = lane >> 3;
                {
                    f32x2 sm[8][3]; u32x4 v[8][3];
#pragma unroll
                    for (int i = 0; i < 8; ++i)
#pragma unroll
                        for (int g = 0; g < 3; ++g) { sm[i][g] = ML[((size_t)g * NTOK + t0 + i) * 8 + hh]; v[i][g] = *(const u32x4*)(OG + ((size_t)g * NTOK + t0 + i) * AW + c0); }
#pragma unroll
                    for (int i = 0; i < 8; ++i) {
                        const float M = fmaxf(fmaxf(sm[i][0][0], sm[i][1][0]), sm[i][2][0]);
                        float w[3], W = 0.f;
#pragma unroll
                        for (int g = 0; g < 3; ++g) { w[g] = sm[i][g][1] * __expf(sm[i][g][0] - M); W += w[g]; }
                        const float iw = 1.0f / W;
                        float o[8] = {0.f, 0.f, 0.f, 0.f, 0.f, 0.f, 0.f, 0.f}, f[8];
#pragma unroll
                        for (int g = 0; g < 3; ++g) { unpack8(v[i][g], f); const float q = w[g] * iw;
#pragma unroll
                            for (int c = 0; c < 8; ++c) o[c] += q * f[c]; }
                        u32x4 ow; ow.x = pack2(o[0], o[1]); ow.y = pack2(o[2], o[3]); ow.z = pack2(o[4], o[5]); ow.w = pack2(o[6], o[7]);
                        *(u32x4*)(AC + (t0 + i) * AW + c0) = ow;
                    }
                }
                {
                    const int pos0 = (int)(t0 & (SEQ - 1)), g4 = lane >> 4, wnd = 2 << g4;
                    u32x4 r[23];
#pragma unroll
                    for (int k = 0; k < 23; ++k) { const bool need = (k >= 16 - wnd) && (pos0 - 15 + k >= 0);
                        r[k] = need ? *(const u32x4*)(PROJ + (t0 - 15 + k) * INW + 3 * AW + c0) : (u32x4){0u, 0u, 0u, 0u}; }
                    if (g4 == 0) pool_path<2>(r, pos0, PL, t0, c0);
                    else if (g4 == 1) pool_path<4>(r, pos0, PL, t0, c0);
                    else if (g4 == 2) pool_path<8>(r, pos0, PL, t0, c0);
                    else pool_path<16>(r, pos0, PL, t0, c0);
                }
            }
        }
        SEAM(pb + 2);
        STAMP_BEGIN(pb + 3);
        for (int rep = 0; rep < REPS(3); ++rep) if (EN(3) && IN(pb + 3)) {
            asm volatile("; PHASE_MARK 3");
            LAYER_PTRS;
            { pg8::DenseOrder S; S.init(AC, WaT + (size_t)l * DM * AW, NTOK, DM, AW * 2, G, bx);
              pg8::EpiGate<0> E{PROJ + 2048, nullptr, T1};
              pg8::gemm_phase<pg8::EpiGate<0>, pg8::DenseOrder, 0, false>(lds, AW * 2, S, E); }
            { pg8::DenseOrder S; S.init(PL, WppT + (size_t)l * DM * PW, NTOK, DM, PW * 2, G, bx);
              pg8::EpiGate<1> E{PROJ + 3072, T1, MG};
              pg8::gemm_phase<pg8::EpiGate<1>, pg8::DenseOrder, 0, false>(lds, PW * 2, S, E); }
        }
        SEAM(pb + 3);
        STAMP_BEGIN(pb + 4);
        if (EN(4) && IN(pb + 4)) {
            asm volatile("; PHASE_MARK 4");
            LAYER_PTRS;
            pg8::DenseOrder S; S.init(MG, WoT + (size_t)l * DM * DM, NTOK, DM, DM * 2, G, bx);
            pg8::EpiResid<l == 0> E{x_in, XB};
            pg8::gemm_phase<pg8::EpiResid<l == 0>, pg8::DenseOrder, 0, false>(lds, DM * 2, S, E);
        }
        SEAM(pb + 4);
        STAMP_BEGIN(pb + 5);
        if (EN(5) && IN(pb + 5)) {
            asm volatile("; PHASE_MARK 5");
            LAYER_PTRS;
            LAS float* part = (LAS float*)lds;
            LAS float* lg = (LAS float*)(lds + 100352);
            LAS int* aE = (LAS int*)(lds + 110592); LAS float* aW = (LAS float*)(lds + 110592 + 512); LAS int* bs = (LAS int*)(lds + 110592 + 1024); LAS float* rs = (LAS float*)(lds + 110592 + 1536);
            const float* g2 = ka->in[10] + (size_t)l * DM; const float* brg = ka->in[12] + (size_t)l * 4; const float* bre = ka->in[14] + (size_t)l * 32;
            const bf16_t* Wh = (const bf16_t*)(ws + OFF_WRH) + (size_t)l * 48 * DM; const bf16_t* Wl = (const bf16_t*)(ws + OFF_WRL) + (size_t)l * 48 * DM;
            for (int chunk = bx; chunk < NTOK / 64; chunk += G) {
                {
                    const int fr = lane & 15, fq = lane >> 4;
                    f32x4 acc[4][3]; float ssl[4] = {0.f, 0.f, 0.f, 0.f};
#pragma unroll
                    for (int mt = 0; mt < 4; ++mt)
#pragma unroll
                        for (int nt = 0; nt < 3; ++nt) acc[mt][nt] = (f32x4){0.f, 0.f, 0.f, 0.f};
#pragma unroll 1
                    for (int ks = 0; ks < 4; ++ks) {
                        const int d0 = 128 * wid + 32 * ks + 8 * fq;
                        bf16x8 bh[3], bl[3];
#pragma unroll
                        for (int nt = 0; nt < 3; ++nt) { bh[nt] = *(const bf16x8*)(Wh + (size_t)(16 * nt + fr) * DM + d0); bl[nt] = *(const bf16x8*)(Wl + (size_t)(16 * nt + fr) * DM + d0); }
#pragma unroll
                        for (int mt = 0; mt < 4; ++mt) {
                            const u32x4 hw = *(const u32x4*)(XB + (size_t)(chunk * 64 + 16 * mt + fr) * DM + d0);
                            { float f[8]; unpack8(hw, f); ssl[mt] += (f[0] * f[0] + f[1] * f[1]) + (f[2] * f[2] + f[3] * f[3]) + (f[4] * f[4] + f[5] * f[5]) + (f[6] * f[6] + f[7] * f[7]); }
                            const bf16x8 ah = __builtin_bit_cast(bf16x8, hw);
#pragma unroll
                            for (int nt = 0; nt < 3; ++nt) {
                                acc[mt][nt] = __builtin_amdgcn_mfma_f32_16x16x32_bf16(ah, bh[nt], acc[mt][nt], 0, 0, 0);
                                acc[mt][nt] = __builtin_amdgcn_mfma_f32_16x16x32_bf16(ah, bl[nt], acc[mt][nt], 0, 0, 0);
                            }
                        }
                        asm volatile("" ::: "memory");
                    }
#pragma unroll
                    for (int mt = 0; mt < 4; ++mt) {
#pragma unroll
                        for (int nt = 0; nt < 3; ++nt) *(LAS f32x4*)(part + (wid * 49 + 16 * nt + fr) * 64 + 16 * mt + 4 * fq) = acc[mt][nt];
                        float sq = ssl[mt]; sq += __shfl_xor(sq, 16); sq += __shfl_xor(sq, 32);
                        if (fq == 0) part[(wid * 49 + 48) * 64 + 16 * mt + fr] = sq;
                    }
                }
                __syncthreads();
                for (int o = tid >> 6; o < 37; o += 8) { float sum = 0.f; const int po = (o == 36) ? 48 : o;
#pragma unroll
                    for (int w = 0; w < 8; ++w) sum += part[(w * 49 + po) * 64 + lane];
                    lg[o * 64 + lane] = sum; }
                __syncthreads();
                if (tid < 64) {
                    const float rstd = rsqrtf(lg[36 * 64 + tid] * (1.0f / DM) + RMS_EPS); rs[tid] = rstd;
                    float gl[4];
#pragma unroll
                    for (int o = 0; o < 4; ++o) gl[o] = lg[o * 64 + tid] * rstd + brg[o];
                    int gs = 0; float gm = gl[0];
#pragma unroll
                    for (int o = 1; o < 4; ++o) if (gl[o] > gm) { gm = gl[o]; gs = o; }
                    float gden = 0.f;
#pragma unroll
                    for (int o = 0; o < 4; ++o) gden += __expf(gl[o] - gm);
                    const float ggate = 1.0f / gden;
                    float el[8];
#pragma unroll
                    for (int o = 0; o < 8; ++o) el[o] = lg[(4 + 8 * gs + o) * 64 + tid] * rstd + bre[gs * 8 + o];
                    int i0 = 0; float m0 = el[0];
#pragma unroll
                    for (int o = 1; o < 8; ++o) if (el[o] > m0) { m0 = el[o]; i0 = o; }
                    int i1 = 0; float m1 = -3.0e38f;
#pragma unroll
                    for (int o = 0; o < 8; ++o) if (o != i0 && el[o] > m1) { m1 = el[o]; i1 = o; }
                    const float e1 = __expf(m1 - m0);
                    aE[2 * tid] = gs * 8 + i0; aE[2 * tid + 1] = gs * 8 + i1; aW[2 * tid] = ggate / (1.0f + e1); aW[2 * tid + 1] = ggate * e1 / (1.0f + e1);
                }
                __syncthreads();
                int myE = 0, rank = 0;
                if (tid < 128) { myE = aE[tid]; for (int a = 0; a < tid; ++a) rank += (aE[a] == myE) ? 1 : 0; }
                if (tid < NEXP) { int c = 0; for (int a = 0; a < 128; ++a) c += (aE[a] == tid) ? 1 : 0;
                    bs[tid] = c ? (int)__hip_atomic_fetch_add(cnt + tid * 64, (unsigned)c, __ATOMIC_RELAXED, __HIP_MEMORY_SCOPE_AGENT) : 0; }
#pragma unroll 2
                for (int it = 0; it < 8; ++it) {
                    const int ti = wid * 8 + it; const size_t tok = (size_t)chunk * 64 + ti; const float rstd = rs[ti];
#pragma unroll
                    for (int i = 0; i < 4; ++i) { const int d0 = (i * 64 + lane) * 4; const u32x2 xw = *(const u32x2*)(XB + tok * DM + d0); const f32x4 gv = *(const f32x4*)(g2 + d0);
                        const float h0 = bflo(xw.x) * rstd * gv[0], h1 = bfhi(xw.x) * rstd * gv[1], h2v = bflo(xw.y) * rstd * gv[2], h3 = bfhi(xw.y) * rstd * gv[3];
                        if (MOE_FP8) *(unsigned*)((unsigned char*)Hb + tok * DM + d0) = pack4_fp8(h0, h1, h2v, h3);
                        else { u32x2 w; w.x = pack2(h0, h1); w.y = pack2(h2v, h3); *(u32x2*)(Hb + tok * DM + d0) = w; } }
                }
                __syncthreads();
                if (tid < 128) { const int slot = bs[myE] + rank, tok = chunk * 64 + (tid >> 1);
                    tokE[(size_t)myE * ECAP + slot] = tok; tokW[(size_t)myE * ECAP + slot] = aW[tid]; asg[tok * 2 + (tid & 1)] = myE * ECAP + slot; }
                __syncthreads();
            }
        }
        SEAM(pb + 5);
        STAMP_BEGIN(pb + 6);
        for (int rep = 0; rep < REPS(6); ++rep) if (EN(6) && IN(pb + 6)) {
            asm volatile("; PHASE_MARK 6");
            LAYER_PTRS;
            build_moe_tables(LC, cnt);
            constexpr int ES = MOE_FP8 ? 1 : 2;
            pg8::MoeOrder S{(const char*)Hb, (const char*)WguT, (size_t)DM * DM * ES, DM * ES, LC + LI_TB, LC + LI_PS, LC + LI_CN, LC + LI_ORD, tokE, G, vcu, true};
            pg8::EpiSwiGLU<MOE_FP8> E{(void*)ACT};
            pg8::gemm_phase<pg8::EpiSwiGLU<MOE_FP8>, pg8::MoeOrder, 0, true, true, MOE_FP8>(lds, DM * ES, S, E);
        }
        SEAM(pb + 6);
        STAMP_BEGIN(pb + 7);
        for (int rep = 0; rep < REPS(7); ++rep) if (EN(7) && IN(pb + 7)) {
            asm volatile("; PHASE_MARK 7");
            LAYER_PTRS;
            build_moe_tables(LC, cnt);
            constexpr int ES = MOE_FP8 ? 1 : 2;
            pg8::MoeOrder S{(const char*)ACT, (const char*)WdT, (size_t)DM * EH * ES, EH * ES, LC + LI_TB, LC + LI_PS, LC + LI_CN, LC + LI_ORD, tokE, G, vcu, false};
            pg8::EpiDown<MOE_FP8> E{YB, tokW};
            pg8::gemm_phase<pg8::EpiDown<MOE_FP8>, pg8::MoeOrder, 0, false, true, MOE_FP8>(lds, EH * ES, S, E);
        }
        SEAM(pb + 7);
        STAMP_BEGIN(pb + 8);
        if (EN(8) && IN(pb + 8)) {
            asm volatile("; PHASE_MARK 8");
            LAYER_PTRS;
            build_moe_tables(LC, cnt);
            const bool lastl = (l == DEPTH - 1);
            const float* g1n = ka->in[1] + (size_t)(lastl ? 0 : (l + 1)) * DM;
            for (int grp = gw; grp < NTOK / 4; grp += NGW) {
                const size_t t0 = (size_t)grp * 4;
                const int myasg = (lane < 8) ? asg[t0 * 2 + lane] : 0;
                u32x2 xv[4][4], ya[4][4], yb[4][4];
#pragma unroll
                for (int q = 0; q < 4; ++q) {
                    const int i0 = __builtin_amdgcn_readlane(myasg, 2 * q), i1 = __builtin_amdgcn_readlane(myasg, 2 * q + 1);
                    const size_t s0 = (size_t)(LC[LI_PS + (i0 >> 14)] + (i0 & (ECAP - 1))), s1 = (size_t)(LC[LI_PS + (i1 >> 14)] + (i1 & (ECAP - 1)));
#pragma unroll
                    for (int i = 0; i < 4; ++i) { const int d0 = (i * 64 + lane) * 4;
                        xv[q][i] = *(const u32x2*)(XB + (t0 + q) * DM + d0); ya[q][i] = *(const u32x2*)(YB + s0 * DM + d0); yb[q][i] = *(const u32x2*)(YB + s1 * DM + d0); }
                }
#pragma unroll
                for (int q = 0; q < 4; ++q) {
                    f32x4 v[4]; float ss = 0.f;
#pragma unroll
                    for (int i = 0; i < 4; ++i) { const int d0 = (i * 64 + lane) * 4; const u32x2 a = ya[q][i], b = yb[q][i], x4 = xv[q][i];
                        v[i][0] = bflo(x4.x) + bflo(a.x) + bflo(b.x); v[i][1] = bfhi(x4.x) + bfhi(a.x) + bfhi(b.x); v[i][2] = bflo(x4.y) + bflo(a.y) + bflo(b.y); v[i][3] = bfhi(x4.y) + bfhi(a.y) + bfhi(b.y);
                        ss += (v[i][0] * v[i][0] + v[i][1] * v[i][1]) + (v[i][2] * v[i][2] + v[i][3] * v[i][3]);
                        if (lastl) *(f32x4*)(ka->out + (t0 + q) * DM + d0) = v[i];
                        else { u32x2 w; w.x = pack2(v[i][0], v[i][1]); w.y = pack2(v[i][2], v[i][3]); *(u32x2*)(XB + (t0 + q) * DM + d0) = w; } }
                    if (!lastl) {
                        ss = wave_sum(ss);
                        const float rstd = rsqrtf(ss * (1.0f / DM) + RMS_EPS);
#pragma unroll
                        for (int i = 0; i < 4; ++i) { const int d0 = (i * 64 + lane) * 4; const f32x4 gv = *(const f32x4*)(g1n + d0);
                            u32x2 w; w.x = pack2(v[i][0] * rstd * gv[0], v[i][1] * rstd * gv[1]); w.y = pack2(v[i][2] * rstd * gv[2], v[i][3] * rstd * gv[3]);
                            *(u32x2*)(Hb + (t0 + q) * DM + d0) = w; }
                    }
                }
            }
            if (!lastl) {
                __syncthreads();
                const float* e0 = ka->in[15] + (size_t)(l + 1) * NEXP * DM * EH; const float* e1 = ka->in[16] + (size_t)(l + 1) * NEXP * DM * EH; const float* e2 = ka->in[17] + (size_t)(l + 1) * NEXP * EH * DM;
                if (MOE_FP8) { ExpertItems8 I{e0, e1, e2, (unsigned char*)WguT, (unsigned char*)WdT}; convert_items8(I, (LAS float*)(lds + wid * 16384), lane, gw, NGW); }
                else { ExpertItems I{e0, e1, e2, WguT, WdT}; convert_items(I, (LAS float*)(lds + wid * 8704), lane, gw, NGW); }
            }
        }
        if (l + 1 < DEPTH) SEAM(pb + 8); else if (PROBE_B == pb + 8) ts1 = __builtin_amdgcn_s_memrealtime();
    }

__global__ void __launch_bounds__(NTHREADS, 2) fwd_kernel(Args args) {
    extern __shared__ __attribute__((aligned(16))) unsigned char lds_raw[];
    LAS unsigned char* lds = (LAS unsigned char*)lds_raw;
    LAS int* LC = (LAS int*)(lds + LCTL_OFF);
    const int G0 = gridDim.x, bx0 = blockIdx.x;
    const int vcu0 = (G0 % 8 == 0) ? (bx0 % 8) * (G0 / 8) + bx0 / 8 : bx0;
    if (threadIdx.x < 4) LC[LI_BAR + threadIdx.x] = 0;
    __syncthreads();
    XcdBarrier bar; bar.bar = (unsigned*)(args.ws + OFF_CTRL) + CW_BAR; bar.x = 0; bar.st = nullptr;
    if (MK_N_LAUNCHES == 1) bar = xcd_barrier_post(bar.bar, (volatile LAS unsigned*)(LC + LI_BAR));
    const int lo = args.ph_lo, hi = args.ph_hi;
    unsigned long long ts0 = 0ull, ts1 = 0ull;
    STAMP_BEGIN(0);
    for (int rep = 0; rep < REPS(9); ++rep) if (EN(9) && IN(0)) {
        asm volatile("; PHASE_MARK 9");
        PHASE_PTRS; const int tid = opaque_tid(), lane = tid & 63, wid = __builtin_amdgcn_readfirstlane(tid >> 6), gw = vcu * NWAVES + wid;
        LAS float* scr = (LAS float*)(lds + wid * 8704);
        { SmallItems I{ka->in[2], ka->in[5], ka->in[9], WinT, WaT, WoT}; convert_items(I, scr, lane, gw, NGW); }
        for (int o = gw; o < DEPTH * (DM / 64) * (PW / 8); o += NGW) {
            const int l = o / ((DM / 64) * (PW / 8)), r = o % ((DM / 64) * (PW / 8)), kb = r / (DM / 64), n = (r % (DM / 64)) * 64 + lane, k0 = kb * 8, g = k0 >> 7;
            const cfp wm = (cfp)(unsigned long long)(ka->in[6] + (size_t)l * 4 * 128 * 128 + (size_t)k0 * 128);
            const cfp sc = (cfp)(unsigned long long)(ka->in[7] + (size_t)l * PW + g * 128);
            const float* wp = ka->in[8] + (size_t)l * PW * DM + (size_t)(g * 128) * DM + n;
            float a[8] = {0.f, 0.f, 0.f, 0.f, 0.f, 0.f, 0.f, 0.f};
#pragma unroll 8
            for (int dd = 0; dd < 128; ++dd) { const float w = wp[(size_t)dd * DM] * sc[dd];
#pragma unroll
                for (int c = 0; c < 8; ++c) a[c] += w * wm[c * 128 + dd]; }
            u32x4 ow; ow.x = pack2(a[0], a[1]); ow.y = pack2(a[2], a[3]); ow.z = pack2(a[4], a[5]); ow.w = pack2(a[6], a[7]);
            *(u32x4*)(WppT + (size_t)l * DM * PW + (size_t)n * PW + k0) = ow;
        }
        for (int o = bx * NTHREADS + tid; o < DEPTH * 48 * DM; o += G * NTHREADS) {
            const int l = o / (48 * DM), r = o % (48 * DM), oo = r / DM, d = r % DM;
            float w = 0.f;
            if (oo < 4) w = ka->in[11][(size_t)l * DM * 4 + (size_t)d * 4 + oo];
            else if (oo < 36) w = ka->in[13][(size_t)l * 4 * DM * 8 + ((size_t)((oo - 4) >> 3) * DM + d) * 8 + ((oo - 4) & 7)];
            w *= ka->in[10][(size_t)l * DM + d];
            const bf16_t hi = f2bf(w); const float hf = __uint_as_float((unsigned)hi << 16);
            ((bf16_t*)(ws + OFF_WRH))[o] = hi; ((bf16_t*)(ws + OFF_WRL))[o] = f2bf(w - hf);
        }
        if (MOE_FP8) { __syncthreads(); ExpertItems8 I{ka->in[15], ka->in[16], ka->in[17], (unsigned char*)WguT, (unsigned char*)WdT}; convert_items8(I, (LAS float*)(lds + wid * 16384), lane, gw, NGW); __syncthreads(); }
        else { ExpertItems I{ka->in[15], ka->in[16], ka->in[17], WguT, WdT}; convert_items(I, scr, lane, gw, NGW); }
        for (int m = gw; m < NTOK; m += NGW) norm_row(x_in + (size_t)m * DM, ka->in[1], Hb + (size_t)m * DM, lane);
    }
    SEAM(0);

    layer_body<0>(bar, lds, LC, G0, bx0, vcu0, lo, hi, ts0, ts1);
    layer_body<1>(bar, lds, LC, G0, bx0, vcu0, lo, hi, ts0, ts1);
    if (PROBE_A >= 0 && blockIdx.x == 0) { const unsigned long long d = (ts1 - ts0) * 4ull, t0 = __builtin_amdgcn_s_memrealtime(); while (__builtin_amdgcn_s_memrealtime() - t0 < d) __builtin_amdgcn_s_sleep(8); }
#undef IN
#undef SEAM
}

extern "C" void kernel_launch(void* const* d_in, const int* in_sizes, int n_in, void* d_out, int out_size, void* d_ws, size_t ws_size, hipStream_t stream) {
    (void)in_sizes; (void)out_size;
    static int grid = 0;
    if (grid == 0) {
        int dev = 0, cus = 0;
        if (hipGetDevice(&dev) != hipSuccess || hipDeviceGetAttribute(&cus, hipDeviceAttributeMultiprocessorCount, dev) != hipSuccess) { grid = -1; return; }
        if (hipFuncSetAttribute((const void*)fwd_kernel, hipFuncAttributeMaxDynamicSharedMemorySize, LDS_BYTES) != hipSuccess) { grid = -1; return; }
        int per_cu = 0;
        (void)hipOccupancyMaxActiveBlocksPerMultiprocessor(&per_cu, (const void*)fwd_kernel, NTHREADS, LDS_BYTES);
        (void)hipGetLastError();
        grid = cus;
        if (n_in != 18 || ws_size < WS_NEED) { fprintf(stderr, "kernel_launch: unexpected inputs (n_in %d, ws %zu)\n", n_in, ws_size); grid = -1; return; }
    }
    if (grid < 0) return;
    (void)hipMemsetAsync((char*)d_ws + OFF_CTRL, 0, CTRL_BYTES, stream);
    Args a{};
    for (int i = 0; i < 18; ++i) a.in[i] = (const float*)d_in[i];
    a.out = (float*)d_out; a.ws = (unsigned char*)d_ws;
    constexpr int NPH = 1 + 9 * DEPTH;
    if (MK_N_LAUNCHES == 1) { a.ph_lo = 0; a.ph_hi = NPH; hipLaunchKernelGGL(fwd_kernel, dim3(grid), dim3(NTHREADS), LDS_BYTES, stream, a); }
    else { for (int p = 0; p < NPH; ++p) { a.ph_lo = p; a.ph_hi = p + 1; hipLaunchKernelGGL(fwd_kernel, dim3(grid), dim3(NTHREADS), LDS_BYTES, stream, a); } }
}
```

```cpp
#include <hip/hip_runtime.h>
#include <stdint.h>
#include <stdio.h>

#define LAS __attribute__((address_space(3)))
typedef unsigned short bf16_t;
typedef short bf16x8 __attribute__((ext_vector_type(8)));
typedef float f32x2 __attribute__((ext_vector_type(2)));
typedef float f32x4 __attribute__((ext_vector_type(4)));
typedef float f32x16 __attribute__((ext_vector_type(16)));
typedef unsigned u32x2 __attribute__((ext_vector_type(2)));
typedef unsigned u32x4 __attribute__((ext_vector_type(4)));
typedef __bf16 bfv2 __attribute__((ext_vector_type(2)));
typedef int i32x8 __attribute__((ext_vector_type(8)));
constexpr float W8_SCALE = 32.f, A8_SCALE = 8.f;

#ifndef MOE_FP8
#define MOE_FP8 1
#endif
#ifndef MK_N_LAUNCHES
#define MK_N_LAUNCHES 1
#endif

constexpr int DM = 1024, SEQ = 4096, NTOK = 16384, DEPTH = 2;
constexpr int HD = 64, AW = 512, PW = 512, INW = 4096;
constexpr int NEXP = 32, EH = 512, ECAP = NTOK;
constexpr float RMS_EPS = 1e-6f;
constexpr int NTHREADS = 512, NWAVES = 8;

constexpr size_t MB = 1024 * 1024;
constexpr size_t OFF_CTRL = 0, CTRL_BYTES = 65536;
constexpr size_t OFF_WIN  = 1 * MB;
constexpr size_t OFF_WA   = OFF_WIN + 16 * MB;
constexpr size_t OFF_WPP  = OFF_WA + 2 * MB;
constexpr size_t OFF_WO   = OFF_WPP + 2 * MB;
constexpr size_t OFF_WGU  = OFF_WO + 4 * MB;
constexpr size_t OFF_WD   = OFF_WGU + 64 * MB;
constexpr size_t OFF_H    = OFF_WD + 32 * MB;
constexpr size_t OFF_PROJ = OFF_H + 32 * MB;
constexpr size_t OFF_ACT  = OFF_PROJ;
constexpr size_t OFF_YB   = OFF_PROJ + 40 * MB;
constexpr size_t OFF_AC   = OFF_PROJ + 128 * MB;
constexpr size_t OFF_PL   = OFF_AC + 16 * MB;
constexpr size_t OFF_OG   = OFF_PL + 16 * MB;
constexpr size_t OFF_T1   = OFF_OG;
constexpr size_t OFF_ML   = OFF_OG + 48 * MB;
constexpr size_t OFF_XB   = OFF_ML + 4 * MB;
constexpr size_t OFF_TOKE = OFF_XB + 64 * MB;
constexpr size_t OFF_TOKW = OFF_TOKE + 2 * MB;
constexpr size_t OFF_ASG  = OFF_TOKW + 2 * MB;
constexpr size_t OFF_WRH  = OFF_ASG + 1 * MB;
constexpr size_t OFF_WRL  = OFF_WRH + 256 * 1024;
constexpr size_t WS_NEED  = OFF_WRL + 256 * 1024;
constexpr int CW_CNT = 1024;
constexpr int CW_BAR = 8192;
constexpr int RING_BYTES = 131072, LCTL_OFF = RING_BYTES, LDS_BYTES = RING_BYTES + 2048;
constexpr int LI_BAR = 0, LI_TB = 16, LI_PS = 64, LI_CN = 112, LI_NT = 15, LI_ORD = 144;

__device__ __forceinline__ float bflo(unsigned w) { return __uint_as_float(w << 16); }
__device__ __forceinline__ float bfhi(unsigned w) { return __uint_as_float(w & 0xffff0000u); }
__device__ __forceinline__ unsigned pack2(float lo, float hi) { f32x2 v = {lo, hi}; return __builtin_bit_cast(unsigned, __builtin_convertvector(v, bfv2)); }
__device__ __forceinline__ unsigned pack4_fp8(float a, float b, float c, float d) { unsigned w = 0u; w = __builtin_amdgcn_cvt_pk_fp8_f32(a, b, w, false); w = __builtin_amdgcn_cvt_pk_fp8_f32(c, d, w, true); return w; }
__device__ __forceinline__ bf16_t f2bf(float f) { return (bf16_t)(pack2(f, 0.f) & 0xffffu); }
__device__ __forceinline__ float wave_sum(float v) {
#pragma unroll
    for (int o = 32; o >= 1; o >>= 1) v += __shfl_xor(v, o);
    return v;
}
__device__ __forceinline__ int opaque_tid() { int t = (int)threadIdx.x; asm volatile("" : "+v"(t)); return t; }
__device__ __forceinline__ int opaque_s(int v) { asm volatile("" : "+s"(v)); return v; }
__device__ __forceinline__ float sigmoidf_(float v) { return 1.0f / (1.0f + __expf(-v)); }

#define XB_TMO      128
#define XB_XCNT(j)  (256  + 64 * (j))
#define XB_XSUB(j)  (1280 + 64 * (j))
#define XB_XGEN(j)  (2304 + 64 * (j))
#define XB_TOP      3328
#define XB_TOPGEN   3392
#define XCD_BAR_WORDS 3456
#define XB_SPIN_CAP (1u << 18)
__device__ __forceinline__ unsigned xb_ld(unsigned* p)              { return __hip_atomic_load(p, __ATOMIC_RELAXED, __HIP_MEMORY_SCOPE_AGENT); }
__device__ __forceinline__ unsigned xb_add(unsigned* p, unsigned v) { return __hip_atomic_fetch_add(p, v, __ATOMIC_RELAXED, __HIP_MEMORY_SCOPE_AGENT); }
__device__ __forceinline__ unsigned xb_xcc_id() { return (unsigned)__builtin_amdgcn_s_getreg((3 << 11) | 20) & 0xFu; }
#define XB_SPIN(cond, bar) do { unsigned _sp = 0; while (cond) { __builtin_amdgcn_s_sleep(1); \
    if ((++_sp & 255u) == 0u) { if (xb_ld(&(bar)[XB_TMO])) break; if (_sp > XB_SPIN_CAP) { atomicAdd(&(bar)[XB_TMO], 1u); break; } } } } while (0)
struct XcdBarrier { unsigned* bar; unsigned x; volatile LAS unsigned* st; };
__device__ __forceinline__ XcdBarrier xcd_barrier_post(unsigned* bar, volatile LAS unsigned* st) {
    XcdBarrier b; b.bar = bar; b.x = xb_xcc_id(); b.st = st;
    if (threadIdx.x == 0) (void)xb_add(&bar[XB_XCNT(b.x)], 1u);
    return b;
}
__device__ __forceinline__ void xcd_barrier_complete(unsigned* bar, unsigned x, unsigned& nloc, unsigned& nx) {
    const unsigned G = gridDim.x * gridDim.y * gridDim.z;
    unsigned sum, cnt, mine, sp = 0u;
    for (;;) {
        sum = 0u; cnt = 0u; mine = 0u;
#pragma unroll
        for (unsigned j = 0; j < 16; ++j) { const unsigned c = xb_ld(&bar[XB_XCNT(j)]); sum += c; cnt += (c > 0u) ? 1u : 0u; mine = (j == x) ? c : mine; }
        if (sum == G) break;
        __builtin_amdgcn_s_sleep(1);
        if ((++sp & 255u) == 0u) { if (xb_ld(&bar[XB_TMO])) break; if (sp > XB_SPIN_CAP) { atomicAdd(&bar[XB_TMO], 1u); break; } }
    }
    nloc = mine > 0u ? mine : 1u; nx = cnt > 0u ? cnt : 1u;
}
__device__ __forceinline__ void xcd_barrier(const XcdBarrier& b) {
    asm volatile("s_waitcnt vmcnt(0)" ::: "memory");
    __syncthreads();
    if (threadIdx.x == 0) {
        unsigned* bar = b.bar;
        __builtin_amdgcn_s_waitcnt(0);
        unsigned nloc = b.st[0], nx = b.st[1];
        if (nloc == 0u) { xcd_barrier_complete(bar, b.x, nloc, nx); b.st[0] = nloc; b.st[1] = nx; }
        const unsigned old = xb_add(&bar[XB_XSUB(b.x)], 1u);
        const unsigned gen = old / nloc;
        if (old + 1u == (gen + 1u) * nloc) {
            __builtin_amdgcn_fence(__ATOMIC_RELEASE, "agent");
            asm volatile("s_waitcnt vmcnt(0)" ::: "memory");
            const unsigned og = xb_add(&bar[XB_TOP], 1u);
            const unsigned tg = og / nx;
            if (og + 1u == (tg + 1u) * nx) xb_add(&bar[XB_TOPGEN], 1u);
            else XB_SPIN(xb_ld(&bar[XB_TOPGEN]) == tg, bar);
            __builtin_amdgcn_fence(__ATOMIC_ACQUIRE, "agent");
            xb_add(&bar[XB_XGEN(b.x)], 1u);
            asm volatile("s_waitcnt vmcnt(0)" ::: "memory");
        } else {
            XB_SPIN(xb_ld(&bar[XB_XGEN(b.x)]) == gen, bar);
            __builtin_amdgcn_fence(__ATOMIC_ACQUIRE, "agent");
            asm volatile("s_waitcnt vmcnt(0)" ::: "memory");
        }
    }
    __syncthreads();
}

namespace pg8 {
constexpr int BM = 256, BK = 64, HALF = 128, HTB = HALF * BK * 2, NXCD = 8, WGM = 8;
__device__ __forceinline__ int lds_byte(int r, int c) { const int st = (r >> 4) * 2 + (c >> 5), rr = r & 15, cc = c & 31, ob = rr * 64 + cc * 2; return st * 1024 + (ob ^ (((ob >> 9) & 1) << 5)); }
__device__ __forceinline__ void stage_rc(int b, int& R, int& C) { const int st = b / 1024, sb = b % 1024, swz = sb ^ (((sb >> 9) & 1) << 5); R = (st >> 1) * 16 + swz / 64; C = (st & 1) * 32 + (swz % 64) / 2; }
__device__ __forceinline__ int perm32(int rho) { const int n = rho >> 4, i = rho & 15; return 8 * (i >> 2) + 4 * n + (i & 3); }

struct Unit { const char* A; const char* B; int row0, col0, e, nvalid, j0; };

struct DenseOrder {
    const char* A; const char* Bt; int KB, nM, nN, nwg, G, c;
    __device__ __forceinline__ void init(const void* A_, const void* Bt_, int M, int N, int KB_, int G_, int c_) { A = (const char*)A_; Bt = (const char*)Bt_; KB = KB_; nM = M / BM; nN = N / BM; nwg = nM * nN; G = G_; c = c_; }
    __device__ __forceinline__ bool next(int i, Unit& u) const {
        const long L = (long)i * G + c; if (L >= nwg) return false;
        int wgid = (int)L; { const int q = nwg / NXCD, r = nwg % NXCD, xcd = wgid % NXCD, off = wgid / NXCD; wgid = (xcd < r ? xcd * (q + 1) : r * (q + 1) + (xcd - r) * q) + off; }
        const int nig = WGM * nN, gid = wgid / nig, fm = gid * WGM, gsz = (nM - fm) < WGM ? (nM - fm) : WGM;
        const int pm = fm + ((wgid % nig) % gsz), pn = (wgid % nig) / gsz;
        u.A = A + (size_t)pm * BM * KB; u.B = Bt + (size_t)pn * BM * KB; u.row0 = pm * BM; u.col0 = pn * BM; u.e = 0; u.nvalid = BM; u.j0 = 0; return true;
    }
    __device__ __forceinline__ unsigned row_off(const Unit&, int) const { return 0u; }
};
struct MoeOrder {
    const char* A; const char* Bt; size_t bExp; int KB; const LAS int* tb; const LAS int* ps; const LAS int* cn; const LAS int* ord; const int* tokE; int G, c; bool gather;
    __device__ __forceinline__ bool next(int i, Unit& u) const {
        const int L = i * G + c, total = tb[NEXP] * 4; if (L >= total) return false;
        const int rt = L >> 2, pn = L & 3;
        const int ej = __builtin_amdgcn_readfirstlane(ord[rt]);
        const int e = ej >> 8, j = ej & 255;
        const int pse = __builtin_amdgcn_readfirstlane(ps[e]), cne = __builtin_amdgcn_readfirstlane(cn[e]);
        u.e = e; u.row0 = pse + BM * j; u.col0 = pn * BM; u.nvalid = min(BM, cne - BM * j); u.j0 = e * ECAP + BM * j;
        u.B = Bt + (size_t)e * bExp + (size_t)pn * BM * KB;
        u.A = gather ? A : A + (size_t)u.row0 * KB;
        return true;
    }
    __device__ __forceinline__ unsigned row_off(const Unit& u, int R) const { const int t = R < u.nvalid ? tokE[u.j0 + R] : 0; return (unsigned)t * (unsigned)KB; }
};

template <class Epi, class Sched, int BMODE, bool GATHER, bool LIGHT = false, bool F8 = false>
__device__ __forceinline__ void gemm_phase(LAS unsigned char* lds, const int KB, const Sched& S, const Epi& E) {
    const int tid = opaque_tid(), wid = __builtin_amdgcn_readfirstlane(tid >> 6), lane = tid & 63, wr = wid >> 2, wc = wid & 3, fr = lane & 15, fq = lane >> 4;
    const int nt = KB / (BK * 2);
    unsigned voffA[2][2], voffAn[2][2], voffB[2]; int RA[2], CA[2];
#pragma unroll
    for (int i = 0; i < 2; ++i) { int R, C; stage_rc(tid * 16 + i * 8192, R, C); RA[i] = R; CA[i] = C;
        const int Rb = (BMODE == 1) ? (64 * (R >> 5) + perm32(R & 31)) : (Epi::PERM ? ((R & ~31) + perm32(R & 31)) : R);
        voffB[i] = (unsigned)(Rb * KB + C * 2);
#pragma unroll
        for (int h = 0; h < 2; ++h) { voffA[h][i] = (unsigned)((h * HALF + R) * KB + C * 2); voffAn[h][i] = voffA[h][i]; } }
    const size_t kstep = (size_t)(BK * 2);
    const size_t hstepB = (size_t)((BMODE == 1) ? 32 : HALF) * KB;
    const unsigned ldsw = (unsigned)wid * 1024u;
    const int aoff = lds_byte(wr * 64 + fr, fq * 8), boff = lds_byte(wc * 32 + fr, fq * 8);
#define PG8_SA(b, h) (((b) * 2 + (h)) * HTB)
#define PG8_SB(b, h) ((4 + (b) * 2 + (h)) * HTB)
#define PG8_STAGE2(bufoff, gbase, v0, v1) do { \
        __builtin_amdgcn_global_load_lds((const unsigned*)((const char*)(gbase) + (v0)), (LAS unsigned*)(lds + (bufoff) + ldsw), 16, 0, 0); \
        __builtin_amdgcn_global_load_lds((const unsigned*)((const char*)(gbase) + (v1)), (LAS unsigned*)(lds + (bufoff) + ldsw + 8192), 16, 0, 0); } while (0)
#define PG8_STAGEB(bufoff, gbase) PG8_STAGE2(bufoff, gbase, voffB[0], voffB[1])
#define PG8_STAGEA(bufoff, gbase, h, nx) PG8_STAGE2(bufoff, gbase, ((GATHER && (nx)) ? voffAn[h][0] : voffA[h][0]), ((GATHER && (nx)) ? voffAn[h][1] : voffA[h][1]))
#define PG8_LD32(p) __builtin_bit_cast(i32x8, __builtin_shufflevector(*(const LAS u32x4*)(p), *(const LAS u32x4*)((p) + 1024), 0, 1, 2, 3, 4, 5, 6, 7))
#define PG8_LDA(dst, b, h) do { _Pragma("unroll") for (int m = 0; m < 4; ++m) { if constexpr (F8) dst##8[m] = PG8_LD32(lds + PG8_SA(b, h) + aoff + m * 2048); \
        else { _Pragma("unroll") for (int k = 0; k < 2; ++k) dst[m][k] = *(const LAS bf16x8*)(lds + PG8_SA(b, h) + aoff + m * 2048 + k * 1024); } } } while (0)
#define PG8_LDB(dst, b, h) do { _Pragma("unroll") for (int n = 0; n < 2; ++n) { if constexpr (F8) dst##8[n] = PG8_LD32(lds + PG8_SB(b, h) + boff + n * 2048); \
        else { _Pragma("unroll") for (int k = 0; k < 2; ++k) dst[n][k] = *(const LAS bf16x8*)(lds + PG8_SB(b, h) + boff + n * 2048 + k * 1024); } } } while (0)
#define PG8_MMA(ai, bj, At, Bt) do { __builtin_amdgcn_s_setprio(1); _Pragma("unroll") for (int m = 0; m < 4; ++m) _Pragma("unroll") for (int n = 0; n < 2; ++n) { \
        if constexpr (F8) asm volatile("v_mfma_scale_f32_16x16x128_f8f6f4 %0, %1, %2, %0, %3, %3 op_sel_hi:[0,0,0]" : "+v"(acc[ai][bj][m][n]) : "v"(Bt##8[n]), "v"(At##8[m]), "v"(sc8));   \
        else { _Pragma("unroll") for (int k = 0; k < 2; ++k) acc[ai][bj][m][n] = __builtin_amdgcn_mfma_f32_16x16x32_bf16(Bt[n][k], At[m][k], acc[ai][bj][m][n], 0, 0, 0); } } \
        __builtin_amdgcn_s_setprio(0); } while (0)
#define PG8_WAIT_V(n) asm volatile("s_waitcnt vmcnt(" #n ")" ::: "memory")
#define PG8_WAIT_L(n) asm volatile("s_waitcnt lgkmcnt(" #n ")" ::: "memory")
#define PG8_BAR __builtin_amdgcn_s_barrier()
#define PG8_SCHED __builtin_amdgcn_sched_barrier(0)
    Unit cur, nxt; int ui = 0;
    if (!S.next(0, cur)) return;
    if (GATHER) {
#pragma unroll
        for (int h = 0; h < 2; ++h)
#pragma unroll
            for (int i = 0; i < 2; ++i) voffA[h][i] = S.row_off(cur, h * HALF + RA[i]) + (unsigned)CA[i] * 2u;
    }
    f32x4 acc[2][2][4][2];
#pragma unroll
    for (int a = 0; a < 2; ++a)
#pragma unroll
        for (int b = 0; b < 2; ++b)
#pragma unroll
            for (int m = 0; m < 4; ++m)
#pragma unroll
                for (int n = 0; n < 2; ++n) acc[a][b][m][n] = (f32x4){0.f, 0.f, 0.f, 0.f};
    unsigned sc8 = 0x7f7f7f7fu; asm volatile("" : "+v"(sc8));
    bf16x8 At[4][2], B0[2][2], B1[2][2]; i32x8 At8[4], B08[2], B18[2];
    const char* cA = cur.A; const char* cB = cur.B;
    PG8_STAGEB(PG8_SB(0, 0), cB); PG8_STAGEB(PG8_SB(0, 1), cB + hstepB); PG8_STAGEA(PG8_SA(0, 0), cA, 0, false); PG8_STAGEA(PG8_SA(0, 1), cA, 1, false);
    if (wr == 1) PG8_BAR;
    PG8_WAIT_V(2); PG8_BAR;
    PG8_STAGEB(PG8_SB(1, 0), cB + kstep); PG8_STAGEA(PG8_SA(1, 0), cA + kstep, 0, false); PG8_STAGEB(PG8_SB(1, 1), cB + hstepB + kstep);
    PG8_WAIT_V(6); PG8_BAR;
    for (;;) {
        const bool has_next = S.next(ui + 1, nxt);
        if (GATHER) {
#pragma unroll
            for (int h = 0; h < 2; ++h)
#pragma unroll
                for (int i = 0; i < 2; ++i) voffAn[h][i] = has_next ? (S.row_off(nxt, h * HALF + RA[i]) + (unsigned)CA[i] * 2u) : voffA[h][i];
        }
        const char* nA = has_next ? nxt.A : cA; const char* nB = has_next ? nxt.B : cB;
        const bool full = cur.nvalid > HALF;
        for (int t = 0; t < nt; t += 2) {
            const bool last = (t == nt - 2);
            const char* a1 = cA + (size_t)(t + 1) * kstep;
            const char* a2 = last ? nA : cA + (size_t)(t + 2) * kstep; const char* b2 = last ? nB : cB + (size_t)(t + 2) * kstep;
            const char* a3 = a2 + kstep; const char* b3 = b2 + kstep;
            PG8_LDB(B0, 0, 0); PG8_LDB(B1, 0, 1); PG8_SCHED; PG8_LDA(At, 0, 0); PG8_STAGEA(PG8_SA(1, 1), a1, 1, false);
            PG8_WAIT_V(8); PG8_WAIT_L(0); PG8_BAR; PG8_MMA(0, 0, At, B0); PG8_MMA(0, 1, At, B1); PG8_BAR; PG8_SCHED;
            PG8_LDA(At, 0, 1); PG8_STAGEB(PG8_SB(0, 0), b2); PG8_STAGEB(PG8_SB(0, 1), b2 + hstepB); PG8_STAGEA(PG8_SA(0, 0), a2, 0, last);
            PG8_WAIT_V(8); PG8_WAIT_L(0); PG8_BAR; if (!LIGHT || full) { PG8_MMA(1, 0, At, B0); PG8_MMA(1, 1, At, B1); } PG8_BAR; PG8_SCHED;
            PG8_LDB(B0, 1, 0); PG8_LDB(B1, 1, 1); PG8_SCHED; PG8_LDA(At, 1, 0); PG8_STAGEA(PG8_SA(0, 1), a2, 1, last);
            PG8_WAIT_V(8); PG8_WAIT_L(0); PG8_BAR; PG8_MMA(0, 0, At, B0); PG8_MMA(0, 1, At, B1); PG8_BAR; PG8_SCHED;
            PG8_LDA(At, 1, 1); PG8_STAGEB(PG8_SB(1, 0), b3); PG8_STAGEB(PG8_SB(1, 1), b3 + hstepB); PG8_STAGEA(PG8_SA(1, 0), a3, 0, last);
            PG8_WAIT_V(8); PG8_WAIT_L(0); PG8_BAR; if (!LIGHT || full) { PG8_MMA(1, 0, At, B0); PG8_MMA(1, 1, At, B1); } PG8_BAR; PG8_SCHED;
        }
        if (wr == 0) PG8_BAR;
        if constexpr (F8) asm volatile("s_nop 7\n\ts_nop 7\n\ts_nop 7" ::: "memory");
        E(acc, cur, wr, wc, fr, fq);
        if (!has_next) break;
#pragma unroll
        for (int a = 0; a < 2; ++a)
#pragma unroll
            for (int b = 0; b < 2; ++b)
#pragma unroll
                for (int m = 0; m < 4; ++m)
#pragma unroll
                    for (int n = 0; n < 2; ++n) acc[a][b][m][n] = (f32x4){0.f, 0.f, 0.f, 0.f};
        cur = nxt; cA = nA; cB = nB; ++ui;
        if (GATHER) {
#pragma unroll
            for (int h = 0; h < 2; ++h)
#pragma unroll
                for (int i = 0; i < 2; ++i) voffA[h][i] = voffAn[h][i];
        }
        if (wr == 1) PG8_BAR;
    }
    PG8_WAIT_V(0);
    PG8_BAR;
#undef PG8_SA
#undef PG8_SB
#undef PG8_STAGE2
#undef PG8_STAGEA
#undef PG8_STAGEB
#undef PG8_LDA
#undef PG8_LDB
#undef PG8_MMA
#undef PG8_LD32
#undef PG8_WAIT_V
#undef PG8_WAIT_L
#undef PG8_BAR
#undef PG8_SCHED
}

struct EpiProj {
    static constexpr bool PERM = true;
    bf16_t* out; const float* gq; const float* gk;
    __device__ __forceinline__ void operator()(const f32x4 (&acc)[2][2][4][2], const Unit& u, int wr, int wc, int fr, int fq) const {
        const int pn = u.col0 >> 8;
        const int row0 = u.row0 + wr * 64 + fr, colb = u.col0 + 64 * wc + 8 * fq;
        if (pn < 4) {
            const float* g = (pn < 2) ? gq : gk; const float post = (pn < 2) ? 0.125f : 1.0f;
            f32x4 gv[2][2];
#pragma unroll
            for (int bj = 0; bj < 2; ++bj)
#pragma unroll
                for (int n = 0; n < 2; ++n) gv[bj][n] = *(const f32x4*)(g + 32 * bj + 8 * fq + 4 * n) * post;
#pragma unroll
            for (int ai = 0; ai < 2; ++ai)
#pragma unroll
                for (int m = 0; m < 4; ++m) {
                    float ss = 0.f;
#pragma unroll
                    for (int bj = 0; bj < 2; ++bj)
#pragma unroll
                        for (int n = 0; n < 2; ++n) { const f32x4 x = acc[ai][bj][m][n]; ss += (x[0] * x[0] + x[1] * x[1]) + (x[2] * x[2] + x[3] * x[3]); }
                    ss += __shfl_xor(ss, 16); ss += __shfl_xor(ss, 32);
                    const float rstd = rsqrtf(ss * (1.0f / HD) + RMS_EPS);
                    bf16_t* rowp = out + (size_t)(row0 + ai * HALF + m * 16) * INW + colb;
#pragma unroll
                    for (int bj = 0; bj < 2; ++bj) { const f32x4 v0 = acc[ai][bj][m][0] * rstd * gv[bj][0], v1 = acc[ai][bj][m][1] * rstd * gv[bj][1];
                        u32x4 w; w.x = pack2(v0[0], v0[1]); w.y = pack2(v0[2], v0[3]); w.z = pack2(v1[0], v1[1]); w.w = pack2(v1[2], v1[3]);
                        *(u32x4*)(rowp + 32 * bj) = w; }
                }
        } else {
            const bool sg = pn >= 8;
#pragma unroll
            for (int ai = 0; ai < 2; ++ai)
#pragma unroll
                for (int m = 0; m < 4; ++m) {
                    bf16_t* rowp = out + (size_t)(row0 + ai * HALF + m * 16) * INW + colb;
#pragma unroll
                    for (int bj = 0; bj < 2; ++bj) { f32x4 v0 = acc[ai][bj][m][0], v1 = acc[ai][bj][m][1];
                        if (sg) {
#pragma unroll
                            for (int j = 0; j < 4; ++j) { v0[j] = sigmoidf_(v0[j]); v1[j] = sigmoidf_(v1[j]); } }
                        u32x4 w; w.x = pack2(v0[0], v0[1]); w.y = pack2(v0[2], v0[3]); w.z = pack2(v1[0], v1[1]); w.w = pack2(v1[2], v1[3]);
                        *(u32x4*)(rowp + 32 * bj) = w; }
                }
        }
    }
};
template <int MODE> struct EpiGate {
    static constexpr bool PERM = true;
    const bf16_t* gate; const bf16_t* t1in; bf16_t* out;
    __device__ __forceinline__ void operator()(const f32x4 (&acc)[2][2][4][2], const Unit& u, int wr, int wc, int fr, int fq) const {
        const int row0 = u.row0 + wr * 64 + fr, col0 = u.col0 + wc * 32 + 8 * fq;
#pragma unroll
        for (int ai = 0; ai < 2; ++ai)
#pragma unroll
            for (int m = 0; m < 4; ++m) {
                const size_t r = (size_t)(row0 + ai * HALF + m * 16);
#pragma unroll
                for (int bj = 0; bj < 2; ++bj) {
                    const int c = col0 + bj * HALF;
                    const u32x4 g = *(const u32x4*)(gate + r * INW + c);
                    const f32x4 a0 = acc[ai][bj][m][0], a1 = acc[ai][bj][m][1];
                    float o[8] = {a0[0] * bflo(g.x), a0[1] * bfhi(g.x), a0[2] * bflo(g.y), a0[3] * bfhi(g.y), a1[0] * bflo(g.z), a1[1] * bfhi(g.z), a1[2] * bflo(g.w), a1[3] * bfhi(g.w)};
                    if (MODE == 1) { const u32x4 t = *(const u32x4*)(t1in + r * DM + c);
                        o[0] += bflo(t.x); o[1] += bfhi(t.x); o[2] += bflo(t.y); o[3] += bfhi(t.y); o[4] += bflo(t.z); o[5] += bfhi(t.z); o[6] += bflo(t.w); o[7] += bfhi(t.w); }
                    u32x4 w; w.x = pack2(o[0], o[1]); w.y = pack2(o[2], o[3]); w.z = pack2(o[4], o[5]); w.w = pack2(o[6], o[7]);
                    *(u32x4*)(out + r * DM + c) = w;
                }
            }
    }
};
template <bool XF32> struct EpiResid {
    static constexpr bool PERM = true;
    const float* xf; bf16_t* xb;
    __device__ __forceinline__ void operator()(const f32x4 (&acc)[2][2][4][2], const Unit& u, int wr, int wc, int fr, int fq) const {
        const int row0 = u.row0 + wr * 64 + fr, col0 = u.col0 + wc * 32 + 8 * fq;
#pragma unroll
        for (int ai = 0; ai < 2; ++ai)
#pragma unroll
            for (int m = 0; m < 4; ++m) { const size_t off = (size_t)(row0 + ai * HALF + m * 16) * DM + col0;
#pragma unroll
                for (int bj = 0; bj < 2; ++bj) {
                    float x[8];
                    if (XF32) { const f32x4 a = *(const f32x4*)(xf + off + bj * HALF), b = *(const f32x4*)(xf + off + bj * HALF + 4);
                        x[0] = a[0]; x[1] = a[1]; x[2] = a[2]; x[3] = a[3]; x[4] = b[0]; x[5] = b[1]; x[6] = b[2]; x[7] = b[3]; }
                    else { const u32x4 t = *(const u32x4*)(xb + off + bj * HALF);
                        x[0] = bflo(t.x); x[1] = bfhi(t.x); x[2] = bflo(t.y); x[3] = bfhi(t.y); x[4] = bflo(t.z); x[5] = bfhi(t.z); x[6] = bflo(t.w); x[7] = bfhi(t.w); }
                    const f32x4 a0 = acc[ai][bj][m][0], a1 = acc[ai][bj][m][1];
                    u32x4 w; w.x = pack2(x[0] + a0[0], x[1] + a0[1]); w.y = pack2(x[2] + a0[2], x[3] + a0[3]); w.z = pack2(x[4] + a1[0], x[5] + a1[1]); w.w = pack2(x[6] + a1[2], x[7] + a1[3]);
                    *(u32x4*)(xb + off + bj * HALF) = w;
                }
            }
    }
};
template <bool F8> struct EpiSwiGLU {
    static constexpr bool PERM = true;
    void* act;
    __device__ __forceinline__ void operator()(const f32x4 (&acc)[2][2][4][2], const Unit& u, int wr, int wc, int fr, int fq) const {
        const int row0 = u.row0 + wr * 64 + fr, col0 = (u.col0 >> 1) + wc * 32 + 8 * fq;
        const float si = F8 ? (1.0f / W8_SCALE) : 1.0f, so = F8 ? A8_SCALE : 1.0f;
#pragma unroll
        for (int ai = 0; ai < 2; ++ai)
#pragma unroll
            for (int m = 0; m < 4; ++m) {
                float o[8];
#pragma unroll
                for (int n = 0; n < 2; ++n)
#pragma unroll
                    for (int j = 0; j < 4; ++j) { const float a = acc[ai][0][m][n][j] * si, b = acc[ai][1][m][n][j] * (si * so); o[4 * n + j] = a * sigmoidf_(a) * b; }
                const size_t off = (size_t)(row0 + ai * HALF + m * 16) * EH + col0;
                if (F8) { u32x2 w; w.x = pack4_fp8(o[0], o[1], o[2], o[3]); w.y = pack4_fp8(o[4], o[5], o[6], o[7]); *(u32x2*)((unsigned char*)act + off) = w; }
                else { u32x4 w; w.x = pack2(o[0], o[1]); w.y = pack2(o[2], o[3]); w.z = pack2(o[4], o[5]); w.w = pack2(o[6], o[7]); *(u32x4*)((bf16_t*)act + off) = w; }
            }
    }
};
template <bool F8> struct EpiDown {
    static constexpr bool PERM = true;
    bf16_t* yb; const float* tokW;
    __device__ __forceinline__ void operator()(const f32x4 (&acc)[2][2][4][2], const Unit& u, int wr, int wc, int fr, int fq) const {
        const int col0 = u.col0 + wc * 32 + 8 * fq;
        const float si = F8 ? (1.0f / (W8_SCALE * A8_SCALE)) : 1.0f;
#pragma unroll
        for (int ai = 0; ai < 2; ++ai)
#pragma unroll
            for (int m = 0; m < 4; ++m) {
                const int rl = wr * 64 + fr + ai * HALF + m * 16;
                const float w = rl < u.nvalid ? tokW[u.j0 + rl] * si : 0.f;
#pragma unroll
                for (int bj = 0; bj < 2; ++bj) { const f32x4 v0 = acc[ai][bj][m][0] * w, v1 = acc[ai][bj][m][1] * w;
                    u32x4 o; o.x = pack2(v0[0], v0[1]); o.y = pack2(v0[2], v0[3]); o.z = pack2(v1[0], v1[1]); o.w = pack2(v1[2], v1[3]);
                    *(u32x4*)(yb + (size_t)(u.row0 + rl) * DM + col0 + bj * HALF) = o; }
            }
    }
};
}

constexpr int ATT_K_OFF = 0, ATT_V_OFF = 49152;
__device__ __forceinline__ unsigned kv_off(unsigned row, unsigned ch) { return row * 128u + 16u * (ch ^ (((row >> 1) & 7u) ^ ((row & 2u) << 1))); }

struct AttnU { int tok0, d, blk, g, h; };
__device__ __forceinline__ AttnU attn_decode(int uidx) {
    const int bh = uidx / 48, r48 = uidx % 48, g = r48 >> 4, rr = r48 & 15;
    AttnU U; U.g = g; U.h = bh & 7;
    U.d = (g == 0) ? 1 : (g == 1 ? 4 : 16);
    const int c = (g == 0) ? 0 : (g == 1 ? (rr >> 2) : rr);
    U.blk = (g == 0) ? rr : (g == 1 ? (rr & 3) : 0);
    U.tok0 = (bh >> 3) * SEQ + c;
    return U;
}
__device__ __forceinline__ void attn_load_q(const AttnU& U, const bf16_t* __restrict__ proj, int wid, int lane, bf16x8 (&qn)[4]) {
    const size_t qt = (size_t)(U.tok0 + (256 * U.blk + 32 * wid + (lane & 31)) * U.d);
#pragma unroll
    for (int ks = 0; ks < 4; ++ks) qn[ks] = *(const bf16x8*)(proj + qt * INW + U.h * HD + 16 * ks + 8 * (lane >> 5));
}
__device__ __forceinline__ void attn_load(const AttnU& U, const bf16_t* __restrict__ proj, int tid, u32x4 (&kr)[6], u32x4 (&vr)[6]) {
    const int kbase = 256 * U.blk - 128, kr_min = (U.blk == 0) ? 128 : 0;
#pragma unroll
    for (int i = 0; i < 6; ++i) {
        const int idx = tid + NTHREADS * i, row = idx >> 3, ch = idx & 7;
        if (row >= kr_min) {
            const size_t t = (size_t)(U.tok0 + (kbase + row) * U.d);
            kr[i] = *(const u32x4*)(proj + t * INW + AW + U.h * HD + ch * 8);
            vr[i] = *(const u32x4*)(proj + t * INW + 2 * AW + U.h * HD + ch * 8);
        }
    }
}
__device__ __forceinline__ void attn_lds_store(const AttnU& U, LAS unsigned char* lds, int tid, const u32x4 (&kr)[6], const u32x4 (&vr)[6]) {
    const int kr_min = (U.blk == 0) ? 128 : 0;
#pragma unroll
    for (int i = 0; i < 6; ++i) {
        const int idx = tid + NTHREADS * i, row = idx >> 3, ch = idx & 7;
        if (row >= kr_min) { *(LAS u32x4*)(lds + ATT_K_OFF + kv_off(row, ch)) = kr[i]; *(LAS u32x4*)(lds + ATT_V_OFF + kv_off(row, ch)) = vr[i]; }
    }
}
__device__ __forceinline__ void attn_compute(const AttnU& U, LAS unsigned char* lds, const bf16x8 (&qf)[4], bf16_t* __restrict__ og, f32x2* __restrict__ ml, int wid, int lane) {
    const int blk = U.blk, g = U.g, h = U.h;
    const size_t qt = (size_t)(U.tok0 + (256 * blk + 32 * wid + (lane & 31)) * U.d);
    const int kt_min = (blk == 0) ? max(0, 4 - wid) : 0;
    const int hq = lane >> 5, qi = lane & 31;
    f32x16 S[5];
#pragma unroll
    for (int kt = 0; kt < 5; ++kt) {
#pragma unroll
        for (int i = 0; i < 16; ++i) S[kt][i] = 0.f;
        if (kt >= kt_min) {
            const unsigned krow = (unsigned)(32 * wid + 32 * kt + qi);
#pragma unroll
            for (int ks = 0; ks < 4; ++ks) {
                const bf16x8 kf = *(const LAS bf16x8*)(lds + ATT_K_OFF + kv_off(krow, (unsigned)(2 * ks + hq)));
                S[kt] = __builtin_amdgcn_mfma_f32_32x32x16_bf16(kf, qf[ks], S[kt], 0, 0, 0);
            }
        }
    }
    float mx = -3.0e38f;
#pragma unroll
    for (int kt = 0; kt < 5; ++kt)
#pragma unroll
        for (int i = 0; i < 16; ++i) {
            const int row = (i & 3) + 8 * (i >> 2) + 4 * hq;
            bool valid = kt >= kt_min;
            if (kt == 0) valid = valid && (row >= qi);
            if (kt == 4) valid = valid && (row <= qi);
            S[kt][i] = valid ? S[kt][i] : -3.0e38f;
            mx = fmaxf(mx, S[kt][i]);
        }
    mx = fmaxf(mx, __shfl_xor(mx, 32));
    float lsum = 0.f;
#pragma unroll
    for (int kt = 0; kt < 5; ++kt)
#pragma unroll
        for (int i = 0; i < 16; ++i) { const float p = (S[kt][i] > -1.0e38f) ? __expf(S[kt][i] - mx) : 0.f; S[kt][i] = p; lsum += p; }
    lsum += __shfl_xor(lsum, 32);
    f32x16 O[2];
#pragma unroll
    for (int dt = 0; dt < 2; ++dt)
#pragma unroll
        for (int i = 0; i < 16; ++i) O[dt][i] = 0.f;
    const unsigned blkq = (lane >> 4) & 1, q4 = (lane & 15) >> 2, p4 = lane & 3;
    const unsigned vbase = (unsigned)(size_t)(lds + ATT_V_OFF);
#pragma unroll
    for (int kt = 0; kt < 5; ++kt) {
        if (kt >= kt_min) {
#pragma unroll
            for (int s = 0; s < 2; ++s) {
                u32x4 pw;
                pw.x = pack2(S[kt][8 * s + 0], S[kt][8 * s + 1]); pw.y = pack2(S[kt][8 * s + 2], S[kt][8 * s + 3]);
                pw.z = pack2(S[kt][8 * s + 4], S[kt][8 * s + 5]); pw.w = pack2(S[kt][8 * s + 6], S[kt][8 * s + 7]);
                const bf16x8 pf = __builtin_bit_cast(bf16x8, pw);
                u32x2 v00, v01, v10, v11;
                const unsigned r0 = (unsigned)(32 * wid + 32 * kt + 16 * s + 4 * hq) + q4, r1 = r0 + 8;
                const unsigned a00 = vbase + kv_off(r0, 0u + 2 * blkq + (p4 >> 1)) + 8 * (p4 & 1), a01 = vbase + kv_off(r1, 0u + 2 * blkq + (p4 >> 1)) + 8 * (p4 & 1);
                const unsigned a10 = vbase + kv_off(r0, 4u + 2 * blkq + (p4 >> 1)) + 8 * (p4 & 1), a11 = vbase + kv_off(r1, 4u + 2 * blkq + (p4 >> 1)) + 8 * (p4 & 1);
                asm volatile("ds_read_b64_tr_b16 %0, %4\n\tds_read_b64_tr_b16 %1, %5\n\tds_read_b64_tr_b16 %2, %6\n\tds_read_b64_tr_b16 %3, %7\n\ts_waitcnt lgkmcnt(0)"
                             : "=&v"(v00), "=&v"(v01), "=&v"(v10), "=&v"(v11) : "v"(a00), "v"(a01), "v"(a10), "v"(a11) : "memory");
                u32x4 f0; f0.x = v00.x; f0.y = v00.y; f0.z = v01.x; f0.w = v01.y;
                u32x4 f1; f1.x = v10.x; f1.y = v10.y; f1.z = v11.x; f1.w = v11.y;
                O[0] = __builtin_amdgcn_mfma_f32_32x32x16_bf16(__builtin_bit_cast(bf16x8, f0), pf, O[0], 0, 0, 0);
                O[1] = __builtin_amdgcn_mfma_f32_32x32x16_bf16(__builtin_bit_cast(bf16x8, f1), pf, O[1], 0, 0, 0);
            }
        }
    }
    const float inv = 1.0f / lsum;
    bf16_t* orow = og + ((size_t)g * NTOK + qt) * AW + h * HD;
#pragma unroll
    for (int dt = 0; dt < 2; ++dt)
#pragma unroll
        for (int gq4 = 0; gq4 < 4; ++gq4) {
            u32x2 w; w.x = pack2(O[dt][4 * gq4 + 0] * inv, O[dt][4 * gq4 + 1] * inv); w.y = pack2(O[dt][4 * gq4 + 2] * inv, O[dt][4 * gq4 + 3] * inv);
            *(u32x2*)(orow + 32 * dt + 8 * gq4 + 4 * hq) = w;
        }
    if (lane < 32) ml[((size_t)g * NTOK + qt) * 8 + h] = (f32x2){mx, lsum};
    __syncthreads();
}

struct TrDesc { const float* src; bf16_t* dst; int N, K; };
__device__ __forceinline__ void tr_load(const TrDesc& d, int lane, f32x4 (&r)[8]) {
#pragma unroll
    for (int i = 0; i < 8; ++i) r[i] = __builtin_nontemporal_load((const f32x4*)(d.src + (size_t)((lane >> 3) + 8 * i) * d.N + 4 * (lane & 7)));
}
__device__ __forceinline__ void tr_store(const TrDesc& d, LAS float* scr, int lane, const f32x4 (&r)[8]) {
#pragma unroll
    for (int i = 0; i < 8; ++i) { LAS float* p = scr + ((lane >> 3) + 8 * i) * 33 + 4 * (lane & 7); p[0] = r[i][0]; p[1] = r[i][1]; p[2] = r[i][2]; p[3] = r[i][3]; }
    const int c = lane & 7;
#pragma unroll
    for (int j = 0; j < 4; ++j) { const int n = (lane >> 3) + 8 * j; const LAS float* q = scr + (8 * c) * 33 + n;
        u32x4 o; o.x = pack2(q[0 * 33], q[1 * 33]); o.y = pack2(q[2 * 33], q[3 * 33]); o.z = pack2(q[4 * 33], q[5 * 33]); o.w = pack2(q[6 * 33], q[7 * 33]);
        *(u32x4*)(d.dst + (size_t)n * d.K + 8 * c) = o; }
}
struct ExpertItems {
    const float* weg; const float* weu; const float* wed; bf16_t* WguT; bf16_t* WdT;
    static constexpr int TOTAL = 3 * NEXP * 256;
    __device__ __forceinline__ TrDesc operator()(int it) const {
        const int which = it >> 13, r = it & 8191, e = r >> 8, item = r & 255; TrDesc d;
        if (which < 2) { const int kb = item >> 4, nb = item & 15, k0 = 64 * kb, n0 = 32 * nb, nn0 = (n0 >> 7) * 256 + which * 128 + (n0 & 127);
            d.src = (which == 0 ? weg : weu) + (size_t)e * DM * EH + (size_t)k0 * EH + n0; d.dst = WguT + (size_t)e * DM * DM + (size_t)nn0 * DM + k0; d.N = EH; d.K = DM; }
        else { const int kb = item >> 5, nb = item & 31, k0 = 64 * kb, n0 = 32 * nb;
            d.src = wed + (size_t)e * EH * DM + (size_t)k0 * DM + n0; d.dst = WdT + (size_t)e * DM * EH + (size_t)n0 * EH + k0; d.N = DM; d.K = EH; }
        return d;
    }
};
struct SmallItems {
    const float* win; const float* wa; const float* wo; bf16_t* WinT; bf16_t* WaT; bf16_t* WoT;
    static constexpr int TOTAL = 2 * 2816;
    __device__ __forceinline__ TrDesc operator()(int it) const {
        const int l = it / 2816, r = it % 2816; TrDesc d;
        if (r < 2048) { const int kb = r >> 7, nb = r & 127; d.src = win + (size_t)l * DM * INW + (size_t)(64 * kb) * INW + 32 * nb; d.dst = WinT + (size_t)l * INW * DM + (size_t)(32 * nb) * DM + 64 * kb; d.N = INW; d.K = DM; }
        else if (r < 2304) { const int q = r - 2048, kb = q >> 5, nb = q & 31; d.src = wa + (size_t)l * AW * DM + (size_t)(64 * kb) * DM + 32 * nb; d.dst = WaT + (size_t)l * DM * AW + (size_t)(32 * nb) * AW + 64 * kb; d.N = DM; d.K = AW; }
        else { const int q = r - 2304, kb = q >> 5, nb = q & 31; d.src = wo + (size_t)l * DM * DM + (size_t)(64 * kb) * DM + 32 * nb; d.dst = WoT + (size_t)l * DM * DM + (size_t)(32 * nb) * DM + 64 * kb; d.N = DM; d.K = DM; }
        return d;
    }
};
template <class Items>
__device__ __forceinline__ void convert_items(const Items& I, LAS float* scr, int lane, int gw, int NGW) {
    f32x4 ra[8], rb[8];
    int it = gw;
    if (it >= Items::TOTAL) return;
    TrDesc da = I(it), db = da;
    tr_load(da, lane, ra);
    for (;;) {
        int it2 = it + NGW;
        if (it2 < Items::TOTAL) { db = I(it2); tr_load(db, lane, rb); }
        tr_store(da, scr, lane, ra);
        it = it2; if (it >= Items::TOTAL) break;
        it2 = it + NGW;
        if (it2 < Items::TOTAL) { da = I(it2); tr_load(da, lane, ra); }
        tr_store(db, scr, lane, rb);
        it = it2; if (it >= Items::TOTAL) break;
    }
}
__device__ __forceinline__ int tr8_swz(int k) { return (k & 31) ^ ((k >> 5) << 3); }
__device__ __forceinline__ void tr_load8(const TrDesc& d, int lane, f32x4 (&r)[16]) {
#pragma unroll
    for (int i = 0; i < 16; ++i) r[i] = __builtin_nontemporal_load((const f32x4*)(d.src + (size_t)((lane >> 3) + 8 * i) * d.N + 4 * (lane & 7)));
}
__device__ __forceinline__ void tr_write8(LAS float* scr, int lane, const f32x4 (&r)[16]) {
#pragma unroll
    for (int i = 0; i < 16; ++i) { const int kk = (lane >> 3) + 8 * i, sw = tr8_swz(kk), n4 = 4 * (lane & 7); LAS float* p = scr + kk * 32;
        p[(n4 + 0) ^ sw] = r[i][0]; p[(n4 + 1) ^ sw] = r[i][1]; p[(n4 + 2) ^ sw] = r[i][2]; p[(n4 + 3) ^ sw] = r[i][3]; }
}
__device__ __forceinline__ void tr_out8(const TrDesc& d, const LAS float* scr, int lane) {
    const int c = lane >> 3;
#pragma unroll
    for (int j = 0; j < 4; ++j) { const int n = (lane & 7) + 8 * j; float f[16];
#pragma unroll
        for (int q = 0; q < 16; ++q) { const int k = 16 * c + q; f[q] = scr[k * 32 + (n ^ tr8_swz(k))] * W8_SCALE; }
        u32x4 o; o.x = pack4_fp8(f[0], f[1], f[2], f[3]); o.y = pack4_fp8(f[4], f[5], f[6], f[7]); o.z = pack4_fp8(f[8], f[9], f[10], f[11]); o.w = pack4_fp8(f[12], f[13], f[14], f[15]);
        *(u32x4*)((unsigned char*)d.dst + (size_t)n * d.K + 16 * c) = o; }
}
struct ExpertItems8 {
    const float* weg; const float* weu; const float* wed; unsigned char* WguT; unsigned char* WdT;
    static constexpr int TOTAL = 3 * NEXP * 128;
    __device__ __forceinline__ TrDesc operator()(int it) const {
        const int which = it >> 12, r = it & 4095, e = r >> 7, item = r & 127; TrDesc d;
        if (which < 2) { const int kb = item >> 4, nb = item & 15, k0 = 128 * kb, n0 = 32 * nb, nn0 = (n0 >> 7) * 256 + which * 128 + (n0 & 127);
            d.src = (which == 0 ? weg : weu) + (size_t)e * DM * EH + (size_t)k0 * EH + n0; d.dst = (bf16_t*)(WguT + (size_t)e * DM * DM + (size_t)nn0 * DM + k0); d.N = EH; d.K = DM; }
        else { const int kb = item >> 5, nb = item & 31, k0 = 128 * kb, n0 = 32 * nb;
            d.src = wed + (size_t)e * EH * DM + (size_t)k0 * DM + n0; d.dst = (bf16_t*)(WdT + (size_t)e * DM * EH + (size_t)n0 * EH + k0); d.N = DM; d.K = EH; }
        return d;
    }
};
template <class Items>
__device__ __forceinline__ void convert_items8(const Items& I, LAS float* scr, int lane, int gw, int NGW) {
    f32x4 r[16];
    int it = gw;
    if (it >= Items::TOTAL) return;
    TrDesc d = I(it);
    tr_load8(d, lane, r);
    for (;;) {
        tr_write8(scr, lane, r);
        const int it2 = it + NGW; const bool has = it2 < Items::TOTAL;
        TrDesc dn = d;
        if (has) { dn = I(it2); tr_load8(dn, lane, r); }
        tr_out8(d, scr, lane);
        if (!has) break;
        d = dn; it = it2;
    }
}
__device__ __forceinline__ void norm_row(const float* __restrict__ xr, const float* __restrict__ g, bf16_t* __restrict__ hr, int lane) {
    f32x4 v[4]; float ss = 0.f;
#pragma unroll
    for (int i = 0; i < 4; ++i) { v[i] = *(const f32x4*)(xr + (i * 64 + lane) * 4); ss += (v[i][0] * v[i][0] + v[i][1] * v[i][1]) + (v[i][2] * v[i][2] + v[i][3] * v[i][3]); }
    ss = wave_sum(ss);
    const float rstd = rsqrtf(ss * (1.0f / DM) + RMS_EPS);
#pragma unroll
    for (int i = 0; i < 4; ++i) {
        const f32x4 gv = *(const f32x4*)(g + (i * 64 + lane) * 4);
        u32x2 w; w.x = pack2(v[i][0] * rstd * gv[0], v[i][1] * rstd * gv[1]); w.y = pack2(v[i][2] * rstd * gv[2], v[i][3] * rstd * gv[3]);
        *(u32x2*)(hr + (i * 64 + lane) * 4) = w;
    }
}
typedef const __attribute__((address_space(4))) float* cfp;
typedef const __attribute__((address_space(4))) f32x2* cf2p;
__device__ __forceinline__ void unpack8(const u32x4 v, float (&f)[8]) { f[0] = bflo(v.x); f[1] = bfhi(v.x); f[2] = bflo(v.y); f[3] = bfhi(v.y); f[4] = bflo(v.z); f[5] = bfhi(v.z); f[6] = bflo(v.w); f[7] = bfhi(v.w); }
template <int W>
__device__ __forceinline__ void pool_path(const u32x4 (&r)[23], int pos0, bf16_t* __restrict__ pl, size_t t0, int c0) {
    float sum[8] = {0.f, 0.f, 0.f, 0.f, 0.f, 0.f, 0.f, 0.f}, f[8];
#pragma unroll
    for (int j = 1; j < W; ++j) { unpack8(r[15 - j], f);
#pragma unroll
        for (int c = 0; c < 8; ++c) sum[c] += f[c]; }
#pragma unroll
    for (int i = 0; i < 8; ++i) {
        float u[8]; unpack8(r[15 + i], u);
        if (i > 0) { unpack8(r[15 + i - W], f);
#pragma unroll
            for (int c = 0; c < 8; ++c) sum[c] -= f[c]; }
#pragma unroll
        for (int c = 0; c < 8; ++c) sum[c] += u[c];
        const float ic = 1.0f / (float)min(pos0 + i + 1, W);
        u32x4 o; o.x = pack2(sum[0] * ic - u[0], sum[1] * ic - u[1]); o.y = pack2(sum[2] * ic - u[2], sum[3] * ic - u[3]);
        o.z = pack2(sum[4] * ic - u[4], sum[5] * ic - u[5]); o.w = pack2(sum[6] * ic - u[6], sum[7] * ic - u[7]);
        *(u32x4*)(pl + (t0 + i) * PW + c0) = o;
    }
}
__device__ __forceinline__ int scan32_excl(int v, int lane, int& total) {
    int inc = v;
#pragma unroll
    for (int o = 1; o < 32; o <<= 1) { const int t = __shfl_up(inc, o, 32); if ((lane & 31) >= o) inc += t; }
    total = __shfl(inc, 31, 32);
    return inc - v;
}
__device__ __forceinline__ void build_moe_tables(LAS int* L, const unsigned* cnt) {
    { unsigned a_ = (unsigned)(size_t)L; asm volatile("" : "+s"(a_)); L = (LAS int*)(size_t)a_; }
    const int tid = opaque_tid();
    if (tid < 64) {
        const int lane = tid, e = lane & 31;
        const int c = (int)__hip_atomic_load(cnt + e * 64, __ATOMIC_RELAXED, __HIP_MEMORY_SCOPE_AGENT);
        const int nt = (c + 255) >> 8, lastv = c - 256 * (nt - 1);
        const int lt = (nt > 0 && lastv <= 128) ? 1 : 0, hv = nt - lt;
        int Tt, Th, Tl;
        const int tbx = scan32_excl(nt, lane, Tt), hx = scan32_excl(hv, lane, Th), lx = scan32_excl(lt, lane, Tl);
        if (lane < 32) {
            L[LI_TB + e] = tbx; L[LI_PS + e] = tbx * 256; L[LI_CN + e] = c;
            for (int j = 0; j < hv; ++j) L[LI_ORD + hx + j] = (e << 8) | j;
            if (lt) L[LI_ORD + Th + lx] = (e << 8) | (nt - 1);
            if (lane == 31) { L[LI_TB + NEXP] = Tt; L[LI_PS + NEXP] = Tt * 256; L[LI_NT] = Tt; }
        }
    }
    __syncthreads();
}

struct Args { const float* in[18]; float* out; unsigned char* ws; int ph_lo, ph_hi; };
typedef const __attribute__((address_space(4))) Args* CArgsP;
__device__ __forceinline__ CArgsP kargs() { unsigned long long p = (unsigned long long)__builtin_amdgcn_kernarg_segment_ptr(); asm volatile("" : "+s"(p)); return (CArgsP)p; }
#define PHASE_PTRS \
    const int G = opaque_s(G0), bx = opaque_s(bx0), vcu = opaque_s(vcu0), NGW = G * NWAVES; (void)bx; (void)vcu; (void)NGW; \
    const CArgsP ka = kargs(); unsigned char* const ws = ka->ws; \
    unsigned* const ctrl = (unsigned*)(ws + OFF_CTRL); const float* const x_in = ka->in[0]; \
    bf16_t* const WinT = (bf16_t*)(ws + OFF_WIN); bf16_t* const WaT = (bf16_t*)(ws + OFF_WA); bf16_t* const WppT = (bf16_t*)(ws + OFF_WPP); bf16_t* const WoT = (bf16_t*)(ws + OFF_WO); \
    bf16_t* const WguT = (bf16_t*)(ws + OFF_WGU); bf16_t* const WdT = (bf16_t*)(ws + OFF_WD); \
    bf16_t* const Hb = (bf16_t*)(ws + OFF_H); bf16_t* const MG = Hb; bf16_t* const PROJ = (bf16_t*)(ws + OFF_PROJ); bf16_t* const ACT = (bf16_t*)(ws + OFF_ACT); bf16_t* const YB = (bf16_t*)(ws + OFF_YB); \
    bf16_t* const AC = (bf16_t*)(ws + OFF_AC); bf16_t* const PL = (bf16_t*)(ws + OFF_PL); bf16_t* const OG = (bf16_t*)(ws + OFF_OG); bf16_t* const T1 = (bf16_t*)(ws + OFF_T1); \
    f32x2* const ML = (f32x2*)(ws + OFF_ML); bf16_t* const XB = (bf16_t*)(ws + OFF_XB); int* const tokE = (int*)(ws + OFF_TOKE); float* const tokW = (float*)(ws + OFF_TOKW); int* const asg = (int*)(ws + OFF_ASG); \
    (void)ctrl; (void)x_in; (void)WinT; (void)WaT; (void)WppT; (void)WoT; (void)WguT; (void)WdT; (void)Hb; (void)MG; (void)PROJ; (void)ACT; (void)YB; (void)AC; (void)PL; (void)OG; (void)T1; (void)ML; (void)XB; (void)tokE; (void)tokW; (void)asg
#define LAYER_PTRS PHASE_PTRS; const int tid = opaque_tid(), lane = tid & 63, wid = __builtin_amdgcn_readfirstlane(tid >> 6), gw = vcu * NWAVES + wid; (void)lane; (void)gw; unsigned* const cnt = ctrl + CW_CNT + l * 2048; (void)cnt

#ifndef PHASE_MASK
#define PHASE_MASK 0x3ff
#endif
#define EN(j) (((PHASE_MASK) >> (j)) & 1)
#ifndef REP_MASK
#define REP_MASK 0
#endif
#define REPS(j) (1 + (((REP_MASK) >> (j)) & 1))
#define IN(k) (MK_N_LAUNCHES == 1 || (lo <= (k) && (k) < hi))
#ifndef PROBE_A
#define PROBE_A -1
#define PROBE_B -1
#endif
#define STAMP_BEGIN(k) do { if (PROBE_A == (k)) ts0 = __builtin_amdgcn_s_memrealtime(); } while (0)
#define SEAM(k) do { if (IN(k) && IN((k) + 1)) { XcdBarrier b2_ = bar; unsigned long long p_ = (unsigned long long)b2_.bar; asm volatile("" : "+s"(p_)); b2_.bar = (unsigned*)p_; xcd_barrier(b2_); } if (PROBE_B == (k)) ts1 = __builtin_amdgcn_s_memrealtime(); } while (0)

template <int l>
__device__ __forceinline__ void layer_body(const XcdBarrier& bar, LAS unsigned char* lds, LAS int* LC, const int G0, const int bx0, const int vcu0, const int lo, const int hi, unsigned long long& ts0, unsigned long long& ts1) {
        const int pb = 1 + 9 * l;
        STAMP_BEGIN(pb + 0);
        for (int rep = 0; rep < REPS(0); ++rep) if (EN(0) && IN(pb + 0)) {
            asm volatile("; PHASE_MARK 0");
            LAYER_PTRS;
            pg8::DenseOrder S; S.init(Hb, WinT + (size_t)l * INW * DM, NTOK, INW, DM * 2, G, bx);
            pg8::EpiProj E{PROJ, ka->in[3] + (size_t)l * HD, ka->in[4] + (size_t)l * HD};
            pg8::gemm_phase<pg8::EpiProj, pg8::DenseOrder, 1, false>(lds, DM * 2, S, E);
        }
        SEAM(pb + 0);
        STAMP_BEGIN(pb + 1);
        for (int rep = 0; rep < REPS(1); ++rep) if (EN(1) && IN(pb + 1)) {
            asm volatile("; PHASE_MARK 1");
            LAYER_PTRS;
            int u = vcu;
            if (u < 1536) {
                AttnU cu = attn_decode(u), nu = cu;
                u32x4 kr[6], vr[6]; bf16x8 qf[4];
                attn_load(cu, PROJ, tid, kr, vr);
                for (;;) {
                    attn_load_q(cu, PROJ, wid, lane, qf);
                    attn_lds_store(cu, lds, tid, kr, vr);
                    __syncthreads();
                    const int un = u + G; const bool hn = un < 1536;
                    if (hn) { nu = attn_decode(un); attn_load(nu, PROJ, tid, kr, vr); }
                    attn_compute(cu, lds, qf, OG, ML, wid, lane);
                    if (!hn) break;
                    cu = nu; u = un;
                }
            }
        }
        SEAM(pb + 1);
        STAMP_BEGIN(pb + 2);
        for (int rep = 0; rep < REPS(2); ++rep) if (EN(2) && IN(pb + 2)) {
            asm volatile("; PHASE_MARK 2");
            LAYER_PTRS;
            for (int grp = gw; grp < NTOK / 8; grp += NGW) {
                const size_t t0 = (size_t)grp * 8; const int c0 = 8 * lane, hh = lane >> 3;
                {
                    f32x2 sm[8][3]; u32x4 v[8][3];
#pragma unroll
                    for (int i = 0; i < 8; ++i)
#pragma unroll
                        for (int g = 0; g < 3; ++g) { sm[i][g] = ML[((size_t)g * NTOK + t0 + i) * 8 + hh]; v[i][g] = *(const u32x4*)(OG + ((size_t)g * NTOK + t0 + i) * AW + c0); }
#pragma unroll
                    for (int i = 0; i < 8; ++i) {
                        const float M = fmaxf(fmaxf(sm[i][0][0], sm[i][1][0]), sm[i][2][0]);
                        float w[3], W = 0.f;
#pragma unroll
                        for (int g = 0; g < 3; ++g) { w[g] = sm[i][g][1] * __expf(sm[i][g][0] - M); W += w[g]; }
                        const float iw = 1.0f / W;
                        float o[8] = {0.f, 0.f, 0.f, 0.f, 0.f, 0.f, 0.f, 0.f}, f[8];
#pragma unroll
                        for (int g = 0; g < 3; ++g) { unpack8(v[i][g], f); const float q = w[g] * iw;
#pragma unroll
                            for (int c = 0; c < 8; ++c) o[c] += q * f[c]; }
                        u32x4 ow; ow.x = pack2(o[0], o[1]); ow.y = pack2(o[2], o[3]); ow.z = pack2(o[4], o[5]); ow.w = pack2(o[6], o[7]);
                        *(u32x4*)(AC + (t0 + i) * AW + c0) = ow;
                    }
                }
                {
                    const int pos0 = (int)(t0 & (SEQ - 1)), g4 = lane >> 4, wnd = 2 << g4;
                    u32x4 r[23];
#pragma unroll
                    for (int k = 0; k < 23; ++k) { const bool need = (k >= 16 - wnd) && (pos0 - 15 + k >= 0);
                        r[k] = need ? *(const u32x4*)(PROJ + (t0 - 15 + k) * INW + 3 * AW + c0) : (u32x4){0u, 0u, 0u, 0u}; }
                    if (g4 == 0) pool_path<2>(r, pos0, PL, t0, c0);
                    else if (g4 == 1) pool_path<4>(r, pos0, PL, t0, c0);
                    else if (g4 == 2) pool_path<8>(r, pos0, PL, t0, c0);
                    else pool_path<16>(r, pos0, PL, t0, c0);
                }
            }
        }
        SEAM(pb + 2);
        STAMP_BEGIN(pb + 3);
        for (int rep = 0; rep < REPS(3); ++rep) if (EN(3) && IN(pb + 3)) {
            asm volatile("; PHASE_MARK 3");
            LAYER_PTRS;
            { pg8::DenseOrder S; S.init(AC, WaT + (size_t)l * DM * AW, NTOK, DM, AW * 2, G, bx);
              pg8::EpiGate<0> E{PROJ + 2048, nullptr, T1};
              pg8::gemm_phase<pg8::EpiGate<0>, pg8::DenseOrder, 0, false>(lds, AW * 2, S, E); }
            { pg8::DenseOrder S; S.init(PL, WppT + (size_t)l * DM * PW, NTOK, DM, PW * 2, G, bx);
              pg8::EpiGate<1> E{PROJ + 3072, T1, MG};
              pg8::gemm_phase<pg8::EpiGate<1>, pg8::DenseOrder, 0, false>(lds, PW * 2, S, E); }
        }
        SEAM(pb + 3);
        STAMP_BEGIN(pb + 4);
        if (EN(4) && IN(pb + 4)) {
            asm volatile("; PHASE_MARK 4");
            LAYER_PTRS;
            pg8::DenseOrder S; S.init(MG, WoT + (size_t)l * DM * DM, NTOK, DM, DM * 2, G, bx);
            pg8::EpiResid<l == 0> E{x_in, XB};
            pg8::gemm_phase<pg8::EpiResid<l == 0>, pg8::DenseOrder, 0, false>(lds, DM * 2, S, E);
        }
        SEAM(pb + 4);
        STAMP_BEGIN(pb + 5);
        if (EN(5) && IN(pb + 5)) {
            asm volatile("; PHASE_MARK 5");
            LAYER_PTRS;
            LAS float* part = (LAS float*)lds;
            LAS float* lg = (LAS float*)(lds + 100352);
            LAS int* aE = (LAS int*)(lds + 110592); LAS float* aW = (LAS float*)(lds + 110592 + 512); LAS int* bs = (LAS int*)(lds + 110592 + 1024); LAS float* rs = (LAS float*)(lds + 110592 + 1536);
            const float* g2 = ka->in[10] + (size_t)l * DM; const float* brg = ka->in[12] + (size_t)l * 4; const float* bre = ka->in[14] + (size_t)l * 32;
            const bf16_t* Wh = (const bf16_t*)(ws + OFF_WRH) + (size_t)l * 48 * DM; const bf16_t* Wl = (const bf16_t*)(ws + OFF_WRL) + (size_t)l * 48 * DM;
            for (int chunk = bx; chunk < NTOK / 64; chunk += G) {
                {
                    const int fr = lane & 15, fq = lane >> 4;
                    f32x4 acc[4][3]; float ssl[4] = {0.f, 0.f, 0.f, 0.f};
#pragma unroll
                    for (int mt = 0; mt < 4; ++mt)
#pragma unroll
                        for (int nt = 0; nt < 3; ++nt) acc[mt][nt] = (f32x4){0.f, 0.f, 0.f, 0.f};
#pragma unroll 1
                    for (int ks = 0; ks < 4; ++ks) {
                        const int d0 = 128 * wid + 32 * ks + 8 * fq;
                        bf16x8 bh[3], bl[3];
#pragma unroll
                        for (int nt = 0; nt < 3; ++nt) { bh[nt] = *(const bf16x8*)(Wh + (size_t)(16 * nt + fr) * DM + d0); bl[nt] = *(const bf16x8*)(Wl + (size_t)(16 * nt + fr) * DM + d0); }
#pragma unroll
                        for (int mt = 0; mt < 4; ++mt) {
                            const u32x4 hw = *(const u32x4*)(XB + (size_t)(chunk * 64 + 16 * mt + fr) * DM + d0);
                            { float f[8]; unpack8(hw, f); ssl[mt] += (f[0] * f[0] + f[1] * f[1]) + (f[2] * f[2] + f[3] * f[3]) + (f[4] * f[4] + f[5] * f[5]) + (f[6] * f[6] + f[7] * f[7]); }
                            const bf16x8 ah = __builtin_bit_cast(bf16x8, hw);
#pragma unroll
                            for (int nt = 0; nt < 3; ++nt) {
                                acc[mt][nt] = __builtin_amdgcn_mfma_f32_16x16x32_bf16(ah, bh[nt], acc[mt][nt], 0, 0, 0);
                                acc[mt][nt] = __builtin_amdgcn_mfma_f32_16x16x32_bf16(ah, bl[nt], acc[mt][nt], 0, 0, 0);
                            }
                        }
                        asm volatile("" ::: "memory");
                    }
#pragma unroll
                    for (int mt = 0; mt < 4; ++mt) {
#pragma unroll
                        for (int nt = 0; nt < 3; ++nt) *(LAS f32x4*)(part + (wid * 49 + 16 * nt + fr) * 64 + 16 * mt + 4 * fq) = acc[mt][nt];
                        float sq = ssl[mt]; sq += __shfl_xor(sq, 16); sq += __shfl_xor(sq, 32);
                        if (fq == 0) part[(wid * 49 + 48) * 64 + 16 * mt + fr] = sq;
                    }
                }
                __syncthreads();
                for (int o = tid >> 6; o < 37; o += 8) { float sum = 0.f; const int po = (o == 36) ? 48 : o;
#pragma unroll
                    for (int w = 0; w < 8; ++w) sum += part[(w * 49 + po) * 64 + lane];
                    lg[o * 64 + lane] = sum; }
                __syncthreads();
                if (tid < 64) {
                    const float rstd = rsqrtf(lg[36 * 64 + tid] * (1.0f / DM) + RMS_EPS); rs[tid] = rstd;
                    float gl[4];
#pragma unroll
                    for (int o = 0; o < 4; ++o) gl[o] = lg[o * 64 + tid] * rstd + brg[o];
                    int gs = 0; float gm = gl[0];
#pragma unroll
                    for (int o = 1; o < 4; ++o) if (gl[o] > gm) { gm = gl[o]; gs = o; }
                    float gden = 0.f;
#pragma unroll
                    for (int o = 0; o < 4; ++o) gden += __expf(gl[o] - gm);
                    const float ggate = 1.0f / gden;
                    float el[8];
#pragma unroll
                    for (int o = 0; o < 8; ++o) el[o] = lg[(4 + 8 * gs + o) * 64 + tid] * rstd + bre[gs * 8 + o];
                    int i0 = 0; float m0 = el[0];
#pragma unroll
                    for (int o = 1; o < 8; ++o) if (el[o] > m0) { m0 = el[o]; i0 = o; }
                    int i1 = 0; float m1 = -3.0e38f;
#pragma unroll
                    for (int o = 0; o < 8; ++o) if (o != i0 && el[o] > m1) { m1 = el[o]; i1 = o; }
                    const float e1 = __expf(m1 - m0);
                    aE[2 * tid] = gs * 8 + i0; aE[2 * tid + 1] = gs * 8 + i1; aW[2 * tid] = ggate / (1.0f + e1); aW[2 * tid + 1] = ggate * e1 / (1.0f + e1);
                }
                __syncthreads();
                int myE = 0, rank = 0;
                if (tid < 128) { myE = aE[tid]; for (int a = 0; a < tid; ++a) rank += (aE[a] == myE) ? 1 : 0; }
                if (tid < NEXP) { int c = 0; for (int a = 0; a < 128; ++a) c += (aE[a] == tid) ? 1 : 0;
                    bs[tid] = c ? (int)__hip_atomic_fetch_add(cnt + tid * 64, (unsigned)c, __ATOMIC_RELAXED, __HIP_MEMORY_SCOPE_AGENT) : 0; }
#pragma unroll 2
                for (int it = 0; it < 8; ++it) {
                    const int ti = wid * 8 + it; const size_t tok = (size_t)chunk * 64 + ti; const float rstd = rs[ti];
#pragma unroll
                    for (int i = 0; i < 4; ++i) { const int d0 = (i * 64 + lane) * 4; const u32x2 xw = *(const u32x2*)(XB + tok * DM + d0); const f32x4 gv = *(const f32x4*)(g2 + d0);
                        const float h0 = bflo(xw.x) * rstd * gv[0], h1 = bfhi(xw.x) * rstd * gv[1], h2v = bflo(xw.y) * rstd * gv[2], h3 = bfhi(xw.y) * rstd * gv[3];
                        if (MOE_FP8) *(unsigned*)((unsigned char*)Hb + tok * DM + d0) = pack4_fp8(h0, h1, h2v, h3);
                        else { u32x2 w; w.x = pack2(h0, h1); w.y = pack2(h2v, h3); *(u32x2*)(Hb + tok * DM + d0) = w; } }
                }
                __syncthreads();
                if (tid < 128) { const int slot = bs[myE] + rank, tok = chunk * 64 + (tid >> 1);
                    tokE[(size_t)myE * ECAP + slot] = tok; tokW[(size_t)myE * ECAP + slot] = aW[tid]; asg[tok * 2 + (tid & 1)] = myE * ECAP + slot; }
                __syncthreads();
            }
        }
        SEAM(pb + 5);
        STAMP_BEGIN(pb + 6);
        for (int rep = 0; rep < REPS(6); ++rep) if (EN(6) && IN(pb + 6)) {
            asm volatile("; PHASE_MARK 6");
            LAYER_PTRS;
            build_moe_tables(LC, cnt);
            constexpr int ES = MOE_FP8 ? 1 : 2;
            pg8::MoeOrder S{(const char*)Hb, (const char*)WguT, (size_t)DM * DM * ES, DM * ES, LC + LI_TB, LC + LI_PS, LC + LI_CN, LC + LI_ORD, tokE, G, vcu, true};
            pg8::EpiSwiGLU<MOE_FP8> E{(void*)ACT};
            pg8::gemm_phase<pg8::EpiSwiGLU<MOE_FP8>, pg8::MoeOrder, 0, true, true, MOE_FP8>(lds, DM * ES, S, E);
        }
        SEAM(pb + 6);
        STAMP_BEGIN(pb + 7);
        for (int rep = 0; rep < REPS(7); ++rep) if (EN(7) && IN(pb + 7)) {
            asm volatile("; PHASE_MARK 7");
            LAYER_PTRS;
            build_moe_tables(LC, cnt);
            constexpr int ES = MOE_FP8 ? 1 : 2;
            pg8::MoeOrder S{(const char*)ACT, (const char*)WdT, (size_t)DM * EH * ES, EH * ES, LC + LI_TB, LC + LI_PS, LC + LI_CN, LC + LI_ORD, tokE, G, vcu, false};
            pg8::EpiDown<MOE_FP8> E{YB, tokW};
            pg8::gemm_phase<pg8::EpiDown<MOE_FP8>, pg8::MoeOrder, 0, false, true, MOE_FP8>(lds, EH * ES, S, E);
        }
        SEAM(pb + 7);
        STAMP_BEGIN(pb + 8);
        if (EN(8) && IN(pb + 8)) {
            asm volatile("; PHASE_MARK 8");
            LAYER_PTRS;
            build_moe_tables(LC, cnt);
            const bool lastl = (l == DEPTH - 1);
            const float* g1n = ka->in[1] + (size_t)(lastl ? 0 : (l + 1)) * DM;
            for (int grp = gw; grp < NTOK / 4; grp += NGW) {
                const size_t t0 = (size_t)grp * 4;
                const int myasg = (lane < 8) ? asg[t0 * 2 + lane] : 0;
                u32x2 xv[4][4], ya[4][4], yb[4][4];
#pragma unroll
                for (int q = 0; q < 4; ++q) {
                    const int i0 = __builtin_amdgcn_readlane(myasg, 2 * q), i1 = __builtin_amdgcn_readlane(myasg, 2 * q + 1);
                    const size_t s0 = (size_t)(LC[LI_PS + (i0 >> 14)] + (i0 & (ECAP - 1))), s1 = (size_t)(LC[LI_PS + (i1 >> 14)] + (i1 & (ECAP - 1)));
#pragma unroll
                    for (int i = 0; i < 4; ++i) { const int d0 = (i * 64 + lane) * 4;
                        xv[q][i] = *(const u32x2*)(XB + (t0 + q) * DM + d0); ya[q][i] = *(const u32x2*)(YB + s0 * DM + d0); yb[q][i] = *(const u32x2*)(YB + s1 * DM + d0); }
                }
#pragma unroll
                for (int q = 0; q < 4; ++q) {
                    f32x4 v[4]; float ss = 0.f;
#pragma unroll
                    for (int i = 0; i < 4; ++i) { const int d0 = (i * 64 + lane) * 4; const u32x2 a = ya[q][i], b = yb[q][i], x4 = xv[q][i];
                        v[i][0] = bflo(x4.x) + bflo(a.x) + bflo(b.x); v[i][1] = bfhi(x4.x) + bfhi(a.x) + bfhi(b.x); v[i][2] = bflo(x4.y) + bflo(a.y) + bflo(b.y); v[i][3] = bfhi(x4.y) + bfhi(a.y) + bfhi(b.y);
                        ss += (v[i][0] * v[i][0] + v[i][1] * v[i][1]) + (v[i][2] * v[i][2] + v[i][3] * v[i][3]);
                        if (lastl) *(f32x4*)(ka->out + (t0 + q) * DM + d0) = v[i];
                        else { u32x2 w; w.x = pack2(v[i][0], v[i][1]); w.y = pack2(v[i][2], v[i][3]); *(u32x2*)(XB + (t0 + q) * DM + d0) = w; } }
                    if (!lastl) {
                        ss = wave_sum(ss);
                        const float rstd = rsqrtf(ss * (1.0f / DM) + RMS_EPS);
#pragma unroll
                        for (int i = 0; i < 4; ++i) { const int d0 = (i * 64 + lane) * 4; const f32x4 gv = *(const f32x4*)(g1n + d0);
                            u32x2 w; w.x = pack2(v[i][0] * rstd * gv[0], v[i][1] * rstd * gv[1]); w.y = pack2(v[i][2] * rstd * gv[2], v[i][3] * rstd * gv[3]);
                            *(u32x2*)(Hb + (t0 + q) * DM + d0) = w; }
                    }
                }
            }
            if (!lastl) {
                __syncthreads();
                const float* e0 = ka->in[15] + (size_t)(l + 1) * NEXP * DM * EH; const float* e1 = ka->in[16] + (size_t)(l + 1) * NEXP * DM * EH; const float* e2 = ka->in[17] + (size_t)(l + 1) * NEXP * EH * DM;
                if (MOE_FP8) { ExpertItems8 I{e0, e1, e2, (unsigned char*)WguT, (unsigned char*)WdT}; convert_items8(I, (LAS float*)(lds + wid * 16384), lane, gw, NGW); }
                else { ExpertItems I{e0, e1, e2, WguT, WdT}; convert_items(I, (LAS float*)(lds + wid * 16384), lane, gw, NGW); }
            }
        }
        if (l + 1 < DEPTH) SEAM(pb + 8); else if (PROBE_B == pb + 8) ts1 = __builtin_amdgcn_s_memrealtime();
    }

__global__ void __launch_bounds__(NTHREADS, 2) fwd_kernel(Args args) {
    extern __shared__ __attribute__((aligned(16))) unsigned char lds_raw[];
    LAS unsigned char* lds = (LAS unsigned char*)lds_raw;
    LAS int* LC = (LAS int*)(lds + LCTL_OFF);
    const int G0 = gridDim.x, bx0 = blockIdx.x;
    const int vcu0 = (G0 % 8 == 0) ? (bx0 % 8) * (G0 / 8) + bx0 / 8 : bx0;
    if (threadIdx.x < 4) LC[LI_BAR + threadIdx.x] = 0;
    __syncthreads();
    XcdBarrier bar; bar.bar = (unsigned*)(args.ws + OFF_CTRL) + CW_BAR; bar.x = 0; bar.st = nullptr;
    if (MK_N_LAUNCHES == 1) bar = xcd_barrier_post(bar.bar, (volatile LAS unsigned*)(LC + LI_BAR));
    const int lo = args.ph_lo, hi = args.ph_hi;
    unsigned long long ts0 = 0ull, ts1 = 0ull;
    STAMP_BEGIN(0);
    for (int rep = 0; rep < REPS(9); ++rep) if (EN(9) && IN(0)) {
        asm volatile("; PHASE_MARK 9");
        PHASE_PTRS; const int tid = opaque_tid(), lane = tid & 63, wid = __builtin_amdgcn_readfirstlane(tid >> 6), gw = vcu * NWAVES + wid;
        LAS float* scr = (LAS float*)(lds + wid * 16384);
        if (wid == 7) {
            for (int o = vcu; o < DEPTH * 4 * 16 * 4; o += G) {
                const int l = o >> 8, g = (o >> 6) & 3, nb = (o >> 2) & 15, cb = o & 3, c0 = 32 * cb, n = 64 * nb + lane;
                const float* wm = ka->in[6] + (size_t)l * 4 * 128 * 128 + (size_t)(g * 128 + c0) * 128;
                const float* sc = ka->in[7] + (size_t)l * PW + g * 128;
                const float* wp = ka->in[8] + (size_t)l * PW * DM + (size_t)(g * 128) * DM + n;
                {
                    const f32x4 sv = *(const f32x4*)(sc + 4 * (lane & 31));
#pragma unroll 8
                    for (int i = 0; i < 16; ++i) { const int c = (lane >> 5) + 2 * i; const f32x4 v = *(const f32x4*)(wm + (size_t)c * 128 + 4 * (lane & 31)) * sv;
#pragma unroll
                        for (int j = 0; j < 4; ++j) scr[(4 * (lane & 31) + j) * 32 + c] = v[j]; }
                }
                float a[32];
#pragma unroll
                for (int c = 0; c < 32; ++c) a[c] = 0.f;
                float wa[32];
#define FOLD_BLOCK(WV, D0) do { _Pragma("unroll") for (int q = 0; q < 32; ++q) { const float w = WV[q]; _Pragma("unroll") for (int c4 = 0; c4 < 8; ++c4) { \
                    const f32x4 m4 = *(const LAS f32x4*)(scr + ((D0) + q) * 32 + 4 * c4); a[4 * c4] += w * m4[0]; a[4 * c4 + 1] += w * m4[1]; a[4 * c4 + 2] += w * m4[2]; a[4 * c4 + 3] += w * m4[3]; } \
                    if (q & 1) asm volatile("" ::: "memory"); } } while (0)
#pragma unroll 1
                for (int d0 = 0; d0 < 128; d0 += 32) {
#pragma unroll
                    for (int q = 0; q < 32; ++q) wa[q] = wp[(size_t)(d0 + q) * DM];
                    FOLD_BLOCK(wa, d0);
                }
#undef FOLD_BLOCK
                bf16_t* op = WppT + (size_t)l * DM * PW + (size_t)n * PW + g * 128 + c0;
#pragma unroll
                for (int q = 0; q < 4; ++q) { u32x4 ow; ow.x = pack2(a[8 * q], a[8 * q + 1]); ow.y = pack2(a[8 * q + 2], a[8 * q + 3]); ow.z = pack2(a[8 * q + 4], a[8 * q + 5]); ow.w = pack2(a[8 * q + 6], a[8 * q + 7]);
                    *(u32x4*)(op + 8 * q) = ow; }
            }
            for (int o = vcu * 64 + lane; o < DEPTH * 48 * DM; o += G * 64) {
                const int l = o / (48 * DM), r = o % (48 * DM), oo = r / DM, d = r % DM;
                float w = 0.f;
                if (oo < 4) w = ka->in[11][(size_t)l * DM * 4 + (size_t)d * 4 + oo];
                else if (oo < 36) w = ka->in[13][(size_t)l * 4 * DM * 8 + ((size_t)((oo - 4) >> 3) * DM + d) * 8 + ((oo - 4) & 7)];
                w *= ka->in[10][(size_t)l * DM + d];
                const bf16_t hi = f2bf(w); const float hf = __uint_as_float((unsigned)hi << 16);
                ((bf16_t*)(ws + OFF_WRH))[o] = hi; ((bf16_t*)(ws + OFF_WRL))[o] = f2bf(w - hf);
            }
        } else {
            const int gw7 = vcu * 7 + wid, NGW7 = G * 7;
            { SmallItems I{ka->in[2], ka->in[5], ka->in[9], WinT, WaT, WoT}; convert_items(I, scr, lane, gw7, NGW7); }
            if (MOE_FP8) { ExpertItems8 I{ka->in[15], ka->in[16], ka->in[17], (unsigned char*)WguT, (unsigned char*)WdT}; convert_items8(I, scr, lane, gw7, NGW7); }
            else { ExpertItems I{ka->in[15], ka->in[16], ka->in[17], WguT, WdT}; convert_items(I, scr, lane, gw7, NGW7); }
        }
        for (int m = gw; m < NTOK; m += NGW) norm_row(x_in + (size_t)m * DM, ka->in[1], Hb + (size_t)m * DM, lane);
    }
    SEAM(0);

    layer_body<0>(bar, lds, LC, G0, bx0, vcu0, lo, hi, ts0, ts1);
    layer_body<1>(bar, lds, LC, G0, bx0, vcu0, lo, hi, ts0, ts1);
    if (PROBE_A >= 0 && blockIdx.x == 0) { const unsigned long long d = (ts1 - ts0) * 4ull, t0 = __builtin_amdgcn_s_memrealtime(); while (__builtin_amdgcn_s_memrealtime() - t0 < d) __builtin_amdgcn_s_sleep(8); }
#undef IN
#undef SEAM
}

extern "C" void kernel_launch(void* const* d_in, const int* in_sizes, int n_in, void* d_out, int out_size, void* d_ws, size_t ws_size, hipStream_t stream) {
    (void)in_sizes; (void)out_size;
    static int grid = 0;
    if (grid == 0) {
        int dev = 0, cus = 0;
        if (hipGetDevice(&dev) != hipSuccess || hipDeviceGetAttribute(&cus, hipDeviceAttributeMultiprocessorCount, dev) != hipSuccess) { grid = -1; return; }
        if (hipFuncSetAttribute((const void*)fwd_kernel, hipFuncAttributeMaxDynamicSharedMemorySize, LDS_BYTES) != hipSuccess) { grid = -1; return; }
        int per_cu = 0;
        (void)hipOccupancyMaxActiveBlocksPerMultiprocessor(&per_cu, (const void*)fwd_kernel, NTHREADS, LDS_BYTES);
        (void)hipGetLastError();
        grid = cus;
        if (n_in != 18 || ws_size < WS_NEED) { fprintf(stderr, "kernel_launch: unexpected inputs (n_in %d, ws %zu)\n", n_in, ws_size); grid = -1; return; }
    }
    if (grid < 0) return;
    (void)hipMemsetAsync((char*)d_ws + OFF_CTRL, 0, CTRL_BYTES, stream);
    Args a{};
    for (int i = 0; i < 18; ++i) a.in[i] = (const float*)d_in[i];
    a.out = (float*)d_out; a.ws = (unsigned char*)d_ws;
    constexpr int NPH = 1 + 9 * DEPTH;
    if (MK_N_LAUNCHES == 1) { a.ph_lo = 0; a.ph_hi = NPH; hipLaunchKernelGGL(fwd_kernel, dim3(grid), dim3(NTHREADS), LDS_BYTES, stream, a); }
    else { for (int p = 0; p < NPH; ++p) { a.ph_lo = p; a.ph_hi = p + 1; hipLaunchKernelGGL(fwd_kernel, dim3(grid), dim3(NTHREADS), LDS_BYTES, stream, a); } }
}
```

```cpp
#include <hip/hip_runtime.h>
#include <stdint.h>
#include <stdio.h>

#define LAS __attribute__((address_space(3)))
typedef unsigned short bf16_t;
typedef short bf16x8 __attribute__((ext_vector_type(8)));
typedef float f32x2 __attribute__((ext_vector_type(2)));
typedef float f32x4 __attribute__((ext_vector_type(4)));
typedef float f32x16 __attribute__((ext_vector_type(16)));
typedef unsigned u32x2 __attribute__((ext_vector_type(2)));
typedef unsigned u32x4 __attribute__((ext_vector_type(4)));
typedef __bf16 bfv2 __attribute__((ext_vector_type(2)));
typedef int i32x8 __attribute__((ext_vector_type(8)));
constexpr float W8_SCALE = 32.f, A8_SCALE = 8.f;

#ifndef MOE_FP8
#define MOE_FP8 1
#endif
#ifndef MK_N_LAUNCHES
#define MK_N_LAUNCHES 1
#endif

constexpr int DM = 1024, SEQ = 4096, NTOK = 16384, DEPTH = 2;
constexpr int HD = 64, AW = 512, PW = 512, INW = 4096;
constexpr int NEXP = 32, EH = 512, ECAP = NTOK;
constexpr float RMS_EPS = 1e-6f;
constexpr int NTHREADS = 512, NWAVES = 8;

constexpr size_t MB = 1024 * 1024;
constexpr size_t OFF_CTRL = 0, CTRL_BYTES = 65536;
constexpr size_t OFF_WIN  = 1 * MB;
constexpr size_t OFF_WA   = OFF_WIN + 16 * MB;
constexpr size_t OFF_WPP  = OFF_WA + 2 * MB;
constexpr size_t OFF_WO   = OFF_WPP + 2 * MB;
constexpr size_t OFF_WGU  = OFF_WO + 4 * MB;
constexpr size_t OFF_WD   = OFF_WGU + 64 * MB;
constexpr size_t OFF_H    = OFF_WD + 32 * MB;
constexpr size_t OFF_PROJ = OFF_H + 32 * MB;
constexpr size_t OFF_ACT  = OFF_PROJ;
constexpr size_t OFF_YB   = OFF_PROJ + 40 * MB;
constexpr size_t OFF_AC   = OFF_PROJ + 128 * MB;
constexpr size_t OFF_PL   = OFF_AC + 16 * MB;
constexpr size_t OFF_OG   = OFF_PL + 16 * MB;
constexpr size_t OFF_T1   = OFF_OG;
constexpr size_t OFF_ML   = OFF_OG + 48 * MB;
constexpr size_t OFF_XB   = OFF_ML + 4 * MB;
constexpr size_t OFF_TOKE = OFF_XB + 64 * MB;
constexpr size_t OFF_TOKW = OFF_TOKE + 2 * MB;
constexpr size_t OFF_ASG  = OFF_TOKW + 2 * MB;
constexpr size_t OFF_WRH  = OFF_ASG + 1 * MB;
constexpr size_t OFF_WRL  = OFF_WRH + 256 * 1024;
constexpr size_t WS_NEED  = OFF_WRL + 256 * 1024;
constexpr int CW_CNT = 1024;
constexpr int CW_BAR = 8192;
constexpr int RING_BYTES = 131072, LCTL_OFF = RING_BYTES, LDS_BYTES = RING_BYTES + 2048;
constexpr int LI_BAR = 0, LI_TB = 16, LI_PS = 64, LI_CN = 112, LI_NT = 15, LI_ORD = 144;

__device__ __forceinline__ float bflo(unsigned w) { return __uint_as_float(w << 16); }
__device__ __forceinline__ float bfhi(unsigned w) { return __uint_as_float(w & 0xffff0000u); }
__device__ __forceinline__ void unpack8(const u32x4 v, float (&f)[8]) { f[0] = bflo(v.x); f[1] = bfhi(v.x); f[2] = bflo(v.y); f[3] = bfhi(v.y); f[4] = bflo(v.z); f[5] = bfhi(v.z); f[6] = bflo(v.w); f[7] = bfhi(v.w); }
__device__ __forceinline__ unsigned pack2(float lo, float hi) { f32x2 v = {lo, hi}; return __builtin_bit_cast(unsigned, __builtin_convertvector(v, bfv2)); }
__device__ __forceinline__ unsigned pack4_fp8(float a, float b, float c, float d) { unsigned w = 0u; w = __builtin_amdgcn_cvt_pk_fp8_f32(a, b, w, false); w = __builtin_amdgcn_cvt_pk_fp8_f32(c, d, w, true); return w; }
__device__ __forceinline__ bf16_t f2bf(float f) { return (bf16_t)(pack2(f, 0.f) & 0xffffu); }
__device__ __forceinline__ float wave_sum(float v) {
#pragma unroll
    for (int o = 32; o >= 1; o >>= 1) v += __shfl_xor(v, o);
    return v;
}
__device__ __forceinline__ int opaque_tid() { int t = (int)threadIdx.x; asm volatile("" : "+v"(t)); return t; }
__device__ __forceinline__ int opaque_s(int v) { asm volatile("" : "+s"(v)); return v; }
__device__ __forceinline__ float sigmoidf_(float v) { return 1.0f / (1.0f + __expf(-v)); }

#define XB_TMO      128
#define XB_XCNT(j)  (256  + 64 * (j))
#define XB_XSUB(j)  (1280 + 64 * (j))
#define XB_XGEN(j)  (2304 + 64 * (j))
#define XB_TOP      3328
#define XB_TOPGEN   3392
#define XCD_BAR_WORDS 3456
#define XB_SPIN_CAP (1u << 18)
__device__ __forceinline__ unsigned xb_ld(unsigned* p)              { return __hip_atomic_load(p, __ATOMIC_RELAXED, __HIP_MEMORY_SCOPE_AGENT); }
__device__ __forceinline__ unsigned xb_add(unsigned* p, unsigned v) { return __hip_atomic_fetch_add(p, v, __ATOMIC_RELAXED, __HIP_MEMORY_SCOPE_AGENT); }
__device__ __forceinline__ unsigned xb_xcc_id() { return (unsigned)__builtin_amdgcn_s_getreg((3 << 11) | 20) & 0xFu; }
#define XB_SPIN(cond, bar) do { unsigned _sp = 0; while (cond) { __builtin_amdgcn_s_sleep(1); \
    if ((++_sp & 255u) == 0u) { if (xb_ld(&(bar)[XB_TMO])) break; if (_sp > XB_SPIN_CAP) { atomicAdd(&(bar)[XB_TMO], 1u); break; } } } } while (0)
struct XcdBarrier { unsigned* bar; unsigned x; volatile LAS unsigned* st; };
__device__ __forceinline__ XcdBarrier xcd_barrier_post(unsigned* bar, volatile LAS unsigned* st) {
    XcdBarrier b; b.bar = bar; b.x = xb_xcc_id(); b.st = st;
    if (threadIdx.x == 0) (void)xb_add(&bar[XB_XCNT(b.x)], 1u);
    return b;
}
__device__ __forceinline__ void xcd_barrier_complete(unsigned* bar, unsigned x, unsigned& nloc, unsigned& nx) {
    const unsigned G = gridDim.x * gridDim.y * gridDim.z;
    unsigned sum, cnt, mine, sp = 0u;
    for (;;) {
        sum = 0u; cnt = 0u; mine = 0u;
#pragma unroll
        for (unsigned j = 0; j < 16; ++j) { const unsigned c = xb_ld(&bar[XB_XCNT(j)]); sum += c; cnt += (c > 0u) ? 1u : 0u; mine = (j == x) ? c : mine; }
        if (sum == G) break;
        __builtin_amdgcn_s_sleep(1);
        if ((++sp & 255u) == 0u) { if (xb_ld(&bar[XB_TMO])) break; if (sp > XB_SPIN_CAP) { atomicAdd(&bar[XB_TMO], 1u); break; } }
    }
    nloc = mine > 0u ? mine : 1u; nx = cnt > 0u ? cnt : 1u;
}
__device__ __forceinline__ void xcd_barrier(const XcdBarrier& b) {
    asm volatile("s_waitcnt vmcnt(0)" ::: "memory");
    __syncthreads();
    if (threadIdx.x == 0) {
        unsigned* bar = b.bar;
        __builtin_amdgcn_s_waitcnt(0);
        unsigned nloc = b.st[0], nx = b.st[1];
        if (nloc == 0u) { xcd_barrier_complete(bar, b.x, nloc, nx); b.st[0] = nloc; b.st[1] = nx; }
        const unsigned old = xb_add(&bar[XB_XSUB(b.x)], 1u);
        const unsigned gen = old / nloc;
        if (old + 1u == (gen + 1u) * nloc) {
            __builtin_amdgcn_fence(__ATOMIC_RELEASE, "agent");
            asm volatile("s_waitcnt vmcnt(0)" ::: "memory");
            const unsigned og = xb_add(&bar[XB_TOP], 1u);
            const unsigned tg = og / nx;
            if (og + 1u == (tg + 1u) * nx) xb_add(&bar[XB_TOPGEN], 1u);
            else XB_SPIN(xb_ld(&bar[XB_TOPGEN]) == tg, bar);
            __builtin_amdgcn_fence(__ATOMIC_ACQUIRE, "agent");
            xb_add(&bar[XB_XGEN(b.x)], 1u);
            asm volatile("s_waitcnt vmcnt(0)" ::: "memory");
        } else {
            XB_SPIN(xb_ld(&bar[XB_XGEN(b.x)]) == gen, bar);
            __builtin_amdgcn_fence(__ATOMIC_ACQUIRE, "agent");
            asm volatile("s_waitcnt vmcnt(0)" ::: "memory");
        }
    }
    __syncthreads();
}

namespace pg8 {
constexpr int BM = 256, BK = 64, HALF = 128, HTB = HALF * BK * 2, NXCD = 8, WGM = 8;
__device__ __forceinline__ int lds_byte(int r, int c) { const int st = (r >> 4) * 2 + (c >> 5), rr = r & 15, cc = c & 31, ob = rr * 64 + cc * 2; return st * 1024 + (ob ^ (((ob >> 9) & 1) << 5)); }
__device__ __forceinline__ void stage_rc(int b, int& R, int& C) { const int st = b / 1024, sb = b % 1024, swz = sb ^ (((sb >> 9) & 1) << 5); R = (st >> 1) * 16 + swz / 64; C = (st & 1) * 32 + (swz % 64) / 2; }
__device__ __forceinline__ int perm32(int rho) { const int n = rho >> 4, i = rho & 15; return 8 * (i >> 2) + 4 * n + (i & 3); }

struct Unit { const char* A; const char* B; int row0, col0, e, nvalid, j0; };

struct DenseOrder {
    const char* A; const char* Bt; int KB, nM, nN, nwg, G, c;
    __device__ __forceinline__ void init(const void* A_, const void* Bt_, int M, int N, int KB_, int G_, int c_) { A = (const char*)A_; Bt = (const char*)Bt_; KB = KB_; nM = M / BM; nN = N / BM; nwg = nM * nN; G = G_; c = c_; }
    __device__ __forceinline__ bool next(int i, Unit& u) const {
        const long L = (long)i * G + c; if (L >= nwg) return false;
        int wgid = (int)L; { const int q = nwg / NXCD, r = nwg % NXCD, xcd = wgid % NXCD, off = wgid / NXCD; wgid = (xcd < r ? xcd * (q + 1) : r * (q + 1) + (xcd - r) * q) + off; }
        const int nig = WGM * nN, gid = wgid / nig, fm = gid * WGM, gsz = (nM - fm) < WGM ? (nM - fm) : WGM;
        const int pm = fm + ((wgid % nig) % gsz), pn = (wgid % nig) / gsz;
        u.A = A + (size_t)pm * BM * KB; u.B = Bt + (size_t)pn * BM * KB; u.row0 = pm * BM; u.col0 = pn * BM; u.e = 0; u.nvalid = BM; u.j0 = 0; return true;
    }
    __device__ __forceinline__ unsigned row_off(const Unit&, int) const { return 0u; }
};
struct MoeOrder {
    const char* A; const char* Bt; size_t bExp; int KB; const LAS int* tb; const LAS int* ps; const LAS int* cn; const LAS int* ord; const int* tokE; int G, c; bool gather;
    __device__ __forceinline__ bool next(int i, Unit& u) const {
        const int L = i * G + c, total = tb[NEXP] * 4; if (L >= total) return false;
        const int rt = L >> 2, pn = L & 3;
        const int ej = __builtin_amdgcn_readfirstlane(ord[rt]);
        const int e = ej >> 8, j = ej & 255;
        const int pse = __builtin_amdgcn_readfirstlane(ps[e]), cne = __builtin_amdgcn_readfirstlane(cn[e]);
        u.e = e; u.row0 = pse + BM * j; u.col0 = pn * BM; u.nvalid = min(BM, cne - BM * j); u.j0 = e * ECAP + BM * j;
        u.B = Bt + (size_t)e * bExp + (size_t)pn * BM * KB;
        u.A = gather ? A : A + (size_t)u.row0 * KB;
        return true;
    }
    __device__ __forceinline__ unsigned row_off(const Unit& u, int R) const { const int t = R < u.nvalid ? tokE[u.j0 + R] : 0; return (unsigned)t * (unsigned)KB; }
};

template <class Epi, class Sched, int BMODE, bool GATHER, bool LIGHT = false, bool F8 = false, bool MIDK = false>
__device__ __forceinline__ void gemm_phase(LAS unsigned char* lds, const int KB, const Sched& S, const Epi& E) {
    const int tid = opaque_tid(), wid = __builtin_amdgcn_readfirstlane(tid >> 6), lane = tid & 63, wr = wid >> 2, wc = wid & 3, fr = lane & 15, fq = lane >> 4;
    const int nt = KB / (BK * 2);
    unsigned voffA[2][2], voffAn[2][2], voffB[2]; int RA[2], CA[2];
#pragma unroll
    for (int i = 0; i < 2; ++i) { int R, C; stage_rc(tid * 16 + i * 8192, R, C); RA[i] = R; CA[i] = C;
        const int Rb = (BMODE == 1) ? (64 * (R >> 5) + perm32(R & 31)) : (Epi::PERM ? ((R & ~31) + perm32(R & 31)) : R);
        voffB[i] = (unsigned)(Rb * KB + C * 2);
#pragma unroll
        for (int h = 0; h < 2; ++h) { voffA[h][i] = (unsigned)((h * HALF + R) * KB + C * 2); voffAn[h][i] = voffA[h][i]; } }
    const size_t kstep = (size_t)(BK * 2);
    const size_t hstepB = (size_t)((BMODE == 1) ? 32 : HALF) * KB;
    const unsigned ldsw = (unsigned)wid * 1024u;
    const int aoff = lds_byte(wr * 64 + fr, fq * 8), boff = lds_byte(wc * 32 + fr, fq * 8);
#define PG8_SA(b, h) (((b) * 2 + (h)) * HTB)
#define PG8_SB(b, h) ((4 + (b) * 2 + (h)) * HTB)
#define PG8_STAGE2(bufoff, gbase, v0, v1) do { \
        __builtin_amdgcn_global_load_lds((const unsigned*)((const char*)(gbase) + (v0)), (LAS unsigned*)(lds + (bufoff) + ldsw), 16, 0, 0); \
        __builtin_amdgcn_global_load_lds((const unsigned*)((const char*)(gbase) + (v1)), (LAS unsigned*)(lds + (bufoff) + ldsw + 8192), 16, 0, 0); } while (0)
#define PG8_STAGEB(bufoff, gbase) PG8_STAGE2(bufoff, gbase, voffB[0], voffB[1])
#define PG8_STAGEA(bufoff, gbase, h, nx) PG8_STAGE2(bufoff, gbase, ((GATHER && (nx)) ? voffAn[h][0] : voffA[h][0]), ((GATHER && (nx)) ? voffAn[h][1] : voffA[h][1]))
#define PG8_LD32(p) __builtin_bit_cast(i32x8, __builtin_shufflevector(*(const LAS u32x4*)(p), *(const LAS u32x4*)((p) + 1024), 0, 1, 2, 3, 4, 5, 6, 7))
#define PG8_LDA(dst, b, h) do { _Pragma("unroll") for (int m = 0; m < 4; ++m) { if constexpr (F8) dst##8[m] = PG8_LD32(lds + PG8_SA(b, h) + aoff + m * 2048); \
        else { _Pragma("unroll") for (int k = 0; k < 2; ++k) dst[m][k] = *(const LAS bf16x8*)(lds + PG8_SA(b, h) + aoff + m * 2048 + k * 1024); } } } while (0)
#define PG8_LDB(dst, b, h) do { _Pragma("unroll") for (int n = 0; n < 2; ++n) { if constexpr (F8) dst##8[n] = PG8_LD32(lds + PG8_SB(b, h) + boff + n * 2048); \
        else { _Pragma("unroll") for (int k = 0; k < 2; ++k) dst[n][k] = *(const LAS bf16x8*)(lds + PG8_SB(b, h) + boff + n * 2048 + k * 1024); } } } while (0)
#define PG8_MMA(ai, bj, At, Bt) do { __builtin_amdgcn_s_setprio(1); _Pragma("unroll") for (int m = 0; m < 4; ++m) _Pragma("unroll") for (int n = 0; n < 2; ++n) { \
        if constexpr (F8) asm volatile("v_mfma_scale_f32_16x16x128_f8f6f4 %0, %1, %2, %0, %3, %3 op_sel_hi:[0,0,0]" : "+v"(acc[ai][bj][m][n]) : "v"(Bt##8[n]), "v"(At##8[m]), "v"(sc8));   \
        else { _Pragma("unroll") for (int k = 0; k < 2; ++k) acc[ai][bj][m][n] = __builtin_amdgcn_mfma_f32_16x16x32_bf16(Bt[n][k], At[m][k], acc[ai][bj][m][n], 0, 0, 0); } } \
        __builtin_amdgcn_s_setprio(0); } while (0)
#define PG8_WAIT_V(n) asm volatile("s_waitcnt vmcnt(" #n ")" ::: "memory")
#define PG8_WAIT_L(n) asm volatile("s_waitcnt lgkmcnt(" #n ")" ::: "memory")
#define PG8_BAR __builtin_amdgcn_s_barrier()
#define PG8_SCHED __builtin_amdgcn_sched_barrier(0)
    Unit cur, nxt; int ui = 0;
    if (!S.next(0, cur)) return;
    if (GATHER) {
#pragma unroll
        for (int h = 0; h < 2; ++h)
#pragma unroll
            for (int i = 0; i < 2; ++i) voffA[h][i] = S.row_off(cur, h * HALF + RA[i]) + (unsigned)CA[i] * 2u;
    }
    f32x4 acc[2][2][4][2];
#pragma unroll
    for (int a = 0; a < 2; ++a)
#pragma unroll
        for (int b = 0; b < 2; ++b)
#pragma unroll
            for (int m = 0; m < 4; ++m)
#pragma unroll
                for (int n = 0; n < 2; ++n) acc[a][b][m][n] = (f32x4){0.f, 0.f, 0.f, 0.f};
    unsigned sc8 = 0x7f7f7f7fu; asm volatile("" : "+v"(sc8));
    bf16x8 At[4][2], B0[2][2], B1[2][2]; i32x8 At8[4], B08[2], B18[2];
    const char* cA = cur.A; const char* cB = cur.B;
    PG8_STAGEB(PG8_SB(0, 0), cB); PG8_STAGEB(PG8_SB(0, 1), cB + hstepB); PG8_STAGEA(PG8_SA(0, 0), cA, 0, false); PG8_STAGEA(PG8_SA(0, 1), cA, 1, false);
    if (wr == 1) PG8_BAR;
    PG8_WAIT_V(2); PG8_BAR;
    PG8_STAGEB(PG8_SB(1, 0), cB + kstep); PG8_STAGEA(PG8_SA(1, 0), cA + kstep, 0, false); PG8_STAGEB(PG8_SB(1, 1), cB + hstepB + kstep);
    PG8_WAIT_V(6); PG8_BAR;
    for (;;) {
        const bool has_next = S.next(ui + 1, nxt);
        if (GATHER) {
#pragma unroll
            for (int h = 0; h < 2; ++h)
#pragma unroll
                for (int i = 0; i < 2; ++i) voffAn[h][i] = has_next ? (S.row_off(nxt, h * HALF + RA[i]) + (unsigned)CA[i] * 2u) : voffA[h][i];
        }
        const char* nA = has_next ? nxt.A : cA; const char* nB = has_next ? nxt.B : cB;
        const bool full = cur.nvalid > HALF;
        for (int t = 0; t < nt; t += 2) {
            if constexpr (MIDK) { if (t == nt / 2) { PG8_SCHED; E.mid(acc, cur, wr, wc, fr, fq); PG8_SCHED; } }
            const bool last = (t == nt - 2);
            const char* a1 = cA + (size_t)(t + 1) * kstep;
            const char* a2 = last ? nA : cA + (size_t)(t + 2) * kstep; const char* b2 = last ? nB : cB + (size_t)(t + 2) * kstep;
            const char* a3 = a2 + kstep; const char* b3 = b2 + kstep;
            PG8_LDB(B0, 0, 0); PG8_LDB(B1, 0, 1); PG8_SCHED; PG8_LDA(At, 0, 0); PG8_STAGEA(PG8_SA(1, 1), a1, 1, false);
            PG8_WAIT_V(8); PG8_WAIT_L(0); PG8_BAR; PG8_MMA(0, 0, At, B0); PG8_MMA(0, 1, At, B1); PG8_BAR; PG8_SCHED;
            PG8_LDA(At, 0, 1); PG8_STAGEB(PG8_SB(0, 0), b2); PG8_STAGEB(PG8_SB(0, 1), b2 + hstepB); PG8_STAGEA(PG8_SA(0, 0), a2, 0, last);
            PG8_WAIT_V(8); PG8_WAIT_L(0); PG8_BAR; if (!LIGHT || full) { PG8_MMA(1, 0, At, B0); PG8_MMA(1, 1, At, B1); } PG8_BAR; PG8_SCHED;
            PG8_LDB(B0, 1, 0); PG8_LDB(B1, 1, 1); PG8_SCHED; PG8_LDA(At, 1, 0); PG8_STAGEA(PG8_SA(0, 1), a2, 1, last);
            PG8_WAIT_V(8); PG8_WAIT_L(0); PG8_BAR; PG8_MMA(0, 0, At, B0); PG8_MMA(0, 1, At, B1); PG8_BAR; PG8_SCHED;
            PG8_LDA(At, 1, 1); PG8_STAGEB(PG8_SB(1, 0), b3); PG8_STAGEB(PG8_SB(1, 1), b3 + hstepB); PG8_STAGEA(PG8_SA(1, 0), a3, 0, last);
            PG8_WAIT_V(8); PG8_WAIT_L(0); PG8_BAR; if (!LIGHT || full) { PG8_MMA(1, 0, At, B0); PG8_MMA(1, 1, At, B1); } PG8_BAR; PG8_SCHED;
        }
        if (wr == 0) PG8_BAR;
        if constexpr (F8) asm volatile("s_nop 7\n\ts_nop 7\n\ts_nop 7" ::: "memory");
        E(acc, cur, wr, wc, fr, fq);
        if (!has_next) break;
#pragma unroll
        for (int a = 0; a < 2; ++a)
#pragma unroll
            for (int b = 0; b < 2; ++b)
#pragma unroll
                for (int m = 0; m < 4; ++m)
#pragma unroll
                    for (int n = 0; n < 2; ++n) acc[a][b][m][n] = (f32x4){0.f, 0.f, 0.f, 0.f};
        cur = nxt; cA = nA; cB = nB; ++ui;
        if (GATHER) {
#pragma unroll
            for (int h = 0; h < 2; ++h)
#pragma unroll
                for (int i = 0; i < 2; ++i) voffA[h][i] = voffAn[h][i];
        }
        if (wr == 1) PG8_BAR;
    }
    PG8_WAIT_V(0);
    PG8_BAR;
#undef PG8_SA
#undef PG8_SB
#undef PG8_STAGE2
#undef PG8_STAGEA
#undef PG8_STAGEB
#undef PG8_LDA
#undef PG8_LDB
#undef PG8_MMA
#undef PG8_LD32
#undef PG8_WAIT_V
#undef PG8_WAIT_L
#undef PG8_BAR
#undef PG8_SCHED
}

struct EpiProj {
    static constexpr bool PERM = true;
    bf16_t* out; const float* gq; const float* gk;
    __device__ __forceinline__ void operator()(const f32x4 (&acc)[2][2][4][2], const Unit& u, int wr, int wc, int fr, int fq) const {
        const int pn = u.col0 >> 8;
        const int row0 = u.row0 + wr * 64 + fr, colb = u.col0 + 64 * wc + 8 * fq;
        if (pn < 4) {
            const float* g = (pn < 2) ? gq : gk; const float post = (pn < 2) ? 0.125f : 1.0f;
            f32x4 gv[2][2];
#pragma unroll
            for (int bj = 0; bj < 2; ++bj)
#pragma unroll
                for (int n = 0; n < 2; ++n) gv[bj][n] = *(const f32x4*)(g + 32 * bj + 8 * fq + 4 * n) * post;
#pragma unroll
            for (int ai = 0; ai < 2; ++ai)
#pragma unroll
                for (int m = 0; m < 4; ++m) {
                    float ss = 0.f;
#pragma unroll
                    for (int bj = 0; bj < 2; ++bj)
#pragma unroll
                        for (int n = 0; n < 2; ++n) { const f32x4 x = acc[ai][bj][m][n]; ss += (x[0] * x[0] + x[1] * x[1]) + (x[2] * x[2] + x[3] * x[3]); }
                    ss += __shfl_xor(ss, 16); ss += __shfl_xor(ss, 32);
                    const float rstd = rsqrtf(ss * (1.0f / HD) + RMS_EPS);
                    bf16_t* rowp = out + (size_t)(row0 + ai * HALF + m * 16) * INW + colb;
#pragma unroll
                    for (int bj = 0; bj < 2; ++bj) { const f32x4 v0 = acc[ai][bj][m][0] * rstd * gv[bj][0], v1 = acc[ai][bj][m][1] * rstd * gv[bj][1];
                        u32x4 w; w.x = pack2(v0[0], v0[1]); w.y = pack2(v0[2], v0[3]); w.z = pack2(v1[0], v1[1]); w.w = pack2(v1[2], v1[3]);
                        *(u32x4*)(rowp + 32 * bj) = w; }
                }
        } else {
            const bool sg = pn >= 8;
#pragma unroll
            for (int ai = 0; ai < 2; ++ai)
#pragma unroll
                for (int m = 0; m < 4; ++m) {
                    bf16_t* rowp = out + (size_t)(row0 + ai * HALF + m * 16) * INW + colb;
#pragma unroll
                    for (int bj = 0; bj < 2; ++bj) { f32x4 v0 = acc[ai][bj][m][0], v1 = acc[ai][bj][m][1];
                        if (sg) {
#pragma unroll
                            for (int j = 0; j < 4; ++j) { v0[j] = sigmoidf_(v0[j]); v1[j] = sigmoidf_(v1[j]); } }
                        u32x4 w; w.x = pack2(v0[0], v0[1]); w.y = pack2(v0[2], v0[3]); w.z = pack2(v1[0], v1[1]); w.w = pack2(v1[2], v1[3]);
                        *(u32x4*)(rowp + 32 * bj) = w; }
                }
        }
    }
};
struct EpiGateMerge {
    static constexpr bool PERM = true;
    const bf16_t* proj; bf16_t* out;
    __device__ __forceinline__ void mid(f32x4 (&acc)[2][2][4][2], const Unit& u, int wr, int wc, int fr, int fq) const {
        asm volatile("" : "+v"(fr), "+v"(fq));
        const int row0 = u.row0 + wr * 64 + fr, col0 = u.col0 + wc * 32 + 8 * fq;
#pragma unroll
        for (int ai = 0; ai < 2; ++ai)
#pragma unroll
            for (int m = 0; m < 4; ++m) {
                const size_t r = (size_t)(row0 + ai * HALF + m * 16);
#pragma unroll
                for (int bj = 0; bj < 2; ++bj) {
                    const int c = col0 + bj * HALF;
                    const u32x4 ga = *(const u32x4*)(proj + r * INW + 2048 + c), gp = *(const u32x4*)(proj + r * INW + 3072 + c);
                    float fa[8], fp[8]; unpack8(ga, fa); unpack8(gp, fp);
#pragma unroll
                    for (int j = 0; j < 4; ++j) { acc[ai][bj][m][0][j] *= fa[j] * __builtin_amdgcn_rcpf(fp[j]); acc[ai][bj][m][1][j] *= fa[4 + j] * __builtin_amdgcn_rcpf(fp[4 + j]); }
                }
                asm volatile("" ::: "memory");
            }
    }
    __device__ __forceinline__ void operator()(const f32x4 (&acc)[2][2][4][2], const Unit& u, int wr, int wc, int fr, int fq) const {
        const int row0 = u.row0 + wr * 64 + fr, col0 = u.col0 + wc * 32 + 8 * fq;
#pragma unroll
        for (int ai = 0; ai < 2; ++ai)
#pragma unroll
            for (int m = 0; m < 4; ++m) {
                const size_t r = (size_t)(row0 + ai * HALF + m * 16);
#pragma unroll
                for (int bj = 0; bj < 2; ++bj) {
                    const int c = col0 + bj * HALF;
                    const u32x4 gp = *(const u32x4*)(proj + r * INW + 3072 + c);
                    float fp[8]; unpack8(gp, fp);
                    const f32x4 a0 = acc[ai][bj][m][0], a1 = acc[ai][bj][m][1];
                    u32x4 w; w.x = pack2(a0[0] * fp[0], a0[1] * fp[1]); w.y = pack2(a0[2] * fp[2], a0[3] * fp[3]); w.z = pack2(a1[0] * fp[4], a1[1] * fp[5]); w.w = pack2(a1[2] * fp[6], a1[3] * fp[7]);
                    *(u32x4*)(out + r * DM + c) = w;
                }
            }
    }
};
template <bool XF32> struct EpiResid {
    static constexpr bool PERM = true;
    const float* xf; bf16_t* xb;
    __device__ __forceinline__ void operator()(const f32x4 (&acc)[2][2][4][2], const Unit& u, int wr, int wc, int fr, int fq) const {
        const int row0 = u.row0 + wr * 64 + fr, col0 = u.col0 + wc * 32 + 8 * fq;
#pragma unroll
        for (int ai = 0; ai < 2; ++ai)
#pragma unroll
            for (int m = 0; m < 4; ++m) { const size_t off = (size_t)(row0 + ai * HALF + m * 16) * DM + col0;
#pragma unroll
                for (int bj = 0; bj < 2; ++bj) {
                    float x[8];
                    if (XF32) { const f32x4 a = *(const f32x4*)(xf + off + bj * HALF), b = *(const f32x4*)(xf + off + bj * HALF + 4);
                        x[0] = a[0]; x[1] = a[1]; x[2] = a[2]; x[3] = a[3]; x[4] = b[0]; x[5] = b[1]; x[6] = b[2]; x[7] = b[3]; }
                    else { const u32x4 t = *(const u32x4*)(xb + off + bj * HALF);
                        x[0] = bflo(t.x); x[1] = bfhi(t.x); x[2] = bflo(t.y); x[3] = bfhi(t.y); x[4] = bflo(t.z); x[5] = bfhi(t.z); x[6] = bflo(t.w); x[7] = bfhi(t.w); }
                    const f32x4 a0 = acc[ai][bj][m][0], a1 = acc[ai][bj][m][1];
                    u32x4 w; w.x = pack2(x[0] + a0[0], x[1] + a0[1]); w.y = pack2(x[2] + a0[2], x[3] + a0[3]); w.z = pack2(x[4] + a1[0], x[5] + a1[1]); w.w = pack2(x[6] + a1[2], x[7] + a1[3]);
                    *(u32x4*)(xb + off + bj * HALF) = w;
                }
            }
    }
};
template <bool F8> struct EpiSwiGLU {
    static constexpr bool PERM = true;
    void* act;
    __device__ __forceinline__ void operator()(const f32x4 (&acc)[2][2][4][2], const Unit& u, int wr, int wc, int fr, int fq) const {
        const int row0 = u.row0 + wr * 64 + fr, col0 = (u.col0 >> 1) + wc * 32 + 8 * fq;
        const float si = F8 ? (1.0f / W8_SCALE) : 1.0f, so = F8 ? A8_SCALE : 1.0f;
#pragma unroll
        for (int ai = 0; ai < 2; ++ai)
#pragma unroll
            for (int m = 0; m < 4; ++m) {
                float o[8];
#pragma unroll
                for (int n = 0; n < 2; ++n)
#pragma unroll
                    for (int j = 0; j < 4; ++j) { const float a = acc[ai][0][m][n][j] * si, b = acc[ai][1][m][n][j] * (si * so); o[4 * n + j] = a * sigmoidf_(a) * b; }
                const size_t off = (size_t)(row0 + ai * HALF + m * 16) * EH + col0;
                if (F8) { u32x2 w; w.x = pack4_fp8(o[0], o[1], o[2], o[3]); w.y = pack4_fp8(o[4], o[5], o[6], o[7]); *(u32x2*)((unsigned char*)act + off) = w; }
                else { u32x4 w; w.x = pack2(o[0], o[1]); w.y = pack2(o[2], o[3]); w.z = pack2(o[4], o[5]); w.w = pack2(o[6], o[7]); *(u32x4*)((bf16_t*)act + off) = w; }
            }
    }
};
template <bool F8> struct EpiDown {
    static constexpr bool PERM = true;
    bf16_t* yb; const float* tokW;
    __device__ __forceinline__ void operator()(const f32x4 (&acc)[2][2][4][2], const Unit& u, int wr, int wc, int fr, int fq) const {
        const int col0 = u.col0 + wc * 32 + 8 * fq;
        const float si = F8 ? (1.0f / (W8_SCALE * A8_SCALE)) : 1.0f;
#pragma unroll
        for (int ai = 0; ai < 2; ++ai)
#pragma unroll
            for (int m = 0; m < 4; ++m) {
                const int rl = wr * 64 + fr + ai * HALF + m * 16;
                const float w = rl < u.nvalid ? tokW[u.j0 + rl] * si : 0.f;
#pragma unroll
                for (int bj = 0; bj < 2; ++bj) { const f32x4 v0 = acc[ai][bj][m][0] * w, v1 = acc[ai][bj][m][1] * w;
                    u32x4 o; o.x = pack2(v0[0], v0[1]); o.y = pack2(v0[2], v0[3]); o.z = pack2(v1[0], v1[1]); o.w = pack2(v1[2], v1[3]);
                    *(u32x4*)(yb + (size_t)(u.row0 + rl) * DM + col0 + bj * HALF) = o; }
            }
    }
};
}

constexpr int ATT_K_OFF = 0, ATT_V_OFF = 49152;
__device__ __forceinline__ unsigned kv_off(unsigned row, unsigned ch) { return row * 128u + 16u * (ch ^ (((row >> 1) & 7u) ^ ((row & 2u) << 1))); }

struct AttnU { int tok0, d, blk, g, h; };
__device__ __forceinline__ AttnU attn_decode(int uidx) {
    const int bh = uidx / 48, r48 = uidx % 48, g = r48 >> 4, rr = r48 & 15;
    AttnU U; U.g = g; U.h = bh & 7;
    U.d = (g == 0) ? 1 : (g == 1 ? 4 : 16);
    const int c = (g == 0) ? 0 : (g == 1 ? (rr >> 2) : rr);
    U.blk = (g == 0) ? rr : (g == 1 ? (rr & 3) : 0);
    U.tok0 = (bh >> 3) * SEQ + c;
    return U;
}
__device__ __forceinline__ void attn_load_q(const AttnU& U, const bf16_t* __restrict__ proj, int wid, int lane, bf16x8 (&qn)[4]) {
    const size_t qt = (size_t)(U.tok0 + (256 * U.blk + 32 * wid + (lane & 31)) * U.d);
#pragma unroll
    for (int ks = 0; ks < 4; ++ks) qn[ks] = *(const bf16x8*)(proj + qt * INW + U.h * HD + 16 * ks + 8 * (lane >> 5));
}
__device__ __forceinline__ void attn_load(const AttnU& U, const bf16_t* __restrict__ proj, int tid, u32x4 (&kr)[6], u32x4 (&vr)[6]) {
    const int kbase = 256 * U.blk - 128, kr_min = (U.blk == 0) ? 128 : 0;
#pragma unroll
    for (int i = 0; i < 6; ++i) {
        const int idx = tid + NTHREADS * i, row = idx >> 3, ch = idx & 7;
        if (row >= kr_min) {
            const size_t t = (size_t)(U.tok0 + (kbase + row) * U.d);
            kr[i] = *(const u32x4*)(proj + t * INW + AW + U.h * HD + ch * 8);
            vr[i] = *(const u32x4*)(proj + t * INW + 2 * AW + U.h * HD + ch * 8);
        }
    }
}
__device__ __forceinline__ void attn_lds_store(const AttnU& U, LAS unsigned char* lds, int tid, const u32x4 (&kr)[6], const u32x4 (&vr)[6]) {
    const int kr_min = (U.blk == 0) ? 128 : 0;
#pragma unroll
    for (int i = 0; i < 6; ++i) {
        const int idx = tid + NTHREADS * i, row = idx >> 3, ch = idx & 7;
        if (row >= kr_min) { *(LAS u32x4*)(lds + ATT_K_OFF + kv_off(row, ch)) = kr[i]; *(LAS u32x4*)(lds + ATT_V_OFF + kv_off(row, ch)) = vr[i]; }
    }
}
__device__ __forceinline__ void attn_compute(const AttnU& U, LAS unsigned char* lds, const bf16x8 (&qf)[4], bf16_t* __restrict__ og, f32x2* __restrict__ ml, int wid, int lane) {
    const int blk = U.blk, g = U.g, h = U.h;
    const size_t qt = (size_t)(U.tok0 + (256 * blk + 32 * wid + (lane & 31)) * U.d);
    const int kt_min = (blk == 0) ? max(0, 4 - wid) : 0;
    const int hq = lane >> 5, qi = lane & 31;
    f32x16 S[5];
#pragma unroll
    for (int kt = 0; kt < 5; ++kt) {
#pragma unroll
        for (int i = 0; i < 16; ++i) S[kt][i] = 0.f;
        if (kt >= kt_min) {
            const unsigned krow = (unsigned)(32 * wid + 32 * kt + qi);
#pragma unroll
            for (int ks = 0; ks < 4; ++ks) {
                const bf16x8 kf = *(const LAS bf16x8*)(lds + ATT_K_OFF + kv_off(krow, (unsigned)(2 * ks + hq)));
                S[kt] = __builtin_amdgcn_mfma_f32_32x32x16_bf16(kf, qf[ks], S[kt], 0, 0, 0);
            }
        }
    }
    const float NINF = -__builtin_inff(), L2E = 1.4426950408889634f;
    float mx = NINF;
#pragma unroll
    for (int kt = 0; kt < 5; ++kt) {
        if (kt >= kt_min) {
#pragma unroll
            for (int i = 0; i < 16; ++i) {
                const int row = (i & 3) + 8 * (i >> 2) + 4 * hq;
                if (kt == 0) S[kt][i] = (row >= qi) ? S[kt][i] : NINF;
                if (kt == 4) S[kt][i] = (row <= qi) ? S[kt][i] : NINF;
            }
#pragma unroll
            for (int i = 0; i < 16; i += 2) mx = fmaxf(mx, fmaxf(S[kt][i], S[kt][i + 1]));
        }
    }
    mx = fmaxf(mx, __shfl_xor(mx, 32));
    const float mb = mx * L2E;
    float lsum = 0.f;
#pragma unroll
    for (int kt = 0; kt < 5; ++kt) {
        if (kt >= kt_min) {
#pragma unroll
            for (int i = 0; i < 16; ++i) { const float p = __builtin_amdgcn_exp2f(__builtin_fmaf(S[kt][i], L2E, -mb)); S[kt][i] = p; lsum += p; }
        }
    }
    lsum += __shfl_xor(lsum, 32);
    f32x16 O[2];
#pragma unroll
    for (int dt = 0; dt < 2; ++dt)
#pragma unroll
        for (int i = 0; i < 16; ++i) O[dt][i] = 0.f;
    const unsigned blkq = (lane >> 4) & 1, q4 = (lane & 15) >> 2, p4 = lane & 3;
    const unsigned vbase = (unsigned)(size_t)(lds + ATT_V_OFF) + (unsigned)(32 * wid) * 128u;
    unsigned tb[2][2];
#pragma unroll
    for (int t = 0; t < 2; ++t)
#pragma unroll
        for (int dt = 0; dt < 2; ++dt) tb[t][dt] = vbase + kv_off((unsigned)(8 * t + 4 * hq) + q4, (unsigned)(4 * dt) + 2 * blkq + (p4 >> 1)) + 8 * (p4 & 1);
#define ATT_TR_ISSUE(V, KT) asm volatile("ds_read_b64_tr_b16 %0, %8\n\tds_read_b64_tr_b16 %1, %9\n\tds_read_b64_tr_b16 %2, %10\n\tds_read_b64_tr_b16 %3, %11\n\t" \
        "ds_read_b64_tr_b16 %4, %12\n\tds_read_b64_tr_b16 %5, %13\n\tds_read_b64_tr_b16 %6, %14\n\tds_read_b64_tr_b16 %7, %15" \
        : "=&v"(V[0][0][0]), "=&v"(V[0][0][1]), "=&v"(V[0][1][0]), "=&v"(V[0][1][1]), "=&v"(V[1][0][0]), "=&v"(V[1][0][1]), "=&v"(V[1][1][0]), "=&v"(V[1][1][1]) \
        : "v"(tb[0][0] + 4096u * (KT)), "v"(tb[1][0] + 4096u * (KT)), "v"(tb[0][1] + 4096u * (KT)), "v"(tb[1][1] + 4096u * (KT)), \
          "v"(tb[0][0] + 4096u * (KT) + 2048u), "v"(tb[1][0] + 4096u * (KT) + 2048u), "v"(tb[0][1] + 4096u * (KT) + 2048u), "v"(tb[1][1] + 4096u * (KT) + 2048u) : "memory")
#define ATT_TR_WAIT(V) asm volatile("s_waitcnt lgkmcnt(0)" : "+v"(V[0][0][0]), "+v"(V[0][0][1]), "+v"(V[0][1][0]), "+v"(V[0][1][1]), "+v"(V[1][0][0]), "+v"(V[1][0][1]), "+v"(V[1][1][0]), "+v"(V[1][1][1]) :: "memory")
#define ATT_PV(V, KT) do { _Pragma("unroll") for (int s = 0; s < 2; ++s) { \
        u32x4 pw; pw.x = pack2(S[KT][8 * s + 0], S[KT][8 * s + 1]); pw.y = pack2(S[KT][8 * s + 2], S[KT][8 * s + 3]); pw.z = pack2(S[KT][8 * s + 4], S[KT][8 * s + 5]); pw.w = pack2(S[KT][8 * s + 6], S[KT][8 * s + 7]); \
        const bf16x8 pf = __builtin_bit_cast(bf16x8, pw); \
        u32x4 f0; f0.x = V[s][0][0].x; f0.y = V[s][0][0].y; f0.z = V[s][0][1].x; f0.w = V[s][0][1].y; \
        u32x4 f1; f1.x = V[s][1][0].x; f1.y = V[s][1][0].y; f1.z = V[s][1][1].x; f1.w = V[s][1][1].y; \
        O[0] = __builtin_amdgcn_mfma_f32_32x32x16_bf16(__builtin_bit_cast(bf16x8, f0), pf, O[0], 0, 0, 0); \
        O[1] = __builtin_amdgcn_mfma_f32_32x32x16_bf16(__builtin_bit_cast(bf16x8, f1), pf, O[1], 0, 0, 0); } } while (0)
    u32x2 va[2][2][2];
#pragma unroll
    for (int kt = 0; kt < 5; ++kt) {
        if (kt >= kt_min) { ATT_TR_ISSUE(va, kt); ATT_TR_WAIT(va); ATT_PV(va, kt); }
    }
#undef ATT_TR_ISSUE
#undef ATT_TR_WAIT
#undef ATT_PV
    const float inv = 1.0f / lsum;
    bf16_t* orow = og + ((size_t)g * NTOK + qt) * AW + h * HD;
#pragma unroll
    for (int dt = 0; dt < 2; ++dt)
#pragma unroll
        for (int gq4 = 0; gq4 < 4; ++gq4) {
            u32x2 w; w.x = pack2(O[dt][4 * gq4 + 0] * inv, O[dt][4 * gq4 + 1] * inv); w.y = pack2(O[dt][4 * gq4 + 2] * inv, O[dt][4 * gq4 + 3] * inv);
            *(u32x2*)(orow + 32 * dt + 8 * gq4 + 4 * hq) = w;
        }
    if (lane < 32) ml[((size_t)g * NTOK + qt) * 8 + h] = (f32x2){mx, lsum};
    __syncthreads();
}

struct TrDesc { const float* src; bf16_t* dst; int N, K; };
__device__ __forceinline__ void tr_load(const TrDesc& d, int lane, f32x4 (&r)[8]) {
#pragma unroll
    for (int i = 0; i < 8; ++i) r[i] = __builtin_nontemporal_load((const f32x4*)(d.src + (size_t)((lane >> 3) + 8 * i) * d.N + 4 * (lane & 7)));
}
__device__ __forceinline__ void tr_store(const TrDesc& d, LAS float* scr, int lane, const f32x4 (&r)[8]) {
#pragma unroll
    for (int i = 0; i < 8; ++i) { LAS float* p = scr + ((lane >> 3) + 8 * i) * 33 + 4 * (lane & 7); p[0] = r[i][0]; p[1] = r[i][1]; p[2] = r[i][2]; p[3] = r[i][3]; }
    const int c = lane & 7;
#pragma unroll
    for (int j = 0; j < 4; ++j) { const int n = (lane >> 3) + 8 * j; const LAS float* q = scr + (8 * c) * 33 + n;
        u32x4 o; o.x = pack2(q[0 * 33], q[1 * 33]); o.y = pack2(q[2 * 33], q[3 * 33]); o.z = pack2(q[4 * 33], q[5 * 33]); o.w = pack2(q[6 * 33], q[7 * 33]);
        *(u32x4*)(d.dst + (size_t)n * d.K + 8 * c) = o; }
}
struct ExpertItems {
    const float* weg; const float* weu; const float* wed; bf16_t* WguT; bf16_t* WdT;
    static constexpr int TOTAL = 3 * NEXP * 256;
    __device__ __forceinline__ TrDesc operator()(int it) const {
        const int which = it >> 13, r = it & 8191, e = r >> 8, item = r & 255; TrDesc d;
        if (which < 2) { const int kb = item >> 4, nb = item & 15, k0 = 64 * kb, n0 = 32 * nb, nn0 = (n0 >> 7) * 256 + which * 128 + (n0 & 127);
            d.src = (which == 0 ? weg : weu) + (size_t)e * DM * EH + (size_t)k0 * EH + n0; d.dst = WguT + (size_t)e * DM * DM + (size_t)nn0 * DM + k0; d.N = EH; d.K = DM; }
        else { const int kb = item >> 5, nb = item & 31, k0 = 64 * kb, n0 = 32 * nb;
            d.src = wed + (size_t)e * EH * DM + (size_t)k0 * DM + n0; d.dst = WdT + (size_t)e * DM * EH + (size_t)n0 * EH + k0; d.N = DM; d.K = EH; }
        return d;
    }
};
struct SmallItems {
    const float* win; const float* wa; const float* wo; bf16_t* WinT; bf16_t* WaT; bf16_t* WoT;
    static constexpr int TOTAL = 2 * 2816;
    __device__ __forceinline__ TrDesc operator()(int it) const {
        const int l = it / 2816, r = it % 2816; TrDesc d;
        if (r < 2048) { const int kb = r >> 7, nb = r & 127; d.src = win + (size_t)l * DM * INW + (size_t)(64 * kb) * INW + 32 * nb; d.dst = WinT + (size_t)l * INW * DM + (size_t)(32 * nb) * DM + 64 * kb; d.N = INW; d.K = DM; }
        else if (r < 2304) { const int q = r - 2048, kb = q >> 5, nb = q & 31; d.src = wa + (size_t)l * AW * DM + (size_t)(64 * kb) * DM + 32 * nb; d.dst = WaT + (size_t)l * DM * DM + (size_t)(32 * nb) * DM + 64 * kb; d.N = DM; d.K = DM; }
        else { const int q = r - 2304, kb = q >> 5, nb = q & 31; d.src = wo + (size_t)l * DM * DM + (size_t)(64 * kb) * DM + 32 * nb; d.dst = WoT + (size_t)l * DM * DM + (size_t)(32 * nb) * DM + 64 * kb; d.N = DM; d.K = DM; }
        return d;
    }
};
template <class Items>
__device__ __forceinline__ void convert_items(const Items& I, LAS float* scr, int lane, int gw, int NGW) {
    f32x4 ra[8], rb[8];
    int it = gw;
    if (it >= Items::TOTAL) return;
    TrDesc da = I(it), db = da;
    tr_load(da, lane, ra);
    for (;;) {
        int it2 = it + NGW;
        if (it2 < Items::TOTAL) { db = I(it2); tr_load(db, lane, rb); }
        tr_store(da, scr, lane, ra);
        it = it2; if (it >= Items::TOTAL) break;
        it2 = it + NGW;
        if (it2 < Items::TOTAL) { da = I(it2); tr_load(da, lane, ra); }
        tr_store(db, scr, lane, rb);
        it = it2; if (it >= Items::TOTAL) break;
    }
}
__device__ __forceinline__ int tr8_swz(int k) { return (k & 31) ^ ((k >> 5) << 3); }
__device__ __forceinline__ void tr_load8(const TrDesc& d, int lane, f32x4 (&r)[16]) {
#pragma unroll
    for (int i = 0; i < 16; ++i) r[i] = __builtin_nontemporal_load((const f32x4*)(d.src + (size_t)((lane >> 3) + 8 * i) * d.N + 4 * (lane & 7)));
}
__device__ __forceinline__ void tr_write8(LAS float* scr, int lane, const f32x4 (&r)[16]) {
#pragma unroll
    for (int i = 0; i < 16; ++i) { const int kk = (lane >> 3) + 8 * i, sw = tr8_swz(kk), n4 = 4 * (lane & 7); LAS float* p = scr + kk * 32;
        p[(n4 + 0) ^ sw] = r[i][0]; p[(n4 + 1) ^ sw] = r[i][1]; p[(n4 + 2) ^ sw] = r[i][2]; p[(n4 + 3) ^ sw] = r[i][3]; }
}
__device__ __forceinline__ void tr_out8(const TrDesc& d, const LAS float* scr, int lane) {
    const int c = lane >> 3;
#pragma unroll
    for (int j = 0; j < 4; ++j) { const int n = (lane & 7) + 8 * j; float f[16];
#pragma unroll
        for (int q = 0; q < 16; ++q) { const int k = 16 * c + q; f[q] = scr[k * 32 + (n ^ tr8_swz(k))] * W8_SCALE; }
        u32x4 o; o.x = pack4_fp8(f[0], f[1], f[2], f[3]); o.y = pack4_fp8(f[4], f[5], f[6], f[7]); o.z = pack4_fp8(f[8], f[9], f[10], f[11]); o.w = pack4_fp8(f[12], f[13], f[14], f[15]);
        *(u32x4*)((unsigned char*)d.dst + (size_t)n * d.K + 16 * c) = o; }
}
struct ExpertItems8 {
    const float* weg; const float* weu; const float* wed; unsigned char* WguT; unsigned char* WdT;
    static constexpr int TOTAL = 3 * NEXP * 128;
    __device__ __forceinline__ TrDesc operator()(int it) const {
        const int which = it >> 12, r = it & 4095, e = r >> 7, item = r & 127; TrDesc d;
        if (which < 2) { const int kb = item >> 4, nb = item & 15, k0 = 128 * kb, n0 = 32 * nb, nn0 = (n0 >> 7) * 256 + which * 128 + (n0 & 127);
            d.src = (which == 0 ? weg : weu) + (size_t)e * DM * EH + (size_t)k0 * EH + n0; d.dst = (bf16_t*)(WguT + (size_t)e * DM * DM + (size_t)nn0 * DM + k0); d.N = EH; d.K = DM; }
        else { const int kb = item >> 5, nb = item & 31, k0 = 128 * kb, n0 = 32 * nb;
            d.src = wed + (size_t)e * EH * DM + (size_t)k0 * DM + n0; d.dst = (bf16_t*)(WdT + (size_t)e * DM * EH + (size_t)n0 * EH + k0); d.N = DM; d.K = EH; }
        return d;
    }
};
template <class Items>
__device__ __forceinline__ void convert_items8(const Items& I, LAS float* scr, int lane, int gw, int NGW) {
    f32x4 r[16];
    int it = gw;
    if (it >= Items::TOTAL) return;
    TrDesc d = I(it);
    tr_load8(d, lane, r);
    for (;;) {
        tr_write8(scr, lane, r);
        const int it2 = it + NGW; const bool has = it2 < Items::TOTAL;
        TrDesc dn = d;
        if (has) { dn = I(it2); tr_load8(dn, lane, r); }
        tr_out8(d, scr, lane);
        if (!has) break;
        d = dn; it = it2;
    }
}
__device__ __forceinline__ void norm_row(const float* __restrict__ xr, const float* __restrict__ g, bf16_t* __restrict__ hr, int lane) {
    f32x4 v[4]; float ss = 0.f;
#pragma unroll
    for (int i = 0; i < 4; ++i) { v[i] = *(const f32x4*)(xr + (i * 64 + lane) * 4); ss += (v[i][0] * v[i][0] + v[i][1] * v[i][1]) + (v[i][2] * v[i][2] + v[i][3] * v[i][3]); }
    ss = wave_sum(ss);
    const float rstd = rsqrtf(ss * (1.0f / DM) + RMS_EPS);
#pragma unroll
    for (int i = 0; i < 4; ++i) {
        const f32x4 gv = *(const f32x4*)(g + (i * 64 + lane) * 4);
        u32x2 w; w.x = pack2(v[i][0] * rstd * gv[0], v[i][1] * rstd * gv[1]); w.y = pack2(v[i][2] * rstd * gv[2], v[i][3] * rstd * gv[3]);
        *(u32x2*)(hr + (i * 64 + lane) * 4) = w;
    }
}
typedef const __attribute__((address_space(4))) float* cfp;
typedef const __attribute__((address_space(4))) f32x2* cf2p;
template <int W>
__device__ __forceinline__ void pool_path(const u32x4 (&r)[23], int pos0, bf16_t* __restrict__ pl, size_t t0, int c0) {
    float sum[8] = {0.f, 0.f, 0.f, 0.f, 0.f, 0.f, 0.f, 0.f}, f[8];
#pragma unroll
    for (int j = 1; j < W; ++j) { unpack8(r[15 - j], f);
#pragma unroll
        for (int c = 0; c < 8; ++c) sum[c] += f[c]; }
#pragma unroll
    for (int i = 0; i < 8; ++i) {
        float u[8]; unpack8(r[15 + i], u);
        if (i > 0) { unpack8(r[15 + i - W], f);
#pragma unroll
            for (int c = 0; c < 8; ++c) sum[c] -= f[c]; }
#pragma unroll
        for (int c = 0; c < 8; ++c) sum[c] += u[c];
        const float ic = 1.0f / (float)min(pos0 + i + 1, W);
        u32x4 o; o.x = pack2(sum[0] * ic - u[0], sum[1] * ic - u[1]); o.y = pack2(sum[2] * ic - u[2], sum[3] * ic - u[3]);
        o.z = pack2(sum[4] * ic - u[4], sum[5] * ic - u[5]); o.w = pack2(sum[6] * ic - u[6], sum[7] * ic - u[7]);
        *(u32x4*)(pl + (t0 + i) * DM + c0) = o;
    }
}
__device__ __forceinline__ int scan32_excl(int v, int lane, int& total) {
    int inc = v;
#pragma unroll
    for (int o = 1; o < 32; o <<= 1) { const int t = __shfl_up(inc, o, 32); if ((lane & 31) >= o) inc += t; }
    total = __shfl(inc, 31, 32);
    return inc - v;
}
__device__ __forceinline__ void build_moe_tables(LAS int* L, const unsigned* cnt) {
    { unsigned a_ = (unsigned)(size_t)L; asm volatile("" : "+s"(a_)); L = (LAS int*)(size_t)a_; }
    const int tid = opaque_tid();
    if (tid < 64) {
        const int lane = tid, e = lane & 31;
        const int c = (int)__hip_atomic_load(cnt + e * 64, __ATOMIC_RELAXED, __HIP_MEMORY_SCOPE_AGENT);
        const int nt = (c + 255) >> 8, lastv = c - 256 * (nt - 1);
        const int lt = (nt > 0 && lastv <= 128) ? 1 : 0, hv = nt - lt;
        int Tt, Th, Tl;
        const int tbx = scan32_excl(nt, lane, Tt), hx = scan32_excl(hv, lane, Th), lx = scan32_excl(lt, lane, Tl);
        if (lane < 32) {
            L[LI_TB + e] = tbx; L[LI_PS + e] = tbx * 256; L[LI_CN + e] = c;
            for (int j = 0; j < hv; ++j) L[LI_ORD + hx + j] = (e << 8) | j;
            if (lt) L[LI_ORD + Th + lx] = (e << 8) | (nt - 1);
            if (lane == 31) { L[LI_TB + NEXP] = Tt; L[LI_PS + NEXP] = Tt * 256; L[LI_NT] = Tt; }
        }
    }
    __syncthreads();
}

struct Args { const float* in[18]; float* out; unsigned char* ws; int ph_lo, ph_hi; };
typedef const __attribute__((address_space(4))) Args* CArgsP;
__device__ __forceinline__ CArgsP kargs() { unsigned long long p = (unsigned long long)__builtin_amdgcn_kernarg_segment_ptr(); asm volatile("" : "+s"(p)); return (CArgsP)p; }
#define PHASE_PTRS \
    const int G = opaque_s(G0), bx = opaque_s(bx0), vcu = opaque_s(vcu0), NGW = G * NWAVES; (void)bx; (void)vcu; (void)NGW; \
    const CArgsP ka = kargs(); unsigned char* const ws = ka->ws; \
    unsigned* const ctrl = (unsigned*)(ws + OFF_CTRL); const float* const x_in = ka->in[0]; \
    bf16_t* const WinT = (bf16_t*)(ws + OFF_WIN); bf16_t* const WaT = (bf16_t*)(ws + OFF_WA); bf16_t* const WppT = (bf16_t*)(ws + OFF_WPP); bf16_t* const WoT = (bf16_t*)(ws + OFF_WO); \
    bf16_t* const WguT = (bf16_t*)(ws + OFF_WGU); bf16_t* const WdT = (bf16_t*)(ws + OFF_WD); \
    bf16_t* const Hb = (bf16_t*)(ws + OFF_H); bf16_t* const MG = Hb; bf16_t* const PROJ = (bf16_t*)(ws + OFF_PROJ); bf16_t* const ACT = (bf16_t*)(ws + OFF_ACT); bf16_t* const YB = (bf16_t*)(ws + OFF_YB); \
    bf16_t* const AC = (bf16_t*)(ws + OFF_AC); bf16_t* const PL = (bf16_t*)(ws + OFF_PL); bf16_t* const OG = (bf16_t*)(ws + OFF_OG); bf16_t* const T1 = (bf16_t*)(ws + OFF_T1); \
    f32x2* const ML = (f32x2*)(ws + OFF_ML); bf16_t* const XB = (bf16_t*)(ws + OFF_XB); int* const tokE = (int*)(ws + OFF_TOKE); float* const tokW = (float*)(ws + OFF_TOKW); int* const asg = (int*)(ws + OFF_ASG); \
    (void)ctrl; (void)x_in; (void)WinT; (void)WaT; (void)WppT; (void)WoT; (void)WguT; (void)WdT; (void)Hb; (void)MG; (void)PROJ; (void)ACT; (void)YB; (void)AC; (void)PL; (void)OG; (void)T1; (void)ML; (void)XB; (void)tokE; (void)tokW; (void)asg
#define LAYER_PTRS PHASE_PTRS; const int tid = opaque_tid(), lane = tid & 63, wid = __builtin_amdgcn_readfirstlane(tid >> 6), gw = vcu * NWAVES + wid; (void)lane; (void)gw; unsigned* const cnt = ctrl + CW_CNT + l * 2048; (void)cnt

#ifndef PHASE_MASK
#define PHASE_MASK 0x3ff
#endif
#define EN(j) (((PHASE_MASK) >> (j)) & 1)
#ifndef REP_MASK
#define REP_MASK 0
#endif
#define REPS(j) (1 + (((REP_MASK) >> (j)) & 1))
#define IN(k) (MK_N_LAUNCHES == 1 || (lo <= (k) && (k) < hi))
#ifndef PROBE_A
#define PROBE_A -1
#define PROBE_B -1
#endif
#define STAMP_BEGIN(k) do { if (PROBE_A == (k)) ts0 = __builtin_amdgcn_s_memrealtime(); } while (0)
#define SEAM(k) do { if (IN(k) && IN((k) + 1)) { XcdBarrier b2_ = bar; unsigned long long p_ = (unsigned long long)b2_.bar; asm volatile("" : "+s"(p_)); b2_.bar = (unsigned*)p_; xcd_barrier(b2_); } if (PROBE_B == (k)) ts1 = __builtin_amdgcn_s_memrealtime(); } while (0)

template <int l>
__device__ __forceinline__ void layer_body(const XcdBarrier& bar, LAS unsigned char* lds, LAS int* LC, const int G0, const int bx0, const int vcu0, const int lo, const int hi, unsigned long long& ts0, unsigned long long& ts1) {
        const int pb = 1 + 9 * l;
        STAMP_BEGIN(pb + 0);
        for (int rep = 0; rep < REPS(0); ++rep) if (EN(0) && IN(pb + 0)) {
            asm volatile("; PHASE_MARK 0");
            LAYER_PTRS;
            pg8::DenseOrder S; S.init(Hb, WinT + (size_t)l * INW * DM, NTOK, INW, DM * 2, G, bx);
            pg8::EpiProj E{PROJ, ka->in[3] + (size_t)l * HD, ka->in[4] + (size_t)l * HD};
            pg8::gemm_phase<pg8::EpiProj, pg8::DenseOrder, 1, false>(lds, DM * 2, S, E);
        }
        SEAM(pb + 0);
        STAMP_BEGIN(pb + 1);
        for (int rep = 0; rep < REPS(1); ++rep) if (EN(1) && IN(pb + 1)) {
            asm volatile("; PHASE_MARK 1");
            LAYER_PTRS;
            int u = vcu;
            if (u < 1536) {
                AttnU cu = attn_decode(u), nu = cu;
                u32x4 kr[6], vr[6]; bf16x8 qf[4];
                attn_load(cu, PROJ, tid, kr, vr);
                for (;;) {
                    attn_load_q(cu, PROJ, wid, lane, qf);
                    attn_lds_store(cu, lds, tid, kr, vr);
                    __syncthreads();
                    const int un = u + G; const bool hn = un < 1536;
                    if (hn) { nu = attn_decode(un); attn_load(nu, PROJ, tid, kr, vr); }
                    attn_compute(cu, lds, qf, OG, ML, wid, lane);
                    if (!hn) break;
                    cu = nu; u = un;
                }
            }
        }
        SEAM(pb + 1);
        STAMP_BEGIN(pb + 2);
        for (int rep = 0; rep < REPS(2); ++rep) if (EN(2) && IN(pb + 2)) {
            asm volatile("; PHASE_MARK 2");
            LAYER_PTRS;
            for (int grp = gw; grp < NTOK / 8; grp += NGW) {
                const size_t t0 = (size_t)grp * 8; const int c0 = 8 * lane, hh = lane >> 3;
                {
                    f32x2 sm[8][3]; u32x4 v[8][3];
#pragma unroll
                    for (int i = 0; i < 8; ++i)
#pragma unroll
                        for (int g = 0; g < 3; ++g) { sm[i][g] = ML[((size_t)g * NTOK + t0 + i) * 8 + hh]; v[i][g] = *(const u32x4*)(OG + ((size_t)g * NTOK + t0 + i) * AW + c0); }
#pragma unroll
                    for (int i = 0; i < 8; ++i) {
                        const float M = fmaxf(fmaxf(sm[i][0][0], sm[i][1][0]), sm[i][2][0]);
                        float w[3], W = 0.f;
#pragma unroll
                        for (int g = 0; g < 3; ++g) { w[g] = sm[i][g][1] * __expf(sm[i][g][0] - M); W += w[g]; }
                        const float iw = 1.0f / W;
                        float o[8] = {0.f, 0.f, 0.f, 0.f, 0.f, 0.f, 0.f, 0.f}, f[8];
#pragma unroll
                        for (int g = 0; g < 3; ++g) { unpack8(v[i][g], f); const float q = w[g] * iw;
#pragma unroll
                            for (int c = 0; c < 8; ++c) o[c] += q * f[c]; }
                        u32x4 ow; ow.x = pack2(o[0], o[1]); ow.y = pack2(o[2], o[3]); ow.z = pack2(o[4], o[5]); ow.w = pack2(o[6], o[7]);
                        *(u32x4*)(AC + (t0 + i) * DM + c0) = ow;
                    }
                }
                {
                    const int pos0 = (int)(t0 & (SEQ - 1)), g4 = lane >> 4, wnd = 2 << g4;
                    u32x4 r[23];
#pragma unroll
                    for (int k = 0; k < 23; ++k) { const bool need = (k >= 16 - wnd) && (pos0 - 15 + k >= 0);
                        r[k] = need ? *(const u32x4*)(PROJ + (t0 - 15 + k) * INW + 3 * AW + c0) : (u32x4){0u, 0u, 0u, 0u}; }
                    if (g4 == 0) pool_path<2>(r, pos0, AC + PW, t0, c0);
                    else if (g4 == 1) pool_path<4>(r, pos0, AC + PW, t0, c0);
                    else if (g4 == 2) pool_path<8>(r, pos0, AC + PW, t0, c0);
                    else pool_path<16>(r, pos0, AC + PW, t0, c0);
                }
            }
        }
        SEAM(pb + 2);
        STAMP_BEGIN(pb + 3);
        for (int rep = 0; rep < REPS(3); ++rep) if (EN(3) && IN(pb + 3)) {
            asm volatile("; PHASE_MARK 3");
            LAYER_PTRS;
            pg8::DenseOrder S; S.init(AC, WaT + (size_t)l * DM * DM, NTOK, DM, DM * 2, G, bx);
            pg8::EpiGateMerge E{PROJ, MG};
            pg8::gemm_phase<pg8::EpiGateMerge, pg8::DenseOrder, 0, false, false, false, true>(lds, DM * 2, S, E);
        }
        SEAM(pb + 3);
        STAMP_BEGIN(pb + 4);
        if (EN(4) && IN(pb + 4)) {
            asm volatile("; PHASE_MARK 4");
            LAYER_PTRS;
            pg8::DenseOrder S; S.init(MG, WoT + (size_t)l * DM * DM, NTOK, DM, DM * 2, G, bx);
            pg8::EpiResid<l == 0> E{x_in, XB};
            pg8::gemm_phase<pg8::EpiResid<l == 0>, pg8::DenseOrder, 0, false>(lds, DM * 2, S, E);
        }
        SEAM(pb + 4);
        STAMP_BEGIN(pb + 5);
        if (EN(5) && IN(pb + 5)) {
            asm volatile("; PHASE_MARK 5");
            LAYER_PTRS;
            LAS float* part = (LAS float*)lds;
            LAS float* lg = (LAS float*)(lds + 100352);
            LAS int* aE = (LAS int*)(lds + 110592); LAS float* aW = (LAS float*)(lds + 110592 + 512); LAS int* bs = (LAS int*)(lds + 110592 + 1024); LAS float* rs = (LAS float*)(lds + 110592 + 1536);
            const float* g2 = ka->in[10] + (size_t)l * DM; const float* brg = ka->in[12] + (size_t)l * 4; const float* bre = ka->in[14] + (size_t)l * 32;
            const bf16_t* Wh = (const bf16_t*)(ws + OFF_WRH) + (size_t)l * 48 * DM; const bf16_t* Wl = (const bf16_t*)(ws + OFF_WRL) + (size_t)l * 48 * DM;
            for (int chunk = bx; chunk < NTOK / 64; chunk += G) {
                {
                    const int fr = lane & 15, fq = lane >> 4;
                    f32x4 acc[4][3]; float ssl[4] = {0.f, 0.f, 0.f, 0.f};
#pragma unroll
                    for (int mt = 0; mt < 4; ++mt)
#pragma unroll
                        for (int nt = 0; nt < 3; ++nt) acc[mt][nt] = (f32x4){0.f, 0.f, 0.f, 0.f};
#pragma unroll 1
                    for (int ks = 0; ks < 4; ++ks) {
                        const int d0 = 128 * wid + 32 * ks + 8 * fq;
                        bf16x8 bh[3], bl[3];
#pragma unroll
                        for (int nt = 0; nt < 3; ++nt) { bh[nt] = *(const bf16x8*)(Wh + (size_t)(16 * nt + fr) * DM + d0); bl[nt] = *(const bf16x8*)(Wl + (size_t)(16 * nt + fr) * DM + d0); }
#pragma unroll
                        for (int mt = 0; mt < 4; ++mt) {
                            const u32x4 hw = *(const u32x4*)(XB + (size_t)(chunk * 64 + 16 * mt + fr) * DM + d0);
                            { float f[8]; unpack8(hw, f); ssl[mt] += (f[0] * f[0] + f[1] * f[1]) + (f[2] * f[2] + f[3] * f[3]) + (f[4] * f[4] + f[5] * f[5]) + (f[6] * f[6] + f[7] * f[7]); }
                            const bf16x8 ah = __builtin_bit_cast(bf16x8, hw);
#pragma unroll
                            for (int nt = 0; nt < 3; ++nt) {
                                acc[mt][nt] = __builtin_amdgcn_mfma_f32_16x16x32_bf16(ah, bh[nt], acc[mt][nt], 0, 0, 0);
                                acc[mt][nt] = __builtin_amdgcn_mfma_f32_16x16x32_bf16(ah, bl[nt], acc[mt][nt], 0, 0, 0);
                            }
                        }
                        asm volatile("" ::: "memory");
                    }
#pragma unroll
                    for (int mt = 0; mt < 4; ++mt) {
#pragma unroll
                        for (int nt = 0; nt < 3; ++nt) *(LAS f32x4*)(part + (wid * 49 + 16 * nt + fr) * 64 + 16 * mt + 4 * fq) = acc[mt][nt];
                        float sq = ssl[mt]; sq += __shfl_xor(sq, 16); sq += __shfl_xor(sq, 32);
                        if (fq == 0) part[(wid * 49 + 48) * 64 + 16 * mt + fr] = sq;
                    }
                }
                __syncthreads();
                for (int o = tid >> 6; o < 37; o += 8) { float sum = 0.f; const int po = (o == 36) ? 48 : o;
#pragma unroll
                    for (int w = 0; w < 8; ++w) sum += part[(w * 49 + po) * 64 + lane];
                    lg[o * 64 + lane] = sum; }
                __syncthreads();
                if (tid < 64) {
                    const float rstd = rsqrtf(lg[36 * 64 + tid] * (1.0f / DM) + RMS_EPS); rs[tid] = rstd;
                    float gl[4];
#pragma unroll
                    for (int o = 0; o < 4; ++o) gl[o] = lg[o * 64 + tid] * rstd + brg[o];
                    int gs = 0; float gm = gl[0];
#pragma unroll
                    for (int o = 1; o < 4; ++o) if (gl[o] > gm) { gm = gl[o]; gs = o; }
                    float gden = 0.f;
#pragma unroll
                    for (int o = 0; o < 4; ++o) gden += __expf(gl[o] - gm);
                    const float ggate = 1.0f / gden;
                    float el[8];
#pragma unroll
                    for (int o = 0; o < 8; ++o) el[o] = lg[(4 + 8 * gs + o) * 64 + tid] * rstd + bre[gs * 8 + o];
                    int i0 = 0; float m0 = el[0];
#pragma unroll
                    for (int o = 1; o < 8; ++o) if (el[o] > m0) { m0 = el[o]; i0 = o; }
                    int i1 = 0; float m1 = -3.0e38f;
#pragma unroll
                    for (int o = 0; o < 8; ++o) if (o != i0 && el[o] > m1) { m1 = el[o]; i1 = o; }
                    const float e1 = __expf(m1 - m0);
                    aE[2 * tid] = gs * 8 + i0; aE[2 * tid + 1] = gs * 8 + i1; aW[2 * tid] = ggate / (1.0f + e1); aW[2 * tid + 1] = ggate * e1 / (1.0f + e1);
                }
                __syncthreads();
                int myE = 0, rank = 0;
                if (tid < 128) { myE = aE[tid]; for (int a = 0; a < tid; ++a) rank += (aE[a] == myE) ? 1 : 0; }
                if (tid < NEXP) { int c = 0; for (int a = 0; a < 128; ++a) c += (aE[a] == tid) ? 1 : 0;
                    bs[tid] = c ? (int)__hip_atomic_fetch_add(cnt + tid * 64, (unsigned)c, __ATOMIC_RELAXED, __HIP_MEMORY_SCOPE_AGENT) : 0; }
#pragma unroll 2
                for (int it = 0; it < 8; ++it) {
                    const int ti = wid * 8 + it; const size_t tok = (size_t)chunk * 64 + ti; const float rstd = rs[ti];
#pragma unroll
                    for (int i = 0; i < 4; ++i) { const int d0 = (i * 64 + lane) * 4; const u32x2 xw = *(const u32x2*)(XB + tok * DM + d0); const f32x4 gv = *(const f32x4*)(g2 + d0);
                        const float h0 = bflo(xw.x) * rstd * gv[0], h1 = bfhi(xw.x) * rstd * gv[1], h2v = bflo(xw.y) * rstd * gv[2], h3 = bfhi(xw.y) * rstd * gv[3];
                        if (MOE_FP8) *(unsigned*)((unsigned char*)Hb + tok * DM + d0) = pack4_fp8(h0, h1, h2v, h3);
                        else { u32x2 w; w.x = pack2(h0, h1); w.y = pack2(h2v, h3); *(u32x2*)(Hb + tok * DM + d0) = w; } }
                }
                __syncthreads();
                if (tid < 128) { const int slot = bs[myE] + rank, tok = chunk * 64 + (tid >> 1);
                    tokE[(size_t)myE * ECAP + slot] = tok; tokW[(size_t)myE * ECAP + slot] = aW[tid]; asg[tok * 2 + (tid & 1)] = myE * ECAP + slot; }
                __syncthreads();
            }
        }
        SEAM(pb + 5);
        STAMP_BEGIN(pb + 6);
        for (int rep = 0; rep < REPS(6); ++rep) if (EN(6) && IN(pb + 6)) {
            asm volatile("; PHASE_MARK 6");
            LAYER_PTRS;
            build_moe_tables(LC, cnt);
            constexpr int ES = MOE_FP8 ? 1 : 2;
            pg8::MoeOrder S{(const char*)Hb, (const char*)WguT, (size_t)DM * DM * ES, DM * ES, LC + LI_TB, LC + LI_PS, LC + LI_CN, LC + LI_ORD, tokE, G, vcu, true};
            pg8::EpiSwiGLU<MOE_FP8> E{(void*)ACT};
            pg8::gemm_phase<pg8::EpiSwiGLU<MOE_FP8>, pg8::MoeOrder, 0, true, true, MOE_FP8>(lds, DM * ES, S, E);
        }
        SEAM(pb + 6);
        STAMP_BEGIN(pb + 7);
        for (int rep = 0; rep < REPS(7); ++rep) if (EN(7) && IN(pb + 7)) {
            asm volatile("; PHASE_MARK 7");
            LAYER_PTRS;
            build_moe_tables(LC, cnt);
            constexpr int ES = MOE_FP8 ? 1 : 2;
            pg8::MoeOrder S{(const char*)ACT, (const char*)WdT, (size_t)DM * EH * ES, EH * ES, LC + LI_TB, LC + LI_PS, LC + LI_CN, LC + LI_ORD, tokE, G, vcu, false};
            pg8::EpiDown<MOE_FP8> E{YB, tokW};
            pg8::gemm_phase<pg8::EpiDown<MOE_FP8>, pg8::MoeOrder, 0, false, true, MOE_FP8>(lds, EH * ES, S, E);
        }
        SEAM(pb + 7);
        STAMP_BEGIN(pb + 8);
        if (EN(8) && IN(pb + 8)) {
            asm volatile("; PHASE_MARK 8");
            LAYER_PTRS;
            build_moe_tables(LC, cnt);
            const bool lastl = (l == DEPTH - 1);
            const float* g1n = ka->in[1] + (size_t)(lastl ? 0 : (l + 1)) * DM;
            for (int grp = gw; grp < NTOK / 4; grp += NGW) {
                const size_t t0 = (size_t)grp * 4;
                const int myasg = (lane < 8) ? asg[t0 * 2 + lane] : 0;
                u32x2 xv[4][4], ya[4][4], yb[4][4];
#pragma unroll
                for (int q = 0; q < 4; ++q) {
                    const int i0 = __builtin_amdgcn_readlane(myasg, 2 * q), i1 = __builtin_amdgcn_readlane(myasg, 2 * q + 1);
                    const size_t s0 = (size_t)(LC[LI_PS + (i0 >> 14)] + (i0 & (ECAP - 1))), s1 = (size_t)(LC[LI_PS + (i1 >> 14)] + (i1 & (ECAP - 1)));
#pragma unroll
                    for (int i = 0; i < 4; ++i) { const int d0 = (i * 64 + lane) * 4;
                        xv[q][i] = *(const u32x2*)(XB + (t0 + q) * DM + d0); ya[q][i] = *(const u32x2*)(YB + s0 * DM + d0); yb[q][i] = *(const u32x2*)(YB + s1 * DM + d0); }
                }
#pragma unroll
                for (int q = 0; q < 4; ++q) {
                    f32x4 v[4]; float ss = 0.f;
#pragma unroll
                    for (int i = 0; i < 4; ++i) { const int d0 = (i * 64 + lane) * 4; const u32x2 a = ya[q][i], b = yb[q][i], x4 = xv[q][i];
                        v[i][0] = bflo(x4.x) + bflo(a.x) + bflo(b.x); v[i][1] = bfhi(x4.x) + bfhi(a.x) + bfhi(b.x); v[i][2] = bflo(x4.y) + bflo(a.y) + bflo(b.y); v[i][3] = bfhi(x4.y) + bfhi(a.y) + bfhi(b.y);
                        ss += (v[i][0] * v[i][0] + v[i][1] * v[i][1]) + (v[i][2] * v[i][2] + v[i][3] * v[i][3]);
                        if (lastl) *(f32x4*)(ka->out + (t0 + q) * DM + d0) = v[i];
                        else { u32x2 w; w.x = pack2(v[i][0], v[i][1]); w.y = pack2(v[i][2], v[i][3]); *(u32x2*)(XB + (t0 + q) * DM + d0) = w; } }
                    if (!lastl) {
                        ss = wave_sum(ss);
                        const float rstd = rsqrtf(ss * (1.0f / DM) + RMS_EPS);
#pragma unroll
                        for (int i = 0; i < 4; ++i) { const int d0 = (i * 64 + lane) * 4; const f32x4 gv = *(const f32x4*)(g1n + d0);
                            u32x2 w; w.x = pack2(v[i][0] * rstd * gv[0], v[i][1] * rstd * gv[1]); w.y = pack2(v[i][2] * rstd * gv[2], v[i][3] * rstd * gv[3]);
                            *(u32x2*)(Hb + (t0 + q) * DM + d0) = w; }
                    }
                }
            }
            if (!lastl) {
                __syncthreads();
                const float* e0 = ka->in[15] + (size_t)(l + 1) * NEXP * DM * EH; const float* e1 = ka->in[16] + (size_t)(l + 1) * NEXP * DM * EH; const float* e2 = ka->in[17] + (size_t)(l + 1) * NEXP * EH * DM;
                if (MOE_FP8) { ExpertItems8 I{e0, e1, e2, (unsigned char*)WguT, (unsigned char*)WdT}; convert_items8(I, (LAS float*)(lds + wid * 16384), lane, gw, NGW); }
                else { ExpertItems I{e0, e1, e2, WguT, WdT}; convert_items(I, (LAS float*)(lds + wid * 16384), lane, gw, NGW); }
            }
        }
        if (l + 1 < DEPTH) SEAM(pb + 8); else if (PROBE_B == pb + 8) ts1 = __builtin_amdgcn_s_memrealtime();
    }

__global__ void __launch_bounds__(NTHREADS, 2) fwd_kernel(Args args) {
    extern __shared__ __attribute__((aligned(16))) unsigned char lds_raw[];
    LAS unsigned char* lds = (LAS unsigned char*)lds_raw;
    LAS int* LC = (LAS int*)(lds + LCTL_OFF);
    const int G0 = gridDim.x, bx0 = blockIdx.x;
    const int vcu0 = (G0 % 8 == 0) ? (bx0 % 8) * (G0 / 8) + bx0 / 8 : bx0;
    if (threadIdx.x < 4) LC[LI_BAR + threadIdx.x] = 0;
    __syncthreads();
    XcdBarrier bar; bar.bar = (unsigned*)(args.ws + OFF_CTRL) + CW_BAR; bar.x = 0; bar.st = nullptr;
    if (MK_N_LAUNCHES == 1) bar = xcd_barrier_post(bar.bar, (volatile LAS unsigned*)(LC + LI_BAR));
    const int lo = args.ph_lo, hi = args.ph_hi;
    unsigned long long ts0 = 0ull, ts1 = 0ull;
    STAMP_BEGIN(0);
    for (int rep = 0; rep < REPS(9); ++rep) if (EN(9) && IN(0)) {
        asm volatile("; PHASE_MARK 9");
        PHASE_PTRS; const int tid = opaque_tid(), lane = tid & 63, wid = __builtin_amdgcn_readfirstlane(tid >> 6), gw = vcu * NWAVES + wid;
        LAS float* scr = (LAS float*)(lds + wid * 16384);
        if (wid == 7) {
            for (int o = vcu; o < DEPTH * 4 * 16 * 4; o += G) {
                const int l = o >> 8, g = (o >> 6) & 3, nb = (o >> 2) & 15, cb = o & 3, c0 = 32 * cb, n = 64 * nb + lane;
                const float* wm = ka->in[6] + (size_t)l * 4 * 128 * 128 + (size_t)(g * 128 + c0) * 128;
                const float* sc = ka->in[7] + (size_t)l * PW + g * 128;
                const float* wp = ka->in[8] + (size_t)l * PW * DM + (size_t)(g * 128) * DM + n;
                {
                    const f32x4 sv = *(const f32x4*)(sc + 4 * (lane & 31));
#pragma unroll 8
                    for (int i = 0; i < 16; ++i) { const int c = (lane >> 5) + 2 * i; const f32x4 v = *(const f32x4*)(wm + (size_t)c * 128 + 4 * (lane & 31)) * sv;
#pragma unroll
                        for (int j = 0; j < 4; ++j) scr[(4 * (lane & 31) + j) * 32 + c] = v[j]; }
                }
                float a[32];
#pragma unroll
                for (int c = 0; c < 32; ++c) a[c] = 0.f;
                float wa[32];
#define FOLD_BLOCK(WV, D0) do { _Pragma("unroll") for (int q = 0; q < 32; ++q) { const float w = WV[q]; _Pragma("unroll") for (int c4 = 0; c4 < 8; ++c4) { \
                    const f32x4 m4 = *(const LAS f32x4*)(scr + ((D0) + q) * 32 + 4 * c4); a[4 * c4] += w * m4[0]; a[4 * c4 + 1] += w * m4[1]; a[4 * c4 + 2] += w * m4[2]; a[4 * c4 + 3] += w * m4[3]; } \
                    if (q & 1) asm volatile("" ::: "memory"); } } while (0)
#pragma unroll 1
                for (int d0 = 0; d0 < 128; d0 += 32) {
#pragma unroll
                    for (int q = 0; q < 32; ++q) wa[q] = wp[(size_t)(d0 + q) * DM];
                    FOLD_BLOCK(wa, d0);
                }
#undef FOLD_BLOCK
                bf16_t* op = WaT + (size_t)l * DM * DM + (size_t)n * DM + PW + g * 128 + c0;
#pragma unroll
                for (int q = 0; q < 4; ++q) { u32x4 ow; ow.x = pack2(a[8 * q], a[8 * q + 1]); ow.y = pack2(a[8 * q + 2], a[8 * q + 3]); ow.z = pack2(a[8 * q + 4], a[8 * q + 5]); ow.w = pack2(a[8 * q + 6], a[8 * q + 7]);
                    *(u32x4*)(op + 8 * q) = ow; }
            }
            for (int o = vcu * 64 + lane; o < DEPTH * 48 * DM; o += G * 64) {
                const int l = o / (48 * DM), r = o % (48 * DM), oo = r / DM, d = r % DM;
                float w = 0.f;
                if (oo < 4) w = ka->in[11][(size_t)l * DM * 4 + (size_t)d * 4 + oo];
                else if (oo < 36) w = ka->in[13][(size_t)l * 4 * DM * 8 + ((size_t)((oo - 4) >> 3) * DM + d) * 8 + ((oo - 4) & 7)];
                w *= ka->in[10][(size_t)l * DM + d];
                const bf16_t hi = f2bf(w); const float hf = __uint_as_float((unsigned)hi << 16);
                ((bf16_t*)(ws + OFF_WRH))[o] = hi; ((bf16_t*)(ws + OFF_WRL))[o] = f2bf(w - hf);
            }
        } else {
            const int gw7 = vcu * 7 + wid, NGW7 = G * 7;
            { SmallItems I{ka->in[2], ka->in[5], ka->in[9], WinT, WaT, WoT}; convert_items(I, scr, lane, gw7, NGW7); }
            if (MOE_FP8) { ExpertItems8 I{ka->in[15], ka->in[16], ka->in[17], (unsigned char*)WguT, (unsigned char*)WdT}; convert_items8(I, scr, lane, gw7, NGW7); }
            else { ExpertItems I{ka->in[15], ka->in[16], ka->in[17], WguT, WdT}; convert_items(I, scr, lane, gw7, NGW7); }
        }
        for (int m = gw; m < NTOK; m += NGW) norm_row(x_in + (size_t)m * DM, ka->in[1], Hb + (size_t)m * DM, lane);
    }
    SEAM(0);

    layer_body<0>(bar, lds, LC, G0, bx0, vcu0, lo, hi, ts0, ts1);
    layer_body<1>(bar, lds, LC, G0, bx0, vcu0, lo, hi, ts0, ts1);
    if (PROBE_A >= 0 && blockIdx.x == 0) { const unsigned long long d = (ts1 - ts0) * 4ull, t0 = __builtin_amdgcn_s_memrealtime(); while (__builtin_amdgcn_s_memrealtime() - t0 < d) __builtin_amdgcn_s_sleep(8); }
#undef IN
#undef SEAM
}

extern "C" void kernel_launch(void* const* d_in, const int* in_sizes, int n_in, void* d_out, int out_size, void* d_ws, size_t ws_size, hipStream_t stream) {
    (void)in_sizes; (void)out_size;
    static int grid = 0;
    if (grid == 0) {
        int dev = 0, cus = 0;
        if (hipGetDevice(&dev) != hipSuccess || hipDeviceGetAttribute(&cus, hipDeviceAttributeMultiprocessorCount, dev) != hipSuccess) { grid = -1; return; }
        if (hipFuncSetAttribute((const void*)fwd_kernel, hipFuncAttributeMaxDynamicSharedMemorySize, LDS_BYTES) != hipSuccess) { grid = -1; return; }
        int per_cu = 0;
        (void)hipOccupancyMaxActiveBlocksPerMultiprocessor(&per_cu, (const void*)fwd_kernel, NTHREADS, LDS_BYTES);
        (void)hipGetLastError();
        grid = cus;
        if (n_in != 18 || ws_size < WS_NEED) { fprintf(stderr, "kernel_launch: unexpected inputs (n_in %d, ws %zu)\n", n_in, ws_size); grid = -1; return; }
    }
    if (grid < 0) return;
    (void)hipMemsetAsync((char*)d_ws + OFF_CTRL, 0, CTRL_BYTES, stream);
    Args a{};
    for (int i = 0; i < 18; ++i) a.in[i] = (const float*)d_in[i];
    a.out = (float*)d_out; a.ws = (unsigned char*)d_ws;
    constexpr int NPH = 1 + 9 * DEPTH;
    if (MK_N_LAUNCHES == 1) { a.ph_lo = 0; a.ph_hi = NPH; hipLaunchKernelGGL(fwd_kernel, dim3(grid), dim3(NTHREADS), LDS_BYTES, stream, a); }
    else { for (int p = 0; p < NPH; ++p) { a.ph_lo = p; a.ph_hi = p + 1; hipLaunchKernelGGL(fwd_kernel, dim3(grid), dim3(NTHREADS), LDS_BYTES, stream, a); } }
}
```

```cpp
#include <hip/hip_runtime.h>
#include <stdint.h>
#include <stdio.h>

#define LAS __attribute__((address_space(3)))
typedef unsigned short bf16_t;
typedef short bf16x8 __attribute__((ext_vector_type(8)));
typedef float f32x2 __attribute__((ext_vector_type(2)));
typedef float f32x4 __attribute__((ext_vector_type(4)));
typedef float f32x16 __attribute__((ext_vector_type(16)));
typedef unsigned u32x2 __attribute__((ext_vector_type(2)));
typedef unsigned u32x4 __attribute__((ext_vector_type(4)));
typedef __bf16 bfv2 __attribute__((ext_vector_type(2)));
typedef int i32x8 __attribute__((ext_vector_type(8)));
constexpr float W8_SCALE = 32.f, A8_SCALE = 8.f;

#ifndef MOE_FP8
#define MOE_FP8 1
#endif
#ifndef MK_N_LAUNCHES
#define MK_N_LAUNCHES 1
#endif

constexpr int DM = 1024, SEQ = 4096, NTOK = 16384, DEPTH = 2;
constexpr int HD = 64, AW = 512, PW = 512, INW = 4096;
constexpr int NEXP = 32, EH = 512, ECAP = NTOK;
constexpr float RMS_EPS = 1e-6f;
constexpr int NTHREADS = 512, NWAVES = 8;

constexpr size_t MB = 1024 * 1024;
constexpr size_t OFF_CTRL = 0, CTRL_BYTES = 65536;
constexpr size_t OFF_WIN  = 1 * MB;
constexpr size_t OFF_WA   = OFF_WIN + 16 * MB;
constexpr size_t OFF_WPP  = OFF_WA + 2 * MB;
constexpr size_t OFF_WO   = OFF_WPP + 2 * MB;
constexpr size_t OFF_WGU  = OFF_WO + 4 * MB;
constexpr size_t OFF_WD   = OFF_WGU + 64 * MB;
constexpr size_t OFF_H    = OFF_WD + 32 * MB;
constexpr size_t OFF_PROJ = OFF_H + 32 * MB;
constexpr size_t OFF_ACT  = OFF_PROJ;
constexpr size_t OFF_YB   = OFF_PROJ + 40 * MB;
constexpr size_t OFF_AC   = OFF_PROJ + 128 * MB;
constexpr size_t OFF_PL   = OFF_AC + 16 * MB;
constexpr size_t OFF_OG   = OFF_PL + 16 * MB;
constexpr size_t OFF_T1   = OFF_OG;
constexpr size_t OFF_ML   = OFF_OG + 48 * MB;
constexpr size_t OFF_XB   = OFF_ML + 4 * MB;
constexpr size_t OFF_TOKE = OFF_XB + 64 * MB;
constexpr size_t OFF_TOKW = OFF_TOKE + 2 * MB;
constexpr size_t OFF_ASG  = OFF_TOKW + 2 * MB;
constexpr size_t OFF_WRH  = OFF_ASG + 1 * MB;
constexpr size_t OFF_WRL  = OFF_WRH + 256 * 1024;
constexpr size_t WS_NEED  = OFF_WRL + 256 * 1024;
constexpr int CW_CNT = 1024;
constexpr int CW_BAR = 8192;
constexpr int RING_BYTES = 131072, LCTL_OFF = RING_BYTES, LDS_BYTES = RING_BYTES + 2048;
constexpr int LI_BAR = 0, LI_TB = 16, LI_PS = 64, LI_CN = 112, LI_NT = 15, LI_ORD = 144;

__device__ __forceinline__ float bflo(unsigned w) { return __uint_as_float(w << 16); }
__device__ __forceinline__ float bfhi(unsigned w) { return __uint_as_float(w & 0xffff0000u); }
__device__ __forceinline__ void unpack8(const u32x4 v, float (&f)[8]) { f[0] = bflo(v.x); f[1] = bfhi(v.x); f[2] = bflo(v.y); f[3] = bfhi(v.y); f[4] = bflo(v.z); f[5] = bfhi(v.z); f[6] = bflo(v.w); f[7] = bfhi(v.w); }
__device__ __forceinline__ unsigned pack2(float lo, float hi) { f32x2 v = {lo, hi}; return __builtin_bit_cast(unsigned, __builtin_convertvector(v, bfv2)); }
__device__ __forceinline__ unsigned pack4_fp8(float a, float b, float c, float d) { unsigned w = 0u; w = __builtin_amdgcn_cvt_pk_fp8_f32(a, b, w, false); w = __builtin_amdgcn_cvt_pk_fp8_f32(c, d, w, true); return w; }
__device__ __forceinline__ bf16_t f2bf(float f) { return (bf16_t)(pack2(f, 0.f) & 0xffffu); }
__device__ __forceinline__ float wave_sum(float v) {
#pragma unroll
    for (int o = 32; o >= 1; o >>= 1) v += __shfl_xor(v, o);
    return v;
}
__device__ __forceinline__ int opaque_tid() { int t = (int)threadIdx.x; asm volatile("" : "+v"(t)); return t; }
__device__ __forceinline__ int opaque_s(int v) { asm volatile("" : "+s"(v)); return v; }
__device__ __forceinline__ float sigmoidf_(float v) { return 1.0f / (1.0f + __expf(-v)); }

#define XB_TMO      128
#define XB_XCNT(j)  (256  + 64 * (j))
#define XB_XSUB(j)  (1280 + 64 * (j))
#define XB_XGEN(j)  (2304 + 64 * (j))
#define XB_TOP      3328
#define XB_TOPGEN   3392
#define XCD_BAR_WORDS 3456
#define XB_SPIN_CAP (1u << 18)
__device__ __forceinline__ unsigned xb_ld(unsigned* p)              { return __hip_atomic_load(p, __ATOMIC_RELAXED, __HIP_MEMORY_SCOPE_AGENT); }
__device__ __forceinline__ unsigned xb_add(unsigned* p, unsigned v) { return __hip_atomic_fetch_add(p, v, __ATOMIC_RELAXED, __HIP_MEMORY_SCOPE_AGENT); }
__device__ __forceinline__ unsigned xb_xcc_id() { return (unsigned)__builtin_amdgcn_s_getreg((3 << 11) | 20) & 0xFu; }
#define XB_SPIN(cond, bar) do { unsigned _sp = 0; while (cond) { __builtin_amdgcn_s_sleep(1); \
    if ((++_sp & 255u) == 0u) { if (xb_ld(&(bar)[XB_TMO])) break; if (_sp > XB_SPIN_CAP) { atomicAdd(&(bar)[XB_TMO], 1u); break; } } } } while (0)
struct XcdBarrier { unsigned* bar; unsigned x; volatile LAS unsigned* st; };
__device__ __forceinline__ XcdBarrier xcd_barrier_post(unsigned* bar, volatile LAS unsigned* st) {
    XcdBarrier b; b.bar = bar; b.x = xb_xcc_id(); b.st = st;
    if (threadIdx.x == 0) (void)xb_add(&bar[XB_XCNT(b.x)], 1u);
    return b;
}
__device__ __forceinline__ void xcd_barrier_complete(unsigned* bar, unsigned x, unsigned& nloc, unsigned& nx) {
    const unsigned G = gridDim.x * gridDim.y * gridDim.z;
    unsigned sum, cnt, mine, sp = 0u;
    for (;;) {
        sum = 0u; cnt = 0u; mine = 0u;
#pragma unroll
        for (unsigned j = 0; j < 16; ++j) { const unsigned c = xb_ld(&bar[XB_XCNT(j)]); sum += c; cnt += (c > 0u) ? 1u : 0u; mine = (j == x) ? c : mine; }
        if (sum == G) break;
        __builtin_amdgcn_s_sleep(1);
        if ((++sp & 255u) == 0u) { if (xb_ld(&bar[XB_TMO])) break; if (sp > XB_SPIN_CAP) { atomicAdd(&bar[XB_TMO], 1u); break; } }
    }
    nloc = mine > 0u ? mine : 1u; nx = cnt > 0u ? cnt : 1u;
}
__device__ __forceinline__ void xcd_barrier(const XcdBarrier& b) {
    asm volatile("s_waitcnt vmcnt(0)" ::: "memory");
    __syncthreads();
    if (threadIdx.x == 0) {
        unsigned* bar = b.bar;
        __builtin_amdgcn_s_waitcnt(0);
        unsigned nloc = b.st[0], nx = b.st[1];
        if (nloc == 0u) { xcd_barrier_complete(bar, b.x, nloc, nx); b.st[0] = nloc; b.st[1] = nx; }
        const unsigned old = xb_add(&bar[XB_XSUB(b.x)], 1u);
        const unsigned gen = old / nloc;
        if (old + 1u == (gen + 1u) * nloc) {
            __builtin_amdgcn_fence(__ATOMIC_RELEASE, "agent");
            asm volatile("s_waitcnt vmcnt(0)" ::: "memory");
            const unsigned og = xb_add(&bar[XB_TOP], 1u);
            const unsigned tg = og / nx;
            if (og + 1u == (tg + 1u) * nx) xb_add(&bar[XB_TOPGEN], 1u);
            else XB_SPIN(xb_ld(&bar[XB_TOPGEN]) == tg, bar);
            __builtin_amdgcn_fence(__ATOMIC_ACQUIRE, "agent");
            xb_add(&bar[XB_XGEN(b.x)], 1u);
            asm volatile("s_waitcnt vmcnt(0)" ::: "memory");
        } else {
            XB_SPIN(xb_ld(&bar[XB_XGEN(b.x)]) == gen, bar);
            __builtin_amdgcn_fence(__ATOMIC_ACQUIRE, "agent");
            asm volatile("s_waitcnt vmcnt(0)" ::: "memory");
        }
    }
    __syncthreads();
}

namespace pg8 {
constexpr int BM = 256, BK = 64, HALF = 128, HTB = HALF * BK * 2, NXCD = 8, WGM = 8;
__device__ __forceinline__ int lds_byte(int r, int c) { const int st = (r >> 4) * 2 + (c >> 5), rr = r & 15, cc = c & 31, ob = rr * 64 + cc * 2; return st * 1024 + (ob ^ (((ob >> 9) & 1) << 5)); }
__device__ __forceinline__ void stage_rc(int b, int& R, int& C) { const int st = b / 1024, sb = b % 1024, swz = sb ^ (((sb >> 9) & 1) << 5); R = (st >> 1) * 16 + swz / 64; C = (st & 1) * 32 + (swz % 64) / 2; }
__device__ __forceinline__ int perm32(int rho) { const int n = rho >> 4, i = rho & 15; return 8 * (i >> 2) + 4 * n + (i & 3); }

struct Unit { const char* A; const char* B; int row0, col0, e, nvalid, j0; };

struct DenseOrder {
    const char* A; const char* Bt; int KB, nM, nN, nwg, G, c;
    __device__ __forceinline__ void init(const void* A_, const void* Bt_, int M, int N, int KB_, int G_, int c_) { A = (const char*)A_; Bt = (const char*)Bt_; KB = KB_; nM = M / BM; nN = N / BM; nwg = nM * nN; G = G_; c = c_; }
    __device__ __forceinline__ bool next(int i, Unit& u) const {
        const long L = (long)i * G + c; if (L >= nwg) return false;
        int wgid = (int)L; { const int q = nwg / NXCD, r = nwg % NXCD, xcd = wgid % NXCD, off = wgid / NXCD; wgid = (xcd < r ? xcd * (q + 1) : r * (q + 1) + (xcd - r) * q) + off; }
        const int nig = WGM * nN, gid = wgid / nig, fm = gid * WGM, gsz = (nM - fm) < WGM ? (nM - fm) : WGM;
        const int pm = fm + ((wgid % nig) % gsz), pn = (wgid % nig) / gsz;
        u.A = A + (size_t)pm * BM * KB; u.B = Bt + (size_t)pn * BM * KB; u.row0 = pm * BM; u.col0 = pn * BM; u.e = 0; u.nvalid = BM; u.j0 = 0; return true;
    }
    __device__ __forceinline__ unsigned row_off(const Unit&, int) const { return 0u; }
};
struct MoeOrder {
    const char* A; const char* Bt; size_t bExp; int KB; const LAS int* tb; const LAS int* ps; const LAS int* cn; const LAS int* ord; const int* tokE; int G, c; bool gather;
    __device__ __forceinline__ bool next(int i, Unit& u) const {
        const int L = i * G + c, total = tb[NEXP] * 4; if (L >= total) return false;
        const int rt = L >> 2, pn = L & 3;
        const int ej = __builtin_amdgcn_readfirstlane(ord[rt]);
        const int e = ej >> 8, j = ej & 255;
        const int pse = __builtin_amdgcn_readfirstlane(ps[e]), cne = __builtin_amdgcn_readfirstlane(cn[e]);
        u.e = e; u.row0 = pse + BM * j; u.col0 = pn * BM; u.nvalid = min(BM, cne - BM * j); u.j0 = e * ECAP + BM * j;
        u.B = Bt + (size_t)e * bExp + (size_t)pn * BM * KB;
        u.A = gather ? A : A + (size_t)u.row0 * KB;
        return true;
    }
    __device__ __forceinline__ unsigned row_off(const Unit& u, int R) const { const int t = R < u.nvalid ? tokE[u.j0 + R] : 0; return (unsigned)t * (unsigned)KB; }
};

template <class Epi, class Sched, int BMODE, bool GATHER, bool LIGHT = false, bool F8 = false, bool MIDK = false>
__device__ __forceinline__ void gemm_phase(LAS unsigned char* lds, const int KB, const Sched& S, const Epi& E) {
    const int tid = opaque_tid(), wid = __builtin_amdgcn_readfirstlane(tid >> 6), lane = tid & 63, wr = wid >> 2, wc = wid & 3, fr = lane & 15, fq = lane >> 4;
    const int nt = KB / (BK * 2);
    unsigned voffA[2][2], voffAn[2][2], voffB[2]; int RA[2], CA[2];
#pragma unroll
    for (int i = 0; i < 2; ++i) { int R, C; stage_rc(tid * 16 + i * 8192, R, C); RA[i] = R; CA[i] = C;
        const int Rb = (BMODE == 1) ? (64 * (R >> 5) + perm32(R & 31)) : (Epi::PERM ? ((R & ~31) + perm32(R & 31)) : R);
        voffB[i] = (unsigned)(Rb * KB + C * 2);
#pragma unroll
        for (int h = 0; h < 2; ++h) { voffA[h][i] = (unsigned)((h * HALF + R) * KB + C * 2); voffAn[h][i] = voffA[h][i]; } }
    const size_t kstep = (size_t)(BK * 2);
    const size_t hstepB = (size_t)((BMODE == 1) ? 32 : HALF) * KB;
    const unsigned ldsw = (unsigned)wid * 1024u;
    const int aoff = lds_byte(wr * 64 + fr, fq * 8), boff = lds_byte(wc * 32 + fr, fq * 8);
#define PG8_SA(b, h) (((b) * 2 + (h)) * HTB)
#define PG8_SB(b, h) ((4 + (b) * 2 + (h)) * HTB)
#define PG8_STAGE2(bufoff, gbase, v0, v1) do { \
        __builtin_amdgcn_global_load_lds((const unsigned*)((const char*)(gbase) + (v0)), (LAS unsigned*)(lds + (bufoff) + ldsw), 16, 0, 0); \
        __builtin_amdgcn_global_load_lds((const unsigned*)((const char*)(gbase) + (v1)), (LAS unsigned*)(lds + (bufoff) + ldsw + 8192), 16, 0, 0); } while (0)
#define PG8_STAGEB(bufoff, gbase) PG8_STAGE2(bufoff, gbase, voffB[0], voffB[1])
#define PG8_STAGEA(bufoff, gbase, h, nx) PG8_STAGE2(bufoff, gbase, ((GATHER && (nx)) ? voffAn[h][0] : voffA[h][0]), ((GATHER && (nx)) ? voffAn[h][1] : voffA[h][1]))
#define PG8_LD32(p) __builtin_bit_cast(i32x8, __builtin_shufflevector(*(const LAS u32x4*)(p), *(const LAS u32x4*)((p) + 1024), 0, 1, 2, 3, 4, 5, 6, 7))
#define PG8_LDA(dst, b, h) do { _Pragma("unroll") for (int m = 0; m < 4; ++m) { if constexpr (F8) dst##8[m] = PG8_LD32(lds + PG8_SA(b, h) + aoff + m * 2048); \
        else { _Pragma("unroll") for (int k = 0; k < 2; ++k) dst[m][k] = *(const LAS bf16x8*)(lds + PG8_SA(b, h) + aoff + m * 2048 + k * 1024); } } } while (0)
#define PG8_LDB(dst, b, h) do { _Pragma("unroll") for (int n = 0; n < 2; ++n) { if constexpr (F8) dst##8[n] = PG8_LD32(lds + PG8_SB(b, h) + boff + n * 2048); \
        else { _Pragma("unroll") for (int k = 0; k < 2; ++k) dst[n][k] = *(const LAS bf16x8*)(lds + PG8_SB(b, h) + boff + n * 2048 + k * 1024); } } } while (0)
#define PG8_MMA(ai, bj, At, Bt) do { __builtin_amdgcn_s_setprio(1); _Pragma("unroll") for (int m = 0; m < 4; ++m) _Pragma("unroll") for (int n = 0; n < 2; ++n) { \
        if constexpr (F8) asm volatile("v_mfma_scale_f32_16x16x128_f8f6f4 %0, %1, %2, %0, %3, %3 op_sel_hi:[0,0,0]" : "+v"(acc[ai][bj][m][n]) : "v"(Bt##8[n]), "v"(At##8[m]), "v"(sc8));   \
        else { _Pragma("unroll") for (int k = 0; k < 2; ++k) acc[ai][bj][m][n] = __builtin_amdgcn_mfma_f32_16x16x32_bf16(Bt[n][k], At[m][k], acc[ai][bj][m][n], 0, 0, 0); } } \
        __builtin_amdgcn_s_setprio(0); } while (0)
#define PG8_WAIT_V(n) asm volatile("s_waitcnt vmcnt(" #n ")" ::: "memory")
#define PG8_WAIT_L(n) asm volatile("s_waitcnt lgkmcnt(" #n ")" ::: "memory")
#define PG8_BAR __builtin_amdgcn_s_barrier()
#define PG8_SCHED __builtin_amdgcn_sched_barrier(0)
    Unit cur, nxt; int ui = 0;
    if (!S.next(0, cur)) return;
    if (GATHER) {
#pragma unroll
        for (int h = 0; h < 2; ++h)
#pragma unroll
            for (int i = 0; i < 2; ++i) voffA[h][i] = S.row_off(cur, h * HALF + RA[i]) + (unsigned)CA[i] * 2u;
    }
    f32x4 acc[2][2][4][2];
#pragma unroll
    for (int a = 0; a < 2; ++a)
#pragma unroll
        for (int b = 0; b < 2; ++b)
#pragma unroll
            for (int m = 0; m < 4; ++m)
#pragma unroll
                for (int n = 0; n < 2; ++n) acc[a][b][m][n] = (f32x4){0.f, 0.f, 0.f, 0.f};
    unsigned sc8 = 0x7f7f7f7fu; asm volatile("" : "+v"(sc8));
    bf16x8 At[4][2], B0[2][2], B1[2][2]; i32x8 At8[4], B08[2], B18[2];
    const char* cA = cur.A; const char* cB = cur.B;
    PG8_STAGEB(PG8_SB(0, 0), cB); PG8_STAGEB(PG8_SB(0, 1), cB + hstepB); PG8_STAGEA(PG8_SA(0, 0), cA, 0, false); PG8_STAGEA(PG8_SA(0, 1), cA, 1, false);
    if (wr == 1) PG8_BAR;
    PG8_WAIT_V(2); PG8_BAR;
    PG8_STAGEB(PG8_SB(1, 0), cB + kstep); PG8_STAGEA(PG8_SA(1, 0), cA + kstep, 0, false); PG8_STAGEB(PG8_SB(1, 1), cB + hstepB + kstep);
    PG8_WAIT_V(6); PG8_BAR;
    for (;;) {
        const bool has_next = S.next(ui + 1, nxt);
        if (GATHER) {
#pragma unroll
            for (int h = 0; h < 2; ++h)
#pragma unroll
                for (int i = 0; i < 2; ++i) voffAn[h][i] = has_next ? (S.row_off(nxt, h * HALF + RA[i]) + (unsigned)CA[i] * 2u) : voffA[h][i];
        }
        const char* nA = has_next ? nxt.A : cA; const char* nB = has_next ? nxt.B : cB;
        const bool full = cur.nvalid > HALF;
        for (int t = 0; t < nt; t += 2) {
            if constexpr (MIDK) { if (t == nt / 2) { PG8_SCHED; E.mid(acc, cur, wr, wc, fr, fq); PG8_SCHED; } }
            const bool last = (t == nt - 2);
            const char* a1 = cA + (size_t)(t + 1) * kstep;
            const char* a2 = last ? nA : cA + (size_t)(t + 2) * kstep; const char* b2 = last ? nB : cB + (size_t)(t + 2) * kstep;
            const char* a3 = a2 + kstep; const char* b3 = b2 + kstep;
            PG8_LDB(B0, 0, 0); PG8_LDB(B1, 0, 1); PG8_SCHED; PG8_LDA(At, 0, 0); PG8_STAGEA(PG8_SA(1, 1), a1, 1, false);
            PG8_WAIT_V(8); PG8_WAIT_L(0); PG8_BAR; PG8_MMA(0, 0, At, B0); PG8_MMA(0, 1, At, B1); PG8_BAR; PG8_SCHED;
            PG8_LDA(At, 0, 1); PG8_STAGEB(PG8_SB(0, 0), b2); PG8_STAGEB(PG8_SB(0, 1), b2 + hstepB); PG8_STAGEA(PG8_SA(0, 0), a2, 0, last);
            PG8_WAIT_V(8); PG8_WAIT_L(0); PG8_BAR; if (!LIGHT || full) { PG8_MMA(1, 0, At, B0); PG8_MMA(1, 1, At, B1); } PG8_BAR; PG8_SCHED;
            PG8_LDB(B0, 1, 0); PG8_LDB(B1, 1, 1); PG8_SCHED; PG8_LDA(At, 1, 0); PG8_STAGEA(PG8_SA(0, 1), a2, 1, last);
            PG8_WAIT_V(8); PG8_WAIT_L(0); PG8_BAR; PG8_MMA(0, 0, At, B0); PG8_MMA(0, 1, At, B1); PG8_BAR; PG8_SCHED;
            PG8_LDA(At, 1, 1); PG8_STAGEB(PG8_SB(1, 0), b3); PG8_STAGEB(PG8_SB(1, 1), b3 + hstepB); PG8_STAGEA(PG8_SA(1, 0), a3, 0, last);
            PG8_WAIT_V(8); PG8_WAIT_L(0); PG8_BAR; if (!LIGHT || full) { PG8_MMA(1, 0, At, B0); PG8_MMA(1, 1, At, B1); } PG8_BAR; PG8_SCHED;
        }
        if (wr == 0) PG8_BAR;
        if constexpr (F8) asm volatile("s_nop 7\n\ts_nop 7\n\ts_nop 7" ::: "memory");
        E(acc, cur, wr, wc, fr, fq);
        if (!has_next) break;
#pragma unroll
        for (int a = 0; a < 2; ++a)
#pragma unroll
            for (int b = 0; b < 2; ++b)
#pragma unroll
                for (int m = 0; m < 4; ++m)
#pragma unroll
                    for (int n = 0; n < 2; ++n) acc[a][b][m][n] = (f32x4){0.f, 0.f, 0.f, 0.f};
        cur = nxt; cA = nA; cB = nB; ++ui;
        if (GATHER) {
#pragma unroll
            for (int h = 0; h < 2; ++h)
#pragma unroll
                for (int i = 0; i < 2; ++i) voffA[h][i] = voffAn[h][i];
        }
        if (wr == 1) PG8_BAR;
    }
    PG8_WAIT_V(0);
    PG8_BAR;
#undef PG8_SA
#undef PG8_SB
#undef PG8_STAGE2
#undef PG8_STAGEA
#undef PG8_STAGEB
#undef PG8_LDA
#undef PG8_LDB
#undef PG8_MMA
#undef PG8_LD32
#undef PG8_WAIT_V
#undef PG8_WAIT_L
#undef PG8_BAR
#undef PG8_SCHED
}

struct EpiProj {
    static constexpr bool PERM = true;
    bf16_t* out; const float* gq; const float* gk;
    __device__ __forceinline__ void operator()(const f32x4 (&acc)[2][2][4][2], const Unit& u, int wr, int wc, int fr, int fq) const {
        const int pn = u.col0 >> 8;
        const int row0 = u.row0 + wr * 64 + fr, colb = u.col0 + 64 * wc + 8 * fq;
        if (pn < 4) {
            const float* g = (pn < 2) ? gq : gk; const float post = (pn < 2) ? 0.125f : 1.0f;
            f32x4 gv[2][2];
#pragma unroll
            for (int bj = 0; bj < 2; ++bj)
#pragma unroll
                for (int n = 0; n < 2; ++n) gv[bj][n] = *(const f32x4*)(g + 32 * bj + 8 * fq + 4 * n) * post;
#pragma unroll
            for (int ai = 0; ai < 2; ++ai)
#pragma unroll
                for (int m = 0; m < 4; ++m) {
                    float ss = 0.f;
#pragma unroll
                    for (int bj = 0; bj < 2; ++bj)
#pragma unroll
                        for (int n = 0; n < 2; ++n) { const f32x4 x = acc[ai][bj][m][n]; ss += (x[0] * x[0] + x[1] * x[1]) + (x[2] * x[2] + x[3] * x[3]); }
                    ss += __shfl_xor(ss, 16); ss += __shfl_xor(ss, 32);
                    const float rstd = rsqrtf(ss * (1.0f / HD) + RMS_EPS);
                    bf16_t* rowp = out + (size_t)(row0 + ai * HALF + m * 16) * INW + colb;
#pragma unroll
                    for (int bj = 0; bj < 2; ++bj) { const f32x4 v0 = acc[ai][bj][m][0] * rstd * gv[bj][0], v1 = acc[ai][bj][m][1] * rstd * gv[bj][1];
                        u32x4 w; w.x = pack2(v0[0], v0[1]); w.y = pack2(v0[2], v0[3]); w.z = pack2(v1[0], v1[1]); w.w = pack2(v1[2], v1[3]);
                        *(u32x4*)(rowp + 32 * bj) = w; }
                }
        } else {
            const bool sg = pn >= 8;
#pragma unroll
            for (int ai = 0; ai < 2; ++ai)
#pragma unroll
                for (int m = 0; m < 4; ++m) {
                    const size_t rr = (size_t)(row0 + ai * HALF + m * 16);
#pragma unroll
                    for (int bj = 0; bj < 2; ++bj) { const f32x4 v0 = acc[ai][bj][m][0], v1 = acc[ai][bj][m][1];
                        if (sg) {
                            unsigned q[8];
#pragma unroll
                            for (int j = 0; j < 4; ++j) { q[j] = (unsigned)fmaxf(sigmoidf_(v0[j]) * 255.0f + 0.5f, 1.0f); q[4 + j] = (unsigned)fmaxf(sigmoidf_(v1[j]) * 255.0f + 0.5f, 1.0f); }
                            u32x2 w; w.x = q[0] | (q[1] << 8) | (q[2] << 16) | (q[3] << 24); w.y = q[4] | (q[5] << 8) | (q[6] << 16) | (q[7] << 24);
                            *(u32x2*)((unsigned char*)(out + rr * INW) + 4096 + (colb - 2048) + 32 * bj) = w;
                        } else {
                            u32x4 w; w.x = pack2(v0[0], v0[1]); w.y = pack2(v0[2], v0[3]); w.z = pack2(v1[0], v1[1]); w.w = pack2(v1[2], v1[3]);
                            *(u32x4*)(out + rr * INW + colb + 32 * bj) = w; }
                    }
                }
        }
    }
};
__device__ __forceinline__ void unpack_u8x8(const u32x2 w, float (&f)[8]) {
    f[0] = (float)(w.x & 255u); f[1] = (float)((w.x >> 8) & 255u); f[2] = (float)((w.x >> 16) & 255u); f[3] = (float)(w.x >> 24);
    f[4] = (float)(w.y & 255u); f[5] = (float)((w.y >> 8) & 255u); f[6] = (float)((w.y >> 16) & 255u); f[7] = (float)(w.y >> 24);
}
struct EpiGateMerge {
    static constexpr bool PERM = true;
    const bf16_t* proj; bf16_t* out;
    __device__ __forceinline__ void mid(f32x4 (&acc)[2][2][4][2], const Unit& u, int wr, int wc, int fr, int fq) const {
        asm volatile("" : "+v"(fr), "+v"(fq));
        const int row0 = u.row0 + wr * 64 + fr, col0 = u.col0 + wc * 32 + 8 * fq;
#pragma unroll
        for (int ai = 0; ai < 2; ++ai)
#pragma unroll
            for (int m = 0; m < 4; ++m) {
                const unsigned char* gr = (const unsigned char*)(proj + (size_t)(row0 + ai * HALF + m * 16) * INW) + 4096 + col0;
#pragma unroll
                for (int bj = 0; bj < 2; ++bj) {
                    const u32x2 ga = *(const u32x2*)(gr + bj * HALF), gp = *(const u32x2*)(gr + 1024 + bj * HALF);
                    float fa[8], fp[8]; unpack_u8x8(ga, fa); unpack_u8x8(gp, fp);
#pragma unroll
                    for (int j = 0; j < 4; ++j) { acc[ai][bj][m][0][j] *= fa[j] * __builtin_amdgcn_rcpf(fp[j]); acc[ai][bj][m][1][j] *= fa[4 + j] * __builtin_amdgcn_rcpf(fp[4 + j]); }
                }
                if (m & 1) asm volatile("" ::: "memory");
            }
    }
    __device__ __forceinline__ void operator()(const f32x4 (&acc)[2][2][4][2], const Unit& u, int wr, int wc, int fr, int fq) const {
        const int row0 = u.row0 + wr * 64 + fr, col0 = u.col0 + wc * 32 + 8 * fq;
#pragma unroll
        for (int ai = 0; ai < 2; ++ai)
#pragma unroll
            for (int m = 0; m < 4; ++m) {
                const size_t r = (size_t)(row0 + ai * HALF + m * 16);
                const unsigned char* gr = (const unsigned char*)(proj + r * INW) + 4096 + 1024 + col0;
#pragma unroll
                for (int bj = 0; bj < 2; ++bj) {
                    const u32x2 gp = *(const u32x2*)(gr + bj * HALF);
                    float fp[8]; unpack_u8x8(gp, fp);
                    const f32x4 a0 = acc[ai][bj][m][0] * (1.0f / 255.0f), a1 = acc[ai][bj][m][1] * (1.0f / 255.0f);
                    u32x4 w; w.x = pack2(a0[0] * fp[0], a0[1] * fp[1]); w.y = pack2(a0[2] * fp[2], a0[3] * fp[3]); w.z = pack2(a1[0] * fp[4], a1[1] * fp[5]); w.w = pack2(a1[2] * fp[6], a1[3] * fp[7]);
                    *(u32x4*)(out + r * DM + bj * HALF + col0) = w;
                }
            }
    }
};
template <bool XF32> struct EpiResid {
    static constexpr bool PERM = true;
    const float* xf; bf16_t* xb;
    __device__ __forceinline__ void operator()(const f32x4 (&acc)[2][2][4][2], const Unit& u, int wr, int wc, int fr, int fq) const {
        const int row0 = u.row0 + wr * 64 + fr, col0 = u.col0 + wc * 32 + 8 * fq;
#pragma unroll
        for (int ai = 0; ai < 2; ++ai)
#pragma unroll
            for (int m = 0; m < 4; ++m) { const size_t off = (size_t)(row0 + ai * HALF + m * 16) * DM + col0;
#pragma unroll
                for (int bj = 0; bj < 2; ++bj) {
                    float x[8];
                    if (XF32) { const f32x4 a = *(const f32x4*)(xf + off + bj * HALF), b = *(const f32x4*)(xf + off + bj * HALF + 4);
                        x[0] = a[0]; x[1] = a[1]; x[2] = a[2]; x[3] = a[3]; x[4] = b[0]; x[5] = b[1]; x[6] = b[2]; x[7] = b[3]; }
                    else { const u32x4 t = *(const u32x4*)(xb + off + bj * HALF);
                        x[0] = bflo(t.x); x[1] = bfhi(t.x); x[2] = bflo(t.y); x[3] = bfhi(t.y); x[4] = bflo(t.z); x[5] = bfhi(t.z); x[6] = bflo(t.w); x[7] = bfhi(t.w); }
                    const f32x4 a0 = acc[ai][bj][m][0], a1 = acc[ai][bj][m][1];
                    u32x4 w; w.x = pack2(x[0] + a0[0], x[1] + a0[1]); w.y = pack2(x[2] + a0[2], x[3] + a0[3]); w.z = pack2(x[4] + a1[0], x[5] + a1[1]); w.w = pack2(x[6] + a1[2], x[7] + a1[3]);
                    *(u32x4*)(xb + off + bj * HALF) = w;
                }
            }
    }
};
template <bool F8> struct EpiSwiGLU {
    static constexpr bool PERM = true;
    void* act;
    __device__ __forceinline__ void operator()(const f32x4 (&acc)[2][2][4][2], const Unit& u, int wr, int wc, int fr, int fq) const {
        const int row0 = u.row0 + wr * 64 + fr, col0 = (u.col0 >> 1) + wc * 32 + 8 * fq;
        const float si = F8 ? (1.0f / W8_SCALE) : 1.0f, so = F8 ? A8_SCALE : 1.0f;
#pragma unroll
        for (int ai = 0; ai < 2; ++ai)
#pragma unroll
            for (int m = 0; m < 4; ++m) {
                float o[8];
#pragma unroll
                for (int n = 0; n < 2; ++n)
#pragma unroll
                    for (int j = 0; j < 4; ++j) { const float a = acc[ai][0][m][n][j] * si, b = acc[ai][1][m][n][j] * (si * so); o[4 * n + j] = a * sigmoidf_(a) * b; }
                const size_t off = (size_t)(row0 + ai * HALF + m * 16) * EH + col0;
                if (F8) { u32x2 w; w.x = pack4_fp8(o[0], o[1], o[2], o[3]); w.y = pack4_fp8(o[4], o[5], o[6], o[7]); *(u32x2*)((unsigned char*)act + off) = w; }
                else { u32x4 w; w.x = pack2(o[0], o[1]); w.y = pack2(o[2], o[3]); w.z = pack2(o[4], o[5]); w.w = pack2(o[6], o[7]); *(u32x4*)((bf16_t*)act + off) = w; }
            }
    }
};
template <bool F8> struct EpiDown {
    static constexpr bool PERM = true;
    bf16_t* yb; const float* tokW;
    __device__ __forceinline__ void operator()(const f32x4 (&acc)[2][2][4][2], const Unit& u, int wr, int wc, int fr, int fq) const {
        const int col0 = u.col0 + wc * 32 + 8 * fq;
        const float si = F8 ? (1.0f / (W8_SCALE * A8_SCALE)) : 1.0f;
#pragma unroll
        for (int ai = 0; ai < 2; ++ai)
#pragma unroll
            for (int m = 0; m < 4; ++m) {
                const int rl = wr * 64 + fr + ai * HALF + m * 16;
                const float w = rl < u.nvalid ? tokW[u.j0 + rl] * si : 0.f;
#pragma unroll
                for (int bj = 0; bj < 2; ++bj) { const f32x4 v0 = acc[ai][bj][m][0] * w, v1 = acc[ai][bj][m][1] * w;
                    u32x4 o; o.x = pack2(v0[0], v0[1]); o.y = pack2(v0[2], v0[3]); o.z = pack2(v1[0], v1[1]); o.w = pack2(v1[2], v1[3]);
                    *(u32x4*)(yb + (size_t)(u.row0 + rl) * DM + col0 + bj * HALF) = o; }
            }
    }
};
}

constexpr int ATT_K_OFF = 0, ATT_V_OFF = 49152;
__device__ __forceinline__ unsigned kv_off(unsigned row, unsigned ch) { return row * 128u + 16u * (ch ^ (((row >> 1) & 7u) ^ ((row & 2u) << 1))); }

struct AttnU { int tok0, d, blk, g, h; };
__device__ __forceinline__ AttnU attn_decode(int uidx) {
    const int bh = uidx / 48, r48 = uidx % 48, g = r48 >> 4, rr = r48 & 15;
    AttnU U; U.g = g; U.h = bh & 7;
    U.d = (g == 0) ? 1 : (g == 1 ? 4 : 16);
    const int c = (g == 0) ? 0 : (g == 1 ? (rr >> 2) : rr);
    U.blk = (g == 0) ? rr : (g == 1 ? (rr & 3) : 0);
    U.tok0 = (bh >> 3) * SEQ + c;
    return U;
}
__device__ __forceinline__ void attn_load_q(const AttnU& U, const bf16_t* __restrict__ proj, int wid, int lane, bf16x8 (&qn)[4]) {
    const size_t qt = (size_t)(U.tok0 + (256 * U.blk + 32 * wid + (lane & 31)) * U.d);
#pragma unroll
    for (int ks = 0; ks < 4; ++ks) qn[ks] = *(const bf16x8*)(proj + qt * INW + U.h * HD + 16 * ks + 8 * (lane >> 5));
}
__device__ __forceinline__ void attn_load(const AttnU& U, const bf16_t* __restrict__ proj, int tid, u32x4 (&kr)[6], u32x4 (&vr)[6]) {
    const int kbase = 256 * U.blk - 128, kr_min = (U.blk == 0) ? 128 : 0;
#pragma unroll
    for (int i = 0; i < 6; ++i) {
        const int idx = tid + NTHREADS * i, row = idx >> 3, ch = idx & 7;
        if (row >= kr_min) {
            const size_t t = (size_t)(U.tok0 + (kbase + row) * U.d);
            kr[i] = *(const u32x4*)(proj + t * INW + AW + U.h * HD + ch * 8);
            vr[i] = *(const u32x4*)(proj + t * INW + 2 * AW + U.h * HD + ch * 8);
        }
    }
}
__device__ __forceinline__ void attn_lds_store(const AttnU& U, LAS unsigned char* lds, int tid, const u32x4 (&kr)[6], const u32x4 (&vr)[6]) {
    const int kr_min = (U.blk == 0) ? 128 : 0;
#pragma unroll
    for (int i = 0; i < 6; ++i) {
        const int idx = tid + NTHREADS * i, row = idx >> 3, ch = idx & 7;
        if (row >= kr_min) { *(LAS u32x4*)(lds + ATT_K_OFF + kv_off(row, ch)) = kr[i]; *(LAS u32x4*)(lds + ATT_V_OFF + kv_off(row, ch)) = vr[i]; }
    }
}
__device__ __forceinline__ void attn_compute(const AttnU& U, LAS unsigned char* lds, const bf16x8 (&qf)[4], bf16_t* __restrict__ og, f32x2* __restrict__ ml, int wid, int lane) {
    const int blk = U.blk, g = U.g, h = U.h;
    const size_t qt = (size_t)(U.tok0 + (256 * blk + 32 * wid + (lane & 31)) * U.d);
    const int kt_min = (blk == 0) ? max(0, 4 - wid) : 0;
    const int hq = lane >> 5, qi = lane & 31;
    f32x16 S[5];
#pragma unroll
    for (int kt = 0; kt < 5; ++kt) {
#pragma unroll
        for (int i = 0; i < 16; ++i) S[kt][i] = 0.f;
        if (kt >= kt_min) {
            const unsigned krow = (unsigned)(32 * wid + 32 * kt + qi);
#pragma unroll
            for (int ks = 0; ks < 4; ++ks) {
                const bf16x8 kf = *(const LAS bf16x8*)(lds + ATT_K_OFF + kv_off(krow, (unsigned)(2 * ks + hq)));
                S[kt] = __builtin_amdgcn_mfma_f32_32x32x16_bf16(kf, qf[ks], S[kt], 0, 0, 0);
            }
        }
    }
    const float NINF = -__builtin_inff(), L2E = 1.4426950408889634f;
    float mx = NINF;
#pragma unroll
    for (int kt = 0; kt < 5; ++kt) {
        if (kt >= kt_min) {
#pragma unroll
            for (int i = 0; i < 16; ++i) {
                const int row = (i & 3) + 8 * (i >> 2) + 4 * hq;
                if (kt == 0) S[kt][i] = (row >= qi) ? S[kt][i] : NINF;
                if (kt == 4) S[kt][i] = (row <= qi) ? S[kt][i] : NINF;
            }
#pragma unroll
            for (int i = 0; i < 16; i += 2) mx = fmaxf(mx, fmaxf(S[kt][i], S[kt][i + 1]));
        }
    }
    mx = fmaxf(mx, __shfl_xor(mx, 32));
    const float mb = mx * L2E;
    float lsum = 0.f;
#pragma unroll
    for (int kt = 0; kt < 5; ++kt) {
        if (kt >= kt_min) {
#pragma unroll
            for (int i = 0; i < 16; ++i) { const float p = __builtin_amdgcn_exp2f(__builtin_fmaf(S[kt][i], L2E, -mb)); S[kt][i] = p; lsum += p; }
        }
    }
    lsum += __shfl_xor(lsum, 32);
    f32x16 O[2];
#pragma unroll
    for (int dt = 0; dt < 2; ++dt)
#pragma unroll
        for (int i = 0; i < 16; ++i) O[dt][i] = 0.f;
    const unsigned blkq = (lane >> 4) & 1, q4 = (lane & 15) >> 2, p4 = lane & 3;
    const unsigned vbase = (unsigned)(size_t)(lds + ATT_V_OFF) + (unsigned)(32 * wid) * 128u;
    unsigned tb[2][2];
#pragma unroll
    for (int t = 0; t < 2; ++t)
#pragma unroll
        for (int dt = 0; dt < 2; ++dt) tb[t][dt] = vbase + kv_off((unsigned)(8 * t + 4 * hq) + q4, (unsigned)(4 * dt) + 2 * blkq + (p4 >> 1)) + 8 * (p4 & 1);
#define ATT_TR_ISSUE(V, KT) asm volatile("ds_read_b64_tr_b16 %0, %8\n\tds_read_b64_tr_b16 %1, %9\n\tds_read_b64_tr_b16 %2, %10\n\tds_read_b64_tr_b16 %3, %11\n\t" \
        "ds_read_b64_tr_b16 %4, %12\n\tds_read_b64_tr_b16 %5, %13\n\tds_read_b64_tr_b16 %6, %14\n\tds_read_b64_tr_b16 %7, %15" \
        : "=&v"(V[0][0][0]), "=&v"(V[0][0][1]), "=&v"(V[0][1][0]), "=&v"(V[0][1][1]), "=&v"(V[1][0][0]), "=&v"(V[1][0][1]), "=&v"(V[1][1][0]), "=&v"(V[1][1][1]) \
        : "v"(tb[0][0] + 4096u * (KT)), "v"(tb[1][0] + 4096u * (KT)), "v"(tb[0][1] + 4096u * (KT)), "v"(tb[1][1] + 4096u * (KT)), \
          "v"(tb[0][0] + 4096u * (KT) + 2048u), "v"(tb[1][0] + 4096u * (KT) + 2048u), "v"(tb[0][1] + 4096u * (KT) + 2048u), "v"(tb[1][1] + 4096u * (KT) + 2048u) : "memory")
#define ATT_TR_WAIT(V) asm volatile("s_waitcnt lgkmcnt(0)" : "+v"(V[0][0][0]), "+v"(V[0][0][1]), "+v"(V[0][1][0]), "+v"(V[0][1][1]), "+v"(V[1][0][0]), "+v"(V[1][0][1]), "+v"(V[1][1][0]), "+v"(V[1][1][1]) :: "memory")
#define ATT_PV(V, KT) do { _Pragma("unroll") for (int s = 0; s < 2; ++s) { \
        u32x4 pw; pw.x = pack2(S[KT][8 * s + 0], S[KT][8 * s + 1]); pw.y = pack2(S[KT][8 * s + 2], S[KT][8 * s + 3]); pw.z = pack2(S[KT][8 * s + 4], S[KT][8 * s + 5]); pw.w = pack2(S[KT][8 * s + 6], S[KT][8 * s + 7]); \
        const bf16x8 pf = __builtin_bit_cast(bf16x8, pw); \
        u32x4 f0; f0.x = V[s][0][0].x; f0.y = V[s][0][0].y; f0.z = V[s][0][1].x; f0.w = V[s][0][1].y; \
        u32x4 f1; f1.x = V[s][1][0].x; f1.y = V[s][1][0].y; f1.z = V[s][1][1].x; f1.w = V[s][1][1].y; \
        O[0] = __builtin_amdgcn_mfma_f32_32x32x16_bf16(__builtin_bit_cast(bf16x8, f0), pf, O[0], 0, 0, 0); \
        O[1] = __builtin_amdgcn_mfma_f32_32x32x16_bf16(__builtin_bit_cast(bf16x8, f1), pf, O[1], 0, 0, 0); } } while (0)
    u32x2 va[2][2][2];
#pragma unroll
    for (int kt = 0; kt < 5; ++kt) {
        if (kt >= kt_min) { ATT_TR_ISSUE(va, kt); ATT_TR_WAIT(va); ATT_PV(va, kt); }
    }
#undef ATT_TR_ISSUE
#undef ATT_TR_WAIT
#undef ATT_PV
    const float inv = 1.0f / lsum;
    bf16_t* orow = og + ((size_t)g * NTOK + qt) * AW + h * HD;
#pragma unroll
    for (int dt = 0; dt < 2; ++dt)
#pragma unroll
        for (int gq4 = 0; gq4 < 4; ++gq4) {
            u32x2 w; w.x = pack2(O[dt][4 * gq4 + 0] * inv, O[dt][4 * gq4 + 1] * inv); w.y = pack2(O[dt][4 * gq4 + 2] * inv, O[dt][4 * gq4 + 3] * inv);
            *(u32x2*)(orow + 32 * dt + 8 * gq4 + 4 * hq) = w;
        }
    if (lane < 32) ml[((size_t)g * NTOK + qt) * 8 + h] = (f32x2){mx, lsum};
    __syncthreads();
}

struct TrDesc { const float* src; bf16_t* dst; int N, K; };
__device__ __forceinline__ void tr_load(const TrDesc& d, int lane, f32x4 (&r)[8]) {
#pragma unroll
    for (int i = 0; i < 8; ++i) r[i] = __builtin_nontemporal_load((const f32x4*)(d.src + (size_t)((lane >> 3) + 8 * i) * d.N + 4 * (lane & 7)));
}
__device__ __forceinline__ void tr_store(const TrDesc& d, LAS float* scr, int lane, const f32x4 (&r)[8]) {
#pragma unroll
    for (int i = 0; i < 8; ++i) { LAS float* p = scr + ((lane >> 3) + 8 * i) * 33 + 4 * (lane & 7); p[0] = r[i][0]; p[1] = r[i][1]; p[2] = r[i][2]; p[3] = r[i][3]; }
    const int c = lane & 7;
#pragma unroll
    for (int j = 0; j < 4; ++j) { const int n = (lane >> 3) + 8 * j; const LAS float* q = scr + (8 * c) * 33 + n;
        u32x4 o; o.x = pack2(q[0 * 33], q[1 * 33]); o.y = pack2(q[2 * 33], q[3 * 33]); o.z = pack2(q[4 * 33], q[5 * 33]); o.w = pack2(q[6 * 33], q[7 * 33]);
        *(u32x4*)(d.dst + (size_t)n * d.K + 8 * c) = o; }
}
struct ExpertItems {
    const float* weg; const float* weu; const float* wed; bf16_t* WguT; bf16_t* WdT;
    static constexpr int TOTAL = 3 * NEXP * 256;
    __device__ __forceinline__ TrDesc operator()(int it) const {
        const int which = it >> 13, r = it & 8191, e = r >> 8, item = r & 255; TrDesc d;
        if (which < 2) { const int kb = item >> 4, nb = item & 15, k0 = 64 * kb, n0 = 32 * nb, nn0 = (n0 >> 7) * 256 + which * 128 + (n0 & 127);
            d.src = (which == 0 ? weg : weu) + (size_t)e * DM * EH + (size_t)k0 * EH + n0; d.dst = WguT + (size_t)e * DM * DM + (size_t)nn0 * DM + k0; d.N = EH; d.K = DM; }
        else { const int kb = item >> 5, nb = item & 31, k0 = 64 * kb, n0 = 32 * nb;
            d.src = wed + (size_t)e * EH * DM + (size_t)k0 * DM + n0; d.dst = WdT + (size_t)e * DM * EH + (size_t)n0 * EH + k0; d.N = DM; d.K = EH; }
        return d;
    }
};
struct SmallItems {
    const float* win; const float* wa; const float* wo; bf16_t* WinT; bf16_t* WaT; bf16_t* WoT;
    static constexpr int TOTAL = 2 * 2816;
    __device__ __forceinline__ TrDesc operator()(int it) const {
        const int l = it / 2816, r = it % 2816; TrDesc d;
        if (r < 2048) { const int kb = r >> 7, nb = r & 127; d.src = win + (size_t)l * DM * INW + (size_t)(64 * kb) * INW + 32 * nb; d.dst = WinT + (size_t)l * INW * DM + (size_t)(32 * nb) * DM + 64 * kb; d.N = INW; d.K = DM; }
        else if (r < 2304) { const int q = r - 2048, kb = q >> 5, nb = q & 31; d.src = wa + (size_t)l * AW * DM + (size_t)(64 * kb) * DM + 32 * nb; d.dst = WaT + (size_t)l * DM * DM + (size_t)(32 * nb) * DM + 64 * kb; d.N = DM; d.K = DM; }
        else { const int q = r - 2304, kb = q >> 5, nb = q & 31; d.src = wo + (size_t)l * DM * DM + (size_t)(64 * kb) * DM + 32 * nb; d.dst = WoT + (size_t)l * DM * DM + (size_t)(32 * nb) * DM + 64 * kb; d.N = DM; d.K = DM; }
        return d;
    }
};
template <class Items>
__device__ __forceinline__ void convert_items(const Items& I, LAS float* scr, int lane, int gw, int NGW) {
    f32x4 ra[8], rb[8];
    int it = gw;
    if (it >= Items::TOTAL) return;
    TrDesc da = I(it), db = da;
    tr_load(da, lane, ra);
    for (;;) {
        int it2 = it + NGW;
        if (it2 < Items::TOTAL) { db = I(it2); tr_load(db, lane, rb); }
        tr_store(da, scr, lane, ra);
        it = it2; if (it >= Items::TOTAL) break;
        it2 = it + NGW;
        if (it2 < Items::TOTAL) { da = I(it2); tr_load(da, lane, ra); }
        tr_store(db, scr, lane, rb);
        it = it2; if (it >= Items::TOTAL) break;
    }
}
__device__ __forceinline__ int tr8_swz(int k) { return (k & 31) ^ ((k >> 5) << 3); }
__device__ __forceinline__ void tr_load8(const TrDesc& d, int lane, f32x4 (&r)[16]) {
#pragma unroll
    for (int i = 0; i < 16; ++i) r[i] = __builtin_nontemporal_load((const f32x4*)(d.src + (size_t)((lane >> 3) + 8 * i) * d.N + 4 * (lane & 7)));
}
__device__ __forceinline__ void tr_write8(LAS float* scr, int lane, const f32x4 (&r)[16]) {
#pragma unroll
    for (int i = 0; i < 16; ++i) { const int kk = (lane >> 3) + 8 * i, sw = tr8_swz(kk), n4 = 4 * (lane & 7); LAS float* p = scr + kk * 32;
        p[(n4 + 0) ^ sw] = r[i][0]; p[(n4 + 1) ^ sw] = r[i][1]; p[(n4 + 2) ^ sw] = r[i][2]; p[(n4 + 3) ^ sw] = r[i][3]; }
}
__device__ __forceinline__ void tr_out8(const TrDesc& d, const LAS float* scr, int lane) {
    const int c = lane >> 3;
#pragma unroll
    for (int j = 0; j < 4; ++j) { const int n = (lane & 7) + 8 * j; float f[16];
#pragma unroll
        for (int q = 0; q < 16; ++q) { const int k = 16 * c + q; f[q] = scr[k * 32 + (n ^ tr8_swz(k))] * W8_SCALE; }
        u32x4 o; o.x = pack4_fp8(f[0], f[1], f[2], f[3]); o.y = pack4_fp8(f[4], f[5], f[6], f[7]); o.z = pack4_fp8(f[8], f[9], f[10], f[11]); o.w = pack4_fp8(f[12], f[13], f[14], f[15]);
        *(u32x4*)((unsigned char*)d.dst + (size_t)n * d.K + 16 * c) = o; }
}
struct ExpertItems8 {
    const float* weg; const float* weu; const float* wed; unsigned char* WguT; unsigned char* WdT;
    static constexpr int TOTAL = 3 * NEXP * 128;
    __device__ __forceinline__ TrDesc operator()(int it) const {
        const int which = it >> 12, r = it & 4095, e = r >> 7, item = r & 127; TrDesc d;
        if (which < 2) { const int kb = item >> 4, nb = item & 15, k0 = 128 * kb, n0 = 32 * nb, nn0 = (n0 >> 7) * 256 + which * 128 + (n0 & 127);
            d.src = (which == 0 ? weg : weu) + (size_t)e * DM * EH + (size_t)k0 * EH + n0; d.dst = (bf16_t*)(WguT + (size_t)e * DM * DM + (size_t)nn0 * DM + k0); d.N = EH; d.K = DM; }
        else { const int kb = item >> 5, nb = item & 31, k0 = 128 * kb, n0 = 32 * nb;
            d.src = wed + (size_t)e * EH * DM + (size_t)k0 * DM + n0; d.dst = (bf16_t*)(WdT + (size_t)e * DM * EH + (size_t)n0 * EH + k0); d.N = DM; d.K = EH; }
        return d;
    }
};
template <class Items>
__device__ __forceinline__ void convert_items8(const Items& I, LAS float* scr, int lane, int gw, int NGW) {
    f32x4 r[16];
    int it = gw;
    if (it >= Items::TOTAL) return;
    TrDesc d = I(it);
    tr_load8(d, lane, r);
    for (;;) {
        tr_write8(scr, lane, r);
        const int it2 = it + NGW; const bool has = it2 < Items::TOTAL;
        TrDesc dn = d;
        if (has) { dn = I(it2); tr_load8(dn, lane, r); }
        tr_out8(d, scr, lane);
        if (!has) break;
        d = dn; it = it2;
    }
}
__device__ __forceinline__ void norm_row(const float* __restrict__ xr, const float* __restrict__ g, bf16_t* __restrict__ hr, int lane) {
    f32x4 v[4]; float ss = 0.f;
#pragma unroll
    for (int i = 0; i < 4; ++i) { v[i] = *(const f32x4*)(xr + (i * 64 + lane) * 4); ss += (v[i][0] * v[i][0] + v[i][1] * v[i][1]) + (v[i][2] * v[i][2] + v[i][3] * v[i][3]); }
    ss = wave_sum(ss);
    const float rstd = rsqrtf(ss * (1.0f / DM) + RMS_EPS);
#pragma unroll
    for (int i = 0; i < 4; ++i) {
        const f32x4 gv = *(const f32x4*)(g + (i * 64 + lane) * 4);
        u32x2 w; w.x = pack2(v[i][0] * rstd * gv[0], v[i][1] * rstd * gv[1]); w.y = pack2(v[i][2] * rstd * gv[2], v[i][3] * rstd * gv[3]);
        *(u32x2*)(hr + (i * 64 + lane) * 4) = w;
    }
}
typedef const __attribute__((address_space(4))) float* cfp;
typedef const __attribute__((address_space(4))) f32x2* cf2p;
template <int W>
__device__ __forceinline__ void pool_path(const u32x4 (&r)[23], int pos0, bf16_t* __restrict__ pl, size_t t0, int c0) {
    float sum[8] = {0.f, 0.f, 0.f, 0.f, 0.f, 0.f, 0.f, 0.f}, f[8];
#pragma unroll
    for (int j = 1; j < W; ++j) { unpack8(r[15 - j], f);
#pragma unroll
        for (int c = 0; c < 8; ++c) sum[c] += f[c]; }
#pragma unroll
    for (int i = 0; i < 8; ++i) {
        float u[8]; unpack8(r[15 + i], u);
        if (i > 0) { unpack8(r[15 + i - W], f);
#pragma unroll
            for (int c = 0; c < 8; ++c) sum[c] -= f[c]; }
#pragma unroll
        for (int c = 0; c < 8; ++c) sum[c] += u[c];
        const float ic = 1.0f / (float)min(pos0 + i + 1, W);
        u32x4 o; o.x = pack2(sum[0] * ic - u[0], sum[1] * ic - u[1]); o.y = pack2(sum[2] * ic - u[2], sum[3] * ic - u[3]);
        o.z = pack2(sum[4] * ic - u[4], sum[5] * ic - u[5]); o.w = pack2(sum[6] * ic - u[6], sum[7] * ic - u[7]);
        *(u32x4*)(pl + (t0 + i) * DM + c0) = o;
    }
}
__device__ __forceinline__ int scan32_excl(int v, int lane, int& total) {
    int inc = v;
#pragma unroll
    for (int o = 1; o < 32; o <<= 1) { const int t = __shfl_up(inc, o, 32); if ((lane & 31) >= o) inc += t; }
    total = __shfl(inc, 31, 32);
    return inc - v;
}
__device__ __forceinline__ void build_moe_tables(LAS int* L, const unsigned* cnt) {
    { unsigned a_ = (unsigned)(size_t)L; asm volatile("" : "+s"(a_)); L = (LAS int*)(size_t)a_; }
    const int tid = opaque_tid();
    if (tid < 64) {
        const int lane = tid, e = lane & 31;
        const int c = (int)__hip_atomic_load(cnt + e * 64, __ATOMIC_RELAXED, __HIP_MEMORY_SCOPE_AGENT);
        const int nt = (c + 255) >> 8, lastv = c - 256 * (nt - 1);
        const int lt = (nt > 0 && lastv <= 128) ? 1 : 0, hv = nt - lt;
        int Tt, Th, Tl;
        const int tbx = scan32_excl(nt, lane, Tt), hx = scan32_excl(hv, lane, Th), lx = scan32_excl(lt, lane, Tl);
        if (lane < 32) {
            L[LI_TB + e] = tbx; L[LI_PS + e] = tbx * 256; L[LI_CN + e] = c;
            for (int j = 0; j < hv; ++j) L[LI_ORD + hx + j] = (e << 8) | j;
            if (lt) L[LI_ORD + Th + lx] = (e << 8) | (nt - 1);
            if (lane == 31) { L[LI_TB + NEXP] = Tt; L[LI_PS + NEXP] = Tt * 256; L[LI_NT] = Tt; }
        }
    }
    __syncthreads();
}

struct Args { const float* in[18]; float* out; unsigned char* ws; int ph_lo, ph_hi; };
typedef const __attribute__((address_space(4))) Args* CArgsP;
__device__ __forceinline__ CArgsP kargs() { unsigned long long p = (unsigned long long)__builtin_amdgcn_kernarg_segment_ptr(); asm volatile("" : "+s"(p)); return (CArgsP)p; }
#define PHASE_PTRS \
    const int G = opaque_s(G0), bx = opaque_s(bx0), vcu = opaque_s(vcu0), NGW = G * NWAVES; (void)bx; (void)vcu; (void)NGW; \
    const CArgsP ka = kargs(); unsigned char* const ws = ka->ws; \
    unsigned* const ctrl = (unsigned*)(ws + OFF_CTRL); const float* const x_in = ka->in[0]; \
    bf16_t* const WinT = (bf16_t*)(ws + OFF_WIN); bf16_t* const WaT = (bf16_t*)(ws + OFF_WA); bf16_t* const WppT = (bf16_t*)(ws + OFF_WPP); bf16_t* const WoT = (bf16_t*)(ws + OFF_WO); \
    bf16_t* const WguT = (bf16_t*)(ws + OFF_WGU); bf16_t* const WdT = (bf16_t*)(ws + OFF_WD); \
    bf16_t* const Hb = (bf16_t*)(ws + OFF_H); bf16_t* const MG = Hb; bf16_t* const PROJ = (bf16_t*)(ws + OFF_PROJ); bf16_t* const ACT = (bf16_t*)(ws + OFF_ACT); bf16_t* const YB = (bf16_t*)(ws + OFF_YB); \
    bf16_t* const AC = (bf16_t*)(ws + OFF_AC); bf16_t* const PL = (bf16_t*)(ws + OFF_PL); bf16_t* const OG = (bf16_t*)(ws + OFF_OG); bf16_t* const T1 = (bf16_t*)(ws + OFF_T1); \
    f32x2* const ML = (f32x2*)(ws + OFF_ML); bf16_t* const XB = (bf16_t*)(ws + OFF_XB); int* const tokE = (int*)(ws + OFF_TOKE); float* const tokW = (float*)(ws + OFF_TOKW); int* const asg = (int*)(ws + OFF_ASG); \
    (void)ctrl; (void)x_in; (void)WinT; (void)WaT; (void)WppT; (void)WoT; (void)WguT; (void)WdT; (void)Hb; (void)MG; (void)PROJ; (void)ACT; (void)YB; (void)AC; (void)PL; (void)OG; (void)T1; (void)ML; (void)XB; (void)tokE; (void)tokW; (void)asg
#define LAYER_PTRS PHASE_PTRS; const int tid = opaque_tid(), lane = tid & 63, wid = __builtin_amdgcn_readfirstlane(tid >> 6), gw = vcu * NWAVES + wid; (void)lane; (void)gw; unsigned* const cnt = ctrl + CW_CNT + l * 2048; (void)cnt

#ifndef PHASE_MASK
#define PHASE_MASK 0x3ff
#endif
#define EN(j) (((PHASE_MASK) >> (j)) & 1)
#ifndef REP_MASK
#define REP_MASK 0
#endif
#define REPS(j) (1 + (((REP_MASK) >> (j)) & 1))
#define IN(k) (MK_N_LAUNCHES == 1 || (lo <= (k) && (k) < hi))
#ifndef PROBE_A
#define PROBE_A -1
#define PROBE_B -1
#endif
#define STAMP_BEGIN(k) do { if (PROBE_A == (k)) ts0 = __builtin_amdgcn_s_memrealtime(); } while (0)
#define SEAM(k) do { if (IN(k) && IN((k) + 1)) { XcdBarrier b2_ = bar; unsigned long long p_ = (unsigned long long)b2_.bar; asm volatile("" : "+s"(p_)); b2_.bar = (unsigned*)p_; xcd_barrier(b2_); } if (PROBE_B == (k)) ts1 = __builtin_amdgcn_s_memrealtime(); } while (0)

template <int l>
__device__ __forceinline__ void layer_body(const XcdBarrier& bar, LAS unsigned char* lds, LAS int* LC, const int G0, const int bx0, const int vcu0, const int lo, const int hi, unsigned long long& ts0, unsigned long long& ts1) {
        const int pb = 1 + 9 * l;
        STAMP_BEGIN(pb + 0);
        for (int rep = 0; rep < REPS(0); ++rep) if (EN(0) && IN(pb + 0)) {
            asm volatile("; PHASE_MARK 0");
            LAYER_PTRS;
            pg8::DenseOrder S; S.init(Hb, WinT + (size_t)l * INW * DM, NTOK, INW, DM * 2, G, bx);
            pg8::EpiProj E{PROJ, ka->in[3] + (size_t)l * HD, ka->in[4] + (size_t)l * HD};
            pg8::gemm_phase<pg8::EpiProj, pg8::DenseOrder, 1, false>(lds, DM * 2, S, E);
        }
        SEAM(pb + 0);
        STAMP_BEGIN(pb + 1);
        for (int rep = 0; rep < REPS(1); ++rep) if (EN(1) && IN(pb + 1)) {
            asm volatile("; PHASE_MARK 1");
            LAYER_PTRS;
            int u = vcu;
            if (u < 1536) {
                AttnU cu = attn_decode(u), nu = cu;
                u32x4 kr[6], vr[6]; bf16x8 qf[4];
                attn_load(cu, PROJ, tid, kr, vr);
                for (;;) {
                    attn_load_q(cu, PROJ, wid, lane, qf);
                    attn_lds_store(cu, lds, tid, kr, vr);
                    __syncthreads();
                    const int un = u + G; const bool hn = un < 1536;
                    if (hn) { nu = attn_decode(un); attn_load(nu, PROJ, tid, kr, vr); }
                    attn_compute(cu, lds, qf, OG, ML, wid, lane);
                    if (!hn) break;
                    cu = nu; u = un;
                }
            }
        }
        SEAM(pb + 1);
        STAMP_BEGIN(pb + 2);
        for (int rep = 0; rep < REPS(2); ++rep) if (EN(2) && IN(pb + 2)) {
            asm volatile("; PHASE_MARK 2");
            LAYER_PTRS;
            for (int grp = gw; grp < NTOK / 8; grp += NGW) {
                const size_t t0 = (size_t)grp * 8; const int c0 = 8 * lane, hh = lane >> 3;
                {
                    f32x2 sm[8][3]; u32x4 v[8][3];
#pragma unroll
                    for (int i = 0; i < 8; ++i)
#pragma unroll
                        for (int g = 0; g < 3; ++g) { sm[i][g] = ML[((size_t)g * NTOK + t0 + i) * 8 + hh]; v[i][g] = *(const u32x4*)(OG + ((size_t)g * NTOK + t0 + i) * AW + c0); }
#pragma unroll
                    for (int i = 0; i < 8; ++i) {
                        const float M = fmaxf(fmaxf(sm[i][0][0], sm[i][1][0]), sm[i][2][0]);
                        float w[3], W = 0.f;
#pragma unroll
                        for (int g = 0; g < 3; ++g) { w[g] = sm[i][g][1] * __expf(sm[i][g][0] - M); W += w[g]; }
                        const float iw = 1.0f / W;
                        float o[8] = {0.f, 0.f, 0.f, 0.f, 0.f, 0.f, 0.f, 0.f}, f[8];
#pragma unroll
                        for (int g = 0; g < 3; ++g) { unpack8(v[i][g], f); const float q = w[g] * iw;
#pragma unroll
                            for (int c = 0; c < 8; ++c) o[c] += q * f[c]; }
                        u32x4 ow; ow.x = pack2(o[0], o[1]); ow.y = pack2(o[2], o[3]); ow.z = pack2(o[4], o[5]); ow.w = pack2(o[6], o[7]);
                        *(u32x4*)(AC + (t0 + i) * DM + c0) = ow;
                    }
                }
                {
                    const int pos0 = (int)(t0 & (SEQ - 1)), g4 = lane >> 4, wnd = 2 << g4;
                    u32x4 r[23];
#pragma unroll
                    for (int k = 0; k < 23; ++k) { const bool need = (k >= 16 - wnd) && (pos0 - 15 + k >= 0);
                        r[k] = need ? *(const u32x4*)(PROJ + (t0 - 15 + k) * INW + 3 * AW + c0) : (u32x4){0u, 0u, 0u, 0u}; }
                    if (g4 == 0) pool_path<2>(r, pos0, AC + PW, t0, c0);
                    else if (g4 == 1) pool_path<4>(r, pos0, AC + PW, t0, c0);
                    else if (g4 == 2) pool_path<8>(r, pos0, AC + PW, t0, c0);
                    else pool_path<16>(r, pos0, AC + PW, t0, c0);
                }
            }
        }
        SEAM(pb + 2);
        STAMP_BEGIN(pb + 3);
        for (int rep = 0; rep < REPS(3); ++rep) if (EN(3) && IN(pb + 3)) {
            asm volatile("; PHASE_MARK 3");
            LAYER_PTRS;
            pg8::DenseOrder S; S.init(AC, WaT + (size_t)l * DM * DM, NTOK, DM, DM * 2, G, bx);
            pg8::EpiGateMerge E{PROJ, MG};
            pg8::gemm_phase<pg8::EpiGateMerge, pg8::DenseOrder, 0, false, false, false, true>(lds, DM * 2, S, E);
        }
        SEAM(pb + 3);
        STAMP_BEGIN(pb + 4);
        if (EN(4) && IN(pb + 4)) {
            asm volatile("; PHASE_MARK 4");
            LAYER_PTRS;
            pg8::DenseOrder S; S.init(MG, WoT + (size_t)l * DM * DM, NTOK, DM, DM * 2, G, bx);
            pg8::EpiResid<l == 0> E{x_in, XB};
            pg8::gemm_phase<pg8::EpiResid<l == 0>, pg8::DenseOrder, 0, false>(lds, DM * 2, S, E);
        }
        SEAM(pb + 4);
        STAMP_BEGIN(pb + 5);
        if (EN(5) && IN(pb + 5)) {
            asm volatile("; PHASE_MARK 5");
            LAYER_PTRS;
            LAS float* part = (LAS float*)lds;
            LAS float* lg = (LAS float*)(lds + 100352);
            LAS int* aE = (LAS int*)(lds + 110592); LAS float* aW = (LAS float*)(lds + 110592 + 512); LAS int* bs = (LAS int*)(lds + 110592 + 1024); LAS float* rs = (LAS float*)(lds + 110592 + 1536);
            const float* brg = ka->in[12] + (size_t)l * 4; const float* bre = ka->in[14] + (size_t)l * 32;
            const bf16_t* Wh = (const bf16_t*)(ws + OFF_WRH) + (size_t)l * 48 * DM; const bf16_t* Wl = (const bf16_t*)(ws + OFF_WRL) + (size_t)l * 48 * DM;
            for (int chunk = bx; chunk < NTOK / 64; chunk += G) {
                {
                    const int fr = lane & 15, fq = lane >> 4;
                    f32x4 acc[4][3]; float ssl[4] = {0.f, 0.f, 0.f, 0.f};
#pragma unroll
                    for (int mt = 0; mt < 4; ++mt)
#pragma unroll
                        for (int nt = 0; nt < 3; ++nt) acc[mt][nt] = (f32x4){0.f, 0.f, 0.f, 0.f};
                    bf16x8 bh[3], bl[3]; u32x4 xw[2][4];
#define RT_LOADX(SET, KS) do { const int d0_ = 128 * wid + 32 * (KS) + 8 * fq; \
                        _Pragma("unroll") for (int mt = 0; mt < 4; ++mt) xw[SET][mt] = *(const u32x4*)(XB + (size_t)(chunk * 64 + 16 * mt + fr) * DM + d0_); } while (0)
#define RT_STEP(SET, KS) do { const int d0_ = 128 * wid + 32 * (KS) + 8 * fq; \
                        _Pragma("unroll") for (int nt = 0; nt < 3; ++nt) { bh[nt] = *(const bf16x8*)(Wh + (size_t)(16 * nt + fr) * DM + d0_); bl[nt] = *(const bf16x8*)(Wl + (size_t)(16 * nt + fr) * DM + d0_); } \
                        _Pragma("unroll") for (int mt = 0; mt < 4; ++mt) { const u32x4 hw = xw[SET][mt]; \
                        { float f[8]; unpack8(hw, f); ssl[mt] += (f[0] * f[0] + f[1] * f[1]) + (f[2] * f[2] + f[3] * f[3]) + (f[4] * f[4] + f[5] * f[5]) + (f[6] * f[6] + f[7] * f[7]); } \
                        const bf16x8 ah = __builtin_bit_cast(bf16x8, hw); \
                        _Pragma("unroll") for (int nt = 0; nt < 3; ++nt) { acc[mt][nt] = __builtin_amdgcn_mfma_f32_16x16x32_bf16(ah, bh[nt], acc[mt][nt], 0, 0, 0); \
                            acc[mt][nt] = __builtin_amdgcn_mfma_f32_16x16x32_bf16(ah, bl[nt], acc[mt][nt], 0, 0, 0); } } asm volatile("" ::: "memory"); } while (0)
                    RT_LOADX(0, 0); RT_LOADX(1, 1);
                    RT_STEP(0, 0); RT_LOADX(0, 2);
                    RT_STEP(1, 1); RT_LOADX(1, 3);
                    RT_STEP(0, 2);
                    RT_STEP(1, 3);
#undef RT_LOADX
#undef RT_STEP
#pragma unroll
                    for (int mt = 0; mt < 4; ++mt) {
#pragma unroll
                        for (int nt = 0; nt < 3; ++nt) *(LAS f32x4*)(part + (wid * 49 + 16 * nt + fr) * 64 + 16 * mt + 4 * fq) = acc[mt][nt];
                        float sq = ssl[mt]; sq += __shfl_xor(sq, 16); sq += __shfl_xor(sq, 32);
                        if (fq == 0) part[(wid * 49 + 48) * 64 + 16 * mt + fr] = sq;
                    }
                }
                __syncthreads();
                for (int o = tid >> 6; o < 37; o += 8) { float sum = 0.f; const int po = (o == 36) ? 48 : o;
#pragma unroll
                    for (int w = 0; w < 8; ++w) sum += part[(w * 49 + po) * 64 + lane];
                    lg[o * 64 + lane] = sum; }
                __syncthreads();
                if (tid < 64) {
                    const float rstd = rsqrtf(lg[36 * 64 + tid] * (1.0f / DM) + RMS_EPS); rs[tid] = rstd;
                    float gl[4];
#pragma unroll
                    for (int o = 0; o < 4; ++o) gl[o] = lg[o * 64 + tid] * rstd + brg[o];
                    int gs = 0; float gm = gl[0];
#pragma unroll
                    for (int o = 1; o < 4; ++o) if (gl[o] > gm) { gm = gl[o]; gs = o; }
                    float gden = 0.f;
#pragma unroll
                    for (int o = 0; o < 4; ++o) gden += __expf(gl[o] - gm);
                    const float ggate = 1.0f / gden;
                    float el[8];
#pragma unroll
                    for (int o = 0; o < 8; ++o) el[o] = lg[(4 + 8 * gs + o) * 64 + tid] * rstd + bre[gs * 8 + o];
                    int i0 = 0; float m0 = el[0];
#pragma unroll
                    for (int o = 1; o < 8; ++o) if (el[o] > m0) { m0 = el[o]; i0 = o; }
                    int i1 = 0; float m1 = -3.0e38f;
#pragma unroll
                    for (int o = 0; o < 8; ++o) if (o != i0 && el[o] > m1) { m1 = el[o]; i1 = o; }
                    const float e1 = __expf(m1 - m0);
                    aE[2 * tid] = gs * 8 + i0; aE[2 * tid + 1] = gs * 8 + i1; aW[2 * tid] = ggate / (1.0f + e1); aW[2 * tid + 1] = ggate * e1 / (1.0f + e1);
                }
                __syncthreads();
                int myE = 0, rank = 0;
                if (tid < 128) { myE = aE[tid]; for (int a = 0; a < tid; ++a) rank += (aE[a] == myE) ? 1 : 0; }
                if (tid < NEXP) { int c = 0; for (int a = 0; a < 128; ++a) c += (aE[a] == tid) ? 1 : 0;
                    bs[tid] = c ? (int)__hip_atomic_fetch_add(cnt + tid * 64, (unsigned)c, __ATOMIC_RELAXED, __HIP_MEMORY_SCOPE_AGENT) : 0; }
#pragma unroll 2
                for (int it = 0; it < 8; ++it) {
                    const int ti = wid * 8 + it; const size_t tok = (size_t)chunk * 64 + ti; const float rstd = rs[ti];
                    const CArgsP k2 = kargs(); const float* const g2 = k2->in[10] + (size_t)l * DM; bf16_t* const Hb = (bf16_t*)(k2->ws + OFF_H); const bf16_t* const XB = (const bf16_t*)(k2->ws + OFF_XB);
#pragma unroll
                    for (int i = 0; i < 4; ++i) { const int d0 = (i * 64 + lane) * 4; const u32x2 xw = *(const u32x2*)(XB + tok * DM + d0); const f32x4 gv = *(const f32x4*)(g2 + d0);
                        const float h0 = bflo(xw.x) * rstd * gv[0], h1 = bfhi(xw.x) * rstd * gv[1], h2v = bflo(xw.y) * rstd * gv[2], h3 = bfhi(xw.y) * rstd * gv[3];
                        if (MOE_FP8) *(unsigned*)((unsigned char*)Hb + tok * DM + d0) = pack4_fp8(h0, h1, h2v, h3);
                        else { u32x2 w; w.x = pack2(h0, h1); w.y = pack2(h2v, h3); *(u32x2*)(Hb + tok * DM + d0) = w; } }
                }
                __syncthreads();
                if (tid < 128) { const int slot = bs[myE] + rank, tok = chunk * 64 + (tid >> 1);
                    unsigned char* const w2 = kargs()->ws;
                    ((int*)(w2 + OFF_TOKE))[(size_t)myE * ECAP + slot] = tok; ((float*)(w2 + OFF_TOKW))[(size_t)myE * ECAP + slot] = aW[tid]; ((int*)(w2 + OFF_ASG))[tok * 2 + (tid & 1)] = myE * ECAP + slot; }
                __syncthreads();
            }
        }
        SEAM(pb + 5);
        STAMP_BEGIN(pb + 6);
        for (int rep = 0; rep < REPS(6); ++rep) if (EN(6) && IN(pb + 6)) {
            asm volatile("; PHASE_MARK 6");
            LAYER_PTRS;
            build_moe_tables(LC, cnt);
            constexpr int ES = MOE_FP8 ? 1 : 2;
            pg8::MoeOrder S{(const char*)Hb, (const char*)WguT, (size_t)DM * DM * ES, DM * ES, LC + LI_TB, LC + LI_PS, LC + LI_CN, LC + LI_ORD, tokE, G, vcu, true};
            pg8::EpiSwiGLU<MOE_FP8> E{(void*)ACT};
            pg8::gemm_phase<pg8::EpiSwiGLU<MOE_FP8>, pg8::MoeOrder, 0, true, true, MOE_FP8>(lds, DM * ES, S, E);
        }
        SEAM(pb + 6);
        STAMP_BEGIN(pb + 7);
        for (int rep = 0; rep < REPS(7); ++rep) if (EN(7) && IN(pb + 7)) {
            asm volatile("; PHASE_MARK 7");
            LAYER_PTRS;
            build_moe_tables(LC, cnt);
            constexpr int ES = MOE_FP8 ? 1 : 2;
            pg8::MoeOrder S{(const char*)ACT, (const char*)WdT, (size_t)DM * EH * ES, EH * ES, LC + LI_TB, LC + LI_PS, LC + LI_CN, LC + LI_ORD, tokE, G, vcu, false};
            pg8::EpiDown<MOE_FP8> E{YB, tokW};
            pg8::gemm_phase<pg8::EpiDown<MOE_FP8>, pg8::MoeOrder, 0, false, true, MOE_FP8>(lds, EH * ES, S, E);
        }
        SEAM(pb + 7);
        STAMP_BEGIN(pb + 8);
        if (EN(8) && IN(pb + 8)) {
            asm volatile("; PHASE_MARK 8");
            LAYER_PTRS;
            build_moe_tables(LC, cnt);
            const bool lastl = (l == DEPTH - 1);
            const float* g1n = ka->in[1] + (size_t)(lastl ? 0 : (l + 1)) * DM;
            for (int grp = gw; grp < NTOK / 4; grp += NGW) {
                const size_t t0 = (size_t)grp * 4;
                const int myasg = (lane < 8) ? asg[t0 * 2 + lane] : 0;
                u32x2 xv[4][4], ya[4][4], yb[4][4];
#pragma unroll
                for (int q = 0; q < 4; ++q) {
                    const int i0 = __builtin_amdgcn_readlane(myasg, 2 * q), i1 = __builtin_amdgcn_readlane(myasg, 2 * q + 1);
                    const size_t s0 = (size_t)(LC[LI_PS + (i0 >> 14)] + (i0 & (ECAP - 1))), s1 = (size_t)(LC[LI_PS + (i1 >> 14)] + (i1 & (ECAP - 1)));
#pragma unroll
                    for (int i = 0; i < 4; ++i) { const int d0 = (i * 64 + lane) * 4;
                        xv[q][i] = *(const u32x2*)(XB + (t0 + q) * DM + d0); ya[q][i] = *(const u32x2*)(YB + s0 * DM + d0); yb[q][i] = *(const u32x2*)(YB + s1 * DM + d0); }
                }
#pragma unroll
                for (int q = 0; q < 4; ++q) {
                    f32x4 v[4]; float ss = 0.f;
#pragma unroll
                    for (int i = 0; i < 4; ++i) { const int d0 = (i * 64 + lane) * 4; const u32x2 a = ya[q][i], b = yb[q][i], x4 = xv[q][i];
                        v[i][0] = bflo(x4.x) + bflo(a.x) + bflo(b.x); v[i][1] = bfhi(x4.x) + bfhi(a.x) + bfhi(b.x); v[i][2] = bflo(x4.y) + bflo(a.y) + bflo(b.y); v[i][3] = bfhi(x4.y) + bfhi(a.y) + bfhi(b.y);
                        ss += (v[i][0] * v[i][0] + v[i][1] * v[i][1]) + (v[i][2] * v[i][2] + v[i][3] * v[i][3]);
                        if (lastl) *(f32x4*)(ka->out + (t0 + q) * DM + d0) = v[i];
                        else { u32x2 w; w.x = pack2(v[i][0], v[i][1]); w.y = pack2(v[i][2], v[i][3]); *(u32x2*)(XB + (t0 + q) * DM + d0) = w; } }
                    if (!lastl) {
                        ss = wave_sum(ss);
                        const float rstd = rsqrtf(ss * (1.0f / DM) + RMS_EPS);
#pragma unroll
                        for (int i = 0; i < 4; ++i) { const int d0 = (i * 64 + lane) * 4; const f32x4 gv = *(const f32x4*)(g1n + d0);
                            u32x2 w; w.x = pack2(v[i][0] * rstd * gv[0], v[i][1] * rstd * gv[1]); w.y = pack2(v[i][2] * rstd * gv[2], v[i][3] * rstd * gv[3]);
                            *(u32x2*)(Hb + (t0 + q) * DM + d0) = w; }
                    }
                }
            }
            if (!lastl) {
                __syncthreads();
                const float* e0 = ka->in[15] + (size_t)(l + 1) * NEXP * DM * EH; const float* e1 = ka->in[16] + (size_t)(l + 1) * NEXP * DM * EH; const float* e2 = ka->in[17] + (size_t)(l + 1) * NEXP * EH * DM;
                if (MOE_FP8) { ExpertItems8 I{e0, e1, e2, (unsigned char*)WguT, (unsigned char*)WdT}; convert_items8(I, (LAS float*)(lds + wid * 16384), lane, gw, NGW); }
                else { ExpertItems I{e0, e1, e2, WguT, WdT}; convert_items(I, (LAS float*)(lds + wid * 16384), lane, gw, NGW); }
            }
        }
        if (l + 1 < DEPTH) SEAM(pb + 8); else if (PROBE_B == pb + 8) ts1 = __builtin_amdgcn_s_memrealtime();
    }

__global__ void __launch_bounds__(NTHREADS, 2) fwd_kernel(Args args) {
    extern __shared__ __attribute__((aligned(16))) unsigned char lds_raw[];
    LAS unsigned char* lds = (LAS unsigned char*)lds_raw;
    LAS int* LC = (LAS int*)(lds + LCTL_OFF);
    const int G0 = gridDim.x, bx0 = blockIdx.x;
    const int vcu0 = (G0 % 8 == 0) ? (bx0 % 8) * (G0 / 8) + bx0 / 8 : bx0;
    if (threadIdx.x < 4) LC[LI_BAR + threadIdx.x] = 0;
    __syncthreads();
    XcdBarrier bar; bar.bar = (unsigned*)(args.ws + OFF_CTRL) + CW_BAR; bar.x = 0; bar.st = nullptr;
    if (MK_N_LAUNCHES == 1) bar = xcd_barrier_post(bar.bar, (volatile LAS unsigned*)(LC + LI_BAR));
    const int lo = args.ph_lo, hi = args.ph_hi;
    unsigned long long ts0 = 0ull, ts1 = 0ull;
    STAMP_BEGIN(0);
    for (int rep = 0; rep < REPS(9); ++rep) if (EN(9) && IN(0)) {
        asm volatile("; PHASE_MARK 9");
        PHASE_PTRS; const int tid = opaque_tid(), lane = tid & 63, wid = __builtin_amdgcn_readfirstlane(tid >> 6), gw = vcu * NWAVES + wid;
        LAS float* scr = (LAS float*)(lds + wid * 16384);
        if (wid == 7) {
            for (int o = vcu; o < DEPTH * 4 * 16 * 4; o += G) {
                const int l = o >> 8, g = (o >> 6) & 3, nb = (o >> 2) & 15, cb = o & 3, c0 = 32 * cb, n = 64 * nb + lane;
                const float* wm = ka->in[6] + (size_t)l * 4 * 128 * 128 + (size_t)(g * 128 + c0) * 128;
                const float* sc = ka->in[7] + (size_t)l * PW + g * 128;
                const float* wp = ka->in[8] + (size_t)l * PW * DM + (size_t)(g * 128) * DM + n;
                {
                    const f32x4 sv = *(const f32x4*)(sc + 4 * (lane & 31));
#pragma unroll 8
                    for (int i = 0; i < 16; ++i) { const int c = (lane >> 5) + 2 * i; const f32x4 v = *(const f32x4*)(wm + (size_t)c * 128 + 4 * (lane & 31)) * sv;
#pragma unroll
                        for (int j = 0; j < 4; ++j) scr[(4 * (lane & 31) + j) * 32 + c] = v[j]; }
                }
                float a[32];
#pragma unroll
                for (int c = 0; c < 32; ++c) a[c] = 0.f;
                float wa[32];
#define FOLD_BLOCK(WV, D0) do { _Pragma("unroll") for (int q = 0; q < 32; ++q) { const float w = WV[q]; _Pragma("unroll") for (int c4 = 0; c4 < 8; ++c4) { \
                    const f32x4 m4 = *(const LAS f32x4*)(scr + ((D0) + q) * 32 + 4 * c4); a[4 * c4] += w * m4[0]; a[4 * c4 + 1] += w * m4[1]; a[4 * c4 + 2] += w * m4[2]; a[4 * c4 + 3] += w * m4[3]; } \
                    if (q & 1) asm volatile("" ::: "memory"); } } while (0)
#pragma unroll 1
                for (int d0 = 0; d0 < 128; d0 += 32) {
#pragma unroll
                    for (int q = 0; q < 32; ++q) wa[q] = wp[(size_t)(d0 + q) * DM];
                    FOLD_BLOCK(wa, d0);
                }
#undef FOLD_BLOCK
                bf16_t* op = WaT + (size_t)l * DM * DM + (size_t)n * DM + PW + g * 128 + c0;
#pragma unroll
                for (int q = 0; q < 4; ++q) { u32x4 ow; ow.x = pack2(a[8 * q], a[8 * q + 1]); ow.y = pack2(a[8 * q + 2], a[8 * q + 3]); ow.z = pack2(a[8 * q + 4], a[8 * q + 5]); ow.w = pack2(a[8 * q + 6], a[8 * q + 7]);
                    *(u32x4*)(op + 8 * q) = ow; }
            }
            for (int o = vcu * 64 + lane; o < DEPTH * 48 * DM; o += G * 64) {
                const int l = o / (48 * DM), r = o % (48 * DM), oo = r / DM, d = r % DM;
                float w = 0.f;
                if (oo < 4) w = ka->in[11][(size_t)l * DM * 4 + (size_t)d * 4 + oo];
                else if (oo < 36) w = ka->in[13][(size_t)l * 4 * DM * 8 + ((size_t)((oo - 4) >> 3) * DM + d) * 8 + ((oo - 4) & 7)];
                w *= ka->in[10][(size_t)l * DM + d];
                const bf16_t hi = f2bf(w); const float hf = __uint_as_float((unsigned)hi << 16);
                ((bf16_t*)(ws + OFF_WRH))[o] = hi; ((bf16_t*)(ws + OFF_WRL))[o] = f2bf(w - hf);
            }
        } else {
            const int gw7 = vcu * 7 + wid, NGW7 = G * 7;
            { SmallItems I{ka->in[2], ka->in[5], ka->in[9], WinT, WaT, WoT}; convert_items(I, scr, lane, gw7, NGW7); }
            if (MOE_FP8) { ExpertItems8 I{ka->in[15], ka->in[16], ka->in[17], (unsigned char*)WguT, (unsigned char*)WdT}; convert_items8(I, scr, lane, gw7, NGW7); }
            else { ExpertItems I{ka->in[15], ka->in[16], ka->in[17], WguT, WdT}; convert_items(I, scr, lane, gw7, NGW7); }
        }
        for (int m = gw; m < NTOK; m += NGW) norm_row(x_in + (size_t)m * DM, ka->in[1], Hb + (size_t)m * DM, lane);
    }
    SEAM(0);

    layer_body<0>(bar, lds, LC, G0, bx0, vcu0, lo, hi, ts0, ts1);
    layer_body<1>(bar, lds, LC, G0, bx0, vcu0, lo, hi, ts0, ts1);
    if (PROBE_A >= 0 && blockIdx.x == 0) { const unsigned long long d = (ts1 - ts0) * 4ull, t0 = __builtin_amdgcn_s_memrealtime(); while (__builtin_amdgcn_s_memrealtime() - t0 < d) __builtin_amdgcn_s_sleep(8); }
#undef IN
#undef SEAM
}

extern "C" void kernel_launch(void* const* d_in, const int* in_sizes, int n_in, void* d_out, int out_size, void* d_ws, size_t ws_size, hipStream_t stream) {
    (void)in_sizes; (void)out_size;
    static int grid = 0;
    if (grid == 0) {
        int dev = 0, cus = 0;
        if (hipGetDevice(&dev) != hipSuccess || hipDeviceGetAttribute(&cus, hipDeviceAttributeMultiprocessorCount, dev) != hipSuccess) { grid = -1; return; }
        if (hipFuncSetAttribute((const void*)fwd_kernel, hipFuncAttributeMaxDynamicSharedMemorySize, LDS_BYTES) != hipSuccess) { grid = -1; return; }
        int per_cu = 0;
        (void)hipOccupancyMaxActiveBlocksPerMultiprocessor(&per_cu, (const void*)fwd_kernel, NTHREADS, LDS_BYTES);
        (void)hipGetLastError();
        grid = cus;
        if (n_in != 18 || ws_size < WS_NEED) { fprintf(stderr, "kernel_launch: unexpected inputs (n_in %d, ws %zu)\n", n_in, ws_size); grid = -1; return; }
    }
    if (grid < 0) return;
    (void)hipMemsetAsync((char*)d_ws + OFF_CTRL, 0, CTRL_BYTES, stream);
    Args a{};
    for (int i = 0; i < 18; ++i) a.in[i] = (const float*)d_in[i];
    a.out = (float*)d_out; a.ws = (unsigned char*)d_ws;
    constexpr int NPH = 1 + 9 * DEPTH;
    if (MK_N_LAUNCHES == 1) { a.ph_lo = 0; a.ph_hi = NPH; hipLaunchKernelGGL(fwd_kernel, dim3(grid), dim3(NTHREADS), LDS_BYTES, stream, a); }
    else { for (int p = 0; p < NPH; ++p) { a.ph_lo = p; a.ph_hi = p + 1; hipLaunchKernelGGL(fwd_kernel, dim3(grid), dim3(NTHREADS), LDS_BYTES, stream, a); } }
}
```

```cpp
#include <hip/hip_runtime.h>
#include <stdint.h>
#include <stdio.h>

#define LAS __attribute__((address_space(3)))
typedef unsigned short bf16_t;
typedef short bf16x8 __attribute__((ext_vector_type(8)));
typedef float f32x2 __attribute__((ext_vector_type(2)));
typedef float f32x4 __attribute__((ext_vector_type(4)));
typedef float f32x16 __attribute__((ext_vector_type(16)));
typedef unsigned u32x2 __attribute__((ext_vector_type(2)));
typedef unsigned u32x4 __attribute__((ext_vector_type(4)));
typedef __bf16 bfv2 __attribute__((ext_vector_type(2)));
typedef int i32x8 __attribute__((ext_vector_type(8)));
constexpr float W8_SCALE = 32.f, A8_SCALE = 8.f;

#ifndef MOE_FP8
#define MOE_FP8 1
#endif
#ifndef INPROJ_FP8
#define INPROJ_FP8 1
#endif
#ifndef MK_N_LAUNCHES
#define MK_N_LAUNCHES 1
#endif

constexpr int DM = 1024, SEQ = 4096, NTOK = 16384, DEPTH = 2;
constexpr int HD = 64, AW = 512, PW = 512, INW = 4096;
constexpr int NEXP = 32, EH = 512, ECAP = NTOK;
constexpr float RMS_EPS = 1e-6f;
constexpr int NTHREADS = 512, NWAVES = 8;

constexpr size_t MB = 1024 * 1024;
constexpr size_t OFF_CTRL = 0, CTRL_BYTES = 65536;
constexpr size_t OFF_WIN  = 1 * MB;
constexpr size_t OFF_WIN8 = OFF_WIN + 8 * MB;
constexpr size_t OFF_WA   = OFF_WIN + 16 * MB;
constexpr size_t OFF_WPP  = OFF_WA + 2 * MB;
constexpr size_t OFF_WO   = OFF_WPP + 2 * MB;
constexpr size_t OFF_WGU  = OFF_WO + 4 * MB;
constexpr size_t OFF_WD   = OFF_WGU + 64 * MB;
constexpr size_t OFF_H    = OFF_WD + 32 * MB;
constexpr size_t OFF_PROJ = OFF_H + 32 * MB;
constexpr size_t OFF_ACT  = OFF_PROJ;
constexpr size_t OFF_YB   = OFF_PROJ + 40 * MB;
constexpr size_t OFF_AC   = OFF_PROJ + 128 * MB;
constexpr size_t OFF_PL   = OFF_AC + 16 * MB;
constexpr size_t OFF_OG   = OFF_PL + 16 * MB;
constexpr size_t OFF_T1   = OFF_OG;
constexpr size_t OFF_HIN8 = OFF_OG;
constexpr size_t OFF_ML   = OFF_OG + 48 * MB;
constexpr size_t OFF_XB   = OFF_ML + 4 * MB;
constexpr size_t OFF_TOKE = OFF_XB + 64 * MB;
constexpr size_t OFF_TOKW = OFF_TOKE + 2 * MB;
constexpr size_t OFF_ASG  = OFF_TOKW + 2 * MB;
constexpr size_t OFF_WRH  = OFF_ASG + 1 * MB;
constexpr size_t OFF_WRL  = OFF_WRH + 256 * 1024;
constexpr size_t WS_NEED  = OFF_WRL + 256 * 1024;
constexpr int CW_CNT = 1024;
constexpr int CW_BAR = 8192;
constexpr int RING_BYTES = 131072, LCTL_OFF = RING_BYTES, LDS_BYTES = RING_BYTES + 2048;
constexpr int LI_BAR = 0, LI_TB = 16, LI_PS = 64, LI_CN = 112, LI_NT = 15, LI_ORD = 144;

__device__ __forceinline__ float bflo(unsigned w) { return __uint_as_float(w << 16); }
__device__ __forceinline__ float bfhi(unsigned w) { return __uint_as_float(w & 0xffff0000u); }
__device__ __forceinline__ void unpack8(const u32x4 v, float (&f)[8]) { f[0] = bflo(v.x); f[1] = bfhi(v.x); f[2] = bflo(v.y); f[3] = bfhi(v.y); f[4] = bflo(v.z); f[5] = bfhi(v.z); f[6] = bflo(v.w); f[7] = bfhi(v.w); }
__device__ __forceinline__ unsigned pack2(float lo, float hi) { f32x2 v = {lo, hi}; return __builtin_bit_cast(unsigned, __builtin_convertvector(v, bfv2)); }
__device__ __forceinline__ unsigned pack4_fp8(float a, float b, float c, float d) { unsigned w = 0u; w = __builtin_amdgcn_cvt_pk_fp8_f32(a, b, w, false); w = __builtin_amdgcn_cvt_pk_fp8_f32(c, d, w, true); return w; }
__device__ __forceinline__ bf16_t f2bf(float f) { return (bf16_t)(pack2(f, 0.f) & 0xffffu); }
__device__ __forceinline__ float wave_sum(float v) {
#pragma unroll
    for (int o = 32; o >= 1; o >>= 1) v += __shfl_xor(v, o);
    return v;
}
__device__ __forceinline__ int opaque_tid() { int t = (int)threadIdx.x; asm volatile("" : "+v"(t)); return t; }
__device__ __forceinline__ int opaque_s(int v) { asm volatile("" : "+s"(v)); return v; }
__device__ __forceinline__ float sigmoidf_(float v) { return 1.0f / (1.0f + __expf(-v)); }

#define XB_TMO      128
#define XB_XCNT(j)  (256  + 64 * (j))
#define XB_XSUB(j)  (1280 + 64 * (j))
#define XB_XGEN(j)  (2304 + 64 * (j))
#define XB_TOP      3328
#define XB_TOPGEN   3392
#define XCD_BAR_WORDS 3456
#define XB_SPIN_CAP (1u << 18)
__device__ __forceinline__ unsigned xb_ld(unsigned* p)              { return __hip_atomic_load(p, __ATOMIC_RELAXED, __HIP_MEMORY_SCOPE_AGENT); }
__device__ __forceinline__ unsigned xb_add(unsigned* p, unsigned v) { return __hip_atomic_fetch_add(p, v, __ATOMIC_RELAXED, __HIP_MEMORY_SCOPE_AGENT); }
__device__ __forceinline__ unsigned xb_xcc_id() { return (unsigned)__builtin_amdgcn_s_getreg((3 << 11) | 20) & 0xFu; }
#define XB_SPIN(cond, bar) do { unsigned _sp = 0; while (cond) { __builtin_amdgcn_s_sleep(1); \
    if ((++_sp & 255u) == 0u) { if (xb_ld(&(bar)[XB_TMO])) break; if (_sp > XB_SPIN_CAP) { atomicAdd(&(bar)[XB_TMO], 1u); break; } } } } while (0)
struct XcdBarrier { unsigned* bar; unsigned x; volatile LAS unsigned* st; };
__device__ __forceinline__ XcdBarrier xcd_barrier_post(unsigned* bar, volatile LAS unsigned* st) {
    XcdBarrier b; b.bar = bar; b.x = xb_xcc_id(); b.st = st;
    if (threadIdx.x == 0) (void)xb_add(&bar[XB_XCNT(b.x)], 1u);
    return b;
}
__device__ __forceinline__ void xcd_barrier_complete(unsigned* bar, unsigned x, unsigned& nloc, unsigned& nx) {
    const unsigned G = gridDim.x * gridDim.y * gridDim.z;
    unsigned sum, cnt, mine, sp = 0u;
    for (;;) {
        sum = 0u; cnt = 0u; mine = 0u;
#pragma unroll
        for (unsigned j = 0; j < 16; ++j) { const unsigned c = xb_ld(&bar[XB_XCNT(j)]); sum += c; cnt += (c > 0u) ? 1u : 0u; mine = (j == x) ? c : mine; }
        if (sum == G) break;
        __builtin_amdgcn_s_sleep(1);
        if ((++sp & 255u) == 0u) { if (xb_ld(&bar[XB_TMO])) break; if (sp > XB_SPIN_CAP) { atomicAdd(&bar[XB_TMO], 1u); break; } }
    }
    nloc = mine > 0u ? mine : 1u; nx = cnt > 0u ? cnt : 1u;
}
__device__ __forceinline__ void xcd_barrier(const XcdBarrier& b) {
    asm volatile("s_waitcnt vmcnt(0)" ::: "memory");
    __syncthreads();
    if (threadIdx.x == 0) {
        unsigned* bar = b.bar;
        __builtin_amdgcn_s_waitcnt(0);
        unsigned nloc = b.st[0], nx = b.st[1];
        if (nloc == 0u) { xcd_barrier_complete(bar, b.x, nloc, nx); b.st[0] = nloc; b.st[1] = nx; }
        const unsigned old = xb_add(&bar[XB_XSUB(b.x)], 1u);
        const unsigned gen = old / nloc;
        if (old + 1u == (gen + 1u) * nloc) {
            __builtin_amdgcn_fence(__ATOMIC_RELEASE, "agent");
            asm volatile("s_waitcnt vmcnt(0)" ::: "memory");
            const unsigned og = xb_add(&bar[XB_TOP], 1u);
            const unsigned tg = og / nx;
            if (og + 1u == (tg + 1u) * nx) xb_add(&bar[XB_TOPGEN], 1u);
            else XB_SPIN(xb_ld(&bar[XB_TOPGEN]) == tg, bar);
            __builtin_amdgcn_fence(__ATOMIC_ACQUIRE, "agent");
            xb_add(&bar[XB_XGEN(b.x)], 1u);
            asm volatile("s_waitcnt vmcnt(0)" ::: "memory");
        } else {
            XB_SPIN(xb_ld(&bar[XB_XGEN(b.x)]) == gen, bar);
            __builtin_amdgcn_fence(__ATOMIC_ACQUIRE, "agent");
            asm volatile("s_waitcnt vmcnt(0)" ::: "memory");
        }
    }
    __syncthreads();
}

namespace pg8 {
constexpr int BM = 256, BK = 64, HALF = 128, HTB = HALF * BK * 2, NXCD = 8, WGM = 8;
__device__ __forceinline__ int lds_byte(int r, int c) { const int st = (r >> 4) * 2 + (c >> 5), rr = r & 15, cc = c & 31, ob = rr * 64 + cc * 2; return st * 1024 + (ob ^ (((ob >> 9) & 1) << 5)); }
__device__ __forceinline__ void stage_rc(int b, int& R, int& C) { const int st = b / 1024, sb = b % 1024, swz = sb ^ (((sb >> 9) & 1) << 5); R = (st >> 1) * 16 + swz / 64; C = (st & 1) * 32 + (swz % 64) / 2; }
__device__ __forceinline__ int perm32(int rho) { const int n = rho >> 4, i = rho & 15; return 8 * (i >> 2) + 4 * n + (i & 3); }

struct Unit { const char* A; const char* B; int row0, col0, e, nvalid, j0; };

struct DenseOrder {
    const char* A; const char* Bt; int KB, nM, nN, nwg, G, c;
    __device__ __forceinline__ void init(const void* A_, const void* Bt_, int M, int N, int KB_, int G_, int c_) { A = (const char*)A_; Bt = (const char*)Bt_; KB = KB_; nM = M / BM; nN = N / BM; nwg = nM * nN; G = G_; c = c_; }
    __device__ __forceinline__ bool next(int i, Unit& u) const {
        const long L = (long)i * G + c; if (L >= nwg) return false;
        int wgid = (int)L; { const int q = nwg / NXCD, r = nwg % NXCD, xcd = wgid % NXCD, off = wgid / NXCD; wgid = (xcd < r ? xcd * (q + 1) : r * (q + 1) + (xcd - r) * q) + off; }
        const int nig = WGM * nN, gid = wgid / nig, fm = gid * WGM, gsz = (nM - fm) < WGM ? (nM - fm) : WGM;
        const int pm = fm + ((wgid % nig) % gsz), pn = (wgid % nig) / gsz;
        u.A = A + (size_t)pm * BM * KB; u.B = Bt + (size_t)pn * BM * KB; u.row0 = pm * BM; u.col0 = pn * BM; u.e = 0; u.nvalid = BM; u.j0 = 0; return true;
    }
    __device__ __forceinline__ unsigned row_off(const Unit&, int) const { return 0u; }
};
struct MoeOrder {
    const char* A; const char* Bt; size_t bExp; int KB; const LAS int* tb; const LAS int* ps; const LAS int* cn; const LAS int* ord; const int* tokE; int G, c; bool gather;
    __device__ __forceinline__ bool next(int i, Unit& u) const {
        const int L = i * G + c, total = tb[NEXP] * 4; if (L >= total) return false;
        const int rt = L >> 2, pn = L & 3;
        const int ej = __builtin_amdgcn_readfirstlane(ord[rt]);
        const int e = ej >> 8, j = ej & 255;
        const int pse = __builtin_amdgcn_readfirstlane(ps[e]), cne = __builtin_amdgcn_readfirstlane(cn[e]);
        u.e = e; u.row0 = pse + BM * j; u.col0 = pn * BM; u.nvalid = min(BM, cne - BM * j); u.j0 = e * ECAP + BM * j;
        u.B = Bt + (size_t)e * bExp + (size_t)pn * BM * KB;
        u.A = gather ? A : A + (size_t)u.row0 * KB;
        return true;
    }
    __device__ __forceinline__ unsigned row_off(const Unit& u, int R) const { const int t = R < u.nvalid ? tokE[u.j0 + R] : 0; return (unsigned)t * (unsigned)KB; }
};

template <class Epi, class Sched, int BMODE, bool GATHER, bool LIGHT = false, bool F8 = false, bool MIDK = false>
__device__ __forceinline__ void gemm_phase(LAS unsigned char* lds, const int KB, const Sched& S, const Epi& E) {
    const int tid = opaque_tid(), wid = __builtin_amdgcn_readfirstlane(tid >> 6), lane = tid & 63, wr = wid >> 2, wc = wid & 3, fr = lane & 15, fq = lane >> 4;
    const int nt = KB / (BK * 2);
    unsigned voffA[2][2], voffAn[2][2], voffB[2]; int RA[2], CA[2];
#pragma unroll
    for (int i = 0; i < 2; ++i) { int R, C; stage_rc(tid * 16 + i * 8192, R, C); RA[i] = R; CA[i] = C;
        const int Rb = (BMODE == 1) ? (64 * (R >> 5) + perm32(R & 31)) : (Epi::PERM ? ((R & ~31) + perm32(R & 31)) : R);
        voffB[i] = (unsigned)(Rb * KB + C * 2);
#pragma unroll
        for (int h = 0; h < 2; ++h) { voffA[h][i] = (unsigned)((h * HALF + R) * KB + C * 2); voffAn[h][i] = voffA[h][i]; } }
    const size_t kstep = (size_t)(BK * 2);
    const size_t hstepB = (size_t)((BMODE == 1) ? 32 : HALF) * KB;
    const unsigned ldsw = (unsigned)wid * 1024u;
    const int aoff = lds_byte(wr * 64 + fr, fq * 8), boff = lds_byte(wc * 32 + fr, fq * 8);
#define PG8_SA(b, h) (((b) * 2 + (h)) * HTB)
#define PG8_SB(b, h) ((4 + (b) * 2 + (h)) * HTB)
#define PG8_STAGE2(bufoff, gbase, v0, v1) do { \
        __builtin_amdgcn_global_load_lds((const unsigned*)((const char*)(gbase) + (v0)), (LAS unsigned*)(lds + (bufoff) + ldsw), 16, 0, 0); \
        __builtin_amdgcn_global_load_lds((const unsigned*)((const char*)(gbase) + (v1)), (LAS unsigned*)(lds + (bufoff) + ldsw + 8192), 16, 0, 0); } while (0)
#define PG8_STAGEB(bufoff, gbase) PG8_STAGE2(bufoff, gbase, voffB[0], voffB[1])
#define PG8_STAGEA(bufoff, gbase, h, nx) PG8_STAGE2(bufoff, gbase, ((GATHER && (nx)) ? voffAn[h][0] : voffA[h][0]), ((GATHER && (nx)) ? voffAn[h][1] : voffA[h][1]))
#define PG8_LD32(p) __builtin_bit_cast(i32x8, __builtin_shufflevector(*(const LAS u32x4*)(p), *(const LAS u32x4*)((p) + 1024), 0, 1, 2, 3, 4, 5, 6, 7))
#define PG8_LDA(dst, b, h) do { _Pragma("unroll") for (int m = 0; m < 4; ++m) { if constexpr (F8) dst##8[m] = PG8_LD32(lds + PG8_SA(b, h) + aoff + m * 2048); \
        else { _Pragma("unroll") for (int k = 0; k < 2; ++k) dst[m][k] = *(const LAS bf16x8*)(lds + PG8_SA(b, h) + aoff + m * 2048 + k * 1024); } } } while (0)
#define PG8_LDB(dst, b, h) do { _Pragma("unroll") for (int n = 0; n < 2; ++n) { if constexpr (F8) dst##8[n] = PG8_LD32(lds + PG8_SB(b, h) + boff + n * 2048); \
        else { _Pragma("unroll") for (int k = 0; k < 2; ++k) dst[n][k] = *(const LAS bf16x8*)(lds + PG8_SB(b, h) + boff + n * 2048 + k * 1024); } } } while (0)
#define PG8_MMA(ai, bj, At, Bt) do { __builtin_amdgcn_s_setprio(1); _Pragma("unroll") for (int m = 0; m < 4; ++m) _Pragma("unroll") for (int n = 0; n < 2; ++n) { \
        if constexpr (F8) asm volatile("v_mfma_scale_f32_16x16x128_f8f6f4 %0, %1, %2, %0, %3, %3 op_sel_hi:[0,0,0]" : "+v"(acc[ai][bj][m][n]) : "v"(Bt##8[n]), "v"(At##8[m]), "v"(sc8));   \
        else { _Pragma("unroll") for (int k = 0; k < 2; ++k) acc[ai][bj][m][n] = __builtin_amdgcn_mfma_f32_16x16x32_bf16(Bt[n][k], At[m][k], acc[ai][bj][m][n], 0, 0, 0); } } \
        __builtin_amdgcn_s_setprio(0); } while (0)
#define PG8_WAIT_V(n) asm volatile("s_waitcnt vmcnt(" #n ")" ::: "memory")
#define PG8_WAIT_L(n) asm volatile("s_waitcnt lgkmcnt(" #n ")" ::: "memory")
#define PG8_BAR __builtin_amdgcn_s_barrier()
#define PG8_SCHED __builtin_amdgcn_sched_barrier(0)
    Unit cur, nxt; int ui = 0;
    if (!S.next(0, cur)) return;
    if (GATHER) {
#pragma unroll
        for (int h = 0; h < 2; ++h)
#pragma unroll
            for (int i = 0; i < 2; ++i) voffA[h][i] = S.row_off(cur, h * HALF + RA[i]) + (unsigned)CA[i] * 2u;
    }
    f32x4 acc[2][2][4][2];
#pragma unroll
    for (int a = 0; a < 2; ++a)
#pragma unroll
        for (int b = 0; b < 2; ++b)
#pragma unroll
            for (int m = 0; m < 4; ++m)
#pragma unroll
                for (int n = 0; n < 2; ++n) acc[a][b][m][n] = (f32x4){0.f, 0.f, 0.f, 0.f};
    unsigned sc8 = 0x7f7f7f7fu; asm volatile("" : "+v"(sc8));
    bf16x8 At[4][2], B0[2][2], B1[2][2]; i32x8 At8[4], B08[2], B18[2];
    const char* cA = cur.A; const char* cB = cur.B;
    PG8_STAGEB(PG8_SB(0, 0), cB); PG8_STAGEB(PG8_SB(0, 1), cB + hstepB); PG8_STAGEA(PG8_SA(0, 0), cA, 0, false); PG8_STAGEA(PG8_SA(0, 1), cA, 1, false);
    if (wr == 1) PG8_BAR;
    PG8_WAIT_V(2); PG8_BAR;
    PG8_STAGEB(PG8_SB(1, 0), cB + kstep); PG8_STAGEA(PG8_SA(1, 0), cA + kstep, 0, false); PG8_STAGEB(PG8_SB(1, 1), cB + hstepB + kstep);
    PG8_WAIT_V(6); PG8_BAR;
    for (;;) {
        const bool has_next = S.next(ui + 1, nxt);
        if (GATHER) {
#pragma unroll
            for (int h = 0; h < 2; ++h)
#pragma unroll
                for (int i = 0; i < 2; ++i) voffAn[h][i] = has_next ? (S.row_off(nxt, h * HALF + RA[i]) + (unsigned)CA[i] * 2u) : voffA[h][i];
        }
        const char* nA = has_next ? nxt.A : cA; const char* nB = has_next ? nxt.B : cB;
        const bool full = cur.nvalid > HALF;
        for (int t = 0; t < nt; t += 2) {
            if constexpr (MIDK) { if (t == nt / 2) { PG8_SCHED; E.mid(acc, cur, wr, wc, fr, fq); PG8_SCHED; } }
            const bool last = (t == nt - 2);
            const char* a1 = cA + (size_t)(t + 1) * kstep;
            const char* a2 = last ? nA : cA + (size_t)(t + 2) * kstep; const char* b2 = last ? nB : cB + (size_t)(t + 2) * kstep;
            const char* a3 = a2 + kstep; const char* b3 = b2 + kstep;
            PG8_LDB(B0, 0, 0); PG8_LDB(B1, 0, 1); PG8_SCHED; PG8_LDA(At, 0, 0); PG8_STAGEA(PG8_SA(1, 1), a1, 1, false);
            PG8_WAIT_V(8); PG8_WAIT_L(0); PG8_BAR; PG8_MMA(0, 0, At, B0); PG8_MMA(0, 1, At, B1); PG8_BAR; PG8_SCHED;
            PG8_LDA(At, 0, 1); PG8_STAGEB(PG8_SB(0, 0), b2); PG8_STAGEB(PG8_SB(0, 1), b2 + hstepB); PG8_STAGEA(PG8_SA(0, 0), a2, 0, last);
            PG8_WAIT_V(8); PG8_WAIT_L(0); PG8_BAR; if (!LIGHT || full) { PG8_MMA(1, 0, At, B0); PG8_MMA(1, 1, At, B1); } PG8_BAR; PG8_SCHED;
            PG8_LDB(B0, 1, 0); PG8_LDB(B1, 1, 1); PG8_SCHED; PG8_LDA(At, 1, 0); PG8_STAGEA(PG8_SA(0, 1), a2, 1, last);
            PG8_WAIT_V(8); PG8_WAIT_L(0); PG8_BAR; PG8_MMA(0, 0, At, B0); PG8_MMA(0, 1, At, B1); PG8_BAR; PG8_SCHED;
            PG8_LDA(At, 1, 1); PG8_STAGEB(PG8_SB(1, 0), b3); PG8_STAGEB(PG8_SB(1, 1), b3 + hstepB); PG8_STAGEA(PG8_SA(1, 0), a3, 0, last);
            PG8_WAIT_V(8); PG8_WAIT_L(0); PG8_BAR; if (!LIGHT || full) { PG8_MMA(1, 0, At, B0); PG8_MMA(1, 1, At, B1); } PG8_BAR; PG8_SCHED;
        }
        if (wr == 0) PG8_BAR;
        if constexpr (F8) asm volatile("s_nop 7\n\ts_nop 7\n\ts_nop 7" ::: "memory");
        E(acc, cur, wr, wc, fr, fq);
        if (!has_next) break;
#pragma unroll
        for (int a = 0; a < 2; ++a)
#pragma unroll
            for (int b = 0; b < 2; ++b)
#pragma unroll
                for (int m = 0; m < 4; ++m)
#pragma unroll
                    for (int n = 0; n < 2; ++n) acc[a][b][m][n] = (f32x4){0.f, 0.f, 0.f, 0.f};
        cur = nxt; cA = nA; cB = nB; ++ui;
        if (GATHER) {
#pragma unroll
            for (int h = 0; h < 2; ++h)
#pragma unroll
                for (int i = 0; i < 2; ++i) voffA[h][i] = voffAn[h][i];
        }
        if (wr == 1) PG8_BAR;
    }
    PG8_WAIT_V(0);
    PG8_BAR;
#undef PG8_SA
#undef PG8_SB
#undef PG8_STAGE2
#undef PG8_STAGEA
#undef PG8_STAGEB
#undef PG8_LDA
#undef PG8_LDB
#undef PG8_MMA
#undef PG8_LD32
#undef PG8_WAIT_V
#undef PG8_WAIT_L
#undef PG8_BAR
#undef PG8_SCHED
}

struct EpiProj {
    static constexpr bool PERM = true;
    bf16_t* out; const float* gq; const float* gk; int cmode; float si;
    __device__ __forceinline__ void operator()(const f32x4 (&acc)[2][2][4][2], const Unit& u, int wr, int wc, int fr, int fq) const {
        const int c0 = (cmode == 0) ? u.col0 : (cmode == 1 ? (u.col0 < 1024 ? u.col0 : u.col0 + 1024) : (u.col0 < 1024 ? u.col0 + 1024 : u.col0 + 2048));
        const int pn = c0 >> 8;
        const int row0 = u.row0 + wr * 64 + fr, colb = c0 + 64 * wc + 8 * fq;
        if (pn < 4) {
            const float* g = (pn < 2) ? gq : gk; const float post = (pn < 2) ? 0.125f : 1.0f;
            f32x4 gv[2][2];
#pragma unroll
            for (int bj = 0; bj < 2; ++bj)
#pragma unroll
                for (int n = 0; n < 2; ++n) gv[bj][n] = *(const f32x4*)(g + 32 * bj + 8 * fq + 4 * n) * post;
#pragma unroll
            for (int ai = 0; ai < 2; ++ai)
#pragma unroll
                for (int m = 0; m < 4; ++m) {
                    float ss = 0.f;
#pragma unroll
                    for (int bj = 0; bj < 2; ++bj)
#pragma unroll
                        for (int n = 0; n < 2; ++n) { const f32x4 x = acc[ai][bj][m][n]; ss += (x[0] * x[0] + x[1] * x[1]) + (x[2] * x[2] + x[3] * x[3]); }
                    ss += __shfl_xor(ss, 16); ss += __shfl_xor(ss, 32);
                    const float rstd = rsqrtf(ss * (si * si) * (1.0f / HD) + RMS_EPS) * si;
                    bf16_t* rowp = out + (size_t)(row0 + ai * HALF + m * 16) * INW + colb;
#pragma unroll
                    for (int bj = 0; bj < 2; ++bj) { const f32x4 v0 = acc[ai][bj][m][0] * rstd * gv[bj][0], v1 = acc[ai][bj][m][1] * rstd * gv[bj][1];
                        u32x4 w; w.x = pack2(v0[0], v0[1]); w.y = pack2(v0[2], v0[3]); w.z = pack2(v1[0], v1[1]); w.w = pack2(v1[2], v1[3]);
                        *(u32x4*)(rowp + 32 * bj) = w; }
                }
        } else {
            const bool sg = pn >= 8;
#pragma unroll
            for (int ai = 0; ai < 2; ++ai)
#pragma unroll
                for (int m = 0; m < 4; ++m) {
                    const size_t rr = (size_t)(row0 + ai * HALF + m * 16);
#pragma unroll
                    for (int bj = 0; bj < 2; ++bj) { const f32x4 v0 = acc[ai][bj][m][0], v1 = acc[ai][bj][m][1];
                        if (sg) {
                            unsigned q[8];
#pragma unroll
                            for (int j = 0; j < 4; ++j) { q[j] = (unsigned)fmaxf(sigmoidf_(v0[j] * si) * 255.0f + 0.5f, 1.0f); q[4 + j] = (unsigned)fmaxf(sigmoidf_(v1[j] * si) * 255.0f + 0.5f, 1.0f); }
                            u32x2 w; w.x = q[0] | (q[1] << 8) | (q[2] << 16) | (q[3] << 24); w.y = q[4] | (q[5] << 8) | (q[6] << 16) | (q[7] << 24);
                            *(u32x2*)((unsigned char*)(out + rr * INW) + 4096 + (colb - 2048) + 32 * bj) = w;
                        } else {
                            u32x4 w; w.x = pack2(v0[0], v0[1]); w.y = pack2(v0[2], v0[3]); w.z = pack2(v1[0], v1[1]); w.w = pack2(v1[2], v1[3]);
                            *(u32x4*)(out + rr * INW + colb + 32 * bj) = w; }
                    }
                }
        }
    }
};
__device__ __forceinline__ void unpack_u8x8(const u32x2 w, float (&f)[8]) {
    f[0] = (float)(w.x & 255u); f[1] = (float)((w.x >> 8) & 255u); f[2] = (float)((w.x >> 16) & 255u); f[3] = (float)(w.x >> 24);
    f[4] = (float)(w.y & 255u); f[5] = (float)((w.y >> 8) & 255u); f[6] = (float)((w.y >> 16) & 255u); f[7] = (float)(w.y >> 24);
}
struct EpiGateMerge {
    static constexpr bool PERM = true;
    const bf16_t* proj; bf16_t* out;
    __device__ __forceinline__ void mid(f32x4 (&acc)[2][2][4][2], const Unit& u, int wr, int wc, int fr, int fq) const {
        asm volatile("" : "+v"(fr), "+v"(fq));
        const int row0 = u.row0 + wr * 64 + fr, col0 = u.col0 + wc * 32 + 8 * fq;
#pragma unroll
        for (int ai = 0; ai < 2; ++ai)
#pragma unroll
            for (int m = 0; m < 4; ++m) {
                const unsigned char* gr = (const unsigned char*)(proj + (size_t)(row0 + ai * HALF + m * 16) * INW) + 4096 + col0;
#pragma unroll
                for (int bj = 0; bj < 2; ++bj) {
                    const u32x2 ga = *(const u32x2*)(gr + bj * HALF), gp = *(const u32x2*)(gr + 1024 + bj * HALF);
                    float fa[8], fp[8]; unpack_u8x8(ga, fa); unpack_u8x8(gp, fp);
#pragma unroll
                    for (int j = 0; j < 4; ++j) { acc[ai][bj][m][0][j] *= fa[j] * __builtin_amdgcn_rcpf(fp[j]); acc[ai][bj][m][1][j] *= fa[4 + j] * __builtin_amdgcn_rcpf(fp[4 + j]); }
                }
                if (m & 1) asm volatile("" ::: "memory");
            }
    }
    __device__ __forceinline__ void operator()(const f32x4 (&acc)[2][2][4][2], const Unit& u, int wr, int wc, int fr, int fq) const {
        const int row0 = u.row0 + wr * 64 + fr, col0 = u.col0 + wc * 32 + 8 * fq;
#pragma unroll
        for (int ai = 0; ai < 2; ++ai)
#pragma unroll
            for (int m = 0; m < 4; ++m) {
                const size_t r = (size_t)(row0 + ai * HALF + m * 16);
                const unsigned char* gr = (const unsigned char*)(proj + r * INW) + 4096 + 1024 + col0;
#pragma unroll
                for (int bj = 0; bj < 2; ++bj) {
                    const u32x2 gp = *(const u32x2*)(gr + bj * HALF);
                    float fp[8]; unpack_u8x8(gp, fp);
                    const f32x4 a0 = acc[ai][bj][m][0] * (1.0f / 255.0f), a1 = acc[ai][bj][m][1] * (1.0f / 255.0f);
                    u32x4 w; w.x = pack2(a0[0] * fp[0], a0[1] * fp[1]); w.y = pack2(a0[2] * fp[2], a0[3] * fp[3]); w.z = pack2(a1[0] * fp[4], a1[1] * fp[5]); w.w = pack2(a1[2] * fp[6], a1[3] * fp[7]);
                    *(u32x4*)(out + r * DM + bj * HALF + col0) = w;
                }
            }
    }
};
template <bool XF32> struct EpiResid {
    static constexpr bool PERM = true;
    const float* xf; bf16_t* xb;
    __device__ __forceinline__ void operator()(const f32x4 (&acc)[2][2][4][2], const Unit& u, int wr, int wc, int fr, int fq) const {
        const int row0 = u.row0 + wr * 64 + fr, col0 = u.col0 + wc * 32 + 8 * fq;
#pragma unroll
        for (int ai = 0; ai < 2; ++ai)
#pragma unroll
            for (int m = 0; m < 4; ++m) { const size_t off = (size_t)(row0 + ai * HALF + m * 16) * DM + col0;
#pragma unroll
                for (int bj = 0; bj < 2; ++bj) {
                    float x[8];
                    if (XF32) { const f32x4 a = *(const f32x4*)(xf + off + bj * HALF), b = *(const f32x4*)(xf + off + bj * HALF + 4);
                        x[0] = a[0]; x[1] = a[1]; x[2] = a[2]; x[3] = a[3]; x[4] = b[0]; x[5] = b[1]; x[6] = b[2]; x[7] = b[3]; }
                    else { const u32x4 t = *(const u32x4*)(xb + off + bj * HALF);
                        x[0] = bflo(t.x); x[1] = bfhi(t.x); x[2] = bflo(t.y); x[3] = bfhi(t.y); x[4] = bflo(t.z); x[5] = bfhi(t.z); x[6] = bflo(t.w); x[7] = bfhi(t.w); }
                    const f32x4 a0 = acc[ai][bj][m][0], a1 = acc[ai][bj][m][1];
                    u32x4 w; w.x = pack2(x[0] + a0[0], x[1] + a0[1]); w.y = pack2(x[2] + a0[2], x[3] + a0[3]); w.z = pack2(x[4] + a1[0], x[5] + a1[1]); w.w = pack2(x[6] + a1[2], x[7] + a1[3]);
                    *(u32x4*)(xb + off + bj * HALF) = w;
                }
            }
    }
};
template <bool F8> struct EpiSwiGLU {
    static constexpr bool PERM = true;
    void* act;
    __device__ __forceinline__ void operator()(const f32x4 (&acc)[2][2][4][2], const Unit& u, int wr, int wc, int fr, int fq) const {
        const int row0 = u.row0 + wr * 64 + fr, col0 = (u.col0 >> 1) + wc * 32 + 8 * fq;
        const float si = F8 ? (1.0f / W8_SCALE) : 1.0f, so = F8 ? A8_SCALE : 1.0f;
#pragma unroll
        for (int ai = 0; ai < 2; ++ai)
#pragma unroll
            for (int m = 0; m < 4; ++m) {
                float o[8];
#pragma unroll
                for (int n = 0; n < 2; ++n)
#pragma unroll
                    for (int j = 0; j < 4; ++j) { const float a = acc[ai][0][m][n][j] * si, b = acc[ai][1][m][n][j] * (si * so); o[4 * n + j] = a * sigmoidf_(a) * b; }
                const size_t off = (size_t)(row0 + ai * HALF + m * 16) * EH + col0;
                if (F8) { u32x2 w; w.x = pack4_fp8(o[0], o[1], o[2], o[3]); w.y = pack4_fp8(o[4], o[5], o[6], o[7]); *(u32x2*)((unsigned char*)act + off) = w; }
                else { u32x4 w; w.x = pack2(o[0], o[1]); w.y = pack2(o[2], o[3]); w.z = pack2(o[4], o[5]); w.w = pack2(o[6], o[7]); *(u32x4*)((bf16_t*)act + off) = w; }
            }
    }
};
template <bool F8> struct EpiDown {
    static constexpr bool PERM = true;
    bf16_t* yb; const float* tokW;
    __device__ __forceinline__ void operator()(const f32x4 (&acc)[2][2][4][2], const Unit& u, int wr, int wc, int fr, int fq) const {
        const int col0 = u.col0 + wc * 32 + 8 * fq;
        const float si = F8 ? (1.0f / (W8_SCALE * A8_SCALE)) : 1.0f;
#pragma unroll
        for (int ai = 0; ai < 2; ++ai)
#pragma unroll
            for (int m = 0; m < 4; ++m) {
                const int rl = wr * 64 + fr + ai * HALF + m * 16;
                const float w = rl < u.nvalid ? tokW[u.j0 + rl] * si : 0.f;
#pragma unroll
                for (int bj = 0; bj < 2; ++bj) { const f32x4 v0 = acc[ai][bj][m][0] * w, v1 = acc[ai][bj][m][1] * w;
                    u32x4 o; o.x = pack2(v0[0], v0[1]); o.y = pack2(v0[2], v0[3]); o.z = pack2(v1[0], v1[1]); o.w = pack2(v1[2], v1[3]);
                    *(u32x4*)(yb + (size_t)(u.row0 + rl) * DM + col0 + bj * HALF) = o; }
            }
    }
};
}

constexpr int ATT_K_OFF = 0, ATT_V_OFF = 49152;
__device__ __forceinline__ unsigned kv_off(unsigned row, unsigned ch) { return row * 128u + 16u * (ch ^ (((row >> 1) & 7u) ^ ((row & 2u) << 1))); }

struct AttnU { int tok0, d, blk, g, h; };
__device__ __forceinline__ AttnU attn_decode(int uidx) {
    const int bh = uidx / 48, r48 = uidx % 48, g = r48 >> 4, rr = r48 & 15;
    AttnU U; U.g = g; U.h = bh & 7;
    U.d = (g == 0) ? 1 : (g == 1 ? 4 : 16);
    const int c = (g == 0) ? 0 : (g == 1 ? (rr >> 2) : rr);
    U.blk = (g == 0) ? rr : (g == 1 ? (rr & 3) : 0);
    U.tok0 = (bh >> 3) * SEQ + c;
    return U;
}
__device__ __forceinline__ void attn_load_q(const AttnU& U, const bf16_t* __restrict__ proj, int wid, int lane, bf16x8 (&qn)[4]) {
    const size_t qt = (size_t)(U.tok0 + (256 * U.blk + 32 * wid + (lane & 31)) * U.d);
#pragma unroll
    for (int ks = 0; ks < 4; ++ks) qn[ks] = *(const bf16x8*)(proj + qt * INW + U.h * HD + 16 * ks + 8 * (lane >> 5));
}
__device__ __forceinline__ void attn_load(const AttnU& U, const bf16_t* __restrict__ proj, int tid, u32x4 (&kr)[6], u32x4 (&vr)[6]) {
    const int kbase = 256 * U.blk - 128, kr_min = (U.blk == 0) ? 128 : 0;
#pragma unroll
    for (int i = 0; i < 6; ++i) {
        const int idx = tid + NTHREADS * i, row = idx >> 3, ch = idx & 7;
        if (row >= kr_min) {
            const size_t t = (size_t)(U.tok0 + (kbase + row) * U.d);
            kr[i] = *(const u32x4*)(proj + t * INW + AW + U.h * HD + ch * 8);
            vr[i] = *(const u32x4*)(proj + t * INW + 2 * AW + U.h * HD + ch * 8);
        }
    }
}
__device__ __forceinline__ void attn_lds_store(const AttnU& U, LAS unsigned char* lds, int tid, const u32x4 (&kr)[6], const u32x4 (&vr)[6]) {
    const int kr_min = (U.blk == 0) ? 128 : 0;
#pragma unroll
    for (int i = 0; i < 6; ++i) {
        const int idx = tid + NTHREADS * i, row = idx >> 3, ch = idx & 7;
        if (row >= kr_min) { *(LAS u32x4*)(lds + ATT_K_OFF + kv_off(row, ch)) = kr[i]; *(LAS u32x4*)(lds + ATT_V_OFF + kv_off(row, ch)) = vr[i]; }
    }
}
__device__ __forceinline__ void attn_compute(const AttnU& U, LAS unsigned char* lds, const bf16x8 (&qf)[4], bf16_t* __restrict__ og, f32x2* __restrict__ ml, int wid, int lane) {
    const int blk = U.blk, g = U.g, h = U.h;
    const size_t qt = (size_t)(U.tok0 + (256 * blk + 32 * wid + (lane & 31)) * U.d);
    const int kt_min = (blk == 0) ? max(0, 4 - wid) : 0;
    const int hq = lane >> 5, qi = lane & 31;
    f32x16 S[5];
#pragma unroll
    for (int kt = 0; kt < 5; ++kt) {
#pragma unroll
        for (int i = 0; i < 16; ++i) S[kt][i] = 0.f;
        if (kt >= kt_min) {
            const unsigned krow = (unsigned)(32 * wid + 32 * kt + qi);
#pragma unroll
            for (int ks = 0; ks < 4; ++ks) {
                const bf16x8 kf = *(const LAS bf16x8*)(lds + ATT_K_OFF + kv_off(krow, (unsigned)(2 * ks + hq)));
                S[kt] = __builtin_amdgcn_mfma_f32_32x32x16_bf16(kf, qf[ks], S[kt], 0, 0, 0);
            }
        }
    }
    const float NINF = -__builtin_inff(), L2E = 1.4426950408889634f;
    float mx = NINF;
#pragma unroll
    for (int kt = 0; kt < 5; ++kt) {
        if (kt >= kt_min) {
#pragma unroll
            for (int i = 0; i < 16; ++i) {
                const int row = (i & 3) + 8 * (i >> 2) + 4 * hq;
                if (kt == 0) S[kt][i] = (row >= qi) ? S[kt][i] : NINF;
                if (kt == 4) S[kt][i] = (row <= qi) ? S[kt][i] : NINF;
            }
#pragma unroll
            for (int i = 0; i < 16; i += 2) mx = fmaxf(mx, fmaxf(S[kt][i], S[kt][i + 1]));
        }
    }
    mx = fmaxf(mx, __shfl_xor(mx, 32));
    const float mb = mx * L2E;
    float lsum = 0.f;
#pragma unroll
    for (int kt = 0; kt < 5; ++kt) {
        if (kt >= kt_min) {
#pragma unroll
            for (int i = 0; i < 16; ++i) { const float p = __builtin_amdgcn_exp2f(__builtin_fmaf(S[kt][i], L2E, -mb)); S[kt][i] = p; lsum += p; }
        }
    }
    lsum += __shfl_xor(lsum, 32);
    f32x16 O[2];
#pragma unroll
    for (int dt = 0; dt < 2; ++dt)
#pragma unroll
        for (int i = 0; i < 16; ++i) O[dt][i] = 0.f;
    const unsigned blkq = (lane >> 4) & 1, q4 = (lane & 15) >> 2, p4 = lane & 3;
    const unsigned vbase = (unsigned)(size_t)(lds + ATT_V_OFF) + (unsigned)(32 * wid) * 128u;
    unsigned tb[2][2];
#pragma unroll
    for (int t = 0; t < 2; ++t)
#pragma unroll
        for (int dt = 0; dt < 2; ++dt) tb[t][dt] = vbase + kv_off((unsigned)(8 * t + 4 * hq) + q4, (unsigned)(4 * dt) + 2 * blkq + (p4 >> 1)) + 8 * (p4 & 1);
#define ATT_TR_ISSUE(V, KT) asm volatile("ds_read_b64_tr_b16 %0, %8\n\tds_read_b64_tr_b16 %1, %9\n\tds_read_b64_tr_b16 %2, %10\n\tds_read_b64_tr_b16 %3, %11\n\t" \
        "ds_read_b64_tr_b16 %4, %12\n\tds_read_b64_tr_b16 %5, %13\n\tds_read_b64_tr_b16 %6, %14\n\tds_read_b64_tr_b16 %7, %15" \
        : "=&v"(V[0][0][0]), "=&v"(V[0][0][1]), "=&v"(V[0][1][0]), "=&v"(V[0][1][1]), "=&v"(V[1][0][0]), "=&v"(V[1][0][1]), "=&v"(V[1][1][0]), "=&v"(V[1][1][1]) \
        : "v"(tb[0][0] + 4096u * (KT)), "v"(tb[1][0] + 4096u * (KT)), "v"(tb[0][1] + 4096u * (KT)), "v"(tb[1][1] + 4096u * (KT)), \
          "v"(tb[0][0] + 4096u * (KT) + 2048u), "v"(tb[1][0] + 4096u * (KT) + 2048u), "v"(tb[0][1] + 4096u * (KT) + 2048u), "v"(tb[1][1] + 4096u * (KT) + 2048u) : "memory")
#define ATT_TR_WAIT(V) asm volatile("s_waitcnt lgkmcnt(0)" : "+v"(V[0][0][0]), "+v"(V[0][0][1]), "+v"(V[0][1][0]), "+v"(V[0][1][1]), "+v"(V[1][0][0]), "+v"(V[1][0][1]), "+v"(V[1][1][0]), "+v"(V[1][1][1]) :: "memory")
#define ATT_PV(V, KT) do { _Pragma("unroll") for (int s = 0; s < 2; ++s) { \
        u32x4 pw; pw.x = pack2(S[KT][8 * s + 0], S[KT][8 * s + 1]); pw.y = pack2(S[KT][8 * s + 2], S[KT][8 * s + 3]); pw.z = pack2(S[KT][8 * s + 4], S[KT][8 * s + 5]); pw.w = pack2(S[KT][8 * s + 6], S[KT][8 * s + 7]); \
        const bf16x8 pf = __builtin_bit_cast(bf16x8, pw); \
        u32x4 f0; f0.x = V[s][0][0].x; f0.y = V[s][0][0].y; f0.z = V[s][0][1].x; f0.w = V[s][0][1].y; \
        u32x4 f1; f1.x = V[s][1][0].x; f1.y = V[s][1][0].y; f1.z = V[s][1][1].x; f1.w = V[s][1][1].y; \
        O[0] = __builtin_amdgcn_mfma_f32_32x32x16_bf16(__builtin_bit_cast(bf16x8, f0), pf, O[0], 0, 0, 0); \
        O[1] = __builtin_amdgcn_mfma_f32_32x32x16_bf16(__builtin_bit_cast(bf16x8, f1), pf, O[1], 0, 0, 0); } } while (0)
    u32x2 va[2][2][2];
#pragma unroll
    for (int kt = 0; kt < 5; ++kt) {
        if (kt >= kt_min) { ATT_TR_ISSUE(va, kt); ATT_TR_WAIT(va); ATT_PV(va, kt); }
    }
#undef ATT_TR_ISSUE
#undef ATT_TR_WAIT
#undef ATT_PV
    const float inv = 1.0f / lsum;
    bf16_t* orow = og + ((size_t)g * NTOK + qt) * AW + h * HD;
#pragma unroll
    for (int dt = 0; dt < 2; ++dt)
#pragma unroll
        for (int gq4 = 0; gq4 < 4; ++gq4) {
            u32x2 w; w.x = pack2(O[dt][4 * gq4 + 0] * inv, O[dt][4 * gq4 + 1] * inv); w.y = pack2(O[dt][4 * gq4 + 2] * inv, O[dt][4 * gq4 + 3] * inv);
            *(u32x2*)(orow + 32 * dt + 8 * gq4 + 4 * hq) = w;
        }
    if (lane < 32) ml[((size_t)g * NTOK + qt) * 8 + h] = (f32x2){mx, lsum};
    __syncthreads();
}

struct TrDesc { const float* src; bf16_t* dst; int N, K; };
__device__ __forceinline__ void tr_load(const TrDesc& d, int lane, f32x4 (&r)[8]) {
#pragma unroll
    for (int i = 0; i < 8; ++i) r[i] = __builtin_nontemporal_load((const f32x4*)(d.src + (size_t)((lane >> 3) + 8 * i) * d.N + 4 * (lane & 7)));
}
__device__ __forceinline__ void tr_store(const TrDesc& d, LAS float* scr, int lane, const f32x4 (&r)[8]) {
#pragma unroll
    for (int i = 0; i < 8; ++i) { LAS float* p = scr + ((lane >> 3) + 8 * i) * 33 + 4 * (lane & 7); p[0] = r[i][0]; p[1] = r[i][1]; p[2] = r[i][2]; p[3] = r[i][3]; }
    const int c = lane & 7;
#pragma unroll
    for (int j = 0; j < 4; ++j) { const int n = (lane >> 3) + 8 * j; const LAS float* q = scr + (8 * c) * 33 + n;
        u32x4 o; o.x = pack2(q[0 * 33], q[1 * 33]); o.y = pack2(q[2 * 33], q[3 * 33]); o.z = pack2(q[4 * 33], q[5 * 33]); o.w = pack2(q[6 * 33], q[7 * 33]);
        *(u32x4*)(d.dst + (size_t)n * d.K + 8 * c) = o; }
}
struct ExpertItems {
    const float* weg; const float* weu; const float* wed; bf16_t* WguT; bf16_t* WdT;
    static constexpr int TOTAL = 3 * NEXP * 256;
    __device__ __forceinline__ TrDesc operator()(int it) const {
        const int which = it >> 13, r = it & 8191, e = r >> 8, item = r & 255; TrDesc d;
        if (which < 2) { const int kb = item >> 4, nb = item & 15, k0 = 64 * kb, n0 = 32 * nb, nn0 = (n0 >> 7) * 256 + which * 128 + (n0 & 127);
            d.src = (which == 0 ? weg : weu) + (size_t)e * DM * EH + (size_t)k0 * EH + n0; d.dst = WguT + (size_t)e * DM * DM + (size_t)nn0 * DM + k0; d.N = EH; d.K = DM; }
        else { const int kb = item >> 5, nb = item & 31, k0 = 64 * kb, n0 = 32 * nb;
            d.src = wed + (size_t)e * EH * DM + (size_t)k0 * DM + n0; d.dst = WdT + (size_t)e * DM * EH + (size_t)n0 * EH + k0; d.N = DM; d.K = EH; }
        return d;
    }
};
struct SmallItems {
    const float* win; const float* wa; const float* wo; bf16_t* WinT; bf16_t* WaT; bf16_t* WoT;
    static constexpr int NWIN = INPROJ_FP8 ? 1024 : 2048;
    static constexpr int PER = NWIN + 256 + 512, TOTAL = 2 * PER;
    __device__ __forceinline__ TrDesc operator()(int it) const {
        const int l = it / PER, r = it % PER; TrDesc d;
        if (r < NWIN) {
            if (INPROJ_FP8) { const int kb = r >> 6, nb = r & 63, nv0 = 32 * nb, n0 = nv0 < 1024 ? nv0 + 1024 : nv0 + 2048; d.src = win + (size_t)l * DM * INW + (size_t)(64 * kb) * INW + n0; d.dst = WinT + (size_t)l * 2048 * DM + (size_t)nv0 * DM + 64 * kb; }
            else { const int kb = r >> 7, nb = r & 127; d.src = win + (size_t)l * DM * INW + (size_t)(64 * kb) * INW + 32 * nb; d.dst = WinT + (size_t)l * INW * DM + (size_t)(32 * nb) * DM + 64 * kb; }
            d.N = INW; d.K = DM; }
        else if (r < NWIN + 256) { const int q = r - NWIN, kb = q >> 5, nb = q & 31; d.src = wa + (size_t)l * AW * DM + (size_t)(64 * kb) * DM + 32 * nb; d.dst = WaT + (size_t)l * DM * DM + (size_t)(32 * nb) * DM + 64 * kb; d.N = DM; d.K = DM; }
        else { const int q = r - NWIN - 256, kb = q >> 5, nb = q & 31; d.src = wo + (size_t)l * DM * DM + (size_t)(64 * kb) * DM + 32 * nb; d.dst = WoT + (size_t)l * DM * DM + (size_t)(32 * nb) * DM + 64 * kb; d.N = DM; d.K = DM; }
        return d;
    }
};
template <class Items>
__device__ __forceinline__ void convert_items(const Items& I, LAS float* scr, int lane, int gw, int NGW) {
    f32x4 ra[8], rb[8];
    int it = gw;
    if (it >= Items::TOTAL) return;
    TrDesc da = I(it), db = da;
    tr_load(da, lane, ra);
    for (;;) {
        int it2 = it + NGW;
        if (it2 < Items::TOTAL) { db = I(it2); tr_load(db, lane, rb); }
        tr_store(da, scr, lane, ra);
        it = it2; if (it >= Items::TOTAL) break;
        it2 = it + NGW;
        if (it2 < Items::TOTAL) { da = I(it2); tr_load(da, lane, ra); }
        tr_store(db, scr, lane, rb);
        it = it2; if (it >= Items::TOTAL) break;
    }
}
__device__ __forceinline__ int tr8_swz(int k) { return (k & 31) ^ ((k >> 5) << 3); }
__device__ __forceinline__ void tr_load8(const TrDesc& d, int lane, f32x4 (&r)[16]) {
#pragma unroll
    for (int i = 0; i < 16; ++i) r[i] = __builtin_nontemporal_load((const f32x4*)(d.src + (size_t)((lane >> 3) + 8 * i) * d.N + 4 * (lane & 7)));
}
__device__ __forceinline__ void tr_write8(LAS float* scr, int lane, const f32x4 (&r)[16]) {
#pragma unroll
    for (int i = 0; i < 16; ++i) { const int kk = (lane >> 3) + 8 * i, sw = tr8_swz(kk), n4 = 4 * (lane & 7); LAS float* p = scr + kk * 32;
        p[(n4 + 0) ^ sw] = r[i][0]; p[(n4 + 1) ^ sw] = r[i][1]; p[(n4 + 2) ^ sw] = r[i][2]; p[(n4 + 3) ^ sw] = r[i][3]; }
}
__device__ __forceinline__ void tr_out8(const TrDesc& d, const LAS float* scr, int lane) {
    const int c = lane >> 3;
#pragma unroll
    for (int j = 0; j < 4; ++j) { const int n = (lane & 7) + 8 * j; float f[16];
#pragma unroll
        for (int q = 0; q < 16; ++q) { const int k = 16 * c + q; f[q] = scr[k * 32 + (n ^ tr8_swz(k))] * W8_SCALE; }
        u32x4 o; o.x = pack4_fp8(f[0], f[1], f[2], f[3]); o.y = pack4_fp8(f[4], f[5], f[6], f[7]); o.z = pack4_fp8(f[8], f[9], f[10], f[11]); o.w = pack4_fp8(f[12], f[13], f[14], f[15]);
        *(u32x4*)((unsigned char*)d.dst + (size_t)n * d.K + 16 * c) = o; }
}
struct ExpertItems8 {
    const float* weg; const float* weu; const float* wed; unsigned char* WguT; unsigned char* WdT;
    static constexpr int TOTAL = 3 * NEXP * 128;
    __device__ __forceinline__ TrDesc operator()(int it) const {
        const int which = it >> 12, r = it & 4095, e = r >> 7, item = r & 127; TrDesc d;
        if (which < 2) { const int kb = item >> 4, nb = item & 15, k0 = 128 * kb, n0 = 32 * nb, nn0 = (n0 >> 7) * 256 + which * 128 + (n0 & 127);
            d.src = (which == 0 ? weg : weu) + (size_t)e * DM * EH + (size_t)k0 * EH + n0; d.dst = (bf16_t*)(WguT + (size_t)e * DM * DM + (size_t)nn0 * DM + k0); d.N = EH; d.K = DM; }
        else { const int kb = item >> 5, nb = item & 31, k0 = 128 * kb, n0 = 32 * nb;
            d.src = wed + (size_t)e * EH * DM + (size_t)k0 * DM + n0; d.dst = (bf16_t*)(WdT + (size_t)e * DM * EH + (size_t)n0 * EH + k0); d.N = DM; d.K = EH; }
        return d;
    }
};
struct WinItems8 {
    const float* win; unsigned char* W8;
    static constexpr int TOTAL = 2 * 512;
    __device__ __forceinline__ TrDesc operator()(int it) const {
        const int l = it >> 9, r = it & 511, kb = r >> 6, nb = r & 63, nv0 = 32 * nb, n0 = nv0 < 1024 ? nv0 : nv0 + 1024; TrDesc d;
        d.src = win + (size_t)l * DM * INW + (size_t)(128 * kb) * INW + n0; d.dst = (bf16_t*)(W8 + (size_t)l * 2048 * DM + (size_t)nv0 * DM + 128 * kb); d.N = INW; d.K = DM;
        return d;
    }
};
template <class Items>
__device__ __forceinline__ void convert_items8(const Items& I, LAS float* scr, int lane, int gw, int NGW) {
    f32x4 r[16];
    int it = gw;
    if (it >= Items::TOTAL) return;
    TrDesc d = I(it);
    tr_load8(d, lane, r);
    for (;;) {
        tr_write8(scr, lane, r);
        const int it2 = it + NGW; const bool has = it2 < Items::TOTAL;
        TrDesc dn = d;
        if (has) { dn = I(it2); tr_load8(dn, lane, r); }
        tr_out8(d, scr, lane);
        if (!has) break;
        d = dn; it = it2;
    }
}
__device__ __forceinline__ void norm_row(const float* __restrict__ xr, const float* __restrict__ g, bf16_t* __restrict__ hr, unsigned char* __restrict__ h8, int lane) {
    f32x4 v[4]; float ss = 0.f;
#pragma unroll
    for (int i = 0; i < 4; ++i) { v[i] = *(const f32x4*)(xr + (i * 64 + lane) * 4); ss += (v[i][0] * v[i][0] + v[i][1] * v[i][1]) + (v[i][2] * v[i][2] + v[i][3] * v[i][3]); }
    ss = wave_sum(ss);
    const float rstd = rsqrtf(ss * (1.0f / DM) + RMS_EPS);
#pragma unroll
    for (int i = 0; i < 4; ++i) {
        const f32x4 gv = *(const f32x4*)(g + (i * 64 + lane) * 4);
        const float h0 = v[i][0] * rstd * gv[0], h1 = v[i][1] * rstd * gv[1], h2 = v[i][2] * rstd * gv[2], h3 = v[i][3] * rstd * gv[3];
        u32x2 w; w.x = pack2(h0, h1); w.y = pack2(h2, h3);
        *(u32x2*)(hr + (i * 64 + lane) * 4) = w;
        if (INPROJ_FP8) *(unsigned*)(h8 + (i * 64 + lane) * 4) = pack4_fp8(h0, h1, h2, h3);
    }
}
typedef const __attribute__((address_space(4))) float* cfp;
typedef const __attribute__((address_space(4))) f32x2* cf2p;
template <int W>
__device__ __forceinline__ void pool_path(const u32x4 (&r)[23], int pos0, bf16_t* __restrict__ pl, size_t t0, int c0) {
    float sum[8] = {0.f, 0.f, 0.f, 0.f, 0.f, 0.f, 0.f, 0.f}, f[8];
#pragma unroll
    for (int j = 1; j < W; ++j) { unpack8(r[15 - j], f);
#pragma unroll
        for (int c = 0; c < 8; ++c) sum[c] += f[c]; }
#pragma unroll
    for (int i = 0; i < 8; ++i) {
        float u[8]; unpack8(r[15 + i], u);
        if (i > 0) { unpack8(r[15 + i - W], f);
#pragma unroll
            for (int c = 0; c < 8; ++c) sum[c] -= f[c]; }
#pragma unroll
        for (int c = 0; c < 8; ++c) sum[c] += u[c];
        const float ic = 1.0f / (float)min(pos0 + i + 1, W);
        u32x4 o; o.x = pack2(sum[0] * ic - u[0], sum[1] * ic - u[1]); o.y = pack2(sum[2] * ic - u[2], sum[3] * ic - u[3]);
        o.z = pack2(sum[4] * ic - u[4], sum[5] * ic - u[5]); o.w = pack2(sum[6] * ic - u[6], sum[7] * ic - u[7]);
        *(u32x4*)(pl + (t0 + i) * DM + c0) = o;
    }
}
__device__ __forceinline__ int scan32_excl(int v, int lane, int& total) {
    int inc = v;
#pragma unroll
    for (int o = 1; o < 32; o <<= 1) { const int t = __shfl_up(inc, o, 32); if ((lane & 31) >= o) inc += t; }
    total = __shfl(inc, 31, 32);
    return inc - v;
}
__device__ __forceinline__ void build_moe_tables(LAS int* L, const unsigned* cnt) {
    { unsigned a_ = (unsigned)(size_t)L; asm volatile("" : "+s"(a_)); L = (LAS int*)(size_t)a_; }
    const int tid = opaque_tid();
    if (tid < 64) {
        const int lane = tid, e = lane & 31;
        const int c = (int)__hip_atomic_load(cnt + e * 64, __ATOMIC_RELAXED, __HIP_MEMORY_SCOPE_AGENT);
        const int nt = (c + 255) >> 8, lastv = c - 256 * (nt - 1);
        const int lt = (nt > 0 && lastv <= 128) ? 1 : 0, hv = nt - lt;
        int Tt, Th, Tl;
        const int tbx = scan32_excl(nt, lane, Tt), hx = scan32_excl(hv, lane, Th), lx = scan32_excl(lt, lane, Tl);
        if (lane < 32) {
            L[LI_TB + e] = tbx; L[LI_PS + e] = tbx * 256; L[LI_CN + e] = c;
            for (int j = 0; j < hv; ++j) L[LI_ORD + hx + j] = (e << 8) | j;
            if (lt) L[LI_ORD + Th + lx] = (e << 8) | (nt - 1);
            if (lane == 31) { L[LI_TB + NEXP] = Tt; L[LI_PS + NEXP] = Tt * 256; L[LI_NT] = Tt; }
        }
    }
    __syncthreads();
}

struct Args { const float* in[18]; float* out; unsigned char* ws; int ph_lo, ph_hi; };
typedef const __attribute__((address_space(4))) Args* CArgsP;
__device__ __forceinline__ CArgsP kargs() { unsigned long long p = (unsigned long long)__builtin_amdgcn_kernarg_segment_ptr(); asm volatile("" : "+s"(p)); return (CArgsP)p; }
#define PHASE_PTRS \
    const int G = opaque_s(G0), bx = opaque_s(bx0), vcu = opaque_s(vcu0), NGW = G * NWAVES; (void)bx; (void)vcu; (void)NGW; \
    const CArgsP ka = kargs(); unsigned char* const ws = ka->ws; \
    unsigned* const ctrl = (unsigned*)(ws + OFF_CTRL); const float* const x_in = ka->in[0]; \
    bf16_t* const WinT = (bf16_t*)(ws + OFF_WIN); bf16_t* const WaT = (bf16_t*)(ws + OFF_WA); bf16_t* const WppT = (bf16_t*)(ws + OFF_WPP); bf16_t* const WoT = (bf16_t*)(ws + OFF_WO); \
    bf16_t* const WguT = (bf16_t*)(ws + OFF_WGU); bf16_t* const WdT = (bf16_t*)(ws + OFF_WD); \
    bf16_t* const Hb = (bf16_t*)(ws + OFF_H); bf16_t* const MG = Hb; bf16_t* const PROJ = (bf16_t*)(ws + OFF_PROJ); bf16_t* const ACT = (bf16_t*)(ws + OFF_ACT); bf16_t* const YB = (bf16_t*)(ws + OFF_YB); \
    bf16_t* const AC = (bf16_t*)(ws + OFF_AC); bf16_t* const PL = (bf16_t*)(ws + OFF_PL); bf16_t* const OG = (bf16_t*)(ws + OFF_OG); bf16_t* const T1 = (bf16_t*)(ws + OFF_T1); \
    f32x2* const ML = (f32x2*)(ws + OFF_ML); bf16_t* const XB = (bf16_t*)(ws + OFF_XB); int* const tokE = (int*)(ws + OFF_TOKE); float* const tokW = (float*)(ws + OFF_TOKW); int* const asg = (int*)(ws + OFF_ASG); \
    (void)ctrl; (void)x_in; (void)WinT; (void)WaT; (void)WppT; (void)WoT; (void)WguT; (void)WdT; (void)Hb; (void)MG; (void)PROJ; (void)ACT; (void)YB; (void)AC; (void)PL; (void)OG; (void)T1; (void)ML; (void)XB; (void)tokE; (void)tokW; (void)asg
#define LAYER_PTRS PHASE_PTRS; const int tid = opaque_tid(), lane = tid & 63, wid = __builtin_amdgcn_readfirstlane(tid >> 6), gw = vcu * NWAVES + wid; (void)lane; (void)gw; unsigned* const cnt = ctrl + CW_CNT + l * 2048; (void)cnt

#ifndef PHASE_MASK
#define PHASE_MASK 0x3ff
#endif
#define EN(j) (((PHASE_MASK) >> (j)) & 1)
#ifndef REP_MASK
#define REP_MASK 0
#endif
#define REPS(j) (1 + (((REP_MASK) >> (j)) & 1))
#define IN(k) (MK_N_LAUNCHES == 1 || (lo <= (k) && (k) < hi))
#ifndef PROBE_A
#define PROBE_A -1
#define PROBE_B -1
#endif
#define STAMP_BEGIN(k) do { if (PROBE_A == (k)) ts0 = __builtin_amdgcn_s_memrealtime(); } while (0)
#define SEAM(k) do { if (IN(k) && IN((k) + 1)) { XcdBarrier b2_ = bar; unsigned long long p_ = (unsigned long long)b2_.bar; asm volatile("" : "+s"(p_)); b2_.bar = (unsigned*)p_; xcd_barrier(b2_); } if (PROBE_B == (k)) ts1 = __builtin_amdgcn_s_memrealtime(); } while (0)

template <int l>
__device__ __forceinline__ void layer_body(const XcdBarrier& bar, LAS unsigned char* lds, LAS int* LC, const int G0, const int bx0, const int vcu0, const int lo, const int hi, unsigned long long& ts0, unsigned long long& ts1) {
        const int pb = 1 + 9 * l;
        STAMP_BEGIN(pb + 0);
        for (int rep = 0; rep < REPS(0); ++rep) if (EN(0) && IN(pb + 0)) {
            asm volatile("; PHASE_MARK 0");
            LAYER_PTRS;
            if (INPROJ_FP8) {
                { pg8::DenseOrder S; S.init(Hb, WinT + (size_t)l * 2048 * DM, NTOK, 2048, DM * 2, G, bx);
                  pg8::EpiProj E{PROJ, ka->in[3] + (size_t)l * HD, ka->in[4] + (size_t)l * HD, 2, 1.0f};
                  pg8::gemm_phase<pg8::EpiProj, pg8::DenseOrder, 1, false>(lds, DM * 2, S, E); }
                { pg8::DenseOrder S; S.init(ws + OFF_HIN8, ws + OFF_WIN8 + (size_t)l * 2048 * DM, NTOK, 2048, DM, G, bx);
                  pg8::EpiProj E{PROJ, ka->in[3] + (size_t)l * HD, ka->in[4] + (size_t)l * HD, 1, 1.0f / W8_SCALE};
                  pg8::gemm_phase<pg8::EpiProj, pg8::DenseOrder, 1, false, false, true>(lds, DM, S, E); }
            } else {
                pg8::DenseOrder S; S.init(Hb, WinT + (size_t)l * INW * DM, NTOK, INW, DM * 2, G, bx);
                pg8::EpiProj E{PROJ, ka->in[3] + (size_t)l * HD, ka->in[4] + (size_t)l * HD, 0, 1.0f};
                pg8::gemm_phase<pg8::EpiProj, pg8::DenseOrder, 1, false>(lds, DM * 2, S, E);
            }
        }
        SEAM(pb + 0);
        STAMP_BEGIN(pb + 1);
        for (int rep = 0; rep < REPS(1); ++rep) if (EN(1) && IN(pb + 1)) {
            asm volatile("; PHASE_MARK 1");
            LAYER_PTRS;
            int u = vcu;
            if (u < 1536) {
                AttnU cu = attn_decode(u), nu = cu;
                u32x4 kr[6], vr[6]; bf16x8 qf[4];
                attn_load(cu, PROJ, tid, kr, vr);
                for (;;) {
                    attn_load_q(cu, PROJ, wid, lane, qf);
                    attn_lds_store(cu, lds, tid, kr, vr);
                    __syncthreads();
                    const int un = u + G; const bool hn = un < 1536;
                    if (hn) { nu = attn_decode(un); attn_load(nu, PROJ, tid, kr, vr); }
                    attn_compute(cu, lds, qf, OG, ML, wid, lane);
                    if (!hn) break;
                    cu = nu; u = un;
                }
            }
        }
        SEAM(pb + 1);
        STAMP_BEGIN(pb + 2);
        for (int rep = 0; rep < REPS(2); ++rep) if (EN(2) && IN(pb + 2)) {
            asm volatile("; PHASE_MARK 2");
            LAYER_PTRS;
            for (int grp = gw; grp < NTOK / 8; grp += NGW) {
                const size_t t0 = (size_t)grp * 8; const int c0 = 8 * lane, hh = lane >> 3;
                {
                    f32x2 sm[8][3]; u32x4 v[8][3];
#pragma unroll
                    for (int i = 0; i < 8; ++i)
#pragma unroll
                        for (int g = 0; g < 3; ++g) { sm[i][g] = ML[((size_t)g * NTOK + t0 + i) * 8 + hh]; v[i][g] = *(const u32x4*)(OG + ((size_t)g * NTOK + t0 + i) * AW + c0); }
#pragma unroll
                    for (int i = 0; i < 8; ++i) {
                        const float M = fmaxf(fmaxf(sm[i][0][0], sm[i][1][0]), sm[i][2][0]);
                        float w[3], W = 0.f;
#pragma unroll
                        for (int g = 0; g < 3; ++g) { w[g] = sm[i][g][1] * __expf(sm[i][g][0] - M); W += w[g]; }
                        const float iw = 1.0f / W;
                        float o[8] = {0.f, 0.f, 0.f, 0.f, 0.f, 0.f, 0.f, 0.f}, f[8];
#pragma unroll
                        for (int g = 0; g < 3; ++g) { unpack8(v[i][g], f); const float q = w[g] * iw;
#pragma unroll
                            for (int c = 0; c < 8; ++c) o[c] += q * f[c]; }
                        u32x4 ow; ow.x = pack2(o[0], o[1]); ow.y = pack2(o[2], o[3]); ow.z = pack2(o[4], o[5]); ow.w = pack2(o[6], o[7]);
                        *(u32x4*)(AC + (t0 + i) * DM + c0) = ow;
                    }
                }
                {
                    const int pos0 = (int)(t0 & (SEQ - 1)), g4 = lane >> 4, wnd = 2 << g4;
                    u32x4 r[23];
#pragma unroll
                    for (int k = 0; k < 23; ++k) { const bool need = (k >= 16 - wnd) && (pos0 - 15 + k >= 0);
                        r[k] = need ? *(const u32x4*)(PROJ + (t0 - 15 + k) * INW + 3 * AW + c0) : (u32x4){0u, 0u, 0u, 0u}; }
                    if (g4 == 0) pool_path<2>(r, pos0, AC + PW, t0, c0);
                    else if (g4 == 1) pool_path<4>(r, pos0, AC + PW, t0, c0);
                    else if (g4 == 2) pool_path<8>(r, pos0, AC + PW, t0, c0);
                    else pool_path<16>(r, pos0, AC + PW, t0, c0);
                }
            }
        }
        SEAM(pb + 2);
        STAMP_BEGIN(pb + 3);
        for (int rep = 0; rep < REPS(3); ++rep) if (EN(3) && IN(pb + 3)) {
            asm volatile("; PHASE_MARK 3");
            LAYER_PTRS;
            pg8::DenseOrder S; S.init(AC, WaT + (size_t)l * DM * DM, NTOK, DM, DM * 2, G, bx);
            pg8::EpiGateMerge E{PROJ, MG};
            pg8::gemm_phase<pg8::EpiGateMerge, pg8::DenseOrder, 0, false, false, false, true>(lds, DM * 2, S, E);
        }
        SEAM(pb + 3);
        STAMP_BEGIN(pb + 4);
        if (EN(4) && IN(pb + 4)) {
            asm volatile("; PHASE_MARK 4");
            LAYER_PTRS;
            pg8::DenseOrder S; S.init(MG, WoT + (size_t)l * DM * DM, NTOK, DM, DM * 2, G, bx);
            pg8::EpiResid<l == 0> E{x_in, XB};
            pg8::gemm_phase<pg8::EpiResid<l == 0>, pg8::DenseOrder, 0, false>(lds, DM * 2, S, E);
        }
        SEAM(pb + 4);
        STAMP_BEGIN(pb + 5);
        if (EN(5) && IN(pb + 5)) {
            asm volatile("; PHASE_MARK 5");
            LAYER_PTRS;
            LAS float* part = (LAS float*)lds;
            LAS float* lg = (LAS float*)(lds + 100352);
            LAS int* aE = (LAS int*)(lds + 110592); LAS float* aW = (LAS float*)(lds + 110592 + 512); LAS int* bs = (LAS int*)(lds + 110592 + 1024); LAS float* rs = (LAS float*)(lds + 110592 + 1536);
            const float* brg = ka->in[12] + (size_t)l * 4; const float* bre = ka->in[14] + (size_t)l * 32;
            const bf16_t* Wh = (const bf16_t*)(ws + OFF_WRH) + (size_t)l * 48 * DM; const bf16_t* Wl = (const bf16_t*)(ws + OFF_WRL) + (size_t)l * 48 * DM;
            for (int chunk = bx; chunk < NTOK / 64; chunk += G) {
                {
                    const int fr = lane & 15, fq = lane >> 4;
                    f32x4 acc[4][3]; float ssl[4] = {0.f, 0.f, 0.f, 0.f};
#pragma unroll
                    for (int mt = 0; mt < 4; ++mt)
#pragma unroll
                        for (int nt = 0; nt < 3; ++nt) acc[mt][nt] = (f32x4){0.f, 0.f, 0.f, 0.f};
                    bf16x8 bh[3], bl[3]; u32x4 xw[2][4];
#define RT_LOADX(SET, KS) do { const int d0_ = 128 * wid + 32 * (KS) + 8 * fq; \
                        _Pragma("unroll") for (int mt = 0; mt < 4; ++mt) xw[SET][mt] = *(const u32x4*)(XB + (size_t)(chunk * 64 + 16 * mt + fr) * DM + d0_); } while (0)
#define RT_STEP(SET, KS) do { const int d0_ = 128 * wid + 32 * (KS) + 8 * fq; \
                        _Pragma("unroll") for (int nt = 0; nt < 3; ++nt) { bh[nt] = *(const bf16x8*)(Wh + (size_t)(16 * nt + fr) * DM + d0_); bl[nt] = *(const bf16x8*)(Wl + (size_t)(16 * nt + fr) * DM + d0_); } \
                        _Pragma("unroll") for (int mt = 0; mt < 4; ++mt) { const u32x4 hw = xw[SET][mt]; \
                        { float f[8]; unpack8(hw, f); ssl[mt] += (f[0] * f[0] + f[1] * f[1]) + (f[2] * f[2] + f[3] * f[3]) + (f[4] * f[4] + f[5] * f[5]) + (f[6] * f[6] + f[7] * f[7]); } \
                        const bf16x8 ah = __builtin_bit_cast(bf16x8, hw); \
                        _Pragma("unroll") for (int nt = 0; nt < 3; ++nt) { acc[mt][nt] = __builtin_amdgcn_mfma_f32_16x16x32_bf16(ah, bh[nt], acc[mt][nt], 0, 0, 0); \
                            acc[mt][nt] = __builtin_amdgcn_mfma_f32_16x16x32_bf16(ah, bl[nt], acc[mt][nt], 0, 0, 0); } } asm volatile("" ::: "memory"); } while (0)
                    RT_LOADX(0, 0); RT_LOADX(1, 1);
                    RT_STEP(0, 0); RT_LOADX(0, 2);
                    RT_STEP(1, 1); RT_LOADX(1, 3);
                    RT_STEP(0, 2);
                    RT_STEP(1, 3);
#undef RT_LOADX
#undef RT_STEP
#pragma unroll
                    for (int mt = 0; mt < 4; ++mt) {
#pragma unroll
                        for (int nt = 0; nt < 3; ++nt) *(LAS f32x4*)(part + (wid * 49 + 16 * nt + fr) * 64 + 16 * mt + 4 * fq) = acc[mt][nt];
                        float sq = ssl[mt]; sq += __shfl_xor(sq, 16); sq += __shfl_xor(sq, 32);
                        if (fq == 0) part[(wid * 49 + 48) * 64 + 16 * mt + fr] = sq;
                    }
                }
                __syncthreads();
                for (int o = tid >> 6; o < 37; o += 8) { float sum = 0.f; const int po = (o == 36) ? 48 : o;
#pragma unroll
                    for (int w = 0; w < 8; ++w) sum += part[(w * 49 + po) * 64 + lane];
                    lg[o * 64 + lane] = sum; }
                __syncthreads();
                if (tid < 64) {
                    const float rstd = rsqrtf(lg[36 * 64 + tid] * (1.0f / DM) + RMS_EPS); rs[tid] = rstd;
                    float gl[4];
#pragma unroll
                    for (int o = 0; o < 4; ++o) gl[o] = lg[o * 64 + tid] * rstd + brg[o];
                    int gs = 0; float gm = gl[0];
#pragma unroll
                    for (int o = 1; o < 4; ++o) if (gl[o] > gm) { gm = gl[o]; gs = o; }
                    float gden = 0.f;
#pragma unroll
                    for (int o = 0; o < 4; ++o) gden += __expf(gl[o] - gm);
                    const float ggate = 1.0f / gden;
                    float el[8];
#pragma unroll
                    for (int o = 0; o < 8; ++o) el[o] = lg[(4 + 8 * gs + o) * 64 + tid] * rstd + bre[gs * 8 + o];
                    int i0 = 0; float m0 = el[0];
#pragma unroll
                    for (int o = 1; o < 8; ++o) if (el[o] > m0) { m0 = el[o]; i0 = o; }
                    int i1 = 0; float m1 = -3.0e38f;
#pragma unroll
                    for (int o = 0; o < 8; ++o) if (o != i0 && el[o] > m1) { m1 = el[o]; i1 = o; }
                    const float e1 = __expf(m1 - m0);
                    aE[2 * tid] = gs * 8 + i0; aE[2 * tid + 1] = gs * 8 + i1; aW[2 * tid] = ggate / (1.0f + e1); aW[2 * tid + 1] = ggate * e1 / (1.0f + e1);
                }
                __syncthreads();
                int myE = 0, rank = 0;
                if (tid < 128) { myE = aE[tid]; for (int a = 0; a < tid; ++a) rank += (aE[a] == myE) ? 1 : 0; }
                if (tid < NEXP) { int c = 0; for (int a = 0; a < 128; ++a) c += (aE[a] == tid) ? 1 : 0;
                    bs[tid] = c ? (int)__hip_atomic_fetch_add(cnt + tid * 64, (unsigned)c, __ATOMIC_RELAXED, __HIP_MEMORY_SCOPE_AGENT) : 0; }
#pragma unroll 2
                for (int it = 0; it < 8; ++it) {
                    const int ti = wid * 8 + it; const size_t tok = (size_t)chunk * 64 + ti; const float rstd = rs[ti];
                    const CArgsP k2 = kargs(); const float* const g2 = k2->in[10] + (size_t)l * DM; bf16_t* const Hb = (bf16_t*)(k2->ws + OFF_H); const bf16_t* const XB = (const bf16_t*)(k2->ws + OFF_XB);
#pragma unroll
                    for (int i = 0; i < 4; ++i) { const int d0 = (i * 64 + lane) * 4; const u32x2 xw = *(const u32x2*)(XB + tok * DM + d0); const f32x4 gv = *(const f32x4*)(g2 + d0);
                        const float h0 = bflo(xw.x) * rstd * gv[0], h1 = bfhi(xw.x) * rstd * gv[1], h2v = bflo(xw.y) * rstd * gv[2], h3 = bfhi(xw.y) * rstd * gv[3];
                        if (MOE_FP8) *(unsigned*)((unsigned char*)Hb + tok * DM + d0) = pack4_fp8(h0, h1, h2v, h3);
                        else { u32x2 w; w.x = pack2(h0, h1); w.y = pack2(h2v, h3); *(u32x2*)(Hb + tok * DM + d0) = w; } }
                }
                __syncthreads();
                if (tid < 128) { const int slot = bs[myE] + rank, tok = chunk * 64 + (tid >> 1);
                    unsigned char* const w2 = kargs()->ws;
                    ((int*)(w2 + OFF_TOKE))[(size_t)myE * ECAP + slot] = tok; ((float*)(w2 + OFF_TOKW))[(size_t)myE * ECAP + slot] = aW[tid]; ((int*)(w2 + OFF_ASG))[tok * 2 + (tid & 1)] = myE * ECAP + slot; }
                __syncthreads();
            }
        }
        SEAM(pb + 5);
        STAMP_BEGIN(pb + 6);
        for (int rep = 0; rep < REPS(6); ++rep) if (EN(6) && IN(pb + 6)) {
            asm volatile("; PHASE_MARK 6");
            LAYER_PTRS;
            build_moe_tables(LC, cnt);
            constexpr int ES = MOE_FP8 ? 1 : 2;
            pg8::MoeOrder S{(const char*)Hb, (const char*)WguT, (size_t)DM * DM * ES, DM * ES, LC + LI_TB, LC + LI_PS, LC + LI_CN, LC + LI_ORD, tokE, G, vcu, true};
            pg8::EpiSwiGLU<MOE_FP8> E{(void*)ACT};
            pg8::gemm_phase<pg8::EpiSwiGLU<MOE_FP8>, pg8::MoeOrder, 0, true, true, MOE_FP8>(lds, DM * ES, S, E);
        }
        SEAM(pb + 6);
        STAMP_BEGIN(pb + 7);
        for (int rep = 0; rep < REPS(7); ++rep) if (EN(7) && IN(pb + 7)) {
            asm volatile("; PHASE_MARK 7");
            LAYER_PTRS;
            build_moe_tables(LC, cnt);
            constexpr int ES = MOE_FP8 ? 1 : 2;
            pg8::MoeOrder S{(const char*)ACT, (const char*)WdT, (size_t)DM * EH * ES, EH * ES, LC + LI_TB, LC + LI_PS, LC + LI_CN, LC + LI_ORD, tokE, G, vcu, false};
            pg8::EpiDown<MOE_FP8> E{YB, tokW};
            pg8::gemm_phase<pg8::EpiDown<MOE_FP8>, pg8::MoeOrder, 0, false, true, MOE_FP8>(lds, EH * ES, S, E);
        }
        SEAM(pb + 7);
        STAMP_BEGIN(pb + 8);
        if (EN(8) && IN(pb + 8)) {
            asm volatile("; PHASE_MARK 8");
            LAYER_PTRS;
            build_moe_tables(LC, cnt);
            const bool lastl = (l == DEPTH - 1);
            const float* g1n = ka->in[1] + (size_t)(lastl ? 0 : (l + 1)) * DM;
            for (int grp = gw; grp < NTOK / 4; grp += NGW) {
                const size_t t0 = (size_t)grp * 4;
                const int myasg = (lane < 8) ? asg[t0 * 2 + lane] : 0;
                u32x2 xv[4][4], ya[4][4], yb[4][4];
#pragma unroll
                for (int q = 0; q < 4; ++q) {
                    const int i0 = __builtin_amdgcn_readlane(myasg, 2 * q), i1 = __builtin_amdgcn_readlane(myasg, 2 * q + 1);
                    const size_t s0 = (size_t)(LC[LI_PS + (i0 >> 14)] + (i0 & (ECAP - 1))), s1 = (size_t)(LC[LI_PS + (i1 >> 14)] + (i1 & (ECAP - 1)));
#pragma unroll
                    for (int i = 0; i < 4; ++i) { const int d0 = (i * 64 + lane) * 4;
                        xv[q][i] = *(const u32x2*)(XB + (t0 + q) * DM + d0); ya[q][i] = *(const u32x2*)(YB + s0 * DM + d0); yb[q][i] = *(const u32x2*)(YB + s1 * DM + d0); }
                }
#pragma unroll
                for (int q = 0; q < 4; ++q) {
                    f32x4 v[4]; float ss = 0.f;
#pragma unroll
                    for (int i = 0; i < 4; ++i) { const int d0 = (i * 64 + lane) * 4; const u32x2 a = ya[q][i], b = yb[q][i], x4 = xv[q][i];
                        v[i][0] = bflo(x4.x) + bflo(a.x) + bflo(b.x); v[i][1] = bfhi(x4.x) + bfhi(a.x) + bfhi(b.x); v[i][2] = bflo(x4.y) + bflo(a.y) + bflo(b.y); v[i][3] = bfhi(x4.y) + bfhi(a.y) + bfhi(b.y);
                        ss += (v[i][0] * v[i][0] + v[i][1] * v[i][1]) + (v[i][2] * v[i][2] + v[i][3] * v[i][3]);
                        if (lastl) *(f32x4*)(ka->out + (t0 + q) * DM + d0) = v[i];
                        else { u32x2 w; w.x = pack2(v[i][0], v[i][1]); w.y = pack2(v[i][2], v[i][3]); *(u32x2*)(XB + (t0 + q) * DM + d0) = w; } }
                    if (!lastl) {
                        ss = wave_sum(ss);
                        const float rstd = rsqrtf(ss * (1.0f / DM) + RMS_EPS);
#pragma unroll
                        for (int i = 0; i < 4; ++i) { const int d0 = (i * 64 + lane) * 4; const f32x4 gv = *(const f32x4*)(g1n + d0);
                            const float h0 = v[i][0] * rstd * gv[0], h1 = v[i][1] * rstd * gv[1], h2 = v[i][2] * rstd * gv[2], h3 = v[i][3] * rstd * gv[3];
                            u32x2 w; w.x = pack2(h0, h1); w.y = pack2(h2, h3);
                            *(u32x2*)(Hb + (t0 + q) * DM + d0) = w;
                            if (INPROJ_FP8) *(unsigned*)(ws + OFF_HIN8 + (t0 + q) * DM + d0) = pack4_fp8(h0, h1, h2, h3); }
                    }
                }
            }
            if (!lastl) {
                __syncthreads();
                const float* e0 = ka->in[15] + (size_t)(l + 1) * NEXP * DM * EH; const float* e1 = ka->in[16] + (size_t)(l + 1) * NEXP * DM * EH; const float* e2 = ka->in[17] + (size_t)(l + 1) * NEXP * EH * DM;
                if (MOE_FP8) { ExpertItems8 I{e0, e1, e2, (unsigned char*)WguT, (unsigned char*)WdT}; convert_items8(I, (LAS float*)(lds + wid * 16384), lane, gw, NGW); }
                else { ExpertItems I{e0, e1, e2, WguT, WdT}; convert_items(I, (LAS float*)(lds + wid * 16384), lane, gw, NGW); }
            }
        }
        if (l + 1 < DEPTH) SEAM(pb + 8); else if (PROBE_B == pb + 8) ts1 = __builtin_amdgcn_s_memrealtime();
    }

__global__ void __launch_bounds__(NTHREADS, 2) fwd_kernel(Args args) {
    extern __shared__ __attribute__((aligned(16))) unsigned char lds_raw[];
    LAS unsigned char* lds = (LAS unsigned char*)lds_raw;
    LAS int* LC = (LAS int*)(lds + LCTL_OFF);
    const int G0 = gridDim.x, bx0 = blockIdx.x;
    const int vcu0 = (G0 % 8 == 0) ? (bx0 % 8) * (G0 / 8) + bx0 / 8 : bx0;
    if (threadIdx.x < 4) LC[LI_BAR + threadIdx.x] = 0;
    __syncthreads();
    XcdBarrier bar; bar.bar = (unsigned*)(args.ws + OFF_CTRL) + CW_BAR; bar.x = 0; bar.st = nullptr;
    if (MK_N_LAUNCHES == 1) bar = xcd_barrier_post(bar.bar, (volatile LAS unsigned*)(LC + LI_BAR));
    const int lo = args.ph_lo, hi = args.ph_hi;
    unsigned long long ts0 = 0ull, ts1 = 0ull;
    STAMP_BEGIN(0);
    for (int rep = 0; rep < REPS(9); ++rep) if (EN(9) && IN(0)) {
        asm volatile("; PHASE_MARK 9");
        PHASE_PTRS; const int tid = opaque_tid(), lane = tid & 63, wid = __builtin_amdgcn_readfirstlane(tid >> 6), gw = vcu * NWAVES + wid;
        LAS float* scr = (LAS float*)(lds + wid * 16384);
        if (wid == 7) {
            for (int o = vcu; o < DEPTH * 4 * 16 * 4; o += G) {
                const int l = o >> 8, g = (o >> 6) & 3, nb = (o >> 2) & 15, cb = o & 3, c0 = 32 * cb, n = 64 * nb + lane;
                const float* wm = ka->in[6] + (size_t)l * 4 * 128 * 128 + (size_t)(g * 128 + c0) * 128;
                const float* sc = ka->in[7] + (size_t)l * PW + g * 128;
                const float* wp = ka->in[8] + (size_t)l * PW * DM + (size_t)(g * 128) * DM + n;
                {
                    const f32x4 sv = *(const f32x4*)(sc + 4 * (lane & 31));
#pragma unroll 8
                    for (int i = 0; i < 16; ++i) { const int c = (lane >> 5) + 2 * i; const f32x4 v = *(const f32x4*)(wm + (size_t)c * 128 + 4 * (lane & 31)) * sv;
#pragma unroll
                        for (int j = 0; j < 4; ++j) scr[(4 * (lane & 31) + j) * 32 + c] = v[j]; }
                }
                float a[32];
#pragma unroll
                for (int c = 0; c < 32; ++c) a[c] = 0.f;
                float wa[32];
#define FOLD_BLOCK(WV, D0) do { _Pragma("unroll") for (int q = 0; q < 32; ++q) { const float w = WV[q]; _Pragma("unroll") for (int c4 = 0; c4 < 8; ++c4) { \
                    const f32x4 m4 = *(const LAS f32x4*)(scr + ((D0) + q) * 32 + 4 * c4); a[4 * c4] += w * m4[0]; a[4 * c4 + 1] += w * m4[1]; a[4 * c4 + 2] += w * m4[2]; a[4 * c4 + 3] += w * m4[3]; } \
                    if (q & 1) asm volatile("" ::: "memory"); } } while (0)
#pragma unroll 1
                for (int d0 = 0; d0 < 128; d0 += 32) {
#pragma unroll
                    for (int q = 0; q < 32; ++q) wa[q] = wp[(size_t)(d0 + q) * DM];
                    FOLD_BLOCK(wa, d0);
                }
#undef FOLD_BLOCK
                bf16_t* op = WaT + (size_t)l * DM * DM + (size_t)n * DM + PW + g * 128 + c0;
#pragma unroll
                for (int q = 0; q < 4; ++q) { u32x4 ow; ow.x = pack2(a[8 * q], a[8 * q + 1]); ow.y = pack2(a[8 * q + 2], a[8 * q + 3]); ow.z = pack2(a[8 * q + 4], a[8 * q + 5]); ow.w = pack2(a[8 * q + 6], a[8 * q + 7]);
                    *(u32x4*)(op + 8 * q) = ow; }
            }
            for (int o = vcu * 64 + lane; o < DEPTH * 48 * DM; o += G * 64) {
                const int l = o / (48 * DM), r = o % (48 * DM), oo = r / DM, d = r % DM;
                float w = 0.f;
                if (oo < 4) w = ka->in[11][(size_t)l * DM * 4 + (size_t)d * 4 + oo];
                else if (oo < 36) w = ka->in[13][(size_t)l * 4 * DM * 8 + ((size_t)((oo - 4) >> 3) * DM + d) * 8 + ((oo - 4) & 7)];
                w *= ka->in[10][(size_t)l * DM + d];
                const bf16_t hi = f2bf(w); const float hf = __uint_as_float((unsigned)hi << 16);
                ((bf16_t*)(ws + OFF_WRH))[o] = hi; ((bf16_t*)(ws + OFF_WRL))[o] = f2bf(w - hf);
            }
        } else {
            const int gw7 = vcu * 7 + wid, NGW7 = G * 7;
            { SmallItems I{ka->in[2], ka->in[5], ka->in[9], WinT, WaT, WoT}; convert_items(I, scr, lane, gw7, NGW7); }
            if (INPROJ_FP8) { WinItems8 I{ka->in[2], ws + OFF_WIN8}; convert_items8(I, scr, lane, gw7, NGW7); }
            if (MOE_FP8) { ExpertItems8 I{ka->in[15], ka->in[16], ka->in[17], (unsigned char*)WguT, (unsigned char*)WdT}; convert_items8(I, scr, lane, gw7, NGW7); }
            else { ExpertItems I{ka->in[15], ka->in[16], ka->in[17], WguT, WdT}; convert_items(I, scr, lane, gw7, NGW7); }
        }
        for (int m = gw; m < NTOK; m += NGW) norm_row(x_in + (size_t)m * DM, ka->in[1], Hb + (size_t)m * DM, ws + OFF_HIN8 + (size_t)m * DM, lane);
    }
    SEAM(0);

    layer_body<0>(bar, lds, LC, G0, bx0, vcu0, lo, hi, ts0, ts1);
    layer_body<1>(bar, lds, LC, G0, bx0, vcu0, lo, hi, ts0, ts1);
    if (PROBE_A >= 0 && blockIdx.x == 0) { const unsigned long long d = (ts1 - ts0) * 4ull, t0 = __builtin_amdgcn_s_memrealtime(); while (__builtin_amdgcn_s_memrealtime() - t0 < d) __builtin_amdgcn_s_sleep(8); }
#undef IN
#undef SEAM
}

extern "C" void kernel_launch(void* const* d_in, const int* in_sizes, int n_in, void* d_out, int out_size, void* d_ws, size_t ws_size, hipStream_t stream) {
    (void)in_sizes; (void)out_size;
    static int grid = 0;
    if (grid == 0) {
        int dev = 0, cus = 0;
        if (hipGetDevice(&dev) != hipSuccess || hipDeviceGetAttribute(&cus, hipDeviceAttributeMultiprocessorCount, dev) != hipSuccess) { grid = -1; return; }
        if (hipFuncSetAttribute((const void*)fwd_kernel, hipFuncAttributeMaxDynamicSharedMemorySize, LDS_BYTES) != hipSuccess) { grid = -1; return; }
        int per_cu = 0;
        (void)hipOccupancyMaxActiveBlocksPerMultiprocessor(&per_cu, (const void*)fwd_kernel, NTHREADS, LDS_BYTES);
        (void)hipGetLastError();
        grid = cus;
        if (n_in != 18 || ws_size < WS_NEED) { fprintf(stderr, "kernel_launch: unexpected inputs (n_in %d, ws %zu)\n", n_in, ws_size); grid = -1; return; }
    }
    if (grid < 0) return;
    (void)hipMemsetAsync((char*)d_ws + OFF_CTRL, 0, CTRL_BYTES, stream);
    Args a{};
    for (int i = 0; i < 18; ++i) a.in[i] = (const float*)d_in[i];
    a.out = (float*)d_out; a.ws = (unsigned char*)d_ws;
    constexpr int NPH = 1 + 9 * DEPTH;
    if (MK_N_LAUNCHES == 1) { a.ph_lo = 0; a.ph_hi = NPH; hipLaunchKernelGGL(fwd_kernel, dim3(grid), dim3(NTHREADS), LDS_BYTES, stream, a); }
    else { for (int p = 0; p < NPH; ++p) { a.ph_lo = p; a.ph_hi = p + 1; hipLaunchKernelGGL(fwd_kernel, dim3(grid), dim3(NTHREADS), LDS_BYTES, stream, a); } }
}
```
